# Optimizing an MI355X kernel written in HIP

```python
import math
import jax, jax.numpy as jnp
from jax import lax
import numpy as np

D_MODEL = 1024
BATCH = 4
SEQ = 8192
DEPTH = 2

N_MIXERS = 2
N_HEADS = 16
HEAD_DIM = D_MODEL // N_HEADS
MOBA_BLOCK = 256
MOBA_TOPK = 3
MOBA_QCHUNK = 16
FOX_QBLOCK = 128
REL_BUCKETS = 32
REL_MAX_DIST = 128
N_EXPERTS = 256
TOP_K = 8
N_GROUPS = 8
TOPK_GROUPS = 4
D_EXPERT = 256
D_SHARED = 256
ROUTED_SCALE = 2.5
EXPERT_BLOCK = 128
LN_EPS = 1e-5
DN_ALPHA = (2 * DEPTH) ** 0.25
DN_BETA = (8 * DEPTH) ** -0.25
N_MOBA = (DEPTH + 1) // 2
N_FOX = DEPTH // 2
NEG = -1e30

kernel_name = "hybrid_moba_fox_moe_deepnorm"


def layer_norm(x, g, b):
    xf = x.astype(jnp.float32)
    mu = xf.mean(-1, keepdims=True)
    var = jnp.square(xf - mu).mean(-1, keepdims=True)
    return ((xf - mu) * lax.rsqrt(var + LN_EPS) * g.astype(jnp.float32) + b.astype(jnp.float32)).astype(x.dtype)


def rel_bucket(dist):
    n = jnp.maximum(dist, 0)
    max_exact = REL_BUCKETS // 2
    nf = jnp.maximum(n, 1).astype(jnp.float32)
    large = max_exact + (jnp.log(nf / max_exact) / math.log(REL_MAX_DIST / max_exact)
                         * (REL_BUCKETS - max_exact)).astype(jnp.int32)
    large = jnp.minimum(large, REL_BUCKETS - 1)
    return jnp.where(n < max_exact, n, large)


def split_heads(z):
    B, S, _ = z.shape
    return z.reshape(B, S, N_HEADS, HEAD_DIM).transpose(0, 2, 1, 3)


def merge_heads(o):
    B, H, S, dh = o.shape
    return o.transpose(0, 2, 1, 3).reshape(B, S, H * dh)


def moba_attention(q, k, v, rel_bias):
    B, H, S, dh = q.shape
    nb = -(-S // MOBA_BLOCK)
    pad = nb * MOBA_BLOCK - S
    kp = jnp.pad(k, ((0, 0), (0, 0), (0, pad), (0, 0))).reshape(B, H, nb, MOBA_BLOCK, dh)
    vp = jnp.pad(v, ((0, 0), (0, 0), (0, pad), (0, 0))).reshape(B, H, nb, MOBA_BLOCK, dh)
    k_mean = kp.astype(jnp.float32).mean(axis=3)
    n_sel = min(MOBA_TOPK, nb)
    scale = dh ** -0.5
    bias_t = rel_bias.T.astype(jnp.float32)
    bi = jnp.arange(B)[:, None, None, None]
    hi = jnp.arange(H)[None, :, None, None]
    offs = jnp.arange(MOBA_BLOCK)
    blk_ids = jnp.arange(nb)

    def chunk(c):
        t0 = c * MOBA_QCHUNK
        qc = lax.dynamic_slice_in_dim(q, t0, MOBA_QCHUNK, axis=2)
        pos = t0 + jnp.arange(MOBA_QCHUNK)
        own = t0 // MOBA_BLOCK
        bscore = jnp.einsum('bhqd,bhnd->bhqn', qc.astype(jnp.float32), k_mean)
        bscore = jnp.where(blk_ids < own, bscore, NEG)
        _, sel = lax.top_k(bscore, n_sel)
        sel_valid = sel < own
        ks = kp[bi, hi, sel]
        vs = vp[bi, hi, sel]
        s_sel = jnp.einsum('bhqd,bhqnkd->bhqnk', qc, ks, preferred_element_type=jnp.float32) * scale
        key_pos = sel[..., None] * MOBA_BLOCK + offs
        b_sel = bias_t[hi[..., None], rel_bucket(pos[:, None, None] - key_pos)]
        s_sel = jnp.where(sel_valid[..., None], s_sel + b_sel, NEG)
        s_sel = s_sel.reshape(B, H, MOBA_QCHUNK, n_sel * MOBA_BLOCK)
        k_own = lax.dynamic_index_in_dim(kp, own, axis=2, keepdims=False)
        v_own = lax.dynamic_index_in_dim(vp, own, axis=2, keepdims=False)
        own_pos = own * MOBA_BLOCK + offs
        s_own = (jnp.einsum('bhqd,bhkd->bhqk', qc, k_own, preferred_element_type=jnp.float32) * scale
                 + bias_t[:, rel_bucket(pos[:, None] - own_pos[None, :])])
        s_own = jnp.where(own_pos[None, :] <= pos[:, None], s_own, NEG)
        p = jax.nn.softmax(jnp.concatenate([s_sel, s_own], axis=-1), axis=-1)
        p_sel = p[..., :n_sel * MOBA_BLOCK].reshape(B, H, MOBA_QCHUNK, n_sel, MOBA_BLOCK)
        p_own = p[..., n_sel * MOBA_BLOCK:]
        o = (jnp.einsum('bhqnk,bhqnkd->bhqd', p_sel, vs.astype(jnp.float32))
             + jnp.einsum('bhqk,bhkd->bhqd', p_own, v_own.astype(jnp.float32)))
        return o.astype(q.dtype)

    out = lax.map(chunk, jnp.arange(S // MOBA_QCHUNK))
    return out.transpose(1, 2, 0, 3, 4).reshape(B, H, S, dh)


def forgetting_attention(q, k, v, log_f):
    B, H, S, dh = q.shape
    c = lax.cumsum(log_f, axis=2)
    scale = dh ** -0.5
    key_pos = jnp.arange(S)

    def block(i):
        t0 = i * FOX_QBLOCK
        qb = lax.dynamic_slice_in_dim(q, t0, FOX_QBLOCK, axis=2)
        cb = lax.dynamic_slice_in_dim(c, t0, FOX_QBLOCK, axis=2)
        pos = t0 + jnp.arange(FOX_QBLOCK)
        s = (jnp.einsum('bhqd,bhkd->bhqk', qb, k, preferred_element_type=jnp.float32) * scale
             + cb[..., None] - c[:, :, None, :])
        s = jnp.where(key_pos[None, :] <= pos[:, None], s, NEG)
        p = jax.nn.softmax(s, axis=-1)
        return jnp.einsum('bhqk,bhkd->bhqd', p, v.astype(jnp.float32)).astype(q.dtype)

    out = lax.map(block, jnp.arange(S // FOX_QBLOCK))
    return out.transpose(1, 2, 0, 3, 4).reshape(B, H, S, dh)


def moba_mixer(x, w_in, w_out, rel_bias):
    q, k, v = jnp.split(x @ w_in, 3, axis=-1)
    o = moba_attention(split_heads(q), split_heads(k), split_heads(v), rel_bias)
    return merge_heads(o) @ w_out


def fox_mixer(x, w_in, b_f, w_out):
    proj = x @ w_in
    D = D_MODEL
    q, k, v = proj[..., :D], proj[..., D:2 * D], proj[..., 2 * D:3 * D]
    log_f = jax.nn.log_sigmoid((proj[..., 3 * D:] + b_f).astype(jnp.float32)).transpose(0, 2, 1)
    o = forgetting_attention(split_heads(q), split_heads(k), split_heads(v), log_f)
    return merge_heads(o) @ w_out


def swiglu(h, wg, wu, wd):
    return (jax.nn.silu(h @ wg) * (h @ wu)) @ wd


def route(h, w_router, router_bias):
    T = h.shape[0]
    s = jax.nn.sigmoid((h @ w_router).astype(jnp.float32))
    sb = s + router_bias.astype(jnp.float32)
    grp = sb.reshape(T, N_GROUPS, N_EXPERTS // N_GROUPS)
    gscore = lax.top_k(grp, 2)[0].sum(-1)
    _, gidx = lax.top_k(gscore, TOPK_GROUPS)
    gmask = jax.nn.one_hot(gidx, N_GROUPS, dtype=jnp.float32).sum(-2) > 0
    emask = jnp.repeat(gmask, N_EXPERTS // N_GROUPS, axis=-1)
    _, idx = lax.top_k(jnp.where(emask, sb, NEG), TOP_K)
    w = jnp.take_along_axis(s, idx, axis=-1)
    gates = w / w.sum(-1, keepdims=True) * ROUTED_SCALE
    return idx, gates


def moe_routed(h, idx, gates, w_gate, w_up, w_down):
    T, D = h.shape
    E = w_gate.shape[0]
    flat_e = idx.reshape(-1)
    flat_t = jnp.repeat(jnp.arange(T, dtype=jnp.int32), TOP_K)
    flat_g = gates.reshape(-1)
    order = jnp.argsort(flat_e)
    se = flat_e[order]
    counts = jnp.bincount(flat_e, length=E)
    padded = (counts + EXPERT_BLOCK - 1) // EXPERT_BLOCK * EXPERT_BLOCK
    pad_end = jnp.cumsum(padded)
    pad_start = pad_end - padded
    start = jnp.cumsum(counts) - counts
    dest = pad_start[se] + jnp.arange(T * TOP_K) - start[se]
    n_blocks = (T * TOP_K + E * (EXPERT_BLOCK - 1)) // EXPERT_BLOCK
    n_pad = n_blocks * EXPERT_BLOCK
    tok = jnp.full((n_pad,), T, jnp.int32).at[dest].set(flat_t[order])
    gbuf = jnp.zeros((n_pad,), jnp.float32).at[dest].set(flat_g[order])
    blk_e = jnp.minimum(jnp.searchsorted(pad_end, jnp.arange(n_blocks) * EXPERT_BLOCK, side='right'), E - 1)
    h_pad = jnp.concatenate([h, jnp.zeros((1, D), h.dtype)], axis=0)

    def run(args):
        tb, gb, e = args
        yb = swiglu(h_pad[tb], w_gate[e], w_up[e], w_down[e])
        return yb * gb[:, None].astype(yb.dtype)

    y = lax.map(run, (tok.reshape(n_blocks, EXPERT_BLOCK), gbuf.reshape(n_blocks, EXPERT_BLOCK), blk_e))
    return jax.ops.segment_sum(y.reshape(n_pad, D), tok, num_segments=T + 1)[:T]


def moe_layer(x, w_router, router_bias, w_gate, w_up, w_down, ws_gate, ws_up, ws_down):
    B, S, D = x.shape
    h = x.reshape(B * S, D)
    idx, gates = route(h, w_router, router_bias)
    y = moe_routed(h, idx, gates, w_gate, w_up, w_down) + swiglu(h, ws_gate, ws_up, ws_down)
    return y.reshape(B, S, D)


def setup_inputs(seed: int = 0) -> dict:
    key = jax.random.key(seed)
    ks = jax.random.split(key, 20)
    D, H, E = D_MODEL, N_HEADS, N_EXPERTS
    nrm = jax.random.normal
    s_in = D ** -0.5
    qkv_scale = jnp.concatenate([jnp.full((2 * D,), s_in), jnp.full((D,), s_in * DN_BETA)])
    moba_w_in = nrm(ks[1], (N_MOBA, D, 3 * D), jnp.float32) * qkv_scale
    fox_scale = jnp.concatenate([qkv_scale, jnp.full((H,), s_in)])
    fox_w_in = nrm(ks[2], (N_FOX, D, 3 * D + H), jnp.float32) * fox_scale
    return {
        "x": nrm(ks[0], (BATCH, SEQ, D), jnp.float32),
        "rel_bias": nrm(ks[3], (REL_BUCKETS, H), jnp.float32) * 0.5,
        "moba_w_in": moba_w_in,
        "moba_w_out": nrm(ks[4], (N_MOBA, D, D), jnp.float32) * s_in * DN_BETA,
        "fox_w_in": fox_w_in,
        "fox_b_f": jax.random.uniform(ks[5], (N_FOX, H), jnp.float32, 1.0, 6.0),
        "fox_w_out": nrm(ks[6], (N_FOX, D, D), jnp.float32) * s_in * DN_BETA,
        "ln1_g": 1.0 + 0.05 * nrm(ks[7], (DEPTH, D), jnp.float32),
        "ln1_b": 0.02 * nrm(ks[8], (DEPTH, D), jnp.float32),
        "ln2_g": 1.0 + 0.05 * nrm(ks[9], (DEPTH, D), jnp.float32),
        "ln2_b": 0.02 * nrm(ks[10], (DEPTH, D), jnp.float32),
        "w_router": nrm(ks[11], (DEPTH, D, E), jnp.float32) * s_in,
        "router_bias": 0.01 * nrm(ks[12], (DEPTH, E), jnp.float32),
        "w_gate": nrm(ks[13], (DEPTH, E, D, D_EXPERT), jnp.float32) * s_in,
        "w_up": nrm(ks[14], (DEPTH, E, D, D_EXPERT), jnp.float32) * s_in * DN_BETA,
        "w_down": nrm(ks[15], (DEPTH, E, D_EXPERT, D), jnp.float32) * D_EXPERT ** -0.5 * DN_BETA,
        "ws_gate": nrm(ks[16], (DEPTH, D, D_SHARED), jnp.float32) * s_in,
        "ws_up": nrm(ks[17], (DEPTH, D, D_SHARED), jnp.float32) * s_in * DN_BETA,
        "ws_down": nrm(ks[18], (DEPTH, D_SHARED, D), jnp.float32) * D_SHARED ** -0.5 * DN_BETA,
    }


def reference(x, rel_bias, moba_w_in, moba_w_out, fox_w_in, fox_b_f, fox_w_out,
              ln1_g, ln1_b, ln2_g, ln2_b, w_router, router_bias,
              w_gate, w_up, w_down, ws_gate, ws_up, ws_down):
    for i in range(DEPTH):
        j = i // N_MIXERS
        if i % N_MIXERS == 0:
            y = moba_mixer(x, moba_w_in[j], moba_w_out[j], rel_bias)
        else:
            y = fox_mixer(x, fox_w_in[j], fox_b_f[j], fox_w_out[j])
        x = layer_norm(DN_ALPHA * x + y, ln1_g[i], ln1_b[i])
        y = moe_layer(x, w_router[i], router_bias[i], w_gate[i], w_up[i], w_down[i],
                      ws_gate[i], ws_up[i], ws_down[i])
        x = layer_norm(DN_ALPHA * x + y, ln2_g[i], ln2_b[i])
    return x
```

```cpp
#include <hip/hip_runtime.h>
#include <cstdio>
#include <cstdint>
#define MK_MULTI 1
namespace pg8 {
#define PG8_LAS __attribute__((address_space(3)))
typedef unsigned short bf16_t;
typedef short bf16x8 __attribute__((ext_vector_type(8)));
typedef float f32x4 __attribute__((ext_vector_type(4)));
typedef unsigned u32x4 __attribute__((ext_vector_type(4)));
constexpr int BM = 256, BK = 64, HALF = 128, HTB = HALF * BK * 2  , STAGE_BYTES = 8 * HTB, NXCD = 8, WGM = 8;

__host__ __device__ __forceinline__ int lds_byte(int r, int c) { const int st = (r >> 4) * 2 + (c >> 5), rr = r & 15, cc = c & 31, ob = rr * 64 + cc * 2; return st * 1024 + (ob ^ (((ob >> 9) & 1) << 5)); }
__host__ __device__ __forceinline__ void stage_rc(int b, int& R, int& C) { const int st = b / 1024, sb = b % 1024, swz = sb ^ (((sb >> 9) & 1) << 5); R = (st >> 1) * 16 + swz / 64; C = (st & 1) * 32 + (swz % 64) / 2; }
__host__ __device__ __forceinline__ int perm32(int rho) { const int n = rho >> 4, i = rho & 15; return 8 * (i >> 2) + 4 * n + (i & 3); }

struct Unit { int pm, pn; };
struct Gemm { const bf16_t* A; const bf16_t* Bt; int M, N, K; };

struct StaticOrder {
    int nM, nN, nwg, G, c;
    __host__ __device__ void init(int M, int N, int G_, int c_) { nM = M / BM; nN = N / BM; nwg = nM * nN; G = G_; c = c_; }
    __host__ __device__ bool next(int i, Unit& u) const {
        const long L = (long)i * G + c; if (L >= nwg) return false;
        int wgid = (int)L; { const int q = nwg / NXCD, r = nwg % NXCD, xcd = wgid % NXCD, off = wgid / NXCD; wgid = (xcd < r ? xcd * (q + 1) : r * (q + 1) + (xcd - r) * q) + off; }
        const int nig = WGM * nN, gid = wgid / nig, fm = gid * WGM, gsz = (nM - fm) < WGM ? (nM - fm) : WGM;
        u.pm = fm + ((wgid % nig) % gsz); u.pn = (wgid % nig) / gsz; return true;
    }
    __device__ __forceinline__ void a_ready(const Unit&) const {}
    __device__ __forceinline__ void done(const Unit&) const {}
};

__device__ __forceinline__ unsigned cvt_pk_bf16(float lo, float hi) { unsigned r; asm volatile("v_cvt_pk_bf16_f32 %0, %1, %2" : "=v"(r) : "v"(lo), "v"(hi)); return r; }
typedef float f32x2 __attribute__((ext_vector_type(2)));
__device__ __forceinline__ f32x2 gelu_pk(f32x2 v) {
    const f32x2 av = __builtin_elementwise_abs(v), d = av * 0.2316418882f + 1.0f;
    f32x2 t; t.x = __builtin_amdgcn_rcpf(d.x); t.y = __builtin_amdgcn_rcpf(d.y);
    f32x2 q = t * 0.5307027145f + (-0.7265760135f); q = q * t + 0.7107068705f; q = q * t + (-0.142248368f); q = q * t + 0.127414796f; q = q * t;
    const f32x2 s = (v * v) * (-0.72134752044f);
    f32x2 e; e.x = __builtin_amdgcn_exp2f(s.x); e.y = __builtin_amdgcn_exp2f(s.y);
    const f32x2 m = v * (q * e), r = v - m;
    f32x2 o; o.x = v.x < 0.f ? m.x : r.x; o.y = v.y < 0.f ? m.y : r.y; return o;
}

template <int ACT  > struct EpiBf16 {
    static constexpr bool PERM = true, AFTER_DRAIN = false; static_assert(ACT == 0 || ACT == 1, "EpiBf16: ACT is 0 (none) or 1 (gelu_pk)");
    bf16_t* O; int ldc; const float* bias; int split_cols; size_t split_stride; float scale0;
    __device__ __forceinline__ void operator()(const f32x4 (&acc)[2][2][4][2], const Unit& u, int wr, int wc, int fr, int fq) const {
        const int row0 = u.pm * BM + wr * 64 + fr; int colt = u.pn * BM; bf16_t* base = O;
        float sc = 1.f; if (split_cols) { const int t = colt / split_cols; base += (size_t)t * split_stride; colt -= t * split_cols; if (t == 0) sc = scale0; }
        const int col0 = colt + wc * 32 + 8 * fq, bcol0 = u.pn * BM + wc * 32 + 8 * fq;
        f32x4 bv[2][2];
#pragma unroll
        for (int bj = 0; bj < 2; ++bj)
#pragma unroll
            for (int n = 0; n < 2; ++n) bv[bj][n] = bias ? *(const f32x4*)(bias + bcol0 + bj * HALF + 4 * n) : (f32x4){0.f, 0.f, 0.f, 0.f};
#pragma unroll
        for (int ai = 0; ai < 2; ++ai)
#pragma unroll
            for (int m = 0; m < 4; ++m) { bf16_t* rowp = base + (size_t)(row0 + ai * HALF + m * 16) * ldc + col0;
#pragma unroll
                for (int bj = 0; bj < 2; ++bj) { f32x4 v0 = acc[ai][bj][m][0] + bv[bj][0], v1 = acc[ai][bj][m][1] + bv[bj][1];
                    if (ACT == 1) { f32x2 a = gelu_pk((f32x2){v0[0], v0[1]}), b = gelu_pk((f32x2){v0[2], v0[3]}), c = gelu_pk((f32x2){v1[0], v1[1]}), d = gelu_pk((f32x2){v1[2], v1[3]});
                        v0 = (f32x4){a.x, a.y, b.x, b.y}; v1 = (f32x4){c.x, c.y, d.x, d.y}; }
                    v0 = v0 * sc; v1 = v1 * sc; u32x4 w; w.x = cvt_pk_bf16(v0[0], v0[1]); w.y = cvt_pk_bf16(v0[2], v0[3]); w.z = cvt_pk_bf16(v1[0], v1[1]); w.w = cvt_pk_bf16(v1[2], v1[3]);
                    *(u32x4*)(rowp + bj * HALF) = w; } }
    }
};
template <class Epi, class Sched, bool ALIGN_EPI = false, bool SP2 = false>
__device__ __forceinline__ void gemm_phase(PG8_LAS unsigned char* lds, const Gemm g, const Sched& S, const Epi& E) {
    int tid_ = threadIdx.x; asm volatile("" : "+v"(tid_));
    const int tid = tid_, wid = __builtin_amdgcn_readfirstlane(tid >> 6), lane = tid & 63, wr = wid >> 2, wc = wid & 3, fr = lane & 15, fq = lane >> 4;
    const int K = g.K, nt = K / BK;
    unsigned voffA[2], voffB[2];
#pragma unroll
    for (int i = 0; i < 2; ++i) { int R, C; stage_rc(tid * 16 + i * 8192, R, C); const int Rb = Epi::PERM ? ((R & ~31) + perm32(R & 31)) : R;
        voffA[i] = (unsigned)(R * K + C) * 2u; voffB[i] = (unsigned)(Rb * K + C) * 2u; }
    const size_t kstep = (size_t)(BK * 2);
    const size_t hstep = (size_t)HALF * K * 2;
    const size_t tstep = 2 * hstep;
    const unsigned ldsw = (unsigned)wid * 1024u;
    const int aoff = lds_byte(wr * 64 + fr, fq * 8), boff = lds_byte(wc * 32 + fr, fq * 8);
#define PG8_SA(b, h) (((b) * 2 + (h)) * HTB)
#define PG8_SB(b, h) ((4 + (b) * 2 + (h)) * HTB)
#define PG8_STAGE(bufoff, gbase, voff) do { _Pragma("unroll") for (int _i = 0; _i < 2; ++_i) \
        __builtin_amdgcn_global_load_lds((const unsigned*)((const char*)(gbase) + (voff)[_i]), (PG8_LAS unsigned*)(lds + (bufoff) + ldsw + _i * 8192), 16, 0, 0); } while (0)
#define PG8_LDA(dst, b, h) do { _Pragma("unroll") for (int m = 0; m < 4; ++m) _Pragma("unroll") for (int k = 0; k < 2; ++k) dst[m][k] = *(const PG8_LAS bf16x8*)(lds + PG8_SA(b, h) + aoff + m * 2048 + k * 1024); } while (0)
#define PG8_LDB(dst, b, h) do { _Pragma("unroll") for (int n = 0; n < 2; ++n) _Pragma("unroll") for (int k = 0; k < 2; ++k) dst[n][k] = *(const PG8_LAS bf16x8*)(lds + PG8_SB(b, h) + boff + n * 2048 + k * 1024); } while (0)
#define PG8_MMA(ai, bj, At, Bt) do { __builtin_amdgcn_s_setprio(1); _Pragma("unroll") for (int m = 0; m < 4; ++m) _Pragma("unroll") for (int n = 0; n < 2; ++n) _Pragma("unroll") for (int k = 0; k < 2; ++k) \
        acc[ai][bj][m][n] = __builtin_amdgcn_mfma_f32_16x16x32_bf16(Bt[n][k], At[m][k], acc[ai][bj][m][n], 0, 0, 0); __builtin_amdgcn_s_setprio(0); } while (0)
#define PG8_WAIT_V(n) asm volatile("s_waitcnt vmcnt(" #n ")" ::: "memory")
#define PG8_WAIT_L(n) asm volatile("s_waitcnt lgkmcnt(" #n ")" ::: "memory")
#define PG8_BAR __builtin_amdgcn_s_barrier()
#define PG8_SCHED __builtin_amdgcn_sched_barrier(0)
    Unit cur, nxt; int ui = 0;
    if (!S.next(0, cur)) return;
    f32x4 acc[2][2][4][2];
#pragma unroll
    for (int a = 0; a < 2; ++a)
#pragma unroll
        for (int b = 0; b < 2; ++b)
#pragma unroll
            for (int m = 0; m < 4; ++m)
#pragma unroll
                for (int n = 0; n < 2; ++n) acc[a][b][m][n] = (f32x4){0.f, 0.f, 0.f, 0.f};
    bf16x8 At[4][2], B0[2][2], B1[2][2];
    const char* cA = (const char*)g.A + (size_t)cur.pm * tstep; const char* cB = (const char*)g.Bt + (size_t)cur.pn * tstep;
    S.a_ready(cur);
    if constexpr (SP2) {
        PG8_STAGE(PG8_SB(0, 0), cB, voffB); PG8_STAGE(PG8_SB(0, 1), cB + hstep, voffB); PG8_STAGE(PG8_SA(0, 0), cA, voffA); PG8_STAGE(PG8_SA(0, 1), cA + hstep, voffA);
        if (wr == 1) PG8_BAR;
        PG8_WAIT_V(2); PG8_BAR;
        PG8_STAGE(PG8_SB(1, 0), cB + kstep, voffB); PG8_STAGE(PG8_SA(1, 0), cA + kstep, voffA); PG8_STAGE(PG8_SB(1, 1), cB + hstep + kstep, voffB);
        PG8_WAIT_V(6); PG8_BAR;
    } else {
        PG8_STAGE(PG8_SB(0, 0), cB, voffB); PG8_STAGE(PG8_SA(0, 0), cA, voffA); PG8_STAGE(PG8_SB(0, 1), cB + hstep, voffB); PG8_STAGE(PG8_SA(0, 1), cA + hstep, voffA);
        if (wr == 1) PG8_BAR;
        PG8_WAIT_V(4); PG8_BAR;
        PG8_STAGE(PG8_SB(1, 0), cB + kstep, voffB); PG8_STAGE(PG8_SA(1, 0), cA + kstep, voffA); PG8_STAGE(PG8_SB(1, 1), cB + hstep + kstep, voffB);
        PG8_WAIT_V(6); PG8_BAR;
    }
    for (;;) {
        const bool has_next = S.next(ui + 1, nxt);
        const char* nA = has_next ? (const char*)g.A + (size_t)nxt.pm * tstep : cA; const char* nB = has_next ? (const char*)g.Bt + (size_t)nxt.pn * tstep : cB;
        for (int t = 0; t < nt; t += 2) {
            const bool last = (t == nt - 2);
            const char* a1 = cA + (size_t)(t + 1) * kstep;
            const char* a2 = last ? nA : cA + (size_t)(t + 2) * kstep; const char* b2 = last ? nB : cB + (size_t)(t + 2) * kstep;
            const char* a3 = a2 + kstep; const char* b3 = b2 + kstep;
            if (last && has_next) S.a_ready(nxt);
            if constexpr (SP2) {
            PG8_LDB(B0, 0, 0); PG8_LDB(B1, 0, 1); PG8_SCHED; PG8_LDA(At, 0, 0); PG8_STAGE(PG8_SA(1, 1), a1 + hstep, voffA);
            PG8_WAIT_V(8); PG8_WAIT_L(0); PG8_BAR; PG8_MMA(0, 0, At, B0); PG8_MMA(0, 1, At, B1); PG8_BAR; PG8_SCHED;
            PG8_LDA(At, 0, 1); PG8_STAGE(PG8_SB(0, 0), b2, voffB); PG8_STAGE(PG8_SB(0, 1), b2 + hstep, voffB); PG8_STAGE(PG8_SA(0, 0), a2, voffA);
            PG8_WAIT_V(8); PG8_WAIT_L(0); PG8_BAR; PG8_MMA(1, 0, At, B0); PG8_MMA(1, 1, At, B1); PG8_BAR; PG8_SCHED;
            PG8_LDB(B0, 1, 0); PG8_LDB(B1, 1, 1); PG8_SCHED; PG8_LDA(At, 1, 0); PG8_STAGE(PG8_SA(0, 1), a2 + hstep, voffA);
            PG8_WAIT_V(8); PG8_WAIT_L(0); PG8_BAR; PG8_MMA(0, 0, At, B0); PG8_MMA(0, 1, At, B1); PG8_BAR; PG8_SCHED;
            PG8_LDA(At, 1, 1); PG8_STAGE(PG8_SB(1, 0), b3, voffB); PG8_STAGE(PG8_SB(1, 1), b3 + hstep, voffB); PG8_STAGE(PG8_SA(1, 0), a3, voffA);
            PG8_WAIT_V(8); PG8_WAIT_L(0); PG8_BAR; PG8_MMA(1, 0, At, B0); PG8_MMA(1, 1, At, B1); PG8_BAR; PG8_SCHED;
            } else {
            PG8_LDB(B0, 0, 0); PG8_SCHED; PG8_LDA(At, 0, 0); PG8_STAGE(PG8_SA(1, 1), a1 + hstep, voffA);
            PG8_WAIT_L(8); PG8_BAR; PG8_WAIT_L(0); PG8_MMA(0, 0, At, B0); PG8_BAR; PG8_SCHED;
            PG8_LDB(B1, 0, 1); PG8_STAGE(PG8_SB(0, 0), b2, voffB);
            PG8_BAR; PG8_WAIT_L(0); PG8_MMA(0, 1, At, B1); PG8_BAR;
            PG8_LDA(At, 0, 1); PG8_STAGE(PG8_SA(0, 0), a2, voffA);
            PG8_BAR; PG8_WAIT_L(0); PG8_MMA(1, 0, At, B0); PG8_BAR; PG8_SCHED;
            PG8_STAGE(PG8_SB(0, 1), b2 + hstep, voffB);
            PG8_WAIT_V(6); PG8_BAR; PG8_MMA(1, 1, At, B1); PG8_BAR;
            PG8_LDB(B0, 1, 0); PG8_SCHED; PG8_LDA(At, 1, 0); PG8_STAGE(PG8_SA(0, 1), a2 + hstep, voffA);
            PG8_WAIT_L(8); PG8_BAR; PG8_WAIT_L(0); PG8_MMA(0, 0, At, B0); PG8_BAR; PG8_SCHED;
            PG8_LDB(B1, 1, 1); PG8_STAGE(PG8_SB(1, 0), b3, voffB);
            PG8_BAR; PG8_WAIT_L(0); PG8_MMA(0, 1, At, B1); PG8_BAR;
            PG8_LDA(At, 1, 1); PG8_STAGE(PG8_SA(1, 0), a3, voffA);
            PG8_BAR; PG8_WAIT_L(0); PG8_MMA(1, 0, At, B0); PG8_BAR; PG8_SCHED;
            PG8_STAGE(PG8_SB(1, 1), b3 + hstep, voffB);
            PG8_WAIT_V(6); PG8_BAR; PG8_MMA(1, 1, At, B1); PG8_BAR;
            }
        }
        if constexpr (ALIGN_EPI) { if (wr == 0) PG8_BAR; }
        if constexpr (!Epi::AFTER_DRAIN) { E(acc, cur, wr, wc, fr, fq); S.done(cur); }
        if (!has_next) break;
#pragma unroll
        for (int a = 0; a < 2; ++a)
#pragma unroll
            for (int b = 0; b < 2; ++b)
#pragma unroll
                for (int m = 0; m < 4; ++m)
#pragma unroll
                    for (int n = 0; n < 2; ++n) acc[a][b][m][n] = (f32x4){0.f, 0.f, 0.f, 0.f};
        cur = nxt; cA = nA; cB = nB; ++ui;
        if constexpr (ALIGN_EPI) { if (wr == 1) PG8_BAR; }
    }
    PG8_WAIT_V(0);
    if constexpr (!ALIGN_EPI) { if (wr == 0) PG8_BAR; }
    PG8_BAR;
    if constexpr (Epi::AFTER_DRAIN) { E.fused(acc, cur, wr, wc, fr, fq, lds, wid, lane); S.done(cur); }
#undef PG8_SA
#undef PG8_SB
#undef PG8_STAGE
#undef PG8_LDA
#undef PG8_LDB
#undef PG8_MMA
#undef PG8_WAIT_V
#undef PG8_WAIT_L
#undef PG8_BAR
#undef PG8_SCHED
}
}
#define GAS __attribute__((address_space(1)))
#define LAS __attribute__((address_space(3)))
typedef unsigned short bf16;
typedef unsigned v4u __attribute__((ext_vector_type(4)));
typedef float f32x4 __attribute__((ext_vector_type(4)));
typedef short bf16x8 __attribute__((ext_vector_type(8)));
typedef GAS unsigned gu32;
typedef GAS unsigned long long gu64;
#define RLX_AGENT __ATOMIC_RELAXED, __HIP_MEMORY_SCOPE_AGENT
#define LDS_WAIT() asm volatile("s_waitcnt lgkmcnt(0)" ::: "memory")
#define VM_WAIT() asm volatile("s_waitcnt vmcnt(0)" ::: "memory")
__device__ __forceinline__ unsigned long long rt() { return __builtin_amdgcn_s_memrealtime(); }
__device__ __forceinline__ unsigned f2bf(float f) { unsigned u = __builtin_bit_cast(unsigned, f); return (u + 0x7fffu + ((u >> 16) & 1u)) >> 16; }
__device__ __forceinline__ unsigned pk2(float lo, float hi) { return f2bf(lo) | (f2bf(hi) << 16); }

#define XB_TMO      128
#define XB_XCNT(j)  (256  + 64 * (j))
#define XB_XSUB(j)  (1280 + 64 * (j))
#define XB_XGEN(j)  (2304 + 64 * (j))
#define XB_TOP      3328
#define XB_TOPGEN   3392
#define XCD_BAR_WORDS 3456
#define XB_SPIN_CAP (1u << 18)

__device__ __forceinline__ unsigned xb_ld(unsigned* p)              { return __hip_atomic_load(p, __ATOMIC_RELAXED, __HIP_MEMORY_SCOPE_AGENT); }
__device__ __forceinline__ unsigned xb_add(unsigned* p, unsigned v) { return __hip_atomic_fetch_add(p, v, __ATOMIC_RELAXED, __HIP_MEMORY_SCOPE_AGENT); }
__device__ __forceinline__ unsigned xb_xcc_id() { return (unsigned)__builtin_amdgcn_s_getreg((3 << 11) | 20) & 0xFu; }
#define XB_SPIN(cond, bar) do { unsigned _sp = 0; while (cond) { __builtin_amdgcn_s_sleep(1); \
    if ((++_sp & 255u) == 0u) { if (xb_ld(&(bar)[XB_TMO])) break; if (_sp > XB_SPIN_CAP) { atomicAdd(&(bar)[XB_TMO], 1u); break; } } } } while (0)

struct XcdBarrier {
    unsigned* bar; unsigned x;
    volatile LAS unsigned* st;
};

__device__ __forceinline__ XcdBarrier xcd_barrier_post(unsigned* bar, volatile LAS unsigned* st) {
    XcdBarrier b; b.bar = bar; b.x = xb_xcc_id(); b.st = st;
    if (threadIdx.x == 0) (void)xb_add(&bar[XB_XCNT(b.x)], 1u);
    return b;
}
__device__ __forceinline__ void xcd_barrier_complete(unsigned* bar, unsigned x, unsigned& nloc, unsigned& nx) {
    const unsigned G = gridDim.x * gridDim.y * gridDim.z;
    unsigned sum, cnt, mine, sp = 0u;
    for (;;) {
        sum = 0u; cnt = 0u; mine = 0u;
#pragma unroll
        for (unsigned j = 0; j < 16; ++j) { const unsigned c = xb_ld(&bar[XB_XCNT(j)]); sum += c; cnt += (c > 0u) ? 1u : 0u; mine = (j == x) ? c : mine; }
        if (sum == G) break;
        __builtin_amdgcn_s_sleep(1);
        if ((++sp & 255u) == 0u) { if (xb_ld(&bar[XB_TMO])) break; if (sp > XB_SPIN_CAP) { atomicAdd(&bar[XB_TMO], 1u); break; } }
    }
    nloc = mine > 0u ? mine : 1u; nx = cnt > 0u ? cnt : 1u;
}

__device__ __forceinline__ void xcd_barrier(const XcdBarrier& b) {
    asm volatile("s_waitcnt vmcnt(0)" ::: "memory");
    __syncthreads();
    if (threadIdx.x == 0) {
        unsigned* bar = b.bar;
        __builtin_amdgcn_s_waitcnt(0);
        unsigned nloc = b.st[0], nx = b.st[1];
        if (nloc == 0u) { xcd_barrier_complete(bar, b.x, nloc, nx); b.st[0] = nloc; b.st[1] = nx; }
        const unsigned old = xb_add(&bar[XB_XSUB(b.x)], 1u);
        const unsigned gen = old / nloc;
        if (old + 1u == (gen + 1u) * nloc) {
            __builtin_amdgcn_fence(__ATOMIC_RELEASE, "agent");
            asm volatile("s_waitcnt vmcnt(0)" ::: "memory");
            const unsigned og = xb_add(&bar[XB_TOP], 1u);
            const unsigned tg = og / nx;
            if (og + 1u == (tg + 1u) * nx) xb_add(&bar[XB_TOPGEN], 1u);
            else XB_SPIN(xb_ld(&bar[XB_TOPGEN]) == tg, bar);
            __builtin_amdgcn_fence(__ATOMIC_ACQUIRE, "agent");
            xb_add(&bar[XB_XGEN(b.x)], 1u);
            asm volatile("s_waitcnt vmcnt(0)" ::: "memory");
        } else {
            XB_SPIN(xb_ld(&bar[XB_XGEN(b.x)]) == gen, bar);
            __builtin_amdgcn_fence(__ATOMIC_ACQUIRE, "agent");
            asm volatile("s_waitcnt vmcnt(0)" ::: "memory");
        }
    }
    __syncthreads();
}
namespace mk {
typedef float f32x16 __attribute__((ext_vector_type(16)));
typedef float f32x2 __attribute__((ext_vector_type(2)));
typedef short s16x4 __attribute__((ext_vector_type(4)));
typedef unsigned u32x2 __attribute__((ext_vector_type(2)));
typedef unsigned u32x4 __attribute__((ext_vector_type(4)));

constexpr int NWAVES = 8, NTHR = 512;
constexpr int BATCH = 4, SEQ = 8192, D = 1024, H = 16, HD = 64, T = BATCH * SEQ;
constexpr int NE = 256, TOPK = 8, DE = 256, NGRP = 8, GRPSZ = 32;
constexpr int NBLK = SEQ / 256;
constexpr int NSLOT_MAX = 327680;
constexpr float LN_EPS = 1e-5f;
constexpr float DN_ALPHA = 1.4142135623730951f;
constexpr float ROUTED_SCALE = 2.5f;
constexpr float LOG2E = 1.4426950408889634f;
constexpr float C2 = 0.125f * LOG2E;
constexpr int FOXW = 3 * D + H;

constexpr size_t MiB = 1u << 20;
constexpr size_t WS_CTL = 0, CTL_ZERO_BYTES = 1 * MiB;
constexpr size_t WS_WMI = 2 * MiB;
constexpr size_t WS_WMO = 8 * MiB;
constexpr size_t WS_WFI = 10 * MiB;
constexpr size_t WS_WFO = 16 * MiB;
constexpr size_t WS_WR = 18 * MiB;
constexpr size_t WS_WSGU = 21 * MiB;
constexpr size_t WS_WSDN = 23 * MiB;
constexpr size_t WS_WEGU = 24 * MiB;
constexpr size_t WS_WEDN = 280 * MiB;
constexpr size_t WS_XRES = 408 * MiB;
constexpr size_t WS_Z = 536 * MiB;
constexpr size_t WS_XB = 664 * MiB;
constexpr size_t WS_AR = 728 * MiB;
constexpr size_t WS_LOGP = 920 * MiB;
constexpr size_t WS_ACTSH = 984 * MiB;
constexpr size_t WS_TOPI = 1000 * MiB;
constexpr size_t WS_GATE = 1001 * MiB;
constexpr size_t WS_SLOTOF = 1002 * MiB;
constexpr size_t WS_TOKOF = 1003 * MiB;
constexpr size_t WS_GSLOT = 1005 * MiB;
constexpr size_t WS_KMEAN = 1008 * MiB;
constexpr size_t WS_LOGF = 1009 * MiB;
constexpr size_t WS_CUM = 1011 * MiB;
constexpr size_t WS_OVL = 1016 * MiB;
constexpr size_t WS_Q = WS_OVL, WS_K = WS_OVL + 64 * MiB, WS_V = WS_OVL + 128 * MiB, WS_O = WS_OVL + 192 * MiB;
constexpr size_t WS_MLIST = WS_OVL + 256 * MiB;
constexpr size_t WS_PARTO = WS_OVL + 288 * MiB;
constexpr size_t WS_PARTML = WS_OVL + 480 * MiB;
constexpr size_t WS_HS = WS_OVL;
constexpr size_t WS_ACT = WS_OVL + 640 * MiB;
constexpr size_t WS_END = WS_OVL + 800 * MiB;
static_assert(WS_END <= 2048 * MiB, "d_ws map");
static_assert(WS_PARTML + (size_t)T * H * 3 * 2 * 4 <= WS_END, "attention overlay");
constexpr int MLIST_PER_BH = 256 * 496;
constexpr int CW_BAR = 4096;
constexpr int CW_MCNT = 16384;
constexpr int CW_ECNT = 20480;
constexpr int CW_ECUR = 21504;
constexpr int RING_BYTES = 131072, LDSCTL_OFF = RING_BYTES, MISC_OFF = LDSCTL_OFF + 320, TPRE_OFF = LDSCTL_OFF + 1024, PTAB_OFF = LDSCTL_OFF + 4096, LDS_BYTES = 147456;
typedef __bf16 bf16x2_t __attribute__((ext_vector_type(2)));
__device__ __forceinline__ unsigned cvtpk(float lo, float hi) { f32x2 v = {lo, hi}; bf16x2_t b = __builtin_convertvector(v, bf16x2_t); return __builtin_bit_cast(unsigned, b); }
__device__ __forceinline__ float bf2f(unsigned b) { return __uint_as_float(b << 16); }
__device__ __forceinline__ float bflo(unsigned w) { return __uint_as_float(w << 16); }
__device__ __forceinline__ float bfhi(unsigned w) { return __uint_as_float(w & 0xffff0000u); }
__device__ __forceinline__ float wave_sum(float v) {
#pragma unroll
    for (int o = 1; o < 64; o <<= 1) v += __shfl_xor(v, o);
    return v;
}
__device__ __forceinline__ int crow(int r, int hi) { return (r & 3) + 8 * (r >> 2) + 4 * hi; }
__device__ __forceinline__ s16x4 vtr(const LAS unsigned char* p) { typedef short v4i16_t __attribute__((ext_vector_type(4))); return __builtin_bit_cast(s16x4, __builtin_amdgcn_ds_read_tr16_b64_v4i16((LAS v4i16_t*)p)); }

__device__ __forceinline__ unsigned long long ldptr(const LAS unsigned long long* tab, int i) { const unsigned long long v = tab[i]; const unsigned lo = __builtin_amdgcn_readfirstlane((unsigned)v), hi = __builtin_amdgcn_readfirstlane((unsigned)(v >> 32)); return ((unsigned long long)hi << 32) | lo; }

struct Ctx {
    LAS unsigned char* lds;
    int tid, lane, wave, vcu, G;
};

template <bool LO> __device__ __forceinline__ void tr_item(const float* src, size_t ld, bf16* dst, size_t dpitch, LAS float* scr, int lane) {
#pragma unroll 8
    for (int i = 0; i < 32; ++i) { const int kk = 2 * i + (lane >> 5); scr[kk * 33 + (lane & 31)] = src[(size_t)kk * ld + (lane & 31)]; }
    LDS_WAIT(); asm volatile("" ::: "memory");
    const int c = lane & 7;
#pragma unroll
    for (int j = 0; j < 4; ++j) { const int n = (lane >> 3) + 8 * j; const LAS float* s = scr + (8 * c) * 33 + n;
        float v[8];
#pragma unroll
        for (int i = 0; i < 8; ++i) { v[i] = s[i * 33]; if (LO) v[i] = v[i] - bf2f(f2bf(v[i])); }
        v4u o; o.x = pk2(v[0], v[1]); o.y = pk2(v[2], v[3]); o.z = pk2(v[4], v[5]); o.w = pk2(v[6], v[7]);
        *(GAS v4u*)(dst + (size_t)n * dpitch + 8 * c) = o; }
    LDS_WAIT(); asm volatile("" ::: "memory");
}

__device__ __forceinline__ void conv_experts(const Ctx& C, const float* wg, const float* wu, const float* wd, int l, bf16* WEGU, bf16* WEDN) {
    LAS float* scr = (LAS float*)(C.lds + C.wave * 16384);
    const int gw = C.vcu * NWAVES + C.wave, NGW = C.G * NWAVES;
    constexpr int IG = NE * 16 * 8;
    constexpr int IDN = NE * 4 * 32;
    for (int it = gw; it < 2 * IG + IDN; it += NGW) {
        if (it < 2 * IG) {
            const int up = it >= IG, r = it - up * IG, e = r >> 7, kb = (r >> 3) & 15, nb = r & 7, n0 = 32 * nb;
            const float* src = (up ? wu : wg) + ((size_t)(l * NE + e) * 1024 + 64 * kb) * 256 + n0;
            bf16* dst = WEGU + ((size_t)e * 512 + (n0 >> 7) * 256 + up * 128 + (n0 & 127)) * 1024 + 64 * kb;
            tr_item<false>(src, 256, dst, 1024, scr, C.lane);
        } else {
            const int r = it - 2 * IG, e = r >> 7, kb = (r >> 5) & 3, nb = r & 31, n0 = 32 * nb;
            const float* src = wd + ((size_t)(l * NE + e) * 256 + 64 * kb) * 1024 + n0;
            bf16* dst = WEDN + ((size_t)e * 1024 + n0) * 256 + 64 * kb;
            tr_item<false>(src, 1024, dst, 256, scr, C.lane);
        }
    }
}

struct SmallW {
    const float *moba_in, *moba_out, *fox_in, *fox_out, *w_router, *ws_gate, *ws_up, *ws_down;
    bf16 *WMI, *WMO, *WFI, *WFO, *WR, *WSGU, *WSDN;
};
__device__ __forceinline__ void conv_small(const Ctx& C, const SmallW& W) {
    LAS float* scr = (LAS float*)(C.lds + C.wave * 16384);
    const int gw = C.vcu * NWAVES + C.wave, NGW = C.G * NWAVES;
    constexpr int I_IN = 16 * 96, I_OUT = 16 * 32, I_R = 16 * 8, I_SG = 16 * 8, I_SD = 4 * 32;
    constexpr int NIT = 2 * I_IN + 2 * I_OUT + 2 * (3 * I_R) + 2 * (2 * I_SG + I_SD);
    for (int it = gw; it < NIT; it += NGW) {
        int r = it;
        if (r < I_IN) { const int kb = r / 96, nb = r % 96; tr_item<false>(W.moba_in + (size_t)(64 * kb) * 3072 + 32 * nb, 3072, W.WMI + (size_t)(32 * nb) * 1024 + 64 * kb, 1024, scr, C.lane); continue; } r -= I_IN;
        if (r < I_IN) { const int kb = r / 96, nb = r % 96; tr_item<false>(W.fox_in + (size_t)(64 * kb) * FOXW + 32 * nb, FOXW, W.WFI + (size_t)(32 * nb) * 1024 + 64 * kb, 1024, scr, C.lane); continue; } r -= I_IN;
        if (r < I_OUT) { const int kb = r / 32, nb = r % 32; tr_item<false>(W.moba_out + (size_t)(64 * kb) * 1024 + 32 * nb, 1024, W.WMO + (size_t)(32 * nb) * 1024 + 64 * kb, 1024, scr, C.lane); continue; } r -= I_OUT;
        if (r < I_OUT) { const int kb = r / 32, nb = r % 32; tr_item<false>(W.fox_out + (size_t)(64 * kb) * 1024 + 32 * nb, 1024, W.WFO + (size_t)(32 * nb) * 1024 + 64 * kb, 1024, scr, C.lane); continue; } r -= I_OUT;
        if (r < 6 * I_R) {
            const int l = r / (3 * I_R), q = (r % (3 * I_R)) / I_R, s = r % I_R, kb = s >> 3, nb = s & 7;
            const float* src = W.w_router + ((size_t)l * 1024 + 64 * kb) * 256 + 32 * nb;
            bf16* base = W.WR + (size_t)l * (512 * 1536) + (size_t)(32 * nb) * 1536;
            if (q == 0) tr_item<false>(src, 256, base + 64 * kb, 1536, scr, C.lane);
            else if (q == 1) { if (kb < 8) tr_item<false>(src, 256, base + 1024 + 64 * kb, 1536, scr, C.lane); else tr_item<false>(src, 256, base + (size_t)256 * 1536 + 64 * (kb - 8), 1536, scr, C.lane); }
            else tr_item<true>(src, 256, base + (size_t)256 * 1536 + 512 + 64 * kb, 1536, scr, C.lane);
            continue; } r -= 6 * I_R;
        {
            constexpr int PER = 2 * I_SG + I_SD; const int l = r / PER; int s = r % PER;
            if (s < 2 * I_SG) { const int up = s >= I_SG; s -= up * I_SG; const int kb = s >> 3, nb = s & 7, n0 = 32 * nb;
                const float* src = (up ? W.ws_up : W.ws_gate) + ((size_t)l * 1024 + 64 * kb) * 256 + n0;
                tr_item<false>(src, 256, W.WSGU + (size_t)l * (512 * 1024) + (size_t)((n0 >> 7) * 256 + up * 128 + (n0 & 127)) * 1024 + 64 * kb, 1024, scr, C.lane); }
            else { s -= 2 * I_SG; const int kb = s >> 5, nb = s & 31;
                tr_item<false>(W.ws_down + ((size_t)l * 256 + 64 * kb) * 1024 + 32 * nb, 1024, W.WSDN + (size_t)l * (1024 * 256) + (size_t)(32 * nb) * 256 + 64 * kb, 256, scr, C.lane); }
        }
    }
}
__device__ __forceinline__ void to_bf16_rows(const Ctx& C, const float* x, bf16* xb) {
    const size_t n8 = (size_t)T * D / 8;
    for (size_t i = (size_t)C.vcu * NTHR + C.tid; i < n8; i += (size_t)C.G * NTHR) {
        const f32x4 a = *(const GAS f32x4*)(x + 8 * i), b = *(const GAS f32x4*)(x + 8 * i + 4);
        v4u o; o.x = cvtpk(a.x, a.y); o.y = cvtpk(a.z, a.w); o.z = cvtpk(b.x, b.y); o.w = cvtpk(b.z, b.w);
        *(GAS v4u*)(xb + 8 * i) = o;
    }
}

template <bool COL0> struct EpiF32 {
    static constexpr bool PERM = false, AFTER_DRAIN = false;
    float* out; const float* base; int ldc; float alpha;
    __device__ __forceinline__ void operator()(const pg8::f32x4 (&acc)[2][2][4][2], const pg8::Unit& u, int wr, int wc, int fr, int fq) const {
        const int row0 = u.pm * 256 + wr * 64 + fr, col0 = (COL0 ? 0 : u.pn * 256) + wc * 32 + 4 * fq;
#pragma unroll
        for (int ai = 0; ai < 2; ++ai)
#pragma unroll
            for (int m = 0; m < 4; ++m) { const size_t off = (size_t)(row0 + ai * 128 + m * 16) * ldc + col0;
#pragma unroll
                for (int bj = 0; bj < 2; ++bj)
#pragma unroll
                    for (int n = 0; n < 2; ++n) { f32x4 v = acc[ai][bj][m][n];
                        if (base) { const f32x4 b = *(const GAS f32x4*)(base + off + bj * 128 + n * 16); v = v + b * alpha; }
                        *(GAS f32x4*)(out + off + bj * 128 + n * 16) = v; } }
    }
};
struct EpiSwiGLU {
    static constexpr bool PERM = true, AFTER_DRAIN = false;
    bf16* act; const float* rowscale;
    __device__ __forceinline__ void operator()(const pg8::f32x4 (&acc)[2][2][4][2], const pg8::Unit& u, int wr, int wc, int fr, int fq) const {
        const int row0 = u.pm * 256 + wr * 64 + fr, col0 = (u.pn & 1) * 128 + wc * 32 + 8 * fq;
#pragma unroll
        for (int ai = 0; ai < 2; ++ai)
#pragma unroll
            for (int m = 0; m < 4; ++m) { const int row = row0 + ai * 128 + m * 16; const float rs = rowscale ? rowscale[row] : 1.f;
                float o[8];
#pragma unroll
                for (int n = 0; n < 2; ++n)
#pragma unroll
                    for (int i = 0; i < 4; ++i) { const float g = acc[ai][0][m][n][i], up = acc[ai][1][m][n][i];
                        const float sg = g * __builtin_amdgcn_rcpf(1.f + __builtin_amdgcn_exp2f(-g * LOG2E)); o[4 * n + i] = sg * up * rs; }
                v4u w; w.x = cvtpk(o[0], o[1]); w.y = cvtpk(o[2], o[3]); w.z = cvtpk(o[4], o[5]); w.w = cvtpk(o[6], o[7]);
                *(GAS v4u*)(act + (size_t)row * 256 + col0) = w; }
    }
};
struct EpiDown {
    static constexpr bool PERM = true, AFTER_DRAIN = false;
    bf16* out;
    __device__ __forceinline__ void operator()(const pg8::f32x4 (&acc)[2][2][4][2], const pg8::Unit& u, int wr, int wc, int fr, int fq) const {
        const int row0 = u.pm * 256 + wr * 64 + fr, col0 = (u.pn & 3) * 256 + wc * 32 + 8 * fq;
#pragma unroll
        for (int ai = 0; ai < 2; ++ai)
#pragma unroll
            for (int m = 0; m < 4; ++m) { bf16* rowp = out + (size_t)(row0 + ai * 128 + m * 16) * 1024 + col0;
#pragma unroll
                for (int bj = 0; bj < 2; ++bj) { const f32x4 v0 = acc[ai][bj][m][0], v1 = acc[ai][bj][m][1];
                    v4u w; w.x = cvtpk(v0[0], v0[1]); w.y = cvtpk(v0[2], v0[3]); w.z = cvtpk(v1[0], v1[1]); w.w = cvtpk(v1[2], v1[3]);
                    *(GAS v4u*)(rowp + bj * 128) = w; } }
    }
};
struct RouterOrder {
    int vcu, G;
    __device__ __forceinline__ bool next(int i, pg8::Unit& u) const { const int idx = vcu + i * G; if (idx >= 256) return false; u.pm = idx; u.pn = idx >> 7; return true; }
    __device__ __forceinline__ void a_ready(const pg8::Unit&) const {}
    __device__ __forceinline__ void done(const pg8::Unit&) const {}
};
struct DenseOrder {
    int vcu, G, nN, total;
    __device__ __forceinline__ bool next(int i, pg8::Unit& u) const { const int idx = vcu + i * G; if (idx >= total) return false; u.pm = idx / nN; u.pn = idx % nN; return true; }
    __device__ __forceinline__ void a_ready(const pg8::Unit&) const {}
    __device__ __forceinline__ void done(const pg8::Unit&) const {}
};
template <int SH> struct ExpertOrder {
    int vcu, G; const LAS int* tpre;
    __device__ __forceinline__ bool next(int i, pg8::Unit& u) const {
        const int idx = vcu + i * G, ti = idx >> SH; if (ti >= tpre[NE]) return false;
        int lo = 0, hi = NE;
#pragma unroll
        for (int s = 0; s < 8; ++s) { const int mid = (lo + hi) >> 1; if (tpre[mid] <= ti) lo = mid; else hi = mid; }
        u.pm = __builtin_amdgcn_readfirstlane(ti); u.pn = __builtin_amdgcn_readfirstlane((lo << SH) + (idx & ((1 << SH) - 1))); return true;
    }
    __device__ __forceinline__ void a_ready(const pg8::Unit&) const {}
    __device__ __forceinline__ void done(const pg8::Unit&) const {}
};
__device__ __forceinline__ void build_tpre(const Ctx& C, const unsigned* ecnt) {
    LAS int* tpre = (LAS int*)(C.lds + TPRE_OFF);
    __syncthreads();
    int v = 0;
    if (C.tid < NE) v = (int)((__hip_atomic_load(ecnt + C.tid, __ATOMIC_RELAXED, __HIP_MEMORY_SCOPE_AGENT) + 255u) >> 8);
    int inc = v;
#pragma unroll
    for (int o = 1; o < 64; o <<= 1) { const int t = __shfl_up(inc, o); if (C.lane >= o) inc += t; }
    if (C.tid < NE && C.lane == 63) tpre[260 + C.wave] = inc;
    __syncthreads();
    if (C.tid < NE) { int base = 0; for (int w = 0; w < C.wave; ++w) base += tpre[260 + w]; tpre[C.tid + 1] = base + inc; if (C.tid == 0) tpre[0] = 0; }
    __syncthreads();
}
struct AttnAcc { float m, l; f32x16 o0, o1; };
#define MFMA32(a, b, c) __builtin_amdgcn_mfma_f32_32x32x16_bf16((a), (b), (c), 0, 0, 0)
constexpr float NEG_INF = -__builtin_inff();

__device__ __forceinline__ void stage_load(const bf16* Kg, const bf16* Vg, int wave, int lane, v4u& kreg, v4u& vreg) {
    kreg = *(const GAS v4u*)(Kg + (size_t)lane * D + wave * 8);
    vreg = *(const GAS v4u*)(Vg + (size_t)(16 * (wave & 3) + (lane >> 2)) * D + (wave >> 2) * 32 + (lane & 3) * 8);
}
__device__ __forceinline__ void stage_store(LAS unsigned char* Ks, LAS unsigned char* Vs, int wave, int lane, const v4u& kreg, const v4u& vreg) {
    *(LAS v4u*)(Ks + wave * 1024 + lane * 16) = kreg;
    *(LAS v4u*)(Vs + wave * 1024 + lane * 16) = vreg;
}
__device__ __forceinline__ void load_q(bf16x8 (&qr)[4], const bf16* Qrow, int hi) {
#pragma unroll
    for (int d0 = 0; d0 < 4; ++d0) qr[d0] = *(const GAS bf16x8*)(Qrow + d0 * 16 + hi * 8);
}

template <class Bias> __device__ __forceinline__ void attn_tile(AttnAcc& A, const bf16x8 (&qr)[4], const LAS unsigned char* Ks, const LAS unsigned char* Vs, int r32, int hi, int lane, const Bias& B) {
    f32x16 p0, p1;
#pragma unroll
    for (int r = 0; r < 16; ++r) { p0[r] = 0.f; p1[r] = 0.f; }
    const LAS unsigned char* kb = Ks + hi * 1024 + r32 * 16;
#pragma unroll
    for (int d0 = 0; d0 < 4; ++d0) {
        const bf16x8 k0 = *(const LAS bf16x8*)(kb + d0 * 2048), k1 = *(const LAS bf16x8*)(kb + d0 * 2048 + 512);
        p0 = MFMA32(k0, qr[d0], p0); p1 = MFMA32(k1, qr[d0], p1);
    }
    B.apply(p0, p1, hi);
    float rm = fmaxf(p0[0], p1[0]);
#pragma unroll
    for (int r = 1; r < 16; ++r) rm = fmaxf(rm, fmaxf(p0[r], p1[r]));
    rm = fmaxf(rm, __shfl_xor(rm, 32));
    const float mn = fmaxf(A.m, rm);
    const float f = __builtin_amdgcn_exp2f(A.m - mn);
    A.m = mn;
    float ls = 0.f;
#pragma unroll
    for (int r = 0; r < 16; ++r) { p0[r] = __builtin_amdgcn_exp2f(p0[r] - mn); p1[r] = __builtin_amdgcn_exp2f(p1[r] - mn); ls += p0[r] + p1[r]; }
    A.l = A.l * f + ls;
#pragma unroll
    for (int r = 0; r < 16; ++r) { A.o0[r] *= f; A.o1[r] *= f; }
    v4u pw[4];
#pragma unroll
    for (int s = 0; s < 2; ++s) {
        pw[s].x = cvtpk(p0[8 * s + 0], p0[8 * s + 1]); pw[s].y = cvtpk(p0[8 * s + 2], p0[8 * s + 3]); pw[s].z = cvtpk(p0[8 * s + 4], p0[8 * s + 5]); pw[s].w = cvtpk(p0[8 * s + 6], p0[8 * s + 7]);
        pw[2 + s].x = cvtpk(p1[8 * s + 0], p1[8 * s + 1]); pw[2 + s].y = cvtpk(p1[8 * s + 2], p1[8 * s + 3]); pw[2 + s].z = cvtpk(p1[8 * s + 4], p1[8 * s + 5]); pw[2 + s].w = cvtpk(p1[8 * s + 6], p1[8 * s + 7]);
    }
    const LAS unsigned char* vb = Vs + ((lane >> 4) & 1) * 32 + (lane & 3) * 8 + (4 * hi + ((lane & 15) >> 2)) * 64;
#pragma unroll
    for (int ks = 0; ks < 4; ++ks) {
        const bf16x8 pa = __builtin_bit_cast(bf16x8, pw[ks]);
        const s16x4 a0 = vtr(vb + ks * 1024), a1 = vtr(vb + ks * 1024 + 512), b0 = vtr(vb + (4 + ks) * 1024), b1 = vtr(vb + (4 + ks) * 1024 + 512);
        const bf16x8 v0 = {a0[0], a0[1], a0[2], a0[3], a1[0], a1[1], a1[2], a1[3]}, v1 = {b0[0], b0[1], b0[2], b0[3], b1[0], b1[1], b1[2], b1[3]};
        A.o0 = MFMA32(v0, pa, A.o0); A.o1 = MFMA32(v1, pa, A.o1);
    }
}
__device__ __forceinline__ void acc_init(AttnAcc& A) {
    A.m = NEG_INF; A.l = 0.f;
#pragma unroll
    for (int r = 0; r < 16; ++r) { A.o0[r] = 0.f; A.o1[r] = 0.f; }
}

__device__ __forceinline__ int rel_bucket(int n) {
    if (n < 16) return n;
    int b = 16;
    b += (n >= 19); b += (n >= 21); b += (n >= 24); b += (n >= 27); b += (n >= 31); b += (n >= 35); b += (n >= 40); b += (n >= 46);
    b += (n >= 52); b += (n >= 59); b += (n >= 67); b += (n >= 77); b += (n >= 87); b += (n >= 99); b += (n >= 113);
    return b;
}
__device__ __forceinline__ void build_relb(const Ctx& C, const float* rel_bias, LAS float* relb) {
    for (int i = C.tid; i < H * 128; i += NTHR) { const int h = i >> 7, n = i & 127; relb[i] = rel_bias[rel_bucket(n) * H + h] * LOG2E; }
}
struct MobaBias {
    const LAS float* relb; int qpos, kpos0; bool lookup, causal; float cbias;
    __device__ __forceinline__ void apply(f32x16& p0, f32x16& p1, int hi) const {
        if (lookup) {
#pragma unroll
            for (int r = 0; r < 16; ++r) { const int d0 = qpos - (kpos0 + crow(r, hi)), d1 = d0 - 32;
                const int i0 = d0 < 0 ? 0 : (d0 > 127 ? 127 : d0), i1 = d1 < 0 ? 0 : (d1 > 127 ? 127 : d1);
                p0[r] += relb[i0]; p1[r] += relb[i1];
                if (causal) { if (d0 < 0) p0[r] = NEG_INF; if (d1 < 0) p1[r] = NEG_INF; } }
        } else {
#pragma unroll
            for (int r = 0; r < 16; ++r) { p0[r] += cbias; p1[r] += cbias; }
        }
    }
};
struct FoxBias {
    const LAS float* cb; float cq; int qrel, krel0; bool mask;
    __device__ __forceinline__ void apply(f32x16& p0, f32x16& p1, int hi) const {
#pragma unroll
        for (int g = 0; g < 4; ++g) { const f32x4 c0 = *(const LAS f32x4*)(cb + 8 * g + 4 * hi), c1 = *(const LAS f32x4*)(cb + 32 + 8 * g + 4 * hi);
#pragma unroll
            for (int i = 0; i < 4; ++i) { const int r = 4 * g + i; p0[r] += cq - c0[i]; p1[r] += cq - c1[i];
                if (mask) { const int k0 = krel0 + 8 * g + 4 * hi + i; if (k0 > qrel) p0[r] = NEG_INF; if (k0 + 32 > qrel) p1[r] = NEG_INF; } } }
    }
};

__device__ __forceinline__ void ph_kmean(const Ctx& C, const bf16* K, float* kmean) {
    LAS float* red = (LAS float*)C.lds;
    for (int u = C.vcu; u < BATCH * NBLK; u += C.G) {
        const int half = C.tid >> 8, t = C.tid & 255;
        const bf16* base = K + ((size_t)u * 256 + 128 * half) * D + 4 * t;
        float s0 = 0.f, s1 = 0.f, s2 = 0.f, s3 = 0.f;
#pragma unroll 8
        for (int r = 0; r < 128; ++r) { const u32x2 w = *(const GAS u32x2*)(base + (size_t)r * D); s0 += bflo(w.x); s1 += bfhi(w.x); s2 += bflo(w.y); s3 += bfhi(w.y); }
        __syncthreads();
        if (half) *(LAS f32x4*)(red + 4 * t) = (f32x4){s0, s1, s2, s3};
        __syncthreads();
        if (!half) { const f32x4 o = *(const LAS f32x4*)(red + 4 * t);
            *(GAS f32x4*)(kmean + (size_t)u * D + 4 * t) = (f32x4){(s0 + o.x) * (1.f / 256.f), (s1 + o.y) * (1.f / 256.f), (s2 + o.z) * (1.f / 256.f), (s3 + o.w) * (1.f / 256.f)}; }
    }
}
__device__ __forceinline__ int mlist_off(int j) { return 256 * (31 * j - (j * (j - 1)) / 2); }
__device__ __forceinline__ void ph_select(const Ctx& C, const bf16* Q, const float* kmean, unsigned* mcnt, unsigned* mlist) {
    LAS float* km = (LAS float*)C.lds;
    LAS unsigned* lcnt = (LAS unsigned*)(C.lds + 8192);
    for (int u = C.vcu; u < BATCH * H * 31; u += C.G) {
        const int bh = u / 31, own = 1 + u % 31, b = bh >> 4, h = bh & 15;
        __syncthreads();
        for (int i = C.tid; i < own * 64; i += NTHR) km[i] = kmean[(size_t)(b * NBLK + (i >> 6)) * D + h * 64 + (i & 63)];
        if (C.tid < 64) lcnt[C.tid] = 0u;
        __syncthreads();
        int sel0 = 0, sel1 = 0, sel2 = 0, rk0 = 0, rk1 = 0, rk2 = 0; float sv0 = NEG_INF, sv1 = NEG_INF, sv2 = NEG_INF;
        const int nv = own < 3 ? own : 3;
        if (C.tid < 256) {
            float q[64];
            const bf16* qp = Q + (size_t)(b * SEQ + own * 256 + C.tid) * D + h * 64;
#pragma unroll
            for (int c = 0; c < 8; ++c) { const v4u w = *(const GAS v4u*)(qp + 8 * c);
                q[8 * c + 0] = bflo(w.x); q[8 * c + 1] = bfhi(w.x); q[8 * c + 2] = bflo(w.y); q[8 * c + 3] = bfhi(w.y); q[8 * c + 4] = bflo(w.z); q[8 * c + 5] = bfhi(w.z); q[8 * c + 6] = bflo(w.w); q[8 * c + 7] = bfhi(w.w); }
            for (int j = 0; j < own; ++j) {
                float s = 0.f;
#pragma unroll
                for (int c = 0; c < 16; ++c) { const f32x4 kv = *(const LAS f32x4*)(km + j * 64 + 4 * c); s += q[4 * c] * kv.x; s += q[4 * c + 1] * kv.y; s += q[4 * c + 2] * kv.z; s += q[4 * c + 3] * kv.w; }
                if (s > sv0) { sv2 = sv1; sel2 = sel1; sv1 = sv0; sel1 = sel0; sv0 = s; sel0 = j; }
                else if (s > sv1) { sv2 = sv1; sel2 = sel1; sv1 = s; sel1 = j; }
                else if (s > sv2) { sv2 = s; sel2 = j; }
            }
            rk0 = (int)__hip_atomic_fetch_add(&lcnt[sel0], 1u, __ATOMIC_RELAXED, __HIP_MEMORY_SCOPE_WORKGROUP);
            if (nv > 1) rk1 = (int)__hip_atomic_fetch_add(&lcnt[sel1], 1u, __ATOMIC_RELAXED, __HIP_MEMORY_SCOPE_WORKGROUP);
            if (nv > 2) rk2 = (int)__hip_atomic_fetch_add(&lcnt[sel2], 1u, __ATOMIC_RELAXED, __HIP_MEMORY_SCOPE_WORKGROUP);
        }
        __syncthreads();
        if (C.tid < 32) { const unsigned c = lcnt[C.tid]; if (c) lcnt[32 + C.tid] = __hip_atomic_fetch_add(mcnt + bh * 32 + C.tid, c, __ATOMIC_RELAXED, __HIP_MEMORY_SCOPE_AGENT); }
        __syncthreads();
        if (C.tid < 256) {
            unsigned* lst = mlist + (size_t)bh * MLIST_PER_BH; const unsigned tl = (unsigned)(own * 256 + C.tid);
            lst[mlist_off(sel0) + lcnt[32 + sel0] + rk0] = tl;
            if (nv > 1) lst[mlist_off(sel1) + lcnt[32 + sel1] + rk1] = tl | (1u << 16);
            if (nv > 2) lst[mlist_off(sel2) + lcnt[32 + sel2] + rk2] = tl | (2u << 16);
        }
    }
}
__device__ __forceinline__ void ph_moba_part(const Ctx& C, const bf16* Q, const bf16* K, const bf16* V, const float* rel_bias, const unsigned* mcnt, const unsigned* mlist, bf16* parto, float* partml) {
    LAS unsigned char* Ks = C.lds; LAS unsigned char* Vs = C.lds + 32768;
    LAS float* relb = (LAS float*)(C.lds + 65536);
    LAS int* pre = (LAS int*)(C.lds + 73728);
    const int lane = C.lane, wave = C.wave, r32 = lane & 31, hi = lane >> 5;
    __syncthreads();
    build_relb(C, rel_bias, relb);
    {   int v[4], s = 0;
#pragma unroll
        for (int i = 0; i < 4; ++i) { v[i] = (int)((__hip_atomic_load(mcnt + 4 * C.tid + i, __ATOMIC_RELAXED, __HIP_MEMORY_SCOPE_AGENT) + 255u) >> 8); s += v[i]; }
        int inc = s;
#pragma unroll
        for (int o = 1; o < 64; o <<= 1) { const int t = __shfl_up(inc, o); if (lane >= o) inc += t; }
        if (lane == 63) pre[2056 + wave] = inc;
        __syncthreads();
        int base = 0; for (int w = 0; w < wave; ++w) base += pre[2056 + w];
        const int ex = base + inc - s;
        pre[4 * C.tid] = ex; pre[4 * C.tid + 1] = ex + v[0]; pre[4 * C.tid + 2] = ex + v[0] + v[1]; pre[4 * C.tid + 3] = ex + v[0] + v[1] + v[2];
        if (C.tid == NTHR - 1) pre[2048] = ex + s;
        __syncthreads();
    }
    const int total = pre[2048];
    for (int u = C.vcu; u < total; u += C.G) {
        int lo = 0, hi_ = 2048;
#pragma unroll
        for (int s = 0; s < 11; ++s) { const int mid = (lo + hi_) >> 1; if (pre[mid] <= u) lo = mid; else hi_ = mid; }
        const int bh = lo >> 5, j = lo & 31, b = bh >> 4, h = bh & 15, chunk = u - pre[lo];
        const int n = (int)__hip_atomic_load(mcnt + lo, __ATOMIC_RELAXED, __HIP_MEMORY_SCOPE_AGENT);
        const bf16* Kg = K + (size_t)(b * SEQ + j * 256) * D + h * 64; const bf16* Vg = V + (size_t)(b * SEQ + j * 256) * D + h * 64;
        v4u kreg[4], vreg[4];
#pragma unroll
        for (int t4 = 0; t4 < 4; ++t4) stage_load(Kg + (size_t)t4 * 64 * D, Vg + (size_t)t4 * 64 * D, wave, lane, kreg[t4], vreg[t4]);
        const int i = chunk * 256 + wave * 32 + r32; const bool valid = i < n;
        const unsigned ent = mlist[(size_t)bh * MLIST_PER_BH + mlist_off(j) + (valid ? i : chunk * 256)];
        const int tl = (int)(ent & 0xffffu), slot = (int)(ent >> 16);
        bf16x8 qr[4]; load_q(qr, Q + (size_t)(b * SEQ + tl) * D + h * 64, hi);
        __syncthreads();
#pragma unroll
        for (int t4 = 0; t4 < 4; ++t4) stage_store(Ks + t4 * 8192, Vs + t4 * 8192, wave, lane, kreg[t4], vreg[t4]);
        __syncthreads();
        AttnAcc A; acc_init(A);
        const bool lk = __any((tl - (j * 256 + 255)) < 128) != 0;
        MobaBias B{relb + h * 128, tl, j * 256, lk, false, relb[h * 128 + 127]};
#pragma unroll 1
        for (int t4 = 0; t4 < 4; ++t4) { B.kpos0 = j * 256 + 64 * t4; attn_tile(A, qr, Ks + t4 * 8192, Vs + t4 * 8192, r32, hi, lane, B); }
        const float lt = A.l + __shfl_xor(A.l, 32), inv = 1.f / lt;
        if (valid) {
            const size_t rowi = ((size_t)(b * SEQ + tl) * H + h) * 3 + slot;
            bf16* po = parto + rowi * 64;
#pragma unroll
            for (int g = 0; g < 4; ++g) {
                u32x2 w0, w1; w0.x = cvtpk(A.o0[4 * g] * inv, A.o0[4 * g + 1] * inv); w0.y = cvtpk(A.o0[4 * g + 2] * inv, A.o0[4 * g + 3] * inv);
                w1.x = cvtpk(A.o1[4 * g] * inv, A.o1[4 * g + 1] * inv); w1.y = cvtpk(A.o1[4 * g + 2] * inv, A.o1[4 * g + 3] * inv);
                *(GAS u32x2*)(po + 8 * g + 4 * hi) = w0; *(GAS u32x2*)(po + 32 + 8 * g + 4 * hi) = w1; }
            if (hi == 0) *(GAS f32x2*)(partml + rowi * 2) = (f32x2){A.m, lt};
        }
    }
}
__device__ __forceinline__ void ph_moba_own(const Ctx& C, const bf16* Q, const bf16* K, const bf16* V, const float* rel_bias, const bf16* parto, const float* partml, bf16* O) {
    LAS unsigned char* Ks = C.lds; LAS unsigned char* Vs = C.lds + 32768;
    LAS float* relb = (LAS float*)(C.lds + 65536);
    const int lane = C.lane, wave = C.wave, r32 = lane & 31, hi = lane >> 5;
    __syncthreads();
    build_relb(C, rel_bias, relb);
    for (int u = C.vcu; u < BATCH * H * NBLK; u += C.G) {
        const int bh = u >> 5, own = u & 31, b = bh >> 4, h = bh & 15;
        const bf16* Kg = K + (size_t)(b * SEQ + own * 256) * D + h * 64; const bf16* Vg = V + (size_t)(b * SEQ + own * 256) * D + h * 64;
        v4u kreg[4], vreg[4];
#pragma unroll
        for (int t4 = 0; t4 < 4; ++t4) stage_load(Kg + (size_t)t4 * 64 * D, Vg + (size_t)t4 * 64 * D, wave, lane, kreg[t4], vreg[t4]);
        const int tl = own * 256 + wave * 32 + r32;
        bf16x8 qr[4]; load_q(qr, Q + (size_t)(b * SEQ + tl) * D + h * 64, hi);
        __syncthreads();
#pragma unroll
        for (int t4 = 0; t4 < 4; ++t4) stage_store(Ks + t4 * 8192, Vs + t4 * 8192, wave, lane, kreg[t4], vreg[t4]);
        __syncthreads();
        AttnAcc A; acc_init(A);
        MobaBias B{relb + h * 128, tl, own * 256, true, false, 0.f};
        const int tlast = wave >> 1;
#pragma unroll 1
        for (int t4 = 0; t4 <= tlast; ++t4) { B.kpos0 = own * 256 + 64 * t4; B.causal = (t4 == tlast); attn_tile(A, qr, Ks + t4 * 8192, Vs + t4 * 8192, r32, hi, lane, B); }
        const float lt = A.l + __shfl_xor(A.l, 32);
        const int nv = own < 3 ? own : 3;
        const size_t rowi = ((size_t)(b * SEQ + tl) * H + h) * 3;
        float mi[3], li[3], M = A.m;
#pragma unroll
        for (int i = 0; i < 3; ++i) { mi[i] = NEG_INF; li[i] = 0.f; if (i < nv) { const f32x2 ml = *(const GAS f32x2*)(partml + (rowi + i) * 2); mi[i] = ml.x; li[i] = ml.y; M = fmaxf(M, ml.x); } }
        const float w0 = __builtin_amdgcn_exp2f(A.m - M); float den = w0 * lt;
#pragma unroll
        for (int r = 0; r < 16; ++r) { A.o0[r] *= w0; A.o1[r] *= w0; }
#pragma unroll
        for (int i = 0; i < 3; ++i) if (i < nv) {
            const float wi = li[i] * __builtin_amdgcn_exp2f(mi[i] - M); den += wi;
            const bf16* po = parto + (rowi + i) * 64;
#pragma unroll
            for (int g = 0; g < 4; ++g) { const u32x2 a = *(const GAS u32x2*)(po + 8 * g + 4 * hi), c = *(const GAS u32x2*)(po + 32 + 8 * g + 4 * hi);
                A.o0[4 * g] += wi * bflo(a.x); A.o0[4 * g + 1] += wi * bfhi(a.x); A.o0[4 * g + 2] += wi * bflo(a.y); A.o0[4 * g + 3] += wi * bfhi(a.y);
                A.o1[4 * g] += wi * bflo(c.x); A.o1[4 * g + 1] += wi * bfhi(c.x); A.o1[4 * g + 2] += wi * bflo(c.y); A.o1[4 * g + 3] += wi * bfhi(c.y); }
        }
        const float inv = 1.f / den;
        bf16* op = O + (size_t)(b * SEQ + tl) * D + h * 64;
#pragma unroll
        for (int g = 0; g < 4; ++g) {
            u32x2 w0_, w1_; w0_.x = cvtpk(A.o0[4 * g] * inv, A.o0[4 * g + 1] * inv); w0_.y = cvtpk(A.o0[4 * g + 2] * inv, A.o0[4 * g + 3] * inv);
            w1_.x = cvtpk(A.o1[4 * g] * inv, A.o1[4 * g + 1] * inv); w1_.y = cvtpk(A.o1[4 * g + 2] * inv, A.o1[4 * g + 3] * inv);
            *(GAS u32x2*)(op + 8 * g + 4 * hi) = w0_; *(GAS u32x2*)(op + 32 + 8 * g + 4 * hi) = w1_; }
    }
}

__device__ __forceinline__ void ph_scan(const Ctx& C, const float* logf, float* cum) {
    LAS float* wt = (LAS float*)C.lds;
    for (int bh = C.vcu; bh < BATCH * H; bh += C.G) {
        const int b = bh >> 4, h = bh & 15;
        float v[16], s = 0.f;
#pragma unroll
        for (int i = 0; i < 16; ++i) { v[i] = logf[(size_t)(b * SEQ + C.tid * 16 + i) * H + h]; s += v[i]; }
        float inc = s;
#pragma unroll
        for (int o = 1; o < 64; o <<= 1) { const float t = __shfl_up(inc, o); if (C.lane >= o) inc += t; }
        __syncthreads();
        if (C.lane == 63) wt[C.wave] = inc;
        __syncthreads();
        float run = inc - s; for (int w = 0; w < C.wave; ++w) run += wt[w];
#pragma unroll
        for (int i = 0; i < 16; ++i) { run += v[i]; cum[(size_t)bh * SEQ + C.tid * 16 + i] = run * LOG2E; }
    }
}
__device__ __forceinline__ void ph_fox(const Ctx& C, const bf16* Q, const bf16* K, const bf16* V, const float* cum, bf16* O) {
    constexpr int BUFB = 16384 + 256;
    const int lane = C.lane, wave = C.wave, r32 = lane & 31, hi = lane >> 5;
    __syncthreads();
    for (int idx = C.vcu; idx < BATCH * H * NBLK; idx += C.G) {
        const int rnd = idx >> 8, v = idx & 255, bh = v >> 2, s = v & 3, qb = (rnd & 1) ? (8 * (rnd >> 1) + 7 - s) : (8 * (rnd >> 1) + s);
        const int b = bh >> 4, h = bh & 15, NT = 4 * (qb + 1), tmax = 4 * qb + (wave >> 1);
        const bf16* Kg = K + (size_t)(b * SEQ) * D + h * 64; const bf16* Vg = V + (size_t)(b * SEQ) * D + h * 64; const float* cg = cum + (size_t)bh * SEQ;
        const int qrel = wave * 32 + r32;
        const float cq = cg[qb * 256 + qrel];
        bf16x8 qr[4]; load_q(qr, Q + (size_t)(b * SEQ + qb * 256 + qrel) * D + h * 64, hi);
        v4u kreg, vreg; float creg = 0.f;
        stage_load(Kg, Vg, wave, lane, kreg, vreg); if (wave == 0) creg = cg[lane];
        stage_store(C.lds, C.lds + 8192, wave, lane, kreg, vreg); if (wave == 0) ((LAS float*)(C.lds + 16384))[lane] = creg;
        __syncthreads();
        AttnAcc A; acc_init(A);
#pragma unroll 1
        for (int t = 0; t < NT; ++t) {
            LAS unsigned char* cur = C.lds + (t & 1) * BUFB; LAS unsigned char* nxt = C.lds + ((t + 1) & 1) * BUFB;
            if (t + 1 < NT) { stage_load(Kg + (size_t)(t + 1) * 64 * D, Vg + (size_t)(t + 1) * 64 * D, wave, lane, kreg, vreg); if (wave == 0) creg = cg[(t + 1) * 64 + lane]; }
            if (t <= tmax) { const FoxBias B{(const LAS float*)(cur + 16384), cq, qrel, t * 64 - qb * 256, t >= 4 * qb}; attn_tile(A, qr, cur, cur + 8192, r32, hi, lane, B); }
            if (t + 1 < NT) { stage_store(nxt, nxt + 8192, wave, lane, kreg, vreg); if (wave == 0) ((LAS float*)(nxt + 16384))[lane] = creg; }
            __syncthreads();
        }
        const float lt = A.l + __shfl_xor(A.l, 32), inv = 1.f / lt;
        bf16* op = O + (size_t)(b * SEQ + qb * 256 + qrel) * D + h * 64;
#pragma unroll
        for (int g = 0; g < 4; ++g) {
            u32x2 w0, w1; w0.x = cvtpk(A.o0[4 * g] * inv, A.o0[4 * g + 1] * inv); w0.y = cvtpk(A.o0[4 * g + 2] * inv, A.o0[4 * g + 3] * inv);
            w1.x = cvtpk(A.o1[4 * g] * inv, A.o1[4 * g + 1] * inv); w1.y = cvtpk(A.o1[4 * g + 2] * inv, A.o1[4 * g + 3] * inv);
            *(GAS u32x2*)(op + 8 * g + 4 * hi) = w0; *(GAS u32x2*)(op + 32 + 8 * g + 4 * hi) = w1; }
    }
}
__device__ __forceinline__ void ln_stats(f32x4 (&v)[4], float& rstd) {
    float s = 0.f;
#pragma unroll
    for (int j = 0; j < 4; ++j) s += (v[j].x + v[j].y) + (v[j].z + v[j].w);
    const float mean = wave_sum(s) * (1.f / D); float s2 = 0.f;
#pragma unroll
    for (int j = 0; j < 4; ++j) { v[j] = v[j] - mean; s2 += (v[j].x * v[j].x + v[j].y * v[j].y) + (v[j].z * v[j].z + v[j].w * v[j].w); }
    rstd = 1.f / sqrtf(wave_sum(s2) * (1.f / D) + LN_EPS);
}
__device__ __forceinline__ void ph_ln1(const Ctx& C, const float* z, const float* g, const float* bta, float* xres, bf16* xb, bf16* AR) {
    const int gw = C.vcu * NWAVES + C.wave, NGW = C.G * NWAVES, lane = C.lane;
    f32x4 gv[4], bv[4];
#pragma unroll
    for (int j = 0; j < 4; ++j) { gv[j] = *(const GAS f32x4*)(g + 4 * lane + 256 * j); bv[j] = *(const GAS f32x4*)(bta + 4 * lane + 256 * j); }
    for (int t = gw; t < T; t += NGW) {
        const GAS f32x4* zr = (const GAS f32x4*)(z + (size_t)t * D) + lane;
        f32x4 v[4];
#pragma unroll
        for (int j = 0; j < 4; ++j) v[j] = zr[64 * j];
        float rstd; ln_stats(v, rstd);
#pragma unroll
        for (int j = 0; j < 4; ++j) {
            const f32x4 y = v[j] * rstd * gv[j] + bv[j]; const int d = 4 * lane + 256 * j;
            *(GAS f32x4*)(xres + (size_t)t * D + d) = y;
            u32x2 hw; hw.x = cvtpk(y.x, y.y); hw.y = cvtpk(y.z, y.w);
            u32x2 lw; lw.x = cvtpk(y.x - bflo(hw.x), y.y - bfhi(hw.x)); lw.y = cvtpk(y.z - bflo(hw.y), y.w - bfhi(hw.y));
            *(GAS u32x2*)(xb + (size_t)t * D + d) = hw;
            *(GAS u32x2*)(AR + (size_t)t * 1536 + d) = hw;
            *(GAS u32x2*)(AR + (size_t)(T + t) * 1536 + 512 + d) = hw;
            if (j < 2) *(GAS u32x2*)(AR + (size_t)t * 1536 + 1024 + d) = lw; else *(GAS u32x2*)(AR + (size_t)(T + t) * 1536 + (d - 512)) = lw;
        }
    }
}
__device__ __forceinline__ void ph_route(const Ctx& C, const float* logp, const float* rbias, int* topi, float* gate, unsigned* ecnt) {
    LAS unsigned* hist = (LAS unsigned*)C.lds;
    const int gw = C.vcu * NWAVES + C.wave, NGW = C.G * NWAVES, lane = C.lane;
    __syncthreads();
    if (C.tid < NE) hist[C.tid] = 0u;
    __syncthreads();
    const f32x4 rb = *(const GAS f32x4*)(rbias + 4 * lane);
    for (int t = gw; t < T; t += NGW) {
        const f32x4 a = *(const GAS f32x4*)(logp + (size_t)t * NE + 4 * lane), b2 = *(const GAS f32x4*)(logp + (size_t)(T + t) * NE + 4 * lane);
        float s[4], c[4];
#pragma unroll
        for (int i = 0; i < 4; ++i) { const float lg = a[i] + b2[i]; s[i] = 1.f / (1.f + expf(-lg)); c[i] = s[i] + rb[i]; }
        float m1 = fmaxf(c[0], c[1]), m2 = fminf(c[0], c[1]);
        { const float x = c[2]; const float n1 = fmaxf(m1, x); m2 = fmaxf(m2, fminf(m1, x)); m1 = n1; }
        { const float x = c[3]; const float n1 = fmaxf(m1, x); m2 = fmaxf(m2, fminf(m1, x)); m1 = n1; }
#pragma unroll
        for (int o = 1; o < 8; o <<= 1) { const float o1 = __shfl_xor(m1, o), o2 = __shfl_xor(m2, o); const float n1 = fmaxf(m1, o1), n2 = fmaxf(fminf(m1, o1), fmaxf(m2, o2)); m1 = n1; m2 = n2; }
        const float gs = m1 + m2; const int mygrp = lane >> 3; int rk = 0;
#pragma unroll
        for (int g2 = 0; g2 < NGRP; ++g2) { const float og = __shfl(gs, 8 * g2); rk += (og > gs || (og == gs && g2 < mygrp)) ? 1 : 0; }
        const bool gsel = rk < 4;
#pragma unroll
        for (int i = 0; i < 4; ++i) if (!gsel) c[i] = NEG_INF;
        int myidx = 0; float myw = 0.f;
#pragma unroll 1
        for (int k = 0; k < TOPK; ++k) {
            float bv = c[0]; int bi = 4 * lane;
            if (c[1] > bv) { bv = c[1]; bi = 4 * lane + 1; }
            if (c[2] > bv) { bv = c[2]; bi = 4 * lane + 2; }
            if (c[3] > bv) { bv = c[3]; bi = 4 * lane + 3; }
#pragma unroll
            for (int o = 1; o < 64; o <<= 1) { const float ov = __shfl_xor(bv, o); const int oi = __shfl_xor(bi, o); if (ov > bv || (ov == bv && oi < bi)) { bv = ov; bi = oi; } }
            const int sub = bi & 3, own = bi >> 2;
            const float sv = sub == 0 ? s[0] : (sub == 1 ? s[1] : (sub == 2 ? s[2] : s[3]));
            const float w = __shfl(sv, own);
            if (lane == k) { myidx = bi; myw = w; }
            if (lane == own) { if (sub == 0) c[0] = NEG_INF; else if (sub == 1) c[1] = NEG_INF; else if (sub == 2) c[2] = NEG_INF; else c[3] = NEG_INF; }
        }
        const float wsum = wave_sum(lane < TOPK ? myw : 0.f);
        if (lane < TOPK) { topi[(size_t)t * TOPK + lane] = myidx; gate[(size_t)t * TOPK + lane] = myw / wsum * ROUTED_SCALE; (void)__hip_atomic_fetch_add(&hist[myidx], 1u, __ATOMIC_RELAXED, __HIP_MEMORY_SCOPE_WORKGROUP); }
    }
    __syncthreads();
    if (C.tid < NE) { const unsigned c = hist[C.tid]; if (c) __hip_atomic_fetch_add(ecnt + C.tid, c, __ATOMIC_RELAXED, __HIP_MEMORY_SCOPE_AGENT); }
}
__device__ __forceinline__ void ph_scatter(const Ctx& C, const unsigned* ecnt, unsigned* ecur, const int* topi, const float* gate, const bf16* xb, int* slotof, int* tokof, float* gslot, bf16* HS) {
    build_tpre(C, ecnt);
    const LAS int* tpre = (const LAS int*)(C.lds + TPRE_OFF);
    const int gw = C.vcu * NWAVES + C.wave, NGW = C.G * NWAVES, lane = C.lane;
    for (int t = gw; t < T; t += NGW) {
        int slot = 0;
        if (lane < TOPK) { const int e = topi[(size_t)t * TOPK + lane]; const unsigned pos = __hip_atomic_fetch_add(ecur + e, 1u, __ATOMIC_RELAXED, __HIP_MEMORY_SCOPE_AGENT);
            slot = tpre[e] * 256 + (int)pos; tokof[slot] = t; gslot[slot] = gate[(size_t)t * TOPK + lane]; slotof[(size_t)t * TOPK + lane] = slot; }
        const v4u r0 = *(const GAS v4u*)(xb + (size_t)t * D + lane * 8), r1 = *(const GAS v4u*)(xb + (size_t)t * D + 512 + lane * 8);
#pragma unroll
        for (int k = 0; k < TOPK; ++k) { const int sk = __shfl(slot, k); *(GAS v4u*)(HS + (size_t)sk * D + lane * 8) = r0; *(GAS v4u*)(HS + (size_t)sk * D + 512 + lane * 8) = r1; }
    }
    for (int e = C.vcu; e < NE; e += C.G) {
        const int cnt = (int)__hip_atomic_load(ecnt + e, __ATOMIC_RELAXED, __HIP_MEMORY_SCOPE_AGENT), s0 = tpre[e] * 256 + cnt, s1 = tpre[e + 1] * 256;
        for (int s = s0 + C.tid; s < s1; s += NTHR) { gslot[s] = 0.f; tokof[s] = -1; }
        const v4u zero = {0u, 0u, 0u, 0u};
        for (int i = C.tid; i < (s1 - s0) * 128; i += NTHR) *(GAS v4u*)(HS + (size_t)(s0 + (i >> 7)) * D + (i & 127) * 8) = zero;
    }
}
__device__ __forceinline__ float log_sigmoid(float z) { return fminf(z, 0.f) - log1pf(expf(-fabsf(z))); }
__device__ __forceinline__ void ph_combine(const Ctx& C, const float* z2, const bf16* SO, const int* slotof, const float* g, const float* bta, float* xres, bf16* xb, float* dout,
                                           const float* fox_in, const float* fox_bf, float* logf) {
    const int gw = C.vcu * NWAVES + C.wave, NGW = C.G * NWAVES, lane = C.lane;
    LAS float* wfT = (LAS float*)C.lds;
    __syncthreads();
    if (logf) { for (int i = C.tid; i < D * H; i += NTHR) { const int d = i >> 4, h = i & 15; wfT[h * D + d] = fox_in[(size_t)d * FOXW + 3 * D + h]; } }
    __syncthreads();
    f32x4 gv[4], bv[4];
#pragma unroll
    for (int j = 0; j < 4; ++j) { gv[j] = *(const GAS f32x4*)(g + 4 * lane + 256 * j); bv[j] = *(const GAS f32x4*)(bta + 4 * lane + 256 * j); }
    for (int t = gw; t < T; t += NGW) {
        const GAS f32x4* zr = (const GAS f32x4*)(z2 + (size_t)t * D) + lane;
        f32x4 v[4];
#pragma unroll
        for (int j = 0; j < 4; ++j) v[j] = zr[64 * j];
        const int sl = lane < TOPK ? slotof[(size_t)t * TOPK + lane] : 0;
#pragma unroll
        for (int k = 0; k < TOPK; ++k) { const int sk = __shfl(sl, k); const bf16* row = SO + (size_t)sk * D + 4 * lane;
#pragma unroll
            for (int j = 0; j < 4; ++j) { const u32x2 w = *(const GAS u32x2*)(row + 256 * j); v[j].x += bflo(w.x); v[j].y += bfhi(w.x); v[j].z += bflo(w.y); v[j].w += bfhi(w.y); } }
        float rstd; ln_stats(v, rstd);
        f32x4 y[4];
#pragma unroll
        for (int j = 0; j < 4; ++j) {
            y[j] = v[j] * rstd * gv[j] + bv[j]; const int d = 4 * lane + 256 * j;
            *(GAS f32x4*)(xres + (size_t)t * D + d) = y[j];
            if (dout) *(GAS f32x4*)(dout + (size_t)t * D + d) = y[j];
            u32x2 hw; hw.x = cvtpk(y[j].x, y[j].y); hw.y = cvtpk(y[j].z, y[j].w);
            *(GAS u32x2*)(xb + (size_t)t * D + d) = hw;
        }
        if (logf) {
            float acc[16];
#pragma unroll
            for (int h = 0; h < 16; ++h) { float a = 0.f;
#pragma unroll
                for (int j = 0; j < 4; ++j) { const f32x4 w = *(const LAS f32x4*)(wfT + h * D + 4 * lane + 256 * j); a += y[j].x * w.x; a += y[j].y * w.y; a += y[j].z * w.z; a += y[j].w * w.w; }
                acc[h] = a; }
            float a8[8], a4[4], a2[2], a1;
            { const bool bit = (lane >> 5) & 1;
#pragma unroll
              for (int i = 0; i < 8; ++i) { const float send = bit ? acc[i] : acc[i + 8]; const float recv = __shfl_xor(send, 32); a8[i] = (bit ? acc[i + 8] : acc[i]) + recv; } }
            { const bool bit = (lane >> 4) & 1;
#pragma unroll
              for (int i = 0; i < 4; ++i) { const float send = bit ? a8[i] : a8[i + 4]; const float recv = __shfl_xor(send, 16); a4[i] = (bit ? a8[i + 4] : a8[i]) + recv; } }
            { const bool bit = (lane >> 3) & 1;
#pragma unroll
              for (int i = 0; i < 2; ++i) { const float send = bit ? a4[i] : a4[i + 2]; const float recv = __shfl_xor(send, 8); a2[i] = (bit ? a4[i + 2] : a4[i]) + recv; } }
            { const bool bit = (lane >> 2) & 1; const float send = bit ? a2[0] : a2[1]; const float recv = __shfl_xor(send, 4); a1 = (bit ? a2[1] : a2[0]) + recv; }
            a1 += __shfl_xor(a1, 2); a1 += __shfl_xor(a1, 1);
            const int hh = ((lane >> 5) & 1) * 8 + ((lane >> 4) & 1) * 4 + ((lane >> 3) & 1) * 2 + ((lane >> 2) & 1);
            if ((lane & 3) == 0) logf[(size_t)t * H + hh] = log_sigmoid(a1 + fox_bf[hh]);
        }
    }
}
#ifndef MK_MULTI
#define MK_MULTI 0
#endif
constexpr int NPH = 27;
struct Args { const float* in[19]; float* out; unsigned char* ws; int ph_lo, ph_hi; };

__global__ void __launch_bounds__(NTHR, 2) mk_fwd(Args args) {
    extern __shared__ __attribute__((aligned(16))) unsigned char lds_raw[];
    Ctx C;
    C.lds = (LAS unsigned char*)lds_raw;
    C.tid = threadIdx.x; C.lane = C.tid & 63; C.wave = __builtin_amdgcn_readfirstlane(C.tid >> 6);
    C.G = gridDim.x; { const int bx = blockIdx.x; C.vcu = (C.G % 8 == 0) ? (bx % 8) * (C.G / 8) + bx / 8 : bx; }
    LAS unsigned long long* PTAB = (LAS unsigned long long*)(C.lds + PTAB_OFF);
    if (C.tid == 0) {
#pragma unroll
        for (int i = 0; i < 19; ++i) PTAB[i] = (unsigned long long)(uintptr_t)args.in[i];
        PTAB[19] = (unsigned long long)(uintptr_t)args.out; PTAB[20] = (unsigned long long)(uintptr_t)args.ws;
    }
    for (int u = C.tid; u < (PTAB_OFF - LDSCTL_OFF) / 4; u += NTHR) ((LAS unsigned*)(C.lds + LDSCTL_OFF))[u] = 0u;
    __syncthreads();
#define PIN(i) ((const float*)ldptr(PTAB, (i)))
#define WSP() ((unsigned char*)ldptr(PTAB, 20))
    XcdBarrier bar; bar.bar = (unsigned*)(args.ws + WS_CTL) + CW_BAR; bar.x = 0; bar.st = nullptr;
    if (!MK_MULTI) bar = xcd_barrier_post((unsigned*)(args.ws + WS_CTL) + CW_BAR, (volatile LAS unsigned*)(C.lds + MISC_OFF) + 8);
    const int lo = args.ph_lo, hi = args.ph_hi;
#ifndef MK_PH_MASK
#define MK_PH_MASK 0xFFFFFFFFu
#endif
#define PHON(b) (((MK_PH_MASK) >> (b)) & 1u)
#define IN(k) (lo <= (k) && (k) < hi)
#define SEAM(k) do { if ((k) + 1 < hi) xcd_barrier(bar); } while (0)
#define OPAQ(v) asm volatile("" : "+s"(v))
#define LC() asm volatile("" : "+v"(C.tid), "+v"(C.lane))

    if (PHON(0) && IN(0)) { LC();
        unsigned char* ws = WSP();
        SmallW W{PIN(2), PIN(3), PIN(4), PIN(6), PIN(11), PIN(16), PIN(17), PIN(18),
                 (bf16*)(ws + WS_WMI), (bf16*)(ws + WS_WMO), (bf16*)(ws + WS_WFI), (bf16*)(ws + WS_WFO), (bf16*)(ws + WS_WR), (bf16*)(ws + WS_WSGU), (bf16*)(ws + WS_WSDN)};
        conv_small(C, W);
        to_bf16_rows(C, PIN(0), (bf16*)(ws + WS_XB));
        conv_experts(C, PIN(13), PIN(14), PIN(15), 0, (bf16*)(ws + WS_WEGU), (bf16*)(ws + WS_WEDN));
        SEAM(0);
    }
#pragma unroll 1
    for (int l = 0; l < 2; ++l) {
        const int pb = 1 + 13 * l;
        if (PHON(1) && IN(pb + 0)) { LC();
            unsigned char* ws = WSP();
            if (PHON(15) && l == 1) ph_scan(C, (const float*)(ws + WS_LOGF), (float*)(ws + WS_CUM));
            __syncthreads();
            int kk = D; OPAQ(kk);
            pg8::Gemm g{(const bf16*)(ws + WS_XB), (const bf16*)(ws + (l == 0 ? WS_WMI : WS_WFI)), T, 3 * D, kk}; pg8::StaticOrder S; S.init(T, 3 * D, C.G, (int)blockIdx.x);
            pg8::EpiBf16<0> E{(bf16*)(ws + WS_Q), D, nullptr, D, (size_t)(WS_K - WS_Q) / 2, C2};
            pg8::gemm_phase<pg8::EpiBf16<0>, pg8::StaticOrder, true, true>(C.lds, g, S, E);
            SEAM(pb + 0);
        }
        if (l == 0) {
            if (PHON(2) && IN(pb + 1)) { LC(); unsigned char* ws = WSP(); ph_kmean(C, (const bf16*)(ws + WS_K), (float*)(ws + WS_KMEAN)); SEAM(pb + 1); }
            if (PHON(3) && IN(pb + 2)) { LC(); unsigned char* ws = WSP(); ph_select(C, (const bf16*)(ws + WS_Q), (const float*)(ws + WS_KMEAN), (unsigned*)(ws + WS_CTL) + CW_MCNT, (unsigned*)(ws + WS_MLIST)); SEAM(pb + 2); }
            if (PHON(4) && IN(pb + 3)) { LC(); unsigned char* ws = WSP(); ph_moba_part(C, (const bf16*)(ws + WS_Q), (const bf16*)(ws + WS_K), (const bf16*)(ws + WS_V), PIN(1), (const unsigned*)(ws + WS_CTL) + CW_MCNT, (const unsigned*)(ws + WS_MLIST), (bf16*)(ws + WS_PARTO), (float*)(ws + WS_PARTML)); SEAM(pb + 3); }
            if (PHON(5) && IN(pb + 4)) { LC(); unsigned char* ws = WSP(); ph_moba_own(C, (const bf16*)(ws + WS_Q), (const bf16*)(ws + WS_K), (const bf16*)(ws + WS_V), PIN(1), (const bf16*)(ws + WS_PARTO), (const float*)(ws + WS_PARTML), (bf16*)(ws + WS_O)); SEAM(pb + 4); }
        } else {
            if (PHON(6) && IN(pb + 4)) { LC(); unsigned char* ws = WSP(); ph_fox(C, (const bf16*)(ws + WS_Q), (const bf16*)(ws + WS_K), (const bf16*)(ws + WS_V), (const float*)(ws + WS_CUM), (bf16*)(ws + WS_O)); SEAM(pb + 4); }
        }
        if (PHON(7) && IN(pb + 5)) { LC();
            unsigned char* ws = WSP();
            __syncthreads();
            int kk = D; OPAQ(kk);
            pg8::Gemm g{(const bf16*)(ws + WS_O), (const bf16*)(ws + (l == 0 ? WS_WMO : WS_WFO)), T, D, kk}; pg8::StaticOrder S; S.init(T, D, C.G, (int)blockIdx.x);
            EpiF32<false> E{(float*)(ws + WS_Z), l == 0 ? PIN(0) : (const float*)(ws + WS_XRES), D, DN_ALPHA};
            pg8::gemm_phase<EpiF32<false>, pg8::StaticOrder, true, true>(C.lds, g, S, E);
            SEAM(pb + 5);
        }
        if (PHON(8) && IN(pb + 6)) { LC(); unsigned char* ws = WSP(); ph_ln1(C, (const float*)(ws + WS_Z), PIN(7) + l * D, PIN(8) + l * D, (float*)(ws + WS_XRES), (bf16*)(ws + WS_XB), (bf16*)(ws + WS_AR)); SEAM(pb + 6); }
        if (PHON(9) && IN(pb + 7)) { LC();
            __syncthreads();
            if (PHON(16)) { unsigned char* ws = WSP(); int kk = 1536; OPAQ(kk);
              pg8::Gemm g{(const bf16*)(ws + WS_AR), (const bf16*)(ws + WS_WR) + (size_t)l * (512 * 1536), 2 * T, 512, kk}; RouterOrder S{C.vcu, C.G}; EpiF32<true> E{(float*)(ws + WS_LOGP), nullptr, NE, 0.f};
              pg8::gemm_phase<EpiF32<true>, RouterOrder, true, true>(C.lds, g, S, E); }
            __syncthreads();
            if (PHON(17)) { unsigned char* ws = WSP(); int kk = D; OPAQ(kk);
              pg8::Gemm g{(const bf16*)(ws + WS_XB), (const bf16*)(ws + WS_WSGU) + (size_t)l * (512 * 1024), T, 512, kk}; pg8::StaticOrder S; S.init(T, 512, C.G, (int)blockIdx.x); EpiSwiGLU E{(bf16*)(ws + WS_ACTSH), nullptr};
              pg8::gemm_phase<EpiSwiGLU, pg8::StaticOrder, true, true>(C.lds, g, S, E); }
            SEAM(pb + 7);
        }
        if (PHON(10) && IN(pb + 8)) { LC(); unsigned char* ws = WSP(); ph_route(C, (const float*)(ws + WS_LOGP), PIN(12) + l * NE, (int*)(ws + WS_TOPI), (float*)(ws + WS_GATE), (unsigned*)(ws + WS_CTL) + CW_ECNT + l * NE); SEAM(pb + 8); }
        if (PHON(11) && IN(pb + 9)) { LC(); unsigned char* ws = WSP(); ph_scatter(C, (const unsigned*)(ws + WS_CTL) + CW_ECNT + l * NE, (unsigned*)(ws + WS_CTL) + CW_ECUR + l * NE, (const int*)(ws + WS_TOPI), (const float*)(ws + WS_GATE), (const bf16*)(ws + WS_XB),
                                                                            (int*)(ws + WS_SLOTOF), (int*)(ws + WS_TOKOF), (float*)(ws + WS_GSLOT), (bf16*)(ws + WS_HS)); SEAM(pb + 9); }
        if (PHON(12) && IN(pb + 10)) { LC();
            unsigned char* ws = WSP();
            build_tpre(C, (const unsigned*)(ws + WS_CTL) + CW_ECNT + l * NE);
            int kk = D; OPAQ(kk);
            pg8::Gemm g{(const bf16*)(ws + WS_HS), (const bf16*)(ws + WS_WEGU), NSLOT_MAX, NE * 512, kk}; ExpertOrder<1> S{C.vcu, C.G, (const LAS int*)(C.lds + TPRE_OFF)}; EpiSwiGLU E{(bf16*)(ws + WS_ACT), (const float*)(ws + WS_GSLOT)};
            pg8::gemm_phase<EpiSwiGLU, ExpertOrder<1>, true, true>(C.lds, g, S, E);
            SEAM(pb + 10);
        }
        if (PHON(13) && IN(pb + 11)) { LC();
            { unsigned char* ws = WSP(); build_tpre(C, (const unsigned*)(ws + WS_CTL) + CW_ECNT + l * NE); }
            if (PHON(18)) { unsigned char* ws = WSP(); int kk = DE; OPAQ(kk);
              pg8::Gemm g{(const bf16*)(ws + WS_ACT), (const bf16*)(ws + WS_WEDN), NSLOT_MAX, NE * 1024, kk}; ExpertOrder<2> S{C.vcu, C.G, (const LAS int*)(C.lds + TPRE_OFF)}; EpiDown E{(bf16*)(ws + WS_HS)};
              pg8::gemm_phase<EpiDown, ExpertOrder<2>, true, true>(C.lds, g, S, E); }
            __syncthreads();
            if (PHON(19)) { unsigned char* ws = WSP(); int kk = DE; OPAQ(kk);
              pg8::Gemm g{(const bf16*)(ws + WS_ACTSH), (const bf16*)(ws + WS_WSDN) + (size_t)l * (1024 * 256), T, D, kk}; pg8::StaticOrder S; S.init(T, D, C.G, (int)blockIdx.x); EpiF32<false> E{(float*)(ws + WS_Z), (const float*)(ws + WS_XRES), D, DN_ALPHA};
              pg8::gemm_phase<EpiF32<false>, pg8::StaticOrder, true, true>(C.lds, g, S, E); }
            SEAM(pb + 11);
        }
        if (PHON(14) && IN(pb + 12)) { LC();
            { unsigned char* ws = WSP();
              ph_combine(C, (const float*)(ws + WS_Z), (const bf16*)(ws + WS_HS), (const int*)(ws + WS_SLOTOF), PIN(9) + l * D, PIN(10) + l * D, (float*)(ws + WS_XRES), (bf16*)(ws + WS_XB), l == 1 ? (float*)ldptr(PTAB, 19) : nullptr,
                         PIN(4), PIN(5), l == 0 ? (float*)(ws + WS_LOGF) : nullptr); }
            if (l == 0) { unsigned char* ws = WSP(); __syncthreads(); conv_experts(C, PIN(13), PIN(14), PIN(15), 1, (bf16*)(ws + WS_WEGU), (bf16*)(ws + WS_WEDN)); }
            SEAM(pb + 12);
        }
    }
#undef IN
#undef SEAM
#undef PIN
#undef WSP
#undef OPAQ
}
}

extern "C" void kernel_launch(void* const* d_in, const int* in_sizes, int n_in, void* d_out, int out_size, void* d_ws, size_t ws_size, hipStream_t stream) {
    using namespace mk;
    static int grid = 0;
    if (grid == 0) {
        if (n_in != 19 || in_sizes[0] != T * D || out_size != T * D || ws_size < WS_END) { fprintf(stderr, "kernel_launch: unexpected problem shape (n_in %d, in0 %d, out %d, ws %zu < %zu)\n", n_in, n_in > 0 ? in_sizes[0] : -1, out_size, ws_size, (size_t)WS_END); grid = -1; return; }
        int dev = 0, cus = 0, per_cu = 0;
        if (hipGetDevice(&dev) != hipSuccess || hipDeviceGetAttribute(&cus, hipDeviceAttributeMultiprocessorCount, dev) != hipSuccess) { grid = -1; return; }
        if (hipFuncSetAttribute((const void*)mk_fwd, hipFuncAttributeMaxDynamicSharedMemorySize, LDS_BYTES) != hipSuccess) { fprintf(stderr, "kernel_launch: hipFuncSetAttribute failed\n"); grid = -1; return; }
        if (hipOccupancyMaxActiveBlocksPerMultiprocessor(&per_cu, (const void*)mk_fwd, NTHR, LDS_BYTES) != hipSuccess || per_cu < 1) fprintf(stderr, "kernel_launch: occupancy query reports %d\n", per_cu);
        (void)hipGetLastError();
        grid = cus;
    }
    if (grid < 0) return;
    if (hipMemsetAsync((char*)d_ws + WS_CTL, 0, CTL_ZERO_BYTES, stream) != hipSuccess) return;
    Args a{};
    for (int i = 0; i < 19; ++i) a.in[i] = (const float*)d_in[i];
    a.out = (float*)d_out; a.ws = (unsigned char*)d_ws;
#if MK_MULTI
    for (int p = 0; p < NPH; ++p) {
        if (p >= 15 && p <= 17) continue;
        a.ph_lo = p; a.ph_hi = p + 1;
        hipLaunchKernelGGL(mk_fwd, dim3(grid), dim3(NTHR), LDS_BYTES, stream, a);
    }
#else
    a.ph_lo = 0; a.ph_hi = NPH;
    hipLaunchKernelGGL(mk_fwd, dim3(grid), dim3(NTHR), LDS_BYTES, stream, a);
#endif
    const hipError_t le = hipPeekAtLastError();
    if (le != hipSuccess) fprintf(stderr, "kernel_launch: launch failed: %s\n", hipGetErrorName(le));
}
```

```cpp
#include <hip/hip_runtime.h>
#include <cstdio>
#include <cstdint>
namespace pg8 {
#define PG8_LAS __attribute__((address_space(3)))
typedef unsigned short bf16_t;
typedef short bf16x8 __attribute__((ext_vector_type(8)));
typedef float f32x4 __attribute__((ext_vector_type(4)));
typedef unsigned u32x4 __attribute__((ext_vector_type(4)));
typedef int i32x4 __attribute__((ext_vector_type(4)));
typedef int i32x8 __attribute__((ext_vector_type(8)));
__device__ __forceinline__ i32x8 cat8(bf16x8 a, bf16x8 b) { return __builtin_shufflevector(__builtin_bit_cast(i32x4, a), __builtin_bit_cast(i32x4, b), 0, 1, 2, 3, 4, 5, 6, 7); }
constexpr int BM = 256, BK = 64, HALF = 128, HTB = HALF * BK * 2  , STAGE_BYTES = 8 * HTB, NXCD = 8, WGM = 8;

__host__ __device__ __forceinline__ int lds_byte(int r, int c) { const int st = (r >> 4) * 2 + (c >> 5), rr = r & 15, cc = c & 31, ob = rr * 64 + cc * 2; return st * 1024 + (ob ^ (((ob >> 9) & 1) << 5)); }
__host__ __device__ __forceinline__ void stage_rc(int b, int& R, int& C) { const int st = b / 1024, sb = b % 1024, swz = sb ^ (((sb >> 9) & 1) << 5); R = (st >> 1) * 16 + swz / 64; C = (st & 1) * 32 + (swz % 64) / 2; }
__host__ __device__ __forceinline__ int perm32(int rho) { const int n = rho >> 4, i = rho & 15; return 8 * (i >> 2) + 4 * n + (i & 3); }

struct Unit { int pm, pn; int hf = 0; };
struct Gemm { const bf16_t* A; const bf16_t* Bt; int M, N, K; const int* arow = nullptr; };

struct StaticOrder {
    int nM, nN, nwg, G, c;
    __host__ __device__ void init(int M, int N, int G_, int c_) { nM = M / BM; nN = N / BM; nwg = nM * nN; G = G_; c = c_; }
    __host__ __device__ bool next(int i, Unit& u) const {
        const long L = (long)i * G + c; if (L >= nwg) return false;
        int wgid = (int)L; { const int q = nwg / NXCD, r = nwg % NXCD, xcd = wgid % NXCD, off = wgid / NXCD; wgid = (xcd < r ? xcd * (q + 1) : r * (q + 1) + (xcd - r) * q) + off; }
        const int nig = WGM * nN, gid = wgid / nig, fm = gid * WGM, gsz = (nM - fm) < WGM ? (nM - fm) : WGM;
        u.pm = fm + ((wgid % nig) % gsz); u.pn = (wgid % nig) / gsz; return true;
    }
    __device__ __forceinline__ void a_ready(const Unit&) const {}
    __device__ __forceinline__ void done(const Unit&) const {}
};

__device__ __forceinline__ unsigned cvt_pk_bf16(float lo, float hi) { unsigned r; asm volatile("v_cvt_pk_bf16_f32 %0, %1, %2" : "=v"(r) : "v"(lo), "v"(hi)); return r; }
typedef float f32x2 __attribute__((ext_vector_type(2)));
__device__ __forceinline__ f32x2 gelu_pk(f32x2 v) {
    const f32x2 av = __builtin_elementwise_abs(v), d = av * 0.2316418882f + 1.0f;
    f32x2 t; t.x = __builtin_amdgcn_rcpf(d.x); t.y = __builtin_amdgcn_rcpf(d.y);
    f32x2 q = t * 0.5307027145f + (-0.7265760135f); q = q * t + 0.7107068705f; q = q * t + (-0.142248368f); q = q * t + 0.127414796f; q = q * t;
    const f32x2 s = (v * v) * (-0.72134752044f);
    f32x2 e; e.x = __builtin_amdgcn_exp2f(s.x); e.y = __builtin_amdgcn_exp2f(s.y);
    const f32x2 m = v * (q * e), r = v - m;
    f32x2 o; o.x = v.x < 0.f ? m.x : r.x; o.y = v.y < 0.f ? m.y : r.y; return o;
}

template <int ACT  > struct EpiBf16 {
    static constexpr bool PERM = true, AFTER_DRAIN = false; static_assert(ACT == 0 || ACT == 1, "EpiBf16: ACT is 0 (none) or 1 (gelu_pk)");
    bf16_t* O; int ldc; const float* bias; int split_cols; size_t split_stride; float scale0;
    __device__ __forceinline__ void operator()(const f32x4 (&acc)[2][2][4][2], const Unit& u, int wr, int wc, int fr, int fq) const {
        const int ln = fr + 16 * fq, src4 = ((ln >> 2) + 16 * (ln & 3)) << 2, fr2 = ln >> 2, fq2 = ln & 3;
        const int row0 = u.pm * BM + wr * 64 + fr2; int colt = u.pn * BM; bf16_t* base = O;
        float sc = 1.f; if (split_cols) { const int t = colt / split_cols; base += (size_t)t * split_stride; colt -= t * split_cols; if (t == 0) sc = scale0; }
        const int col0 = colt + wc * 32 + 8 * fq2, bcol0 = u.pn * BM + wc * 32 + 8 * fq;
        f32x4 bv[2][2];
#pragma unroll
        for (int bj = 0; bj < 2; ++bj)
#pragma unroll
            for (int n = 0; n < 2; ++n) bv[bj][n] = bias ? *(const f32x4*)(bias + bcol0 + bj * HALF + 4 * n) : (f32x4){0.f, 0.f, 0.f, 0.f};
#pragma unroll
        for (int ai = 0; ai < 2; ++ai)
#pragma unroll
            for (int m = 0; m < 4; ++m) { bf16_t* rowp = base + (size_t)(row0 + ai * HALF + m * 16) * ldc + col0;
#pragma unroll
                for (int bj = 0; bj < 2; ++bj) { f32x4 v0 = acc[ai][bj][m][0] + bv[bj][0], v1 = acc[ai][bj][m][1] + bv[bj][1];
                    if (ACT == 1) { f32x2 a = gelu_pk((f32x2){v0[0], v0[1]}), b = gelu_pk((f32x2){v0[2], v0[3]}), c = gelu_pk((f32x2){v1[0], v1[1]}), d = gelu_pk((f32x2){v1[2], v1[3]});
                        v0 = (f32x4){a.x, a.y, b.x, b.y}; v1 = (f32x4){c.x, c.y, d.x, d.y}; }
                    v0 = v0 * sc; v1 = v1 * sc; u32x4 w; w.x = cvt_pk_bf16(v0[0], v0[1]); w.y = cvt_pk_bf16(v0[2], v0[3]); w.z = cvt_pk_bf16(v1[0], v1[1]); w.w = cvt_pk_bf16(v1[2], v1[3]);
                    w.x = (unsigned)__builtin_amdgcn_ds_bpermute(src4, (int)w.x); w.y = (unsigned)__builtin_amdgcn_ds_bpermute(src4, (int)w.y); w.z = (unsigned)__builtin_amdgcn_ds_bpermute(src4, (int)w.z); w.w = (unsigned)__builtin_amdgcn_ds_bpermute(src4, (int)w.w);
                    *(u32x4*)(rowp + bj * HALF) = w; } }
    }
};
template <class Epi, class Sched, bool ALIGN_EPI = false, bool SP2 = false, bool GATHER = false, bool F8 = false>
__device__ __forceinline__ void gemm_phase(PG8_LAS unsigned char* lds, const Gemm g, const Sched& S, const Epi& E, const int tid_in) {
    const int tid = tid_in,
              wid = __builtin_amdgcn_readfirstlane(tid >> 6), lane = tid & 63, wr = wid >> 2, wc = wid & 3, fr = lane & 15, fq = lane >> 4;
    const int K = g.K, nt = K / BK;
    unsigned voffA[2], voffB[2], voffA1[2], nvA0[2], nvA1[2]; int gR[2], gC[2];
#pragma unroll
    for (int i = 0; i < 2; ++i) { int R, C; stage_rc(tid * 16 + i * 8192, R, C); const int Rb = Epi::PERM ? ((R & ~31) + perm32(R & 31)) : R;
        voffA[i] = (unsigned)(R * K + C) * 2u; voffB[i] = (unsigned)(Rb * K + C) * 2u; voffA1[i] = voffA[i]; nvA0[i] = voffA[i]; nvA1[i] = voffA[i]; gR[i] = R; gC[i] = C; }
    const size_t kstep = (size_t)(BK * 2);
    const size_t hstep = (size_t)HALF * K * 2;
    const size_t tstep = 2 * hstep;
    const unsigned ldsw = (unsigned)wid * 1024u;
    const unsigned ldsu = (unsigned)__builtin_amdgcn_readfirstlane((int)((unsigned)(uintptr_t)lds + ldsw));
    const int aoff = lds_byte(wr * 64 + fr, fq * 8), boff = lds_byte(wc * 32 + fr, fq * 8);
#define PG8_SA(b, h) (((b) * 2 + (h)) * HTB)
#define PG8_SB(b, h) ((4 + (b) * 2 + (h)) * HTB)
#define PG8_DMA(sbase, vo, ldsdst) do { unsigned keep_; asm volatile("s_mov_b32 %0, m0\n\ts_mov_b32 m0, %3\n\ts_nop 0\n\tglobal_load_lds_dwordx4 %1, %2\n\ts_mov_b32 m0, %0" : "=&s"(keep_) : "v"(vo), "s"(sbase), "s"(ldsdst) : "memory"); } while (0)
#define PG8_STAGE(bufoff, gbase, voff) do { _Pragma("unroll") for (int _i = 0; _i < 2; ++_i) PG8_DMA((const char*)(gbase), (voff)[_i], ldsu + (unsigned)((bufoff) + _i * 8192)); } while (0)
#define PG8_GROW(dst0, dst1, pm_) do { if constexpr (GATHER) { _Pragma("unroll") for (int _i = 0; _i < 2; ++_i) { const int r0_ = g.arow[(pm_) * 256 + gR[_i]], r1_ = g.arow[(pm_) * 256 + 128 + gR[_i]]; \
        dst0[_i] = (unsigned)(r0_ * K + gC[_i]) * 2u; dst1[_i] = (unsigned)(r1_ * K + gC[_i]) * 2u; } } } while (0)
#define PG8_STAGE_A(bufoff, h, koff, nx) do { if constexpr (GATHER) { _Pragma("unroll") for (int _i = 0; _i < 2; ++_i) { const unsigned vo_ = (nx) ? ((h) ? nvA1[_i] : nvA0[_i]) : ((h) ? voffA1[_i] : voffA[_i]); \
        PG8_DMA((const char*)g.A + (koff), vo_, ldsu + (unsigned)((bufoff) + _i * 8192)); } } \
    else { PG8_STAGE(bufoff, ((nx) ? nA : cA) + (koff) + ((h) ? hstep : 0), voffA); } } while (0)
#define PG8_LDA(dst, b, h) do { _Pragma("unroll") for (int m = 0; m < 4; ++m) _Pragma("unroll") for (int k = 0; k < 2; ++k) dst[m][k] = *(const PG8_LAS bf16x8*)(lds + PG8_SA(b, h) + aoff + m * 2048 + k * 1024); } while (0)
#define PG8_LDB(dst, b, h) do { _Pragma("unroll") for (int n = 0; n < 2; ++n) _Pragma("unroll") for (int k = 0; k < 2; ++k) dst[n][k] = *(const PG8_LAS bf16x8*)(lds + PG8_SB(b, h) + boff + n * 2048 + k * 1024); } while (0)
#define PG8_MMA(ai, bj, At, Bt) do { __builtin_amdgcn_s_setprio(1); _Pragma("unroll") for (int m = 0; m < 4; ++m) _Pragma("unroll") for (int n = 0; n < 2; ++n) { \
        if constexpr (F8) acc[ai][bj][m][n] = __builtin_amdgcn_mfma_scale_f32_16x16x128_f8f6f4(cat8(Bt[n][0], Bt[n][1]), cat8(At[m][0], At[m][1]), acc[ai][bj][m][n], 0, 0, 0, 0, 0, 0); \
        else { _Pragma("unroll") for (int k = 0; k < 2; ++k) acc[ai][bj][m][n] = __builtin_amdgcn_mfma_f32_16x16x32_bf16(Bt[n][k], At[m][k], acc[ai][bj][m][n], 0, 0, 0); } } __builtin_amdgcn_s_setprio(0); } while (0)
#define PG8_WAIT_V(n) asm volatile("s_waitcnt vmcnt(" #n ")" ::: "memory")
#define PG8_WAIT_L(n) asm volatile("s_waitcnt lgkmcnt(" #n ")" ::: "memory")
#define PG8_BAR __builtin_amdgcn_s_barrier()
#define PG8_SCHED __builtin_amdgcn_sched_barrier(0)
    Unit cur, nxt; int ui = 0;
    if (!S.next(0, cur)) return;
    f32x4 acc[2][2][4][2];
    float zz = 0.f; asm volatile("" : "+v"(zz));
#pragma unroll
    for (int a = 0; a < 2; ++a)
#pragma unroll
        for (int b = 0; b < 2; ++b)
#pragma unroll
            for (int m = 0; m < 4; ++m)
#pragma unroll
                for (int n = 0; n < 2; ++n) acc[a][b][m][n] = (f32x4){zz, zz, zz, zz};
    bf16x8 At[4][2], B0[2][2], B1[2][2];
    const char* cA = (const char*)g.A + (size_t)cur.pm * tstep; const char* cB = (const char*)g.Bt + (size_t)cur.pn * tstep;
    S.a_ready(cur);
    PG8_GROW(voffA, voffA1, cur.pm);
    const char* nA = cA; const char* nB = cB;
    if constexpr (SP2) {
        PG8_STAGE(PG8_SB(0, 0), cB, voffB); PG8_STAGE(PG8_SB(0, 1), cB + hstep, voffB); PG8_STAGE_A(PG8_SA(0, 0), 0, 0, false); PG8_STAGE_A(PG8_SA(0, 1), 1, 0, false);
        if (wr == 1) PG8_BAR;
        PG8_WAIT_V(2); PG8_BAR;
        PG8_STAGE(PG8_SB(1, 0), cB + kstep, voffB); PG8_STAGE_A(PG8_SA(1, 0), 0, kstep, false); PG8_STAGE(PG8_SB(1, 1), cB + hstep + kstep, voffB);
        PG8_WAIT_V(6); PG8_BAR;
    } else {
        PG8_STAGE(PG8_SB(0, 0), cB, voffB); PG8_STAGE(PG8_SA(0, 0), cA, voffA); PG8_STAGE(PG8_SB(0, 1), cB + hstep, voffB); PG8_STAGE(PG8_SA(0, 1), cA + hstep, voffA);
        if (wr == 1) PG8_BAR;
        PG8_WAIT_V(4); PG8_BAR;
        PG8_STAGE(PG8_SB(1, 0), cB + kstep, voffB); PG8_STAGE(PG8_SA(1, 0), cA + kstep, voffA); PG8_STAGE(PG8_SB(1, 1), cB + hstep + kstep, voffB);
        PG8_WAIT_V(6); PG8_BAR;
    }
    for (;;) {
        const bool has_next = S.next(ui + 1, nxt);
        nA = has_next ? (const char*)g.A + (size_t)nxt.pm * tstep : cA; nB = has_next ? (const char*)g.Bt + (size_t)nxt.pn * tstep : cB;
        if constexpr (GATHER) { if (has_next) PG8_GROW(nvA0, nvA1, nxt.pm); else { _Pragma("unroll") for (int _i = 0; _i < 2; ++_i) { nvA0[_i] = voffA[_i]; nvA1[_i] = voffA1[_i]; } } }
        for (int t = 0; t < nt; t += 2) {
            const bool last = (t == nt - 2);
            const size_t ko1 = (size_t)(t + 1) * kstep, ko2 = last ? 0 : (size_t)(t + 2) * kstep, ko3 = ko2 + kstep;
            const char* b2 = last ? nB : cB + (size_t)(t + 2) * kstep;
            const char* b3 = b2 + kstep;
            if (last && has_next) S.a_ready(nxt);
            if constexpr (SP2) {
            PG8_LDB(B0, 0, 0); PG8_LDB(B1, 0, 1); PG8_SCHED; PG8_LDA(At, 0, 0); PG8_STAGE_A(PG8_SA(1, 1), 1, ko1, false);
            PG8_WAIT_V(8); PG8_WAIT_L(0); PG8_BAR; PG8_MMA(0, 0, At, B0); PG8_MMA(0, 1, At, B1); PG8_BAR; PG8_SCHED;
            PG8_LDA(At, 0, 1); PG8_STAGE(PG8_SB(0, 0), b2, voffB); PG8_STAGE(PG8_SB(0, 1), b2 + hstep, voffB); PG8_STAGE_A(PG8_SA(0, 0), 0, ko2, last);
            PG8_WAIT_V(8); PG8_WAIT_L(0); PG8_BAR; if (!cur.hf) { PG8_MMA(1, 0, At, B0); PG8_MMA(1, 1, At, B1); } PG8_BAR; PG8_SCHED;
            PG8_LDB(B0, 1, 0); PG8_LDB(B1, 1, 1); PG8_SCHED; PG8_LDA(At, 1, 0); PG8_STAGE_A(PG8_SA(0, 1), 1, ko2, last);
            PG8_WAIT_V(8); PG8_WAIT_L(0); PG8_BAR; PG8_MMA(0, 0, At, B0); PG8_MMA(0, 1, At, B1); PG8_BAR; PG8_SCHED;
            PG8_LDA(At, 1, 1); PG8_STAGE(PG8_SB(1, 0), b3, voffB); PG8_STAGE(PG8_SB(1, 1), b3 + hstep, voffB); PG8_STAGE_A(PG8_SA(1, 0), 0, ko3, last);
            PG8_WAIT_V(8); PG8_WAIT_L(0); PG8_BAR; if (!cur.hf) { PG8_MMA(1, 0, At, B0); PG8_MMA(1, 1, At, B1); } PG8_BAR; PG8_SCHED;
            } else {
            const char* a1 = cA + ko1; const char* a2 = (last ? nA : cA) + ko2; const char* a3 = a2 + kstep;
            PG8_LDB(B0, 0, 0); PG8_SCHED; PG8_LDA(At, 0, 0); PG8_STAGE(PG8_SA(1, 1), a1 + hstep, voffA);
            PG8_WAIT_L(8); PG8_BAR; PG8_WAIT_L(0); PG8_MMA(0, 0, At, B0); PG8_BAR; PG8_SCHED;
            PG8_LDB(B1, 0, 1); PG8_STAGE(PG8_SB(0, 0), b2, voffB);
            PG8_BAR; PG8_WAIT_L(0); PG8_MMA(0, 1, At, B1); PG8_BAR;
            PG8_LDA(At, 0, 1); PG8_STAGE(PG8_SA(0, 0), a2, voffA);
            PG8_BAR; PG8_WAIT_L(0); PG8_MMA(1, 0, At, B0); PG8_BAR; PG8_SCHED;
            PG8_STAGE(PG8_SB(0, 1), b2 + hstep, voffB);
            PG8_WAIT_V(6); PG8_BAR; PG8_MMA(1, 1, At, B1); PG8_BAR;
            PG8_LDB(B0, 1, 0); PG8_SCHED; PG8_LDA(At, 1, 0); PG8_STAGE(PG8_SA(0, 1), a2 + hstep, voffA);
            PG8_WAIT_L(8); PG8_BAR; PG8_WAIT_L(0); PG8_MMA(0, 0, At, B0); PG8_BAR; PG8_SCHED;
            PG8_LDB(B1, 1, 1); PG8_STAGE(PG8_SB(1, 0), b3, voffB);
            PG8_BAR; PG8_WAIT_L(0); PG8_MMA(0, 1, At, B1); PG8_BAR;
            PG8_LDA(At, 1, 1); PG8_STAGE(PG8_SA(1, 0), a3, voffA);
            PG8_BAR; PG8_WAIT_L(0); PG8_MMA(1, 0, At, B0); PG8_BAR; PG8_SCHED;
            PG8_STAGE(PG8_SB(1, 1), b3 + hstep, voffB);
            PG8_WAIT_V(6); PG8_BAR; PG8_MMA(1, 1, At, B1); PG8_BAR;
            }
        }
        if constexpr (ALIGN_EPI) { if (wr == 0) PG8_BAR; }
        if constexpr (!Epi::AFTER_DRAIN) { E(acc, cur, wr, wc, fr, fq); S.done(cur); }
        if (!has_next) break;
        zz = 0.f; asm volatile("" : "+v"(zz));
#pragma unroll
        for (int a = 0; a < 2; ++a)
#pragma unroll
            for (int b = 0; b < 2; ++b)
#pragma unroll
                for (int m = 0; m < 4; ++m)
#pragma unroll
                    for (int n = 0; n < 2; ++n) acc[a][b][m][n] = (f32x4){zz, zz, zz, zz};
        cur = nxt; cA = nA; cB = nB; ++ui;
        if constexpr (GATHER) { _Pragma("unroll") for (int _i = 0; _i < 2; ++_i) { voffA[_i] = nvA0[_i]; voffA1[_i] = nvA1[_i]; } }
        if constexpr (ALIGN_EPI) { if (wr == 1) PG8_BAR; }
    }
    PG8_WAIT_V(0);
    if constexpr (!ALIGN_EPI) { if (wr == 0) PG8_BAR; }
    PG8_BAR;
    if constexpr (Epi::AFTER_DRAIN) { E.fused(acc, cur, wr, wc, fr, fq, lds, wid, lane); S.done(cur); }
#undef PG8_SA
#undef PG8_SB
#undef PG8_STAGE
#undef PG8_DMA
#undef PG8_STAGE_A
#undef PG8_GROW
#undef PG8_LDA
#undef PG8_LDB
#undef PG8_MMA
#undef PG8_WAIT_V
#undef PG8_WAIT_L
#undef PG8_BAR
#undef PG8_SCHED
}
}
#define GAS __attribute__((address_space(1)))
#define LAS __attribute__((address_space(3)))
typedef unsigned short bf16;
typedef unsigned v4u __attribute__((ext_vector_type(4)));
typedef float f32x4 __attribute__((ext_vector_type(4)));
typedef short bf16x8 __attribute__((ext_vector_type(8)));
typedef GAS unsigned gu32;
typedef GAS unsigned long long gu64;
#define RLX_AGENT __ATOMIC_RELAXED, __HIP_MEMORY_SCOPE_AGENT
#define LDS_WAIT() asm volatile("s_waitcnt lgkmcnt(0)" ::: "memory")
#define VM_WAIT() asm volatile("s_waitcnt vmcnt(0)" ::: "memory")
__device__ __forceinline__ int lane_now() { int l; asm volatile("v_mbcnt_lo_u32_b32 %0, -1, 0\n\tv_mbcnt_hi_u32_b32 %0, -1, %0" : "=v"(l)); return l; }
__device__ __forceinline__ int shfl_xor_l(int v, int o) { return __builtin_amdgcn_ds_bpermute((lane_now() ^ o) << 2, v); }
__device__ __forceinline__ unsigned shfl_xor_l(unsigned v, int o) { return (unsigned)shfl_xor_l((int)v, o); }
__device__ __forceinline__ float shfl_xor_l(float v, int o) { return __builtin_bit_cast(float, shfl_xor_l(__builtin_bit_cast(int, v), o)); }
__device__ __forceinline__ int shfl_up_l(int v, int o) { const int l = lane_now(), s = l - o; return __builtin_amdgcn_ds_bpermute((s < 0 ? l : s) << 2, v); }
__device__ __forceinline__ float shfl_up_l(float v, int o) { return __builtin_bit_cast(float, shfl_up_l(__builtin_bit_cast(int, v), o)); }
#define __shfl_xor(v, o) shfl_xor_l((v), (o))
#define __shfl_up(v, o) shfl_up_l((v), (o))
__device__ __forceinline__ unsigned long long rt() { return __builtin_amdgcn_s_memrealtime(); }
__device__ __forceinline__ unsigned f2bf(float f) { unsigned u = __builtin_bit_cast(unsigned, f); return (u + 0x7fffu + ((u >> 16) & 1u)) >> 16; }
__device__ __forceinline__ unsigned pk2(float lo, float hi) { return f2bf(lo) | (f2bf(hi) << 16); }

#define XB_TMO      128
#define XB_XCNT(j)  (256  + 64 * (j))
#define XB_XSUB(j)  (1280 + 64 * (j))
#define XB_XGEN(j)  (2304 + 64 * (j))
#define XB_TOP      3328
#define XB_TOPGEN   3392
#define XCD_BAR_WORDS 3456
#define XB_SPIN_CAP (1u << 18)

__device__ __forceinline__ unsigned xb_ld(unsigned* p)              { return __hip_atomic_load(p, __ATOMIC_RELAXED, __HIP_MEMORY_SCOPE_AGENT); }
__device__ __forceinline__ unsigned xb_add(unsigned* p, unsigned v) { return __hip_atomic_fetch_add(p, v, __ATOMIC_RELAXED, __HIP_MEMORY_SCOPE_AGENT); }
__device__ __forceinline__ unsigned xb_xcc_id() { return (unsigned)__builtin_amdgcn_s_getreg((3 << 11) | 20) & 0xFu; }
#define XB_SPIN(cond, bar) do { unsigned _sp = 0; while (cond) { __builtin_amdgcn_s_sleep(1); \
    if ((++_sp & 255u) == 0u) { if (xb_ld(&(bar)[XB_TMO])) break; if (_sp > XB_SPIN_CAP) { atomicAdd(&(bar)[XB_TMO], 1u); break; } } } } while (0)

struct XcdBarrier {
    unsigned* bar; unsigned x;
    volatile LAS unsigned* st;
};

__device__ __forceinline__ XcdBarrier xcd_barrier_post(unsigned* bar, volatile LAS unsigned* st) {
    XcdBarrier b; b.bar = bar; b.x = xb_xcc_id(); b.st = st;
    if (threadIdx.x == 0) (void)xb_add(&bar[XB_XCNT(b.x)], 1u);
    return b;
}
__device__ __forceinline__ void xcd_barrier_complete(unsigned* bar, unsigned x, unsigned& nloc, unsigned& nx) {
    const unsigned G = gridDim.x * gridDim.y * gridDim.z;
    unsigned sum, cnt, mine, sp = 0u;
    for (;;) {
        sum = 0u; cnt = 0u; mine = 0u;
#pragma unroll
        for (unsigned j = 0; j < 16; ++j) { const unsigned c = xb_ld(&bar[XB_XCNT(j)]); sum += c; cnt += (c > 0u) ? 1u : 0u; mine = (j == x) ? c : mine; }
        if (sum == G) break;
        __builtin_amdgcn_s_sleep(1);
        if ((++sp & 255u) == 0u) { if (xb_ld(&bar[XB_TMO])) break; if (sp > XB_SPIN_CAP) { atomicAdd(&bar[XB_TMO], 1u); break; } }
    }
    nloc = mine > 0u ? mine : 1u; nx = cnt > 0u ? cnt : 1u;
}

__device__ __forceinline__ void xcd_barrier(const XcdBarrier& b) {
    asm volatile("s_waitcnt vmcnt(0)" ::: "memory");
    __syncthreads();
    if (threadIdx.x == 0) {
        unsigned* bar = b.bar;
        __builtin_amdgcn_s_waitcnt(0);
        unsigned nloc = b.st[0], nx = b.st[1];
        if (nloc == 0u) { xcd_barrier_complete(bar, b.x, nloc, nx); b.st[0] = nloc; b.st[1] = nx; }
        const unsigned old = xb_add(&bar[XB_XSUB(b.x)], 1u);
        const unsigned gen = old / nloc;
        if (old + 1u == (gen + 1u) * nloc) {
            __builtin_amdgcn_fence(__ATOMIC_RELEASE, "agent");
            asm volatile("s_waitcnt vmcnt(0)" ::: "memory");
            const unsigned og = xb_add(&bar[XB_TOP], 1u);
            const unsigned tg = og / nx;
            if (og + 1u == (tg + 1u) * nx) xb_add(&bar[XB_TOPGEN], 1u);
            else XB_SPIN(xb_ld(&bar[XB_TOPGEN]) == tg, bar);
            __builtin_amdgcn_fence(__ATOMIC_ACQUIRE, "agent");
            xb_add(&bar[XB_XGEN(b.x)], 1u);
            asm volatile("s_waitcnt vmcnt(0)" ::: "memory");
        } else {
            XB_SPIN(xb_ld(&bar[XB_XGEN(b.x)]) == gen, bar);
            __builtin_amdgcn_fence(__ATOMIC_ACQUIRE, "agent");
            asm volatile("s_waitcnt vmcnt(0)" ::: "memory");
        }
    }
    __syncthreads();
}
namespace mk {
typedef float f32x16 __attribute__((ext_vector_type(16)));
typedef float f32x2 __attribute__((ext_vector_type(2)));
typedef short s16x4 __attribute__((ext_vector_type(4)));
typedef unsigned u32x2 __attribute__((ext_vector_type(2)));
typedef unsigned u32x4 __attribute__((ext_vector_type(4)));

constexpr int NWAVES = 8, NTHR = 512;
constexpr int BATCH = 4, SEQ = 8192, D = 1024, H = 16, HD = 64, T = BATCH * SEQ;
constexpr int NE = 256, TOPK = 8, DE = 256, NGRP = 8, GRPSZ = 32;
constexpr int NBLK = SEQ / 256;
constexpr int NSLOT_MAX = 327680;
constexpr float LN_EPS = 1e-5f;
constexpr float DN_ALPHA = 1.4142135623730951f;
constexpr float ROUTED_SCALE = 2.5f;
constexpr float LOG2E = 1.4426950408889634f;
constexpr float C2 = 0.125f * LOG2E;
constexpr float XQ_SCALE = 16.f, WQ_SCALE = 256.f, AQ_SCALE = 64.f, OQ_SCALE = 64.f, F8_MAX = 448.f;
constexpr float GS_FOLD = AQ_SCALE / (XQ_SCALE * WQ_SCALE);
constexpr int FOXW = 3 * D + H;

constexpr size_t MiB = 1u << 20;
constexpr size_t WS_CTL = 0, CTL_ZERO_BYTES = 1 * MiB;
constexpr size_t WS_WMI = 2 * MiB;
constexpr size_t WS_WMO = 8 * MiB;
constexpr size_t WS_WFI = 10 * MiB;
constexpr size_t WS_WFO = 16 * MiB;
constexpr size_t WS_WR = 18 * MiB;
constexpr size_t WS_WSGU = 21 * MiB;
constexpr size_t WS_WSDN = 23 * MiB;
constexpr size_t WS_WEGU = 24 * MiB;
constexpr size_t WS_WEDN = 280 * MiB;
constexpr size_t WS_XRES = 408 * MiB;
constexpr size_t WS_Z = 536 * MiB;
constexpr size_t WS_XB8 = 600 * MiB;
constexpr size_t WS_XB = 664 * MiB;
constexpr size_t WS_AR = 728 * MiB;
constexpr size_t WS_LOGP = 920 * MiB;
constexpr size_t WS_ACTSH = 984 * MiB;
constexpr size_t WS_TOPI = 1000 * MiB;
constexpr size_t WS_GATE = 1001 * MiB;
constexpr size_t WS_SLOTOF = 1002 * MiB;
constexpr size_t WS_TOKOF = 1003 * MiB;
constexpr size_t WS_GSLOT = 1005 * MiB;
constexpr size_t WS_KMEAN = 1008 * MiB;
constexpr size_t WS_LOGF = 1009 * MiB;
constexpr size_t WS_CUM = 1011 * MiB;
constexpr size_t WS_OVL = 1016 * MiB;
constexpr size_t WS_Q = WS_OVL, WS_K = WS_OVL + 64 * MiB, WS_V = WS_OVL + 128 * MiB, WS_O = WS_OVL + 192 * MiB;
constexpr size_t WS_MLIST = WS_OVL + 256 * MiB;
constexpr size_t WS_PARTO = WS_OVL + 288 * MiB;
constexpr size_t WS_PARTML = WS_OVL + 480 * MiB;
constexpr size_t WS_HS = WS_OVL;
constexpr size_t WS_ACT = WS_OVL + 640 * MiB;
constexpr size_t WS_END = WS_OVL + 800 * MiB;
static_assert(WS_END <= 2048 * MiB, "d_ws map");
static_assert(WS_PARTML + (size_t)T * H * 3 * 2 * 4 <= WS_END, "attention overlay");
constexpr int MLIST_PER_BH = 256 * 496;
constexpr int CW_BAR = 4096;
constexpr int CW_MCNT = 16384;
constexpr int CW_ECNT = 20480;
constexpr int CW_ECUR = 21504;
constexpr int CW_FOXQ = 24576;
constexpr int CW_KSUM = 131072;
constexpr int CW_NORM = 24832;
constexpr int RING_BYTES = 131072, LDSCTL_OFF = 155648, MISC_OFF = LDSCTL_OFF + 320, TPRE_OFF = LDSCTL_OFF + 1024, PTAB_OFF = LDSCTL_OFF + 4096, LDS_BYTES = 163840;
typedef __bf16 bf16x2_t __attribute__((ext_vector_type(2)));
__device__ __forceinline__ unsigned cvtpk(float lo, float hi) { f32x2 v = {lo, hi}; bf16x2_t b = __builtin_convertvector(v, bf16x2_t); return __builtin_bit_cast(unsigned, b); }
__device__ __forceinline__ float bf2f(unsigned b) { return __uint_as_float(b << 16); }
__device__ __forceinline__ float bflo(unsigned w) { return __uint_as_float(w << 16); }
__device__ __forceinline__ float bfhi(unsigned w) { return __uint_as_float(w & 0xffff0000u); }
__device__ __forceinline__ float wave_sum(float v) {
#pragma unroll
    for (int o = 1; o < 64; o <<= 1) v += __shfl_xor(v, o);
    return v;
}
__device__ __forceinline__ unsigned sort_key(float x) { const unsigned b = __float_as_uint(x); return b ^ ((unsigned)((int)b >> 31) | 0x80000000u); }
__device__ __forceinline__ int crow(int r, int hi) { return (r & 3) + 8 * (r >> 2) + 4 * hi; }
__device__ __forceinline__ s16x4 vtr(const LAS unsigned char* p) { typedef short v4i16_t __attribute__((ext_vector_type(4))); return __builtin_bit_cast(s16x4, __builtin_amdgcn_ds_read_tr16_b64_v4i16((LAS v4i16_t*)p)); }

__device__ __forceinline__ unsigned long long ldptr(const LAS unsigned long long* tab, int i) { const unsigned long long v = tab[i]; const unsigned lo = __builtin_amdgcn_readfirstlane((unsigned)v), hi = __builtin_amdgcn_readfirstlane((unsigned)(v >> 32)); return ((unsigned long long)hi << 32) | lo; }

struct Ctx {
    LAS unsigned char* lds;
    int tid, lane, wave, vcu, G;
};

template <bool LO> __device__ __forceinline__ void tr_item(const float* src, size_t ld, bf16* dst, size_t dpitch, LAS float* scr, int lane) {
#pragma unroll 8
    for (int i = 0; i < 32; ++i) { const int kk = 2 * i + (lane >> 5); scr[kk * 33 + (lane & 31)] = src[(size_t)kk * ld + (lane & 31)]; }
    LDS_WAIT(); asm volatile("" ::: "memory");
    const int c = lane & 7;
#pragma unroll
    for (int j = 0; j < 4; ++j) { const int n = (lane >> 3) + 8 * j; const LAS float* s = scr + (8 * c) * 33 + n;
        float v[8];
#pragma unroll
        for (int i = 0; i < 8; ++i) { v[i] = s[i * 33]; if (LO) v[i] = v[i] - bf2f(f2bf(v[i])); }
        v4u o; o.x = pk2(v[0], v[1]); o.y = pk2(v[2], v[3]); o.z = pk2(v[4], v[5]); o.w = pk2(v[6], v[7]);
        *(GAS v4u*)(dst + (size_t)n * dpitch + 8 * c) = o; }
    LDS_WAIT(); asm volatile("" ::: "memory");
}

__device__ __forceinline__ void tr_item64(const float* src, size_t ld, bf16* dst0, size_t rstride, LAS unsigned char* scr, int lane) {
    float v[64];
    const GAS float* p = (const GAS float*)src + lane;
#pragma unroll
    for (int k = 0; k < 64; ++k) v[k] = p[(size_t)k * ld];
#pragma unroll
    for (int c = 0; c < 8; ++c) { v4u o; o.x = cvtpk(v[8 * c], v[8 * c + 1]); o.y = cvtpk(v[8 * c + 2], v[8 * c + 3]); o.z = cvtpk(v[8 * c + 4], v[8 * c + 5]); o.w = cvtpk(v[8 * c + 6], v[8 * c + 7]);
        *(LAS v4u*)(scr + lane * 144 + c * 16) = o; }
    LDS_WAIT(); asm volatile("" ::: "memory");
#pragma unroll
    for (int i = 0; i < 8; ++i) { const int row = 8 * i + (lane >> 3), c = lane & 7; const v4u o = *(const LAS v4u*)(scr + row * 144 + c * 16);
        *(GAS v4u*)(dst0 + (size_t)row * rstride + 8 * c) = o; }
    LDS_WAIT(); asm volatile("" ::: "memory");
}
__device__ __forceinline__ unsigned pk4_f8(float a, float b, float c, float d) {
    a = __builtin_amdgcn_fmed3f(a, -F8_MAX, F8_MAX); b = __builtin_amdgcn_fmed3f(b, -F8_MAX, F8_MAX); c = __builtin_amdgcn_fmed3f(c, -F8_MAX, F8_MAX); d = __builtin_amdgcn_fmed3f(d, -F8_MAX, F8_MAX);
    unsigned w = 0u; w = (unsigned)__builtin_amdgcn_cvt_pk_fp8_f32(a, b, (int)w, false); w = (unsigned)__builtin_amdgcn_cvt_pk_fp8_f32(c, d, (int)w, true); return w;
}
__device__ __forceinline__ void tr_item_f8(const float* src, size_t ld, unsigned char* dst0, size_t rstride, LAS unsigned char* scr, int lane) {
#pragma unroll 1
    for (int h = 0; h < 2; ++h) {
        float v[64];
        const GAS float* p = (const GAS float*)src + lane + (size_t)(64 * h) * ld;
#pragma unroll
        for (int k = 0; k < 64; ++k) v[k] = __builtin_nontemporal_load(p + (size_t)k * ld);
#pragma unroll
        for (int c = 0; c < 4; ++c) { v4u o;
            o.x = pk4_f8(v[16 * c] * WQ_SCALE, v[16 * c + 1] * WQ_SCALE, v[16 * c + 2] * WQ_SCALE, v[16 * c + 3] * WQ_SCALE); o.y = pk4_f8(v[16 * c + 4] * WQ_SCALE, v[16 * c + 5] * WQ_SCALE, v[16 * c + 6] * WQ_SCALE, v[16 * c + 7] * WQ_SCALE);
            o.z = pk4_f8(v[16 * c + 8] * WQ_SCALE, v[16 * c + 9] * WQ_SCALE, v[16 * c + 10] * WQ_SCALE, v[16 * c + 11] * WQ_SCALE); o.w = pk4_f8(v[16 * c + 12] * WQ_SCALE, v[16 * c + 13] * WQ_SCALE, v[16 * c + 14] * WQ_SCALE, v[16 * c + 15] * WQ_SCALE);
            *(LAS v4u*)(scr + lane * 144 + h * 64 + c * 16) = o; }
    }
    LDS_WAIT(); asm volatile("" ::: "memory");
#pragma unroll
    for (int i = 0; i < 8; ++i) { const int row = 8 * i + (lane >> 3), c = lane & 7; const v4u o = *(const LAS v4u*)(scr + row * 144 + c * 16);
        *(GAS v4u*)(dst0 + (size_t)row * rstride + 16 * c) = o; }
    LDS_WAIT(); asm volatile("" ::: "memory");
}
__device__ __forceinline__ void conv_experts(const Ctx& C, const float* wg, const float* wu, const float* wd, int l, unsigned char* WEGU, unsigned char* WEDN, int part, int nparts) {
    const int gw = part * NWAVES + C.wave, NGW = nparts * NWAVES, lane = C.lane;
    LAS unsigned char* scr = C.lds + C.wave * 9216;
    constexpr int IG = NE * 8 * 4;
    constexpr int IDN = NE * 2 * 16;
    for (int it = gw; it < 2 * IG + IDN; it += NGW) {
        if (it < 2 * IG) {
            const int up = it >= IG, r = it - up * IG, e = r >> 5, kb = (r >> 2) & 7, nb = r & 3, n0 = 64 * nb;
            const float* src = (up ? wu : wg) + ((size_t)(l * NE + e) * 1024 + 128 * kb) * 256 + 64 * nb;
            unsigned char* dst = WEGU + ((size_t)e * 512 + (n0 >> 7) * 256 + up * 128 + (n0 & 127)) * 1024 + 128 * kb;
            tr_item_f8(src, 256, dst, 1024, scr, lane);
        } else {
            const int r = it - 2 * IG, e = r >> 5, kb = (r >> 4) & 1, nb = r & 15;
            const float* src = wd + ((size_t)(l * NE + e) * 256 + 128 * kb) * 1024 + 64 * nb;
            unsigned char* dst = WEDN + ((size_t)e * 1024 + 64 * nb) * 256 + 128 * kb;
            tr_item_f8(src, 1024, dst, 256, scr, lane);
        }
    }
}

struct SmallW {
    const float *moba_in, *moba_out, *fox_in, *fox_out, *w_router, *ws_gate, *ws_up, *ws_down;
    unsigned char *WMI, *WFI, *WMO, *WFO, *WSGU, *WSDN;
    bf16 *WR;
};
__device__ __forceinline__ void conv_small(const Ctx& C, const SmallW& W) {
    LAS float* scr = (LAS float*)(C.lds + C.wave * 16384);
    const int gw = C.vcu * NWAVES + C.wave, NGW = C.G * NWAVES;
    constexpr int I_IN = 8 * 48  , I_OUT = 8 * 16, I_R = 16 * 8, I_SG = 8 * 4, I_SD = 2 * 16;
    constexpr int NIT = 2 * I_IN + 2 * I_OUT + 2 * (3 * I_R) + 2 * (2 * I_SG + I_SD);
    for (int it = gw; it < NIT; it += NGW) {
        int r = it;
        if (r < I_IN) { const int kb = r / 48, nb = r % 48; tr_item_f8(W.moba_in + (size_t)(128 * kb) * 3072 + 64 * nb, 3072, W.WMI + (size_t)(64 * nb) * 1024 + 128 * kb, 1024, (LAS unsigned char*)scr, C.lane); continue; } r -= I_IN;
        if (r < I_IN) { const int kb = r / 48, nb = r % 48; tr_item_f8(W.fox_in + (size_t)(128 * kb) * FOXW + 64 * nb, FOXW, W.WFI + (size_t)(64 * nb) * 1024 + 128 * kb, 1024, (LAS unsigned char*)scr, C.lane); continue; } r -= I_IN;
        if (r < I_OUT) { const int kb = r >> 4, nb = r & 15; tr_item_f8(W.moba_out + (size_t)(128 * kb) * 1024 + 64 * nb, 1024, W.WMO + (size_t)(64 * nb) * 1024 + 128 * kb, 1024, (LAS unsigned char*)scr, C.lane); continue; } r -= I_OUT;
        if (r < I_OUT) { const int kb = r >> 4, nb = r & 15; tr_item_f8(W.fox_out + (size_t)(128 * kb) * 1024 + 64 * nb, 1024, W.WFO + (size_t)(64 * nb) * 1024 + 128 * kb, 1024, (LAS unsigned char*)scr, C.lane); continue; } r -= I_OUT;
        if (r < 6 * I_R) {
            const int l = r / (3 * I_R), q = (r % (3 * I_R)) / I_R, s = r % I_R, kb = s >> 3, nb = s & 7;
            const float* src = W.w_router + ((size_t)l * 1024 + 64 * kb) * 256 + 32 * nb;
            bf16* base = W.WR + (size_t)l * (512 * 1536) + (size_t)(32 * nb) * 1536;
            if (q == 0) tr_item<false>(src, 256, base + 64 * kb, 1536, scr, C.lane);
            else if (q == 1) { if (kb < 8) tr_item<false>(src, 256, base + 1024 + 64 * kb, 1536, scr, C.lane); else tr_item<false>(src, 256, base + (size_t)256 * 1536 + 64 * (kb - 8), 1536, scr, C.lane); }
            else tr_item<true>(src, 256, base + (size_t)256 * 1536 + 512 + 64 * kb, 1536, scr, C.lane);
            continue; } r -= 6 * I_R;
        {
            constexpr int PER = 2 * I_SG + I_SD; const int l = r / PER; int s = r % PER;
            if (s < 2 * I_SG) { const int up = s >= I_SG; s -= up * I_SG; const int kb = s >> 2, nb = s & 3, n0 = 64 * nb;
                const float* src = (up ? W.ws_up : W.ws_gate) + ((size_t)l * 1024 + 128 * kb) * 256 + n0;
                tr_item_f8(src, 256, W.WSGU + (size_t)l * (512 * 1024) + (size_t)((n0 >> 7) * 256 + up * 128 + (n0 & 127)) * 1024 + 128 * kb, 1024, (LAS unsigned char*)scr, C.lane); }
            else { s -= 2 * I_SG; const int kb = s >> 4, nb = s & 15;
                tr_item_f8(W.ws_down + ((size_t)l * 256 + 128 * kb) * 1024 + 64 * nb, 1024, W.WSDN + (size_t)l * (1024 * 256) + (size_t)(64 * nb) * 256 + 128 * kb, 256, (LAS unsigned char*)scr, C.lane); }
        }
    }
}
__device__ __forceinline__ void to_f8_rows(const Ctx& C, const float* x, unsigned char* xb8) {
    const size_t n16 = (size_t)T * D / 16;
    for (size_t i = (size_t)C.vcu * NTHR + C.tid; i < n16; i += (size_t)C.G * NTHR) {
        const f32x4 a = *(const GAS f32x4*)(x + 16 * i) * XQ_SCALE, b = *(const GAS f32x4*)(x + 16 * i + 4) * XQ_SCALE, c = *(const GAS f32x4*)(x + 16 * i + 8) * XQ_SCALE, d = *(const GAS f32x4*)(x + 16 * i + 12) * XQ_SCALE;
        v4u o; o.x = pk4_f8(a.x, a.y, a.z, a.w); o.y = pk4_f8(b.x, b.y, b.z, b.w); o.z = pk4_f8(c.x, c.y, c.z, c.w); o.w = pk4_f8(d.x, d.y, d.z, d.w);
        *(GAS v4u*)(xb8 + 16 * i) = o;
    }
}

template <bool COL0> struct EpiF32 {
    static constexpr bool PERM = false, AFTER_DRAIN = false;
    float* out; const float* base; int ldc; float alpha;
    __device__ __forceinline__ void operator()(const pg8::f32x4 (&acc)[2][2][4][2], const pg8::Unit& u, int wr, int wc, int fr, int fq) const {
        const int row0 = u.pm * 256 + wr * 64 + fr, col0 = (COL0 ? 0 : u.pn * 256) + wc * 32 + 4 * fq;
#pragma unroll
        for (int ai = 0; ai < 2; ++ai)
#pragma unroll
            for (int m = 0; m < 4; ++m) { const size_t off = (size_t)(row0 + ai * 128 + m * 16) * ldc + col0;
#pragma unroll
                for (int bj = 0; bj < 2; ++bj)
#pragma unroll
                    for (int n = 0; n < 2; ++n) { f32x4 v = acc[ai][bj][m][n];
                        if (base) { const f32x4 b = *(const GAS f32x4*)(base + off + bj * 128 + n * 16); v = v + b * alpha; }
                        *(GAS f32x4*)(out + off + bj * 128 + n * 16) = v; } }
    }
};
struct EpiQKV {
    static constexpr bool PERM = true, AFTER_DRAIN = false;
    bf16* Qb; size_t split_stride; float scale0; unsigned* norms;
    float* ksum;
    __device__ __forceinline__ void operator()(const pg8::f32x4 (&acc)[2][2][4][2], const pg8::Unit& u, int wr, int wc, int fr, int fq) const {
        asm volatile("" : "+v"(fr), "+v"(fq));
        const int t = u.pn >> 2, colt = (u.pn & 3) * 256;
        constexpr float IS = 1.f / (XQ_SCALE * WQ_SCALE);
        bf16* base = Qb + (size_t)t * split_stride; const float sc = (t == 0 ? scale0 : 1.f) * IS;
        const int ln = fr + 16 * fq, src4 = ((ln >> 2) + 16 * (ln & 3)) << 2;
        const int row0 = u.pm * 256 + wr * 64 + (ln >> 2), col0 = colt + wc * 32 + 8 * (ln & 3);
        float nmax[2] = {0.f, 0.f};
#pragma unroll
        for (int ai = 0; ai < 2; ++ai)
#pragma unroll
            for (int m = 0; m < 4; ++m) { bf16* rowp = base + (size_t)(row0 + ai * 128 + m * 16) * D + col0;
#pragma unroll
                for (int bj = 0; bj < 2; ++bj) { const f32x4 v0 = acc[ai][bj][m][0] * sc, v1 = acc[ai][bj][m][1] * sc;
                    v4u w; w.x = cvtpk(v0[0], v0[1]); w.y = cvtpk(v0[2], v0[3]); w.z = cvtpk(v1[0], v1[1]); w.w = cvtpk(v1[2], v1[3]);
                    w.x = (unsigned)__builtin_amdgcn_ds_bpermute(src4, (int)w.x); w.y = (unsigned)__builtin_amdgcn_ds_bpermute(src4, (int)w.y); w.z = (unsigned)__builtin_amdgcn_ds_bpermute(src4, (int)w.z); w.w = (unsigned)__builtin_amdgcn_ds_bpermute(src4, (int)w.w);
                    *(GAS v4u*)(rowp + bj * 128) = w;
                    if (t < 2) { float ss = (v0[0] * v0[0] + v0[1] * v0[1]) + (v0[2] * v0[2] + v0[3] * v0[3]) + (v1[0] * v1[0] + v1[1] * v1[1]) + (v1[2] * v1[2] + v1[3] * v1[3]);
                        ss += __shfl_xor(ss, 16); ss += __shfl_xor(ss, 32); nmax[bj] = fmaxf(nmax[bj], ss); } } }
        if (t == 1 && ksum) {
#pragma unroll
            for (int bj = 0; bj < 2; ++bj)
#pragma unroll
                for (int n = 0; n < 2; ++n) { f32x4 cs = (f32x4){0.f, 0.f, 0.f, 0.f};
#pragma unroll
                    for (int ai = 0; ai < 2; ++ai)
#pragma unroll
                        for (int m = 0; m < 4; ++m) cs = cs + acc[ai][bj][m][n];
#pragma unroll
                    for (int i = 0; i < 4; ++i) { float v = cs[i];
#pragma unroll
                        for (int o = 1; o < 16; o <<= 1) v += __shfl_xor(v, o);
                        if (fr == 0) (void)__hip_atomic_fetch_add(ksum + (size_t)u.pm * D + colt + bj * 128 + wc * 32 + 8 * fq + 4 * n + i, v * IS, __ATOMIC_RELAXED, __HIP_MEMORY_SCOPE_AGENT); } }
        }
        if (t < 2) {
#pragma unroll
            for (int bj = 0; bj < 2; ++bj) { float v = nmax[bj];
#pragma unroll
                for (int o = 1; o < 16; o <<= 1) v = fmaxf(v, __shfl_xor(v, o));
                const int head = (u.pn & 3) * 4 + 2 * bj + (wc >> 1), b = u.pm >> 5;
                if (fr == 0 && fq == 0) (void)__hip_atomic_fetch_max(norms + ((b * 16 + head) * 2 + t) * 2 + (wc & 1), __float_as_uint(v * 1.01f), __ATOMIC_RELAXED, __HIP_MEMORY_SCOPE_AGENT); }
        }
    }
};
template <bool F8> struct EpiSwiGLU {
    static constexpr bool PERM = true, AFTER_DRAIN = false;
    void* actp; const float* rowscale;
    __device__ __forceinline__ void operator()(const pg8::f32x4 (&acc)[2][2][4][2], const pg8::Unit& u, int wr, int wc, int fr, int fq) const {
        asm volatile("" : "+v"(fr), "+v"(fq));
        const int row0 = u.pm * 256 + wr * 64 + fr, col0 = (u.pn & 1) * 128 + wc * 32 + 8 * fq;
        const int ln = fr + 16 * fq, src4 = ((ln >> 2) + 16 * (ln & 3)) << 2, srow0 = u.pm * 256 + wr * 64 + (ln >> 2), scol0 = (u.pn & 1) * 128 + wc * 32 + 8 * (ln & 3);
        constexpr float IS = F8 ? 1.f / (XQ_SCALE * WQ_SCALE) : 1.f;
#pragma unroll
        for (int ai = 0; ai < 2; ++ai) if (ai == 0 || !u.hf)
#pragma unroll
            for (int m = 0; m < 4; ++m) { const int row = row0 + ai * 128 + m * 16; const float rs = rowscale ? rowscale[row] : (F8 ? GS_FOLD : 1.f);
                float o[8];
#pragma unroll
                for (int n = 0; n < 2; ++n)
#pragma unroll
                    for (int i = 0; i < 4; ++i) { const float g = acc[ai][0][m][n][i] * IS, up = acc[ai][1][m][n][i];
                        const float sg = g * __builtin_amdgcn_rcpf(1.f + __builtin_amdgcn_exp2f(-g * LOG2E)); o[4 * n + i] = sg * up * rs; }
                if constexpr (F8) { u32x2 w; w.x = pk4_f8(o[0], o[1], o[2], o[3]); w.y = pk4_f8(o[4], o[5], o[6], o[7]);
                    w.x = (unsigned)__builtin_amdgcn_ds_bpermute(src4, (int)w.x); w.y = (unsigned)__builtin_amdgcn_ds_bpermute(src4, (int)w.y);
                    *(GAS u32x2*)((unsigned char*)actp + (size_t)(srow0 + ai * 128 + m * 16) * 256 + scol0) = w; }
                else { v4u w; w.x = cvtpk(o[0], o[1]); w.y = cvtpk(o[2], o[3]); w.z = cvtpk(o[4], o[5]); w.w = cvtpk(o[6], o[7]);
                    *(GAS v4u*)((bf16*)actp + (size_t)row * 256 + col0) = w; } }
    }
};
constexpr float SO_SCALE = 64.f, SO_INV = 1.f / 64.f;
template <bool F8> struct EpiDown {
    static constexpr bool PERM = true, AFTER_DRAIN = false;
    static constexpr float sc = F8 ? SO_SCALE / (AQ_SCALE * WQ_SCALE) : SO_SCALE;
    unsigned char* out;
    __device__ __forceinline__ void operator()(const pg8::f32x4 (&acc)[2][2][4][2], const pg8::Unit& u, int wr, int wc, int fr, int fq) const {
        const int ln = fr + 16 * fq, src4 = ((ln >> 2) + 16 * (ln & 3)) << 2, fr2 = ln >> 2, fq2 = ln & 3;
        const int row0 = u.pm * 256 + wr * 64 + fr2, col0 = (u.pn & 3) * 256 + wc * 32 + 8 * fq2;
#pragma unroll
        for (int ai = 0; ai < 2; ++ai) if (ai == 0 || !u.hf)
#pragma unroll
            for (int m = 0; m < 4; ++m) { unsigned char* rowp = out + (size_t)(row0 + ai * 128 + m * 16) * 1024 + col0;
#pragma unroll
                for (int bj = 0; bj < 2; ++bj) { const f32x4 v0 = acc[ai][bj][m][0] * sc, v1 = acc[ai][bj][m][1] * sc;
                    u32x2 w; w.x = 0u; w.y = 0u;
                    w.x = __builtin_amdgcn_cvt_pk_fp8_f32(v0[0], v0[1], w.x, false); w.x = __builtin_amdgcn_cvt_pk_fp8_f32(v0[2], v0[3], w.x, true);
                    w.y = __builtin_amdgcn_cvt_pk_fp8_f32(v1[0], v1[1], w.y, false); w.y = __builtin_amdgcn_cvt_pk_fp8_f32(v1[2], v1[3], w.y, true);
                    w.x = (unsigned)__builtin_amdgcn_ds_bpermute(src4, (int)w.x); w.y = (unsigned)__builtin_amdgcn_ds_bpermute(src4, (int)w.y);
                    *(GAS u32x2*)(rowp + bj * 128) = w; } }
    }
};
template <int NN> struct PlainOrder {
    int vcu, G, nunits;
    __device__ __forceinline__ bool next(int i, pg8::Unit& u) const { const int idx = vcu + i * G; if (idx >= nunits) return false;
        u.pm = __builtin_amdgcn_readfirstlane(idx / NN); u.pn = __builtin_amdgcn_readfirstlane(idx % NN);
        int z = 0; asm volatile("" : "+s"(z)); u.hf = z;
        return true; }
    __device__ __forceinline__ void a_ready(const pg8::Unit&) const {}
    __device__ __forceinline__ void done(const pg8::Unit&) const {}
};
struct RouterOrder {
    int vcu, G;
    __device__ __forceinline__ bool next(int i, pg8::Unit& u) const { const int idx = vcu + i * G; if (idx >= 256) return false; u.pm = idx; u.pn = idx >> 7; return true; }
    __device__ __forceinline__ void a_ready(const pg8::Unit&) const {}
    __device__ __forceinline__ void done(const pg8::Unit&) const {}
};
template <int SH> struct ExpertOrder {
    int vcu, G; const LAS int* tpre;
    __device__ __forceinline__ bool next(int i, pg8::Unit& u) const {
        const int idx = vcu + i * G, ti = idx >> SH; if (ti >= tpre[NE]) return false;
        int lo = 0, hi = NE;
#pragma unroll
        for (int s = 0; s < 8; ++s) { const int mid = (lo + hi) >> 1; if (tpre[mid] <= ti) lo = mid; else hi = mid; }
        u.pm = __builtin_amdgcn_readfirstlane(ti); u.pn = __builtin_amdgcn_readfirstlane((lo << SH) + (idx & ((1 << SH) - 1)));
        u.hf = __builtin_amdgcn_readfirstlane((tpre[272 + lo] - 256 * (ti - tpre[lo])) <= 128 ? 1 : 0); return true;
    }
    __device__ __forceinline__ void a_ready(const pg8::Unit&) const {}
    __device__ __forceinline__ void done(const pg8::Unit&) const {}
};
__device__ __forceinline__ void build_tpre(const Ctx& C, const unsigned* ecnt) {
    LAS int* tpre = (LAS int*)(C.lds + TPRE_OFF);
    __syncthreads();
    int v = 0;
    if (C.tid < NE) { const int c = (int)__hip_atomic_load(ecnt + C.tid, __ATOMIC_RELAXED, __HIP_MEMORY_SCOPE_AGENT); v = (c + 255) >> 8; tpre[272 + C.tid] = c; }
    int inc = v;
#pragma unroll
    for (int o = 1; o < 64; o <<= 1) { const int t = __shfl_up(inc, o); if (C.lane >= o) inc += t; }
    if (C.tid < NE && C.lane == 63) tpre[260 + C.wave] = inc;
    __syncthreads();
    if (C.tid < NE) { int base = 0; for (int w = 0; w < C.wave; ++w) base += tpre[260 + w]; tpre[C.tid + 1] = base + inc; if (C.tid == 0) tpre[0] = 0; }
    __syncthreads();
}
struct AttnAcc { float m; f32x16 o0, o1, la; };
#define MFMA32(a, b, c) __builtin_amdgcn_mfma_f32_32x32x16_bf16((a), (b), (c), 0, 0, 0)
constexpr float NEG_INF = -__builtin_inff();

__device__ __forceinline__ void glds16(const void* gsrc, unsigned lds_dst) { unsigned keep;
    asm volatile("s_mov_b32 %0, m0\n\ts_mov_b32 m0, %2\n\ts_nop 0\n\tglobal_load_lds_dwordx4 %1, off\n\ts_mov_b32 m0, %0" : "=&s"(keep) : "v"(gsrc), "s"(lds_dst) : "memory"); }
__device__ __forceinline__ void glds4(const void* gsrc, unsigned lds_dst) { unsigned keep;
    asm volatile("s_mov_b32 %0, m0\n\ts_mov_b32 m0, %2\n\ts_nop 0\n\tglobal_load_lds_dword %1, off\n\ts_mov_b32 m0, %0" : "=&s"(keep) : "v"(gsrc), "s"(lds_dst) : "memory"); }
__device__ __forceinline__ unsigned lds_addr(const LAS unsigned char* p) { return (unsigned)__builtin_amdgcn_readfirstlane((int)(unsigned)(uintptr_t)p); }
__device__ __forceinline__ void dma_tile(const bf16* Kg, const bf16* Vg, LAS unsigned char* Ks, LAS unsigned char* Vs, int wave, int lane) {
    glds16(Kg + (size_t)lane * D + wave * 8, lds_addr(Ks + wave * 1024));
    glds16(Vg + (size_t)(16 * (wave & 3) + (lane >> 2)) * D + (wave >> 2) * 32 + (lane & 3) * 8, lds_addr(Vs + wave * 1024));
}
__device__ __forceinline__ void load_q(bf16x8 (&qr)[4], const bf16* Qrow, int hi) {
#pragma unroll
    for (int d0 = 0; d0 < 4; ++d0) qr[d0] = *(const GAS bf16x8*)(Qrow + d0 * 16 + hi * 8);
}
template <class Bias> __device__ __forceinline__ void qk_tile(f32x16& p0, f32x16& p1, const bf16x8 (&qr)[4], const LAS unsigned char* Ks, int r32, int hi, const Bias& B) {
    __builtin_amdgcn_sched_barrier(0);
    B.init(p0, p1, hi);
    const LAS unsigned char* kb = Ks + hi * 1024 + r32 * 16;
    bf16x8 kf[8];
#pragma unroll
    for (int d0 = 0; d0 < 4; ++d0) { kf[2 * d0] = *(const LAS bf16x8*)(kb + d0 * 2048); kf[2 * d0 + 1] = *(const LAS bf16x8*)(kb + d0 * 2048 + 512); }
    __builtin_amdgcn_sched_barrier(0);
#pragma unroll
    for (int d0 = 0; d0 < 4; ++d0) { p0 = MFMA32(kf[2 * d0], qr[d0], p0); p1 = MFMA32(kf[2 * d0 + 1], qr[d0], p1); }
    B.mask(p0, p1, hi);
    __builtin_amdgcn_sched_barrier(0);
}
constexpr float ATT_THR = 8.f;
__device__ __forceinline__ float half_max(float m) { auto rr = __builtin_amdgcn_permlane32_swap(__float_as_uint(m), __float_as_uint(m), false, false); return fmaxf(__uint_as_float(rr[0]), __uint_as_float(rr[1])); }
__device__ __forceinline__ void attn_rescale(AttnAcc& A, float rm) {
    const bool need = rm > A.m + ATT_THR;
    if (__any(need)) {
        const float mn = need ? rm : A.m, f = __builtin_amdgcn_exp2f(A.m - mn);
        A.la[0] *= f;
#pragma unroll
        for (int r = 0; r < 16; ++r) { A.o0[r] *= f; A.o1[r] *= f; }
        A.m = mn;
    }
}
__device__ __forceinline__ void softmax_pv(AttnAcc& A, f32x16& p0, f32x16& p1, const LAS unsigned char* Vs, int hi, int lane) {
    __builtin_amdgcn_sched_barrier(0);
    const LAS unsigned char* vb = Vs + ((lane >> 4) & 1) * 32 + (lane & 3) * 8 + (4 * hi + ((lane & 15) >> 2)) * 64;
    s16x4 vt[16];
#pragma unroll
    for (int ks = 0; ks < 4; ++ks) { vt[4 * ks] = vtr(vb + ks * 1024); vt[4 * ks + 1] = vtr(vb + ks * 1024 + 512); vt[4 * ks + 2] = vtr(vb + (4 + ks) * 1024); vt[4 * ks + 3] = vtr(vb + (4 + ks) * 1024 + 512); }
    __builtin_amdgcn_sched_barrier(0);
    float rm = fmaxf(p0[0], p1[0]);
#pragma unroll
    for (int r = 1; r < 16; ++r) rm = fmaxf(fmaxf(rm, p0[r]), p1[r]);
    rm = half_max(rm);
    attn_rescale(A, rm);
    const float mn = A.m;
#pragma unroll
    for (int r = 0; r < 16; ++r) { p0[r] = __builtin_amdgcn_exp2f(p0[r] - mn); p1[r] = __builtin_amdgcn_exp2f(p1[r] - mn); }
    v4u pw[4];
#pragma unroll
    for (int s = 0; s < 2; ++s) {
        pw[s].x = cvtpk(p0[8 * s + 0], p0[8 * s + 1]); pw[s].y = cvtpk(p0[8 * s + 2], p0[8 * s + 3]); pw[s].z = cvtpk(p0[8 * s + 4], p0[8 * s + 5]); pw[s].w = cvtpk(p0[8 * s + 6], p0[8 * s + 7]);
        pw[2 + s].x = cvtpk(p1[8 * s + 0], p1[8 * s + 1]); pw[2 + s].y = cvtpk(p1[8 * s + 2], p1[8 * s + 3]); pw[2 + s].z = cvtpk(p1[8 * s + 4], p1[8 * s + 5]); pw[2 + s].w = cvtpk(p1[8 * s + 6], p1[8 * s + 7]);
    }
    const bf16x8 ones = {(short)0x3F80, (short)0x3F80, (short)0x3F80, (short)0x3F80, (short)0x3F80, (short)0x3F80, (short)0x3F80, (short)0x3F80};
#pragma unroll
    for (int ks = 0; ks < 4; ++ks) {
        const bf16x8 pa = __builtin_bit_cast(bf16x8, pw[ks]);
        const s16x4 a0 = vt[4 * ks], a1 = vt[4 * ks + 1], b0 = vt[4 * ks + 2], b1 = vt[4 * ks + 3];
        const bf16x8 v0 = {a0[0], a0[1], a0[2], a0[3], a1[0], a1[1], a1[2], a1[3]}, v1 = {b0[0], b0[1], b0[2], b0[3], b1[0], b1[1], b1[2], b1[3]};
        A.o0 = MFMA32(v0, pa, A.o0); A.o1 = MFMA32(v1, pa, A.o1); A.la = MFMA32(ones, pa, A.la);
    }
    __builtin_amdgcn_sched_barrier(0);
}
__device__ __forceinline__ void acc_init(AttnAcc& A) {
    A.m = NEG_INF;
    float z = 0.f; asm volatile("" : "+v"(z));
#pragma unroll
    for (int r = 0; r < 16; ++r) { A.o0[r] = z; A.o1[r] = z; A.la[r] = z; }
}
#define ATT_SB() __builtin_amdgcn_sched_barrier(0)
template <class Bias> __device__ __forceinline__ void attn_step(AttnAcc& A, f32x16& pc0, f32x16& pc1, f32x16& pn0, f32x16& pn1, const bf16x8 (&qr)[4],
                                                               const LAS unsigned char* Kn, const LAS unsigned char* Vc, int r32, int hi, int lane, const Bias& Bn, const bool doNext) {
    ATT_SB();
    if (doNext) Bn.init(pn0, pn1, hi);
    const LAS unsigned char* kb = Kn + hi * 1024 + r32 * 16;
    bf16x8 ka[4], kc[4];
#pragma unroll
    for (int d0 = 0; d0 < 2; ++d0) { ka[2 * d0] = *(const LAS bf16x8*)(kb + d0 * 2048); ka[2 * d0 + 1] = *(const LAS bf16x8*)(kb + d0 * 2048 + 512); }
    ATT_SB();
    float ra = fmaxf(fmaxf(pc0[0], pc0[1]), fmaxf(pc0[2], pc0[3]));
    if (doNext) pn0 = MFMA32(ka[0], qr[0], pn0);
    ra = fmaxf(fmaxf(ra, pc1[0]), pc1[1]); ra = fmaxf(fmaxf(ra, pc1[2]), pc1[3]); ATT_SB();
    if (doNext) pn1 = MFMA32(ka[1], qr[0], pn1);
#pragma unroll
    for (int d0 = 2; d0 < 4; ++d0) { kc[2 * d0 - 4] = *(const LAS bf16x8*)(kb + d0 * 2048); kc[2 * d0 - 3] = *(const LAS bf16x8*)(kb + d0 * 2048 + 512); }
    ra = fmaxf(fmaxf(ra, pc0[4]), pc0[5]); ra = fmaxf(fmaxf(ra, pc0[6]), pc0[7]); ra = fmaxf(fmaxf(ra, pc1[4]), pc1[5]); ra = fmaxf(fmaxf(ra, pc1[6]), pc1[7]); ATT_SB();
    if (doNext) pn0 = MFMA32(ka[2], qr[1], pn0);
    ra = fmaxf(fmaxf(ra, pc0[8]), pc0[9]); ra = fmaxf(fmaxf(ra, pc0[10]), pc0[11]); ra = fmaxf(fmaxf(ra, pc1[8]), pc1[9]); ra = fmaxf(fmaxf(ra, pc1[10]), pc1[11]); ATT_SB();
    if (doNext) pn1 = MFMA32(ka[3], qr[1], pn1);
    ra = fmaxf(fmaxf(ra, pc0[12]), pc0[13]); ra = fmaxf(fmaxf(ra, pc0[14]), pc0[15]); ra = fmaxf(fmaxf(ra, pc1[12]), pc1[13]); ra = fmaxf(fmaxf(ra, pc1[14]), pc1[15]);
    ra = half_max(ra); ATT_SB();
    attn_rescale(A, ra);
    const float mn = A.m;
    ATT_SB();
    const LAS unsigned char* vb = Vc + ((lane >> 4) & 1) * 32 + (lane & 3) * 8 + (4 * hi + ((lane & 15) >> 2)) * 64;
    s16x4 vt[16];
    v4u pw[4];
#define ATT_VRD(ks) do { vt[4 * (ks)] = vtr(vb + (ks) * 1024); vt[4 * (ks) + 1] = vtr(vb + (ks) * 1024 + 512); vt[4 * (ks) + 2] = vtr(vb + (4 + (ks)) * 1024); vt[4 * (ks) + 3] = vtr(vb + (4 + (ks)) * 1024 + 512); } while (0)
#define ATT_EXP4(P, c) do { _Pragma("unroll") for (int i_ = 0; i_ < 4; ++i_) P[4 * (c) + i_] = __builtin_amdgcn_exp2f(P[4 * (c) + i_] - mn); } while (0)
    ATT_VRD(0); ATT_VRD(1); ATT_SB();
    if (doNext) pn0 = MFMA32(kc[0], qr[2], pn0); ATT_EXP4(pc0, 0); ATT_EXP4(pc0, 1);
    pw[0].x = cvtpk(pc0[0], pc0[1]); pw[0].y = cvtpk(pc0[2], pc0[3]); pw[0].z = cvtpk(pc0[4], pc0[5]); pw[0].w = cvtpk(pc0[6], pc0[7]); ATT_SB();
    if (doNext) pn1 = MFMA32(kc[1], qr[2], pn1); ATT_EXP4(pc0, 2); ATT_EXP4(pc0, 3);
    pw[1].x = cvtpk(pc0[8], pc0[9]); pw[1].y = cvtpk(pc0[10], pc0[11]); pw[1].z = cvtpk(pc0[12], pc0[13]); pw[1].w = cvtpk(pc0[14], pc0[15]); ATT_SB();
    ATT_VRD(2); ATT_VRD(3); ATT_SB();
    if (doNext) pn0 = MFMA32(kc[2], qr[3], pn0); ATT_EXP4(pc1, 0); ATT_EXP4(pc1, 1);
    pw[2].x = cvtpk(pc1[0], pc1[1]); pw[2].y = cvtpk(pc1[2], pc1[3]); pw[2].z = cvtpk(pc1[4], pc1[5]); pw[2].w = cvtpk(pc1[6], pc1[7]); ATT_SB();
    if (doNext) pn1 = MFMA32(kc[3], qr[3], pn1); ATT_EXP4(pc1, 2); ATT_EXP4(pc1, 3);
    pw[3].x = cvtpk(pc1[8], pc1[9]); pw[3].y = cvtpk(pc1[10], pc1[11]); pw[3].z = cvtpk(pc1[12], pc1[13]); pw[3].w = cvtpk(pc1[14], pc1[15]); ATT_SB();
#undef ATT_EXP4
#undef ATT_VRD
    if (doNext) Bn.mask(pn0, pn1, hi);
    ATT_SB();
    const bf16x8 ones = {(short)0x3F80, (short)0x3F80, (short)0x3F80, (short)0x3F80, (short)0x3F80, (short)0x3F80, (short)0x3F80, (short)0x3F80};
#pragma unroll
    for (int ks = 0; ks < 4; ++ks) {
        const bf16x8 pa = __builtin_bit_cast(bf16x8, pw[ks]);
        const s16x4 a0 = vt[4 * ks], a1 = vt[4 * ks + 1], b0 = vt[4 * ks + 2], b1 = vt[4 * ks + 3];
        const bf16x8 v0 = {a0[0], a0[1], a0[2], a0[3], a1[0], a1[1], a1[2], a1[3]}, v1 = {b0[0], b0[1], b0[2], b0[3], b1[0], b1[1], b1[2], b1[3]};
        A.o0 = MFMA32(v0, pa, A.o0); A.o1 = MFMA32(v1, pa, A.o1); A.la = MFMA32(ones, pa, A.la);
    }
    ATT_SB();
}

template <class Bias> __device__ __forceinline__ void attn_step3(AttnAcc& A, f32x16& pc0, f32x16& pc1, f32x16& pn0, f32x16& pn1, const v4u (&pwp)[4], v4u (&pw)[4], const bf16x8 (&qr)[4],
        const LAS unsigned char* Kn, const LAS unsigned char* Vp, int r32, int hi, int lane, const Bias& Bn, const bool doCur) {
    const bf16x8 ones = {(short)0x3F80, (short)0x3F80, (short)0x3F80, (short)0x3F80, (short)0x3F80, (short)0x3F80, (short)0x3F80, (short)0x3F80};
    const LAS unsigned char* kb = Kn + hi * 1024 + r32 * 16;
    const LAS unsigned char* vb = Vp + ((lane >> 4) & 1) * 32 + (lane & 3) * 8 + (4 * hi + ((lane & 15) >> 2)) * 64;
    bf16x8 ka[2], kc[2]; s16x4 va[4], vc[4], vd[4], ve[4];
#define ATT_VRD(dst, ks) do { dst[0] = vtr(vb + (ks) * 1024); dst[1] = vtr(vb + (ks) * 1024 + 512); dst[2] = vtr(vb + (4 + (ks)) * 1024); dst[3] = vtr(vb + (4 + (ks)) * 1024 + 512); } while (0)
#define ATT_V0(v) ((bf16x8){v[0][0], v[0][1], v[0][2], v[0][3], v[1][0], v[1][1], v[1][2], v[1][3]})
#define ATT_V1(v) ((bf16x8){v[2][0], v[2][1], v[2][2], v[2][3], v[3][0], v[3][1], v[3][2], v[3][3]})
#define ATT_PA(k) __builtin_bit_cast(bf16x8, pwp[k])
#define ATT_PIN(x) asm volatile("" : "+v"(x))
    ATT_SB();
    Bn.init(pn0, pn1, hi);
    ka[0] = *(const LAS bf16x8*)(kb); ka[1] = *(const LAS bf16x8*)(kb + 512); kc[0] = *(const LAS bf16x8*)(kb + 2048); kc[1] = *(const LAS bf16x8*)(kb + 2560);
    ATT_VRD(va, 0);
    ATT_SB();
    float ra = fmaxf(fmaxf(pc0[0], pc0[1]), fmaxf(pc0[2], pc0[3]));
    pn0 = MFMA32(ka[0], qr[0], pn0);
    A.o0 = MFMA32(ATT_V0(va), ATT_PA(0), A.o0);
    ra = fmaxf(fmaxf(ra, pc1[0]), pc1[1]); ra = fmaxf(fmaxf(ra, pc1[2]), pc1[3]); ra = fmaxf(fmaxf(ra, pc0[4]), pc0[5]); ra = fmaxf(fmaxf(ra, pc0[6]), pc0[7]); ATT_PIN(ra);
    ATT_VRD(vc, 1);
    ATT_SB();
    pn1 = MFMA32(ka[1], qr[0], pn1);
    A.o1 = MFMA32(ATT_V1(va), ATT_PA(0), A.o1);
    ra = fmaxf(fmaxf(ra, pc1[4]), pc1[5]); ra = fmaxf(fmaxf(ra, pc1[6]), pc1[7]); ra = fmaxf(fmaxf(ra, pc0[8]), pc0[9]); ra = fmaxf(fmaxf(ra, pc0[10]), pc0[11]); ATT_PIN(ra);
    ka[0] = *(const LAS bf16x8*)(kb + 4096); ka[1] = *(const LAS bf16x8*)(kb + 4608);
    ATT_SB();
    pn0 = MFMA32(kc[0], qr[1], pn0);
    A.la = MFMA32(ones, ATT_PA(0), A.la); A.o0 = MFMA32(ATT_V0(vc), ATT_PA(1), A.o0);
    ATT_VRD(vd, 2);
    ra = fmaxf(fmaxf(ra, pc1[8]), pc1[9]); ra = fmaxf(fmaxf(ra, pc1[10]), pc1[11]); ra = fmaxf(fmaxf(ra, pc0[12]), pc0[13]); ra = fmaxf(fmaxf(ra, pc0[14]), pc0[15]); ATT_PIN(ra); ATT_SB();
    pn1 = MFMA32(kc[1], qr[1], pn1);
    A.o1 = MFMA32(ATT_V1(vc), ATT_PA(1), A.o1); A.la = MFMA32(ones, ATT_PA(1), A.la);
    ATT_VRD(ve, 3);
    kc[0] = *(const LAS bf16x8*)(kb + 6144); kc[1] = *(const LAS bf16x8*)(kb + 6656);
    ra = fmaxf(fmaxf(ra, pc1[12]), pc1[13]); ra = fmaxf(fmaxf(ra, pc1[14]), pc1[15]); ra = half_max(ra);
    const bool need = doCur && (ra > A.m + ATT_THR);
    float mn = need ? ra : A.m; const float fr = __builtin_amdgcn_exp2f(A.m - mn); ATT_PIN(mn);
    ATT_SB();
#define ATT_EXP4(P, c) do { _Pragma("unroll") for (int i_ = 0; i_ < 4; ++i_) P[4 * (c) + i_] = __builtin_amdgcn_exp2f(P[4 * (c) + i_] - mn); } while (0)
    pn0 = MFMA32(ka[0], qr[2], pn0);
    A.o0 = MFMA32(ATT_V0(vd), ATT_PA(2), A.o0);
    { ATT_EXP4(pc0, 0); ATT_EXP4(pc0, 1); pw[0].x = cvtpk(pc0[0], pc0[1]); pw[0].y = cvtpk(pc0[2], pc0[3]); pw[0].z = cvtpk(pc0[4], pc0[5]); pw[0].w = cvtpk(pc0[6], pc0[7]); ATT_PIN(pw[0]); }
    ATT_SB();
    pn1 = MFMA32(ka[1], qr[2], pn1);
    A.o1 = MFMA32(ATT_V1(vd), ATT_PA(2), A.o1);
    { ATT_EXP4(pc0, 2); ATT_EXP4(pc0, 3); pw[1].x = cvtpk(pc0[8], pc0[9]); pw[1].y = cvtpk(pc0[10], pc0[11]); pw[1].z = cvtpk(pc0[12], pc0[13]); pw[1].w = cvtpk(pc0[14], pc0[15]); ATT_PIN(pw[1]); }
    ATT_SB();
    pn0 = MFMA32(kc[0], qr[3], pn0);
    A.la = MFMA32(ones, ATT_PA(2), A.la); A.o0 = MFMA32(ATT_V0(ve), ATT_PA(3), A.o0);
    { ATT_EXP4(pc1, 0); ATT_EXP4(pc1, 1); pw[2].x = cvtpk(pc1[0], pc1[1]); pw[2].y = cvtpk(pc1[2], pc1[3]); pw[2].z = cvtpk(pc1[4], pc1[5]); pw[2].w = cvtpk(pc1[6], pc1[7]); ATT_PIN(pw[2]); }
    ATT_SB();
    pn1 = MFMA32(kc[1], qr[3], pn1);
    A.o1 = MFMA32(ATT_V1(ve), ATT_PA(3), A.o1); A.la = MFMA32(ones, ATT_PA(3), A.la);
    { ATT_EXP4(pc1, 2); ATT_EXP4(pc1, 3); pw[3].x = cvtpk(pc1[8], pc1[9]); pw[3].y = cvtpk(pc1[10], pc1[11]); pw[3].z = cvtpk(pc1[12], pc1[13]); pw[3].w = cvtpk(pc1[14], pc1[15]); ATT_PIN(pw[3]); }
    ATT_SB();
#undef ATT_EXP4
#undef ATT_VRD
#undef ATT_V0
#undef ATT_V1
#undef ATT_PA
#undef ATT_PIN
    Bn.mask(pn0, pn1, hi);
    if (__any(need)) {
        A.la[0] *= fr;
#pragma unroll
        for (int r = 0; r < 16; ++r) { A.o0[r] *= fr; A.o1[r] *= fr; }
    }
    A.m = mn;
    ATT_SB();
}

__device__ __forceinline__ void store_o(bf16* op, const AttnAcc& A, float inv, int hi) {
#pragma unroll
    for (int g = 0; g < 4; ++g) {
        u32x2 w0, w1; w0.x = cvtpk(A.o0[4 * g] * inv, A.o0[4 * g + 1] * inv); w0.y = cvtpk(A.o0[4 * g + 2] * inv, A.o0[4 * g + 3] * inv);
        w1.x = cvtpk(A.o1[4 * g] * inv, A.o1[4 * g + 1] * inv); w1.y = cvtpk(A.o1[4 * g + 2] * inv, A.o1[4 * g + 3] * inv);
        *(GAS u32x2*)(op + 8 * g + 4 * hi) = w0; *(GAS u32x2*)(op + 32 + 8 * g + 4 * hi) = w1; }
}

__device__ __forceinline__ void store_o8(unsigned char* op, const AttnAcc& A, float inv, int hi) {
    const float s = inv * OQ_SCALE;
#pragma unroll
    for (int g = 0; g < 4; ++g) {
        *(GAS unsigned*)(op + 8 * g + 4 * hi) = pk4_f8(A.o0[4 * g] * s, A.o0[4 * g + 1] * s, A.o0[4 * g + 2] * s, A.o0[4 * g + 3] * s);
        *(GAS unsigned*)(op + 32 + 8 * g + 4 * hi) = pk4_f8(A.o1[4 * g] * s, A.o1[4 * g + 1] * s, A.o1[4 * g + 2] * s, A.o1[4 * g + 3] * s); }
}

__device__ __forceinline__ int rel_bucket(int n) {
    if (n < 16) return n;
    int b = 16;
    b += (n >= 19); b += (n >= 21); b += (n >= 24); b += (n >= 27); b += (n >= 31); b += (n >= 35); b += (n >= 40); b += (n >= 46);
    b += (n >= 52); b += (n >= 59); b += (n >= 67); b += (n >= 77); b += (n >= 87); b += (n >= 99); b += (n >= 113);
    return b;
}
__device__ __forceinline__ void build_relb(const Ctx& C, const float* rel_bias, LAS float* relb) {
    for (int i = C.tid; i < H * 128; i += NTHR) { const int h = i >> 7, n = i & 127; relb[i] = rel_bias[rel_bucket(n) * H + h] * LOG2E; }
}
struct MobaBias {
    const LAS float* relb; int qpos, kpos0; bool lookup, causal; float cbias;
    __device__ __forceinline__ void init(f32x16& p0, f32x16& p1, int hi) const {
        if (lookup) {
            int dbase = qpos - kpos0 - 4 * hi; asm volatile("" : "+v"(dbase));
#pragma unroll
            for (int r = 0; r < 16; ++r) { const int d0 = dbase - ((r & 3) + 8 * (r >> 2)), d1 = d0 - 32;
                const int i0 = d0 < 0 ? 0 : (d0 > 127 ? 127 : d0), i1 = d1 < 0 ? 0 : (d1 > 127 ? 127 : d1);
                p0[r] = relb[i0]; p1[r] = relb[i1];
                if ((r & 3) == 3) __builtin_amdgcn_sched_barrier(0); }
        } else {
#pragma unroll
            for (int r = 0; r < 16; ++r) { p0[r] = cbias; p1[r] = cbias; }
        }
    }
    __device__ __forceinline__ void mask(f32x16& p0, f32x16& p1, int hi) const {
        if (causal) {
            int d = qpos - kpos0 - 4 * hi; asm volatile("" : "+v"(d));
#pragma unroll
            for (int r = 0; r < 16; ++r) { const int c = (r & 3) + 8 * (r >> 2); if (c > d) p0[r] = NEG_INF; if (c + 32 > d) p1[r] = NEG_INF; }
        }
    }
};
struct FoxBias {
    const LAS float* cb; int qrel, krel0; bool causal;
    __device__ __forceinline__ void init(f32x16& p0, f32x16& p1, int hi) const {
#pragma unroll
        for (int g = 0; g < 4; ++g) { const f32x4 c0 = *(const LAS f32x4*)(cb + 8 * g + 4 * hi), c1 = *(const LAS f32x4*)(cb + 32 + 8 * g + 4 * hi);
#pragma unroll
            for (int i = 0; i < 4; ++i) { p0[4 * g + i] = c0[i]; p1[4 * g + i] = c1[i]; } }
    }
    __device__ __forceinline__ void mask(f32x16& p0, f32x16& p1, int hi) const {
        if (causal) {
            int d = qrel - krel0 - 4 * hi; asm volatile("" : "+v"(d));
#pragma unroll
            for (int r = 0; r < 16; ++r) { const int c = (r & 3) + 8 * (r >> 2); if (c > d) p0[r] = NEG_INF; if (c + 32 > d) p1[r] = NEG_INF; }
        }
    }
};

__device__ __forceinline__ int mlist_off(int j) { return 256 * (31 * j - (j * (j - 1)) / 2); }
#define INS3(s_, j_) do { const float s__ = (s_); const int j__ = (j_); \
    if (s__ > sv0 || (s__ == sv0 && j__ < sel0)) { sv2 = sv1; sel2 = sel1; sv1 = sv0; sel1 = sel0; sv0 = s__; sel0 = j__; } \
    else if (s__ > sv1 || (s__ == sv1 && j__ < sel1)) { sv2 = sv1; sel2 = sel1; sv1 = s__; sel1 = j__; } \
    else if (s__ > sv2 || (s__ == sv2 && j__ < sel2)) { sv2 = s__; sel2 = j__; } } while (0)
__device__ __forceinline__ void ph_select(const Ctx& C, const bf16* Q, const float* ksum, unsigned* mcnt, unsigned* mlist) {
    LAS float* km = (LAS float*)C.lds;
    LAS unsigned* lcnt = (LAS unsigned*)(C.lds + 8192);
    const int lane = C.lane, wave = C.wave, r32 = lane & 31, hi = lane >> 5;
    for (int u = C.vcu; u < BATCH * H * 31; u += C.G) {
        const int bh = u / 31, own = 1 + u % 31, b = bh >> 4, h = bh & 15;
        __syncthreads();
        for (int i = C.tid; i < 32 * 64; i += NTHR) km[i] = ksum[(size_t)(b * NBLK + (i >> 6)) * D + h * 64 + (i & 63)];
        if (C.tid < 64) lcnt[C.tid] = 0u;
        bf16x8 qr[4]; load_q(qr, Q + (size_t)(b * SEQ + own * 256 + wave * 32 + r32) * D + h * 64, hi);
        __syncthreads();
        f32x16 sc; { float z = 0.f; asm volatile("" : "+v"(z));
#pragma unroll
        for (int r = 0; r < 16; ++r) sc[r] = z; }
#pragma unroll
        for (int d0 = 0; d0 < 4; ++d0) {
            const f32x4 x0 = *(const LAS f32x4*)(km + r32 * 64 + 16 * d0 + 8 * hi), x1 = *(const LAS f32x4*)(km + r32 * 64 + 16 * d0 + 8 * hi + 4);
            v4u wh, wl; wh.x = cvtpk(x0.x, x0.y); wh.y = cvtpk(x0.z, x0.w); wh.z = cvtpk(x1.x, x1.y); wh.w = cvtpk(x1.z, x1.w);
            wl.x = cvtpk(x0.x - bflo(wh.x), x0.y - bfhi(wh.x)); wl.y = cvtpk(x0.z - bflo(wh.y), x0.w - bfhi(wh.y)); wl.z = cvtpk(x1.x - bflo(wh.z), x1.y - bfhi(wh.z)); wl.w = cvtpk(x1.z - bflo(wh.w), x1.w - bfhi(wh.w));
            sc = MFMA32(__builtin_bit_cast(bf16x8, wh), qr[d0], sc); sc = MFMA32(__builtin_bit_cast(bf16x8, wl), qr[d0], sc);
        }
        float sv0 = NEG_INF, sv1 = NEG_INF, sv2 = NEG_INF; int sel0 = 64, sel1 = 64, sel2 = 64;
#pragma unroll
        for (int r = 0; r < 16; ++r) { const int j = (r & 3) + 8 * (r >> 2) + 4 * hi; if (j < own) INS3(sc[r], j); }
        {
            const float pv0 = __shfl_xor(sv0, 32), pv1 = __shfl_xor(sv1, 32), pv2 = __shfl_xor(sv2, 32);
            const int p0 = __shfl_xor(sel0, 32), p1 = __shfl_xor(sel1, 32), p2 = __shfl_xor(sel2, 32);
            if (p0 < 64) INS3(pv0, p0);
            if (p1 < 64) INS3(pv1, p1);
            if (p2 < 64) INS3(pv2, p2); }
        const int nv = own < 3 ? own : 3; int rk0 = 0, rk1 = 0, rk2 = 0;
        if (hi == 0) {
            rk0 = (int)__hip_atomic_fetch_add(&lcnt[sel0], 1u, __ATOMIC_RELAXED, __HIP_MEMORY_SCOPE_WORKGROUP);
            if (nv > 1) rk1 = (int)__hip_atomic_fetch_add(&lcnt[sel1], 1u, __ATOMIC_RELAXED, __HIP_MEMORY_SCOPE_WORKGROUP);
            if (nv > 2) rk2 = (int)__hip_atomic_fetch_add(&lcnt[sel2], 1u, __ATOMIC_RELAXED, __HIP_MEMORY_SCOPE_WORKGROUP);
        }
        __syncthreads();
        if (C.tid < 32) { const unsigned c = lcnt[C.tid]; if (c) lcnt[32 + C.tid] = __hip_atomic_fetch_add(mcnt + bh * 32 + C.tid, c, __ATOMIC_RELAXED, __HIP_MEMORY_SCOPE_AGENT); }
        __syncthreads();
        if (hi == 0) {
            unsigned* lst = mlist + (size_t)bh * MLIST_PER_BH; const unsigned tl = (unsigned)(own * 256 + wave * 32 + r32);
            lst[mlist_off(sel0) + lcnt[32 + sel0] + rk0] = tl;
            if (nv > 1) lst[mlist_off(sel1) + lcnt[32 + sel1] + rk1] = tl | (1u << 16);
            if (nv > 2) lst[mlist_off(sel2) + lcnt[32 + sel2] + rk2] = tl | (2u << 16);
        }
    }
}
constexpr int RELB_OFF = 131072;
constexpr int PRE_OFF = 139264;
constexpr int UINFO_OFF = 147456;
static_assert(PRE_OFF + 2080 * 4 <= LDSCTL_OFF && UINFO_OFF + 64 <= LDSCTL_OFF && 4 * 33280 <= UINFO_OFF, "attention LDS map");

__device__ __forceinline__ int part_next(int u, int uw, int usb, int per) { const int k = (u - usb) % per; return (k + 1 < uw) ? u + 1 : u - k + per; }
__device__ __forceinline__ void ph_moba_part(const Ctx& C, const bf16* Q, const bf16* K, const bf16* V, const float* rel_bias, const unsigned* mcnt, const unsigned* mlist, bf16* parto, float* partml, const int uw, const int usb, const int per) {
    if (C.wave >= 4) __builtin_amdgcn_s_setprio(1);
    LAS float* relb = (LAS float*)(C.lds + RELB_OFF);
    LAS int* pre = (LAS int*)(C.lds + PRE_OFF);
    const int lane = C.lane, wave = C.wave, r32 = lane & 31, hi = lane >> 5;
    __syncthreads();
    build_relb(C, rel_bias, relb);
    {   int v[4], s = 0;
#pragma unroll
        for (int i = 0; i < 4; ++i) { v[i] = (int)((__hip_atomic_load(mcnt + 4 * C.tid + i, __ATOMIC_RELAXED, __HIP_MEMORY_SCOPE_AGENT) + 255u) >> 8); s += v[i]; }
        int inc = s;
#pragma unroll
        for (int o = 1; o < 64; o <<= 1) { const int t = __shfl_up(inc, o); if (lane >= o) inc += t; }
        if (lane == 63) pre[2056 + wave] = inc;
        __syncthreads();
        int base = 0; for (int w = 0; w < wave; ++w) base += pre[2056 + w];
        const int ex = base + inc - s;
        pre[4 * C.tid] = ex; pre[4 * C.tid + 1] = ex + v[0]; pre[4 * C.tid + 2] = ex + v[0] + v[1]; pre[4 * C.tid + 3] = ex + v[0] + v[1] + v[2];
        if (C.tid == NTHR - 1) pre[2048] = ex + s;
        __syncthreads();
    }
    const int total = pre[2048];
    int u = usb, cur = 0, idx = 0;
    if (u < total) {
        int lo = 0, hi_ = 2048;
#pragma unroll
        for (int s = 0; s < 11; ++s) { const int mid = (lo + hi_) >> 1; if (pre[mid] <= u) lo = mid; else hi_ = mid; }
        idx = lo;
        const int bh = idx >> 5, j = idx & 31, b = bh >> 4, h = bh & 15;
        const bf16* Kg = K + (size_t)(b * SEQ + j * 256) * D + h * 64; const bf16* Vg = V + (size_t)(b * SEQ + j * 256) * D + h * 64;
#pragma unroll
        for (int t4 = 0; t4 < 4; ++t4) dma_tile(Kg + (size_t)t4 * 64 * D, Vg + (size_t)t4 * 64 * D, C.lds + t4 * 8192, C.lds + 32768 + t4 * 8192, wave, lane);
    }
    unsigned ent = 0u, ent_n = 0u; bool valid = false, valid_n = false;
    if (u < total) { const int bh = idx >> 5, j = idx & 31, chunk = u - pre[idx]; const int n = (int)__hip_atomic_load(mcnt + idx, __ATOMIC_RELAXED, __HIP_MEMORY_SCOPE_AGENT);
        const int i = chunk * 256 + wave * 32 + r32; valid = i < n; ent = mlist[(size_t)bh * MLIST_PER_BH + mlist_off(j) + (valid ? i : chunk * 256)]; }
    while (u < total) {
        const int bh = idx >> 5, j = idx & 31, b = bh >> 4, h = bh & 15;
        const int tl = (int)(ent & 0xffffu), slot = (int)(ent >> 16);
        bf16x8 qr[4]; load_q(qr, Q + (size_t)(b * SEQ + tl) * D + h * 64, hi);
        LAS unsigned char* Ks = C.lds + cur * 65536; LAS unsigned char* Vs = Ks + 32768;
        VM_WAIT(); __syncthreads();
        const int un = u + per; int nidx = 0;
        if (un < total) {
            int lo = 0, hi_ = 2048;
#pragma unroll
            for (int s = 0; s < 11; ++s) { const int mid = (lo + hi_) >> 1; if (pre[mid] <= un) lo = mid; else hi_ = mid; }
            nidx = lo;
            const int nbh = nidx >> 5, nj = nidx & 31, nb = nbh >> 4, nh = nbh & 15;
            const bf16* Kg = K + (size_t)(nb * SEQ + nj * 256) * D + nh * 64; const bf16* Vg = V + (size_t)(nb * SEQ + nj * 256) * D + nh * 64;
            LAS unsigned char* Kn = C.lds + (cur ^ 1) * 65536;
#pragma unroll
            for (int t4 = 0; t4 < 4; ++t4) dma_tile(Kg + (size_t)t4 * 64 * D, Vg + (size_t)t4 * 64 * D, Kn + t4 * 8192, Kn + 32768 + t4 * 8192, wave, lane);
            const int nchunk = un - pre[nidx], nn = (int)__hip_atomic_load(mcnt + nidx, __ATOMIC_RELAXED, __HIP_MEMORY_SCOPE_AGENT), ni = nchunk * 256 + wave * 32 + r32;
            valid_n = ni < nn; ent_n = mlist[(size_t)nbh * MLIST_PER_BH + mlist_off(nj) + (valid_n ? ni : nchunk * 256)];
        }
        AttnAcc A;
        const bool lk = __any((tl - (j * 256 + 255)) < 128) != 0;
        MobaBias B{relb + h * 128, tl, j * 256, lk, false, relb[h * 128 + 127]};
        f32x16 a0, a1, b0, b1;
        acc_init(A); B.kpos0 = j * 256;
        if (__any(valid)) {
        qk_tile(a0, a1, qr, Ks, r32, hi, B);
#pragma unroll 1
        for (int tp = 0; tp < 4; tp += 2) {
            B.kpos0 = j * 256 + 64 * (tp + 1); attn_step(A, a0, a1, b0, b1, qr, Ks + (tp + 1) * 8192, Vs + tp * 8192, r32, hi, lane, B, true);
            B.kpos0 = j * 256 + 64 * (tp + 2); attn_step(A, b0, b1, a0, a1, qr, Ks + ((tp + 2) & 3) * 8192, Vs + (tp + 1) * 8192, r32, hi, lane, B, tp == 0);
        }
        }
        const float lt = A.la[0], inv = 1.f / lt;
        if (valid) {
            const size_t rowi = ((size_t)(b * SEQ + tl) * H + h) * 3 + slot;
            store_o(parto + rowi * 64, A, inv, hi);
            if (hi == 0) *(GAS f32x2*)(partml + rowi * 2) = (f32x2){A.m, lt};
        }
        u = un; idx = nidx; cur ^= 1; ent = ent_n; valid = valid_n;
    }
    __builtin_amdgcn_s_setprio(0);
}
__device__ __forceinline__ void ph_moba_own(const Ctx& C, const bf16* Q, const bf16* K, const bf16* V, const float* rel_bias, const bf16* parto, const float* partml, unsigned char* O) {
    if (C.wave >= 4) __builtin_amdgcn_s_setprio(1);
    LAS float* relb = (LAS float*)(C.lds + RELB_OFF);
    const int lane = C.lane, wave = C.wave, r32 = lane & 31, hi = lane >> 5;
    __syncthreads();
    build_relb(C, rel_bias, relb);
    constexpr int NU = BATCH * H * NBLK;
    int u = C.vcu, cur = 0;
    if (u < NU) {
        const int bh = u >> 5, own = u & 31, b = bh >> 4, h = bh & 15;
        const bf16* Kg = K + (size_t)(b * SEQ + own * 256) * D + h * 64; const bf16* Vg = V + (size_t)(b * SEQ + own * 256) * D + h * 64;
#pragma unroll
        for (int t4 = 0; t4 < 4; ++t4) dma_tile(Kg + (size_t)t4 * 64 * D, Vg + (size_t)t4 * 64 * D, C.lds + t4 * 8192, C.lds + 32768 + t4 * 8192, wave, lane);
    }
    while (u < NU) {
        const int bh = u >> 5, own = u & 31, b = bh >> 4, h = bh & 15;
        const int qblk = wave < 4 ? wave : 11 - wave;
        const int tl = own * 256 + qblk * 32 + r32;
        bf16x8 qr[4]; load_q(qr, Q + (size_t)(b * SEQ + tl) * D + h * 64, hi);
        const int nv = own < 3 ? own : 3;
        const size_t rowi = ((size_t)(b * SEQ + tl) * H + h) * 3;
        LAS unsigned char* Ks = C.lds + cur * 65536; LAS unsigned char* Vs = Ks + 32768;
        VM_WAIT(); __syncthreads();
        const int un = u + C.G;
        if (un < NU) {
            const int nbh = un >> 5, nown = un & 31, nb = nbh >> 4, nh = nbh & 15;
            const bf16* Kg = K + (size_t)(nb * SEQ + nown * 256) * D + nh * 64; const bf16* Vg = V + (size_t)(nb * SEQ + nown * 256) * D + nh * 64;
            LAS unsigned char* Kn = C.lds + (cur ^ 1) * 65536;
#pragma unroll
            for (int t4 = 0; t4 < 4; ++t4) dma_tile(Kg + (size_t)t4 * 64 * D, Vg + (size_t)t4 * 64 * D, Kn + t4 * 8192, Kn + 32768 + t4 * 8192, wave, lane);
        }
        AttnAcc A; acc_init(A);
        const int tlast = qblk >> 1;
        MobaBias B{relb + h * 128, tl, own * 256, true, tlast == 0, 0.f};
        f32x16 a0, a1, b0, b1;
        qk_tile(a0, a1, qr, Ks, r32, hi, B);
#pragma unroll 1
        for (int tp = 0; tp < 4; tp += 2) {
            if (tp <= tlast) { B.kpos0 = own * 256 + 64 * (tp + 1); B.causal = (tp + 1 == tlast); attn_step(A, a0, a1, b0, b1, qr, Ks + (tp + 1) * 8192, Vs + tp * 8192, r32, hi, lane, B, tp + 1 <= tlast); }
            if (tp + 1 <= tlast) { B.kpos0 = own * 256 + 64 * (tp + 2); B.causal = (tp + 2 == tlast); attn_step(A, b0, b1, a0, a1, qr, Ks + ((tp + 2) & 3) * 8192, Vs + (tp + 1) * 8192, r32, hi, lane, B, tp + 2 <= tlast); }
        }
        const float lt = A.la[0];
        float mi[3], li[3];
#pragma unroll
        for (int i = 0; i < 3; ++i) { mi[i] = NEG_INF; li[i] = 0.f; if (i < nv) { const f32x2 ml = *(const GAS f32x2*)(partml + (rowi + i) * 2); mi[i] = ml.x; li[i] = ml.y; } }
        float M = A.m;
#pragma unroll
        for (int i = 0; i < 3; ++i) M = fmaxf(M, mi[i]);
        const float w0 = __builtin_amdgcn_exp2f(A.m - M); float den = w0 * lt;
#pragma unroll
        for (int r = 0; r < 16; ++r) { A.o0[r] *= w0; A.o1[r] *= w0; }
#pragma unroll
        for (int i = 0; i < 3; ++i) if (i < nv) {
            const float wi = li[i] * __builtin_amdgcn_exp2f(mi[i] - M); den += wi;
            const bf16* po = parto + (rowi + i) * 64;
#pragma unroll
            for (int g = 0; g < 4; ++g) { const u32x2 a = *(const GAS u32x2*)(po + 8 * g + 4 * hi), c = *(const GAS u32x2*)(po + 32 + 8 * g + 4 * hi);
                A.o0[4 * g] += wi * bflo(a.x); A.o0[4 * g + 1] += wi * bfhi(a.x); A.o0[4 * g + 2] += wi * bflo(a.y); A.o0[4 * g + 3] += wi * bfhi(a.y);
                A.o1[4 * g] += wi * bflo(c.x); A.o1[4 * g + 1] += wi * bfhi(c.x); A.o1[4 * g + 2] += wi * bflo(c.y); A.o1[4 * g + 3] += wi * bfhi(c.y); }
        }
        store_o8(O + (size_t)(b * SEQ + tl) * D + h * 64, A, 1.f / den, hi);
        u = un; cur ^= 1;
    }
    __builtin_amdgcn_s_setprio(0);
}

__device__ __forceinline__ void ph_scan(const Ctx& C, const float* logf, float* ncum) {
    LAS float* wt = (LAS float*)C.lds;
    for (int bh = C.vcu; bh < BATCH * H; bh += C.G) {
        const int b = bh >> 4, h = bh & 15;
        float v[16], s = 0.f;
#pragma unroll
        for (int i = 0; i < 16; ++i) { v[i] = logf[(size_t)(b * SEQ + C.tid * 16 + i) * H + h]; s += v[i]; }
        float inc = s;
#pragma unroll
        for (int o = 1; o < 64; o <<= 1) { const float t = __shfl_up(inc, o); if (C.lane >= o) inc += t; }
        __syncthreads();
        if (C.lane == 63) wt[C.wave] = inc;
        __syncthreads();
        float run = inc - s; for (int w = 0; w < C.wave; ++w) run += wt[w];
#pragma unroll
        for (int i = 0; i < 16; ++i) { run += v[i]; ncum[(size_t)bh * SEQ + C.tid * 16 + i] = -run * LOG2E; }
    }
}
__device__ __forceinline__ void ph_fox(const Ctx& C, const bf16* Q, const bf16* K, const bf16* V, const float* ncum, const unsigned* norms, unsigned char* O, unsigned* qctr) {
    if (C.wave >= 4) __builtin_amdgcn_s_setprio(1);
    constexpr int GB = 33280;
    LAS int* uinfo = (LAS int*)(C.lds + UINFO_OFF);
    const int lane = C.lane, wave = C.wave, r32 = lane & 31, hi = lane >> 5;
    for (;;) {
        __syncthreads();
        if (C.tid == 0) { uinfo[0] = (int)__hip_atomic_fetch_add(qctr, 1u, __ATOMIC_RELAXED, __HIP_MEMORY_SCOPE_AGENT); uinfo[1] = 0; uinfo[2] = 0; uinfo[3] = -1; }
        __syncthreads();
        const int idx = uinfo[0];
        if (idx >= BATCH * H * NBLK) break;
        const int qb = 31 - (idx >> 6), bh = idx & 63, b = bh >> 4, h = bh & 15, NT = 4 * (qb + 1);
        const float* ng = ncum + (size_t)bh * SEQ; const float nref = ng[qb * 256];
        const int qblk = wave < 4 ? wave : 11 - wave;
        const int qrel = qblk * 32 + r32;
        bf16x8 qr[4]; load_q(qr, Q + (size_t)(b * SEQ + qb * 256 + qrel) * D + h * 64, hi);
        {   float q2 = 0.f;
#pragma unroll
            for (int d0 = 0; d0 < 4; ++d0)
#pragma unroll
                for (int i = 0; i < 8; ++i) { const float x = bf2f((unsigned)(unsigned short)qr[d0][i]); q2 += x * x; }
            q2 += __shfl_xor(q2, 32);
#pragma unroll
            for (int o = 1; o < 32; o <<= 1) q2 = fmaxf(q2, __shfl_xor(q2, o));
            if (lane == 0) (void)__hip_atomic_fetch_max((LAS unsigned*)&uinfo[2], __float_as_uint(q2), __ATOMIC_RELAXED, __HIP_MEMORY_SCOPE_WORKGROUP);
            bf16x8 kr[4]; load_q(kr, K + (size_t)(b * SEQ + qb * 256 + qrel) * D + h * 64, hi);
            float sq = 0.f;
#pragma unroll
            for (int d0 = 0; d0 < 4; ++d0)
#pragma unroll
                for (int i = 0; i < 8; ++i) sq += bf2f((unsigned)(unsigned short)qr[d0][i]) * bf2f((unsigned)(unsigned short)kr[d0][i]);
            sq += __shfl_xor(sq, 32);
#pragma unroll
            for (int o = 1; o < 32; o <<= 1) sq = fminf(sq, __shfl_xor(sq, o));
            if (lane == 0) (void)__hip_atomic_fetch_min((LAS unsigned*)&uinfo[3], sort_key(sq), __ATOMIC_RELAXED, __HIP_MEMORY_SCOPE_WORKGROUP); }
        __syncthreads();
        {   const float qn2 = __uint_as_float((unsigned)uinfo[2]), qa = __uint_as_float(norms[bh * 4 + 0]), qb2 = __uint_as_float(norms[bh * 4 + 1]), ka = __uint_as_float(norms[bh * 4 + 2]), kb2 = __uint_as_float(norms[bh * 4 + 3]);
            const unsigned mk = (unsigned)uinfo[3]; const float smin = __uint_as_float((mk & 0x80000000u) ? (mk ^ 0x80000000u) : ~mk) - 0.05f;
            const float smax = sqrtf(fminf(qn2, qa + qb2)) * sqrtf(ka + kb2) * 1.02f;
            const float thr = smax - fmaxf(smin, -smax) + 40.f;
            if (C.tid < 128) { const bool skip = (C.tid < NT) && (ng[(C.tid < NT ? C.tid : 0) * 64 + 63] - nref < -thr); const int c = __popcll(__ballot(skip)); if (lane == 0 && c) (void)__hip_atomic_fetch_add(&uinfo[1], c, __ATOMIC_RELAXED, __HIP_MEMORY_SCOPE_WORKGROUP); } }
        __syncthreads();
        const int t0 = uinfo[1], tf = t0 & ~1, g0 = t0 >> 1, NG = NT >> 1, tmax = 4 * qb + (qblk >> 1);
        const bf16* Kg = K + (size_t)(b * SEQ) * D + h * 64; const bf16* Vg = V + (size_t)(b * SEQ) * D + h * 64;
#define FOX_DMA(g) do { LAS unsigned char* sb_ = C.lds + ((g) & 3) * GB; \
            dma_tile(Kg + (size_t)(2 * (g)) * 64 * D, Vg + (size_t)(2 * (g)) * 64 * D, sb_, sb_ + 16384, wave, lane); \
            dma_tile(Kg + (size_t)(2 * (g) + 1) * 64 * D, Vg + (size_t)(2 * (g) + 1) * 64 * D, sb_ + 8192, sb_ + 24576, wave, lane); \
            if (wave < 2) glds4(ng + (2 * (g) + wave) * 64 + lane, lds_addr(sb_ + 32768 + wave * 256)); } while (0)
        FOX_DMA(g0);
        if (g0 + 1 < NG) FOX_DMA(g0 + 1);
        VM_WAIT(); __syncthreads();
        AttnAcc A; acc_init(A);
        f32x16 a0, a1, b0, b1; v4u wa[4], wb[4];
        FoxBias B{nullptr, qrel, 0, false};
#define FOX_SETB(t) do { const LAS unsigned char* sb_ = C.lds + (((t) >> 1) & 3) * GB; B.cb = (const LAS float*)(sb_ + 32768 + ((t) & 1) * 256); B.krel0 = (t) * 64 - qb * 256; B.causal = (t) >= 4 * qb; } while (0)
#define FOX_KS(t) (C.lds + (((t) >> 1) & 3) * GB + ((t) & 1) * 8192)
#define FOX_VS(t) (C.lds + (((t) >> 1) & 3) * GB + 16384 + ((t) & 1) * 8192)
#define FOX_STEP(C0, C1, N0, N1, WP, WN, t) do { FOX_SETB((t) + 1); \
            attn_step3(A, C0, C1, N0, N1, WP, WN, qr, FOX_KS((t) + 1), FOX_VS((t) > tf ? (t) - 1 : (t)), r32, hi, lane, B, (t) <= tmax); } while (0)
#pragma unroll
        for (int k_ = 0; k_ < 4; ++k_) { wa[k_] = (v4u){0u, 0u, 0u, 0u}; wb[k_] = (v4u){0u, 0u, 0u, 0u}; }
        if (tf <= tmax) { FOX_SETB(tf); qk_tile(a0, a1, qr, FOX_KS(tf), r32, hi, B); }
#pragma unroll 1
        for (int g = g0; g <= NG; ++g) {
            const int ta = 2 * g, tb = ta + 1;
            if (g + 2 < NG) FOX_DMA(g + 2);
            if (ta <= tmax + 1) FOX_STEP(a0, a1, b0, b1, wb, wa, ta);
            if (tb <= tmax + 1 && g < NG) FOX_STEP(b0, b1, a0, a1, wa, wb, tb);
            VM_WAIT(); __syncthreads();
        }
#undef FOX_DMA
#undef FOX_SETB
#undef FOX_KS
#undef FOX_VS
#undef FOX_STEP
        const float lt = A.la[0];
        store_o8(O + (size_t)(b * SEQ + qb * 256 + qrel) * D + h * 64, A, 1.f / lt, hi);
    }
    __builtin_amdgcn_s_setprio(0);
}
__device__ __forceinline__ void ln_stats(f32x4 (&v)[4], float& rstd) {
    float s = 0.f;
#pragma unroll
    for (int j = 0; j < 4; ++j) s += (v[j].x + v[j].y) + (v[j].z + v[j].w);
    const float mean = wave_sum(s) * (1.f / D); float s2 = 0.f;
#pragma unroll
    for (int j = 0; j < 4; ++j) { v[j] = v[j] - mean; s2 += (v[j].x * v[j].x + v[j].y * v[j].y) + (v[j].z * v[j].z + v[j].w * v[j].w); }
    rstd = 1.f / sqrtf(wave_sum(s2) * (1.f / D) + LN_EPS);
}
__device__ __forceinline__ void ph_ln1(const Ctx& C, const float* xin, const bf16* xin16, const bf16* y, const float* g, const float* bta, bf16* AR, unsigned char* xb8) {
    const int gw = C.vcu * NWAVES + C.wave, NGW = C.G * NWAVES, lane = C.lane;
    f32x4 gv[4], bv[4];
#pragma unroll
    for (int j = 0; j < 4; ++j) { gv[j] = *(const GAS f32x4*)(g + 4 * lane + 256 * j); bv[j] = *(const GAS f32x4*)(bta + 4 * lane + 256 * j); }
    u32x2 wn[4], zn16[4]; f32x4 zn32[4];
    {   const GAS u32x2* yr = (const GAS u32x2*)(y + (size_t)gw * D) + lane;
#pragma unroll
        for (int j = 0; j < 4; ++j) wn[j] = yr[64 * j];
        if (xin16) { const GAS u32x2* zr = (const GAS u32x2*)(xin16 + (size_t)gw * D) + lane;
#pragma unroll
            for (int j = 0; j < 4; ++j) zn16[j] = zr[64 * j];
        } else { const GAS f32x4* zr = (const GAS f32x4*)(xin + (size_t)gw * D) + lane;
#pragma unroll
            for (int j = 0; j < 4; ++j) zn32[j] = zr[64 * j]; } }
    for (int t = gw; t < T; t += NGW) {
        f32x4 v[4];
        const int tn = t + NGW < T ? t + NGW : t;
        const GAS u32x2* yr = (const GAS u32x2*)(y + (size_t)tn * D) + lane;
        if (xin16) { const GAS u32x2* zr = (const GAS u32x2*)(xin16 + (size_t)tn * D) + lane;
#pragma unroll
            for (int j = 0; j < 4; ++j) { const u32x2 w = wn[j], z = zn16[j]; v[j] = (f32x4){bflo(z.x), bfhi(z.x), bflo(z.y), bfhi(z.y)} * DN_ALPHA + (f32x4){bflo(w.x), bfhi(w.x), bflo(w.y), bfhi(w.y)}; }
#pragma unroll
            for (int j = 0; j < 4; ++j) { wn[j] = yr[64 * j]; zn16[j] = zr[64 * j]; }
        } else { const GAS f32x4* zr = (const GAS f32x4*)(xin + (size_t)tn * D) + lane;
#pragma unroll
            for (int j = 0; j < 4; ++j) { const u32x2 w = wn[j]; v[j] = zn32[j] * DN_ALPHA + (f32x4){bflo(w.x), bfhi(w.x), bflo(w.y), bfhi(w.y)}; }
#pragma unroll
            for (int j = 0; j < 4; ++j) { wn[j] = yr[64 * j]; zn32[j] = zr[64 * j]; } }
        float rstd; ln_stats(v, rstd);
#pragma unroll
        for (int j = 0; j < 4; ++j) {
            const f32x4 y = v[j] * rstd * gv[j] + bv[j]; const int d = 4 * lane + 256 * j;
            u32x2 hw; hw.x = cvtpk(y.x, y.y); hw.y = cvtpk(y.z, y.w);
            u32x2 lw; lw.x = cvtpk(y.x - bflo(hw.x), y.y - bfhi(hw.x)); lw.y = cvtpk(y.z - bflo(hw.y), y.w - bfhi(hw.y));
            *(GAS unsigned*)(xb8 + (size_t)t * D + d) = pk4_f8(y.x * XQ_SCALE, y.y * XQ_SCALE, y.z * XQ_SCALE, y.w * XQ_SCALE);
            *(GAS u32x2*)(AR + (size_t)t * 1536 + d) = hw;
            *(GAS u32x2*)(AR + (size_t)(T + t) * 1536 + 512 + d) = hw;
            if (j < 2) *(GAS u32x2*)(AR + (size_t)t * 1536 + 1024 + d) = lw; else *(GAS u32x2*)(AR + (size_t)(T + t) * 1536 + (d - 512)) = lw;
        }
    }
}
__device__ __forceinline__ int below(unsigned long long mask) { return (int)__builtin_amdgcn_mbcnt_hi((unsigned)(mask >> 32), __builtin_amdgcn_mbcnt_lo((unsigned)mask, 0u)); }
__device__ __forceinline__ void ph_route(const Ctx& C, const float* logp, const float* rbias, int* topi, float* gate, unsigned* ecnt) {
    LAS unsigned* hist = (LAS unsigned*)C.lds;
    const int gw = C.vcu * NWAVES + C.wave, NGW = C.G * NWAVES, lane = C.lane;
    __syncthreads();
    if (C.tid < NE) hist[C.tid] = 0u;
    __syncthreads();
    const f32x4 rb = *(const GAS f32x4*)(rbias + 4 * lane);
    f32x4 an = *(const GAS f32x4*)(logp + (size_t)gw * NE + 4 * lane), bn = *(const GAS f32x4*)(logp + (size_t)(T + gw) * NE + 4 * lane);
    for (int t = gw; t < T; t += NGW) {
        const f32x4 a = an, b2 = bn;
        { const int tn = t + NGW < T ? t + NGW : t; an = *(const GAS f32x4*)(logp + (size_t)tn * NE + 4 * lane); bn = *(const GAS f32x4*)(logp + (size_t)(T + tn) * NE + 4 * lane); }
        float s[4], c[4];
#pragma unroll
        for (int i = 0; i < 4; ++i) { const float lg = a[i] + b2[i]; s[i] = 1.f / (1.f + __builtin_amdgcn_exp2f(-lg * LOG2E)); c[i] = s[i] + rb[i]; }
        float m1 = fmaxf(c[0], c[1]), m2 = fminf(c[0], c[1]);
        { const float x = c[2]; const float n1 = fmaxf(m1, x); m2 = fmaxf(m2, fminf(m1, x)); m1 = n1; }
        { const float x = c[3]; const float n1 = fmaxf(m1, x); m2 = fmaxf(m2, fminf(m1, x)); m1 = n1; }
#pragma unroll
        for (int o = 1; o < 8; o <<= 1) { const float o1 = __shfl_xor(m1, o), o2 = __shfl_xor(m2, o); const float n1 = fmaxf(m1, o1), n2 = fmaxf(fminf(m1, o1), fmaxf(m2, o2)); m1 = n1; m2 = n2; }
        const float gs = m1 + m2; const int mygrp = lane >> 3; int rk = 0;
#pragma unroll
        for (int g2 = 0; g2 < NGRP; ++g2) { const float og = __uint_as_float((unsigned)__builtin_amdgcn_readlane((int)__float_as_uint(gs), 8 * g2)); rk += (og > gs || (og == gs && g2 < mygrp)) ? 1 : 0; }
        unsigned k[4];
#pragma unroll
        for (int i = 0; i < 4; ++i) k[i] = rk < 4 ? sort_key(c[i]) : 0u;
        unsigned thr = 0u;
#pragma unroll 1
        for (int b = 31; b >= 0; --b) {
            const unsigned cand = thr | (1u << b);
            const int cnt = __popcll(__ballot(k[0] >= cand)) + __popcll(__ballot(k[1] >= cand)) + __popcll(__ballot(k[2] >= cand)) + __popcll(__ballot(k[3] >= cand));
            if (cnt >= TOPK) thr = cand;
        }
        unsigned long long gm[4], em[4]; int ngt = 0;
#pragma unroll
        for (int i = 0; i < 4; ++i) { gm[i] = __ballot(k[i] > thr); em[i] = __ballot(k[i] == thr); ngt += __popcll(gm[i]); }
        const int need = TOPK - ngt;
        int eqb = below(em[0]) + below(em[1]) + below(em[2]) + below(em[3]);
        bool sel[4];
#pragma unroll
        for (int i = 0; i < 4; ++i) { const bool eq = k[i] == thr; sel[i] = (k[i] > thr) || (eq && eqb < need); eqb += eq ? 1 : 0; }
        unsigned long long sm[4]; float wpart = 0.f;
#pragma unroll
        for (int i = 0; i < 4; ++i) { sm[i] = __ballot(sel[i]); wpart += sel[i] ? s[i] : 0.f; }
        const float wsum = wave_sum(wpart);
        int pos = below(sm[0]) + below(sm[1]) + below(sm[2]) + below(sm[3]);
#pragma unroll
        for (int i = 0; i < 4; ++i) if (sel[i]) { gate[(size_t)t * TOPK + pos] = s[i] / wsum * ROUTED_SCALE;
            const unsigned rk = __hip_atomic_fetch_add(&hist[4 * lane + i], 1u, __ATOMIC_RELAXED, __HIP_MEMORY_SCOPE_WORKGROUP);
            topi[(size_t)t * TOPK + pos] = (4 * lane + i) | (int)(rk << 8); ++pos; }
    }
    __syncthreads();
    if (C.tid < NE) { const unsigned c = hist[C.tid]; hist[NE + C.tid] = c ? __hip_atomic_fetch_add(ecnt + C.tid, c, __ATOMIC_RELAXED, __HIP_MEMORY_SCOPE_AGENT) : 0u; }
}
__device__ __forceinline__ void ph_scatter(const Ctx& C, const unsigned* ecnt, unsigned* ecur, const int* topi, const float* gate, const bf16* xb, int* slotof, int* tokof, float* gslot, bf16* HS) {
    build_tpre(C, ecnt);
    const LAS int* tpre = (const LAS int*)(C.lds + TPRE_OFF);
    const LAS unsigned* wgbase = (const LAS unsigned*)C.lds + NE;
    const int gw = C.vcu * NWAVES + C.wave, NGW = C.G * NWAVES;
    for (int n = C.lane >> 3; gw + n * NGW < T; n += 8) {
        const int t = gw + n * NGW;
        { const int i = t * TOPK + (C.lane & 7); const int v = topi[i], e = v & 255, rk = v >> 8;
            const int slot = tpre[e] * 256 + (int)wgbase[e] + rk; tokof[slot] = t; gslot[slot] = gate[i] * GS_FOLD; slotof[i] = slot; }
    }
    for (int e = C.vcu; e < NE; e += C.G) {
        const int cnt = (int)__hip_atomic_load(ecnt + e, __ATOMIC_RELAXED, __HIP_MEMORY_SCOPE_AGENT), s0 = tpre[e] * 256 + cnt, s1 = tpre[e + 1] * 256;
        for (int s = s0 + C.tid; s < s1; s += NTHR) { gslot[s] = 0.f; tokof[s] = 0; }
    }
}
__device__ __forceinline__ float log_sigmoid(float z) {
    const float e = __builtin_amdgcn_exp2f(-fabsf(z) * LOG2E);
    const float l1p = e < 0.015625f ? e * (1.f - e * (0.5f - e * 0.33333334f)) : __builtin_amdgcn_logf(1.f + e) * 0.6931471805599453f;
    return fminf(z, 0.f) - l1p;
}
__device__ __forceinline__ void ph_combine(const Ctx& C, const bf16* x1hi, const unsigned char* SO, const int* slotof, const float* g, const float* bta, bf16* xres, unsigned char* xb8, float* dout,
                                           const float* fox_in, const float* fox_bf, float* logf) {
    const int gw = C.vcu * NWAVES + C.wave, NGW = C.G * NWAVES, lane = C.lane;
    LAS float* wfT = (LAS float*)C.lds;
    __syncthreads();
    if (logf) { for (int i = C.tid; i < D * H; i += NTHR) { const int d = i >> 4, h = i & 15; wfT[h * D + d] = fox_in[(size_t)d * FOXW + 3 * D + h]; } }
    __syncthreads();
    f32x4 gv[4], bv[4];
#pragma unroll
    for (int j = 0; j < 4; ++j) { gv[j] = *(const GAS f32x4*)(g + 4 * lane + 256 * j); bv[j] = *(const GAS f32x4*)(bta + 4 * lane + 256 * j); }
    int sl_n = lane < TOPK ? slotof[(size_t)gw * TOPK + lane] : 0;
    for (int t = gw; t < T; t += NGW) {
        const GAS u32x2* zr = (const GAS u32x2*)(x1hi + (size_t)t * 1536) + lane;
        f32x4 v[4];
#pragma unroll
        for (int j = 0; j < 4; ++j) { const u32x2 z = zr[64 * j]; v[j] = (f32x4){bflo(z.x), bfhi(z.x), bflo(z.y), bfhi(z.y)} * DN_ALPHA; }
        const int sl = sl_n; { const int tn = t + NGW < T ? t + NGW : t; sl_n = lane < TOPK ? slotof[(size_t)tn * TOPK + lane] : 0; }
        f32x4 rs[4];
#pragma unroll
        for (int j = 0; j < 4; ++j) rs[j] = (f32x4){0.f, 0.f, 0.f, 0.f};
#pragma unroll
        for (int k = 0; k < TOPK; ++k) { const int sk = __builtin_amdgcn_readlane(sl, k); const unsigned char* row = SO + (size_t)sk * D + 4 * lane;
#pragma unroll
            for (int j = 0; j < 4; ++j) { const unsigned w = *(const GAS unsigned*)(row + 256 * j); const f32x2 lo2 = __builtin_amdgcn_cvt_pk_f32_fp8(w, false), hi2 = __builtin_amdgcn_cvt_pk_f32_fp8(w, true);
                rs[j].x += lo2.x; rs[j].y += lo2.y; rs[j].z += hi2.x; rs[j].w += hi2.y; } }
        {   const unsigned char* row = SO + (size_t)(NSLOT_MAX + t) * D + 4 * lane;
#pragma unroll
            for (int j = 0; j < 4; ++j) { const unsigned w = *(const GAS unsigned*)(row + 256 * j); const f32x2 lo2 = __builtin_amdgcn_cvt_pk_f32_fp8(w, false), hi2 = __builtin_amdgcn_cvt_pk_f32_fp8(w, true);
                rs[j].x += lo2.x; rs[j].y += lo2.y; rs[j].z += hi2.x; rs[j].w += hi2.y; } }
#pragma unroll
        for (int j = 0; j < 4; ++j) v[j] = v[j] + rs[j] * SO_INV;
        float rstd; ln_stats(v, rstd);
        f32x4 y[4];
#pragma unroll
        for (int j = 0; j < 4; ++j) {
            y[j] = v[j] * rstd * gv[j] + bv[j]; const int d = 4 * lane + 256 * j;
            if (dout) *(GAS f32x4*)(dout + (size_t)t * D + d) = y[j];
            else { u32x2 hw; hw.x = cvtpk(y[j].x, y[j].y); hw.y = cvtpk(y[j].z, y[j].w); *(GAS u32x2*)(xres + (size_t)t * D + d) = hw;
                *(GAS unsigned*)(xb8 + (size_t)t * D + d) = pk4_f8(y[j].x * XQ_SCALE, y[j].y * XQ_SCALE, y[j].z * XQ_SCALE, y[j].w * XQ_SCALE); }
        }
        if (logf) {
            float acc[16];
#pragma unroll
            for (int h = 0; h < 16; ++h) { float a = 0.f;
#pragma unroll
                for (int j = 0; j < 4; ++j) { const f32x4 w = *(const LAS f32x4*)(wfT + h * D + 4 * lane + 256 * j); a += y[j].x * w.x; a += y[j].y * w.y; a += y[j].z * w.z; a += y[j].w * w.w; }
                acc[h] = a; }
            float a8[8], a4[4], a2[2], a1;
            { const bool bit = (lane >> 5) & 1;
#pragma unroll
              for (int i = 0; i < 8; ++i) { const float send = bit ? acc[i] : acc[i + 8]; const float recv = __shfl_xor(send, 32); a8[i] = (bit ? acc[i + 8] : acc[i]) + recv; } }
            { const bool bit = (lane >> 4) & 1;
#pragma unroll
              for (int i = 0; i < 4; ++i) { const float send = bit ? a8[i] : a8[i + 4]; const float recv = __shfl_xor(send, 16); a4[i] = (bit ? a8[i + 4] : a8[i]) + recv; } }
            { const bool bit = (lane >> 3) & 1;
#pragma unroll
              for (int i = 0; i < 2; ++i) { const float send = bit ? a4[i] : a4[i + 2]; const float recv = __shfl_xor(send, 8); a2[i] = (bit ? a4[i + 2] : a4[i]) + recv; } }
            { const bool bit = (lane >> 2) & 1; const float send = bit ? a2[0] : a2[1]; const float recv = __shfl_xor(send, 4); a1 = (bit ? a2[1] : a2[0]) + recv; }
            a1 += __shfl_xor(a1, 2); a1 += __shfl_xor(a1, 1);
            const int hh = ((lane >> 5) & 1) * 8 + ((lane >> 4) & 1) * 4 + ((lane >> 3) & 1) * 2 + ((lane >> 2) & 1);
            if ((lane & 3) == 0) logf[(size_t)t * H + hh] = log_sigmoid(a1 + fox_bf[hh]);
        }
    }
}
#ifndef MK_MULTI
#define MK_MULTI 0
#endif
constexpr int NPH = 27;
struct Args { const float* in[19]; float* out; unsigned char* ws; int ph_lo, ph_hi; };

__global__ void __launch_bounds__(NTHR, 2) mk_fwd(Args args) {
    extern __shared__ __attribute__((aligned(16))) unsigned char lds_raw[];
    Ctx C;
    C.lds = (LAS unsigned char*)lds_raw;
    C.tid = threadIdx.x; C.lane = C.tid & 63; C.wave = __builtin_amdgcn_readfirstlane(C.tid >> 6);
    C.G = gridDim.x; { const int bx = blockIdx.x; C.vcu = (C.G % 8 == 0) ? (bx % 8) * (C.G / 8) + bx / 8 : bx; }
    LAS unsigned long long* PTAB = (LAS unsigned long long*)(C.lds + PTAB_OFF);
    if (C.tid == 0) {
#pragma unroll
        for (int i = 0; i < 19; ++i) PTAB[i] = (unsigned long long)(uintptr_t)args.in[i];
        PTAB[19] = (unsigned long long)(uintptr_t)args.out; PTAB[20] = (unsigned long long)(uintptr_t)args.ws;
    }
    for (int u = C.tid; u < (PTAB_OFF - LDSCTL_OFF) / 4; u += NTHR) ((LAS unsigned*)(C.lds + LDSCTL_OFF))[u] = 0u;
    __syncthreads();
#define PIN(i) ((const float*)ldptr(PTAB, (i)))
#define WSP() ((unsigned char*)ldptr(PTAB, 20))
    XcdBarrier bar; bar.bar = (unsigned*)(args.ws + WS_CTL) + CW_BAR; bar.x = 0; bar.st = nullptr;
    if (!MK_MULTI) bar = xcd_barrier_post((unsigned*)(args.ws + WS_CTL) + CW_BAR, (volatile LAS unsigned*)(C.lds + MISC_OFF) + 8);
    const int lo = args.ph_lo, hi = args.ph_hi;
#ifndef MK_PH_MASK
#define MK_PH_MASK 0xFFFFFFFFu
#endif
#define PHON(b) (((MK_PH_MASK) >> (b)) & 1u)
#ifndef MK_DUP_MASK
#define MK_DUP_MASK 0u
#endif
#define NREP(b) ((((MK_DUP_MASK) >> (b)) & 1u) ? 2 : 1)
#define REP(b) _Pragma("unroll 1") for (int rep_ = 0; rep_ < NREP(b); ++rep_)
#define IN(k) (lo <= (k) && (k) < hi)
#define SEAM(k) do { if ((k) + 1 < hi) { asm volatile("" : "+s"(bar.bar)); xcd_barrier(bar); if (NREP(23) == 2) xcd_barrier(bar); } } while (0)
#define OPAQ(v) asm volatile("" : "+s"(v))
#define LC() do { int l_; asm volatile("v_mbcnt_lo_u32_b32 %0, -1, 0\n\tv_mbcnt_hi_u32_b32 %0, -1, %0" : "=v"(l_)); C.lane = l_; C.tid = C.wave * 64 + l_; } while (0)

    if (PHON(0) && IN(0)) { LC();
        unsigned char* ws = WSP();
        SmallW W{PIN(2), PIN(3), PIN(4), PIN(6), PIN(11), PIN(16), PIN(17), PIN(18),
                 ws + WS_WMI, ws + WS_WFI, ws + WS_WMO, ws + WS_WFO, ws + WS_WSGU, ws + WS_WSDN, (bf16*)(ws + WS_WR)};
        REP(21) conv_small(C, W);
        REP(22) to_f8_rows(C, PIN(0), ws + WS_XB8);
        __syncthreads();
        REP(0) conv_experts(C, PIN(13), PIN(14), PIN(15), 0, ws + WS_WEGU, ws + WS_WEDN, C.vcu, C.G);
        SEAM(0);
    }
#pragma unroll 1
    for (int l = 0; l < 2; ++l) {
        const int pb = 1 + 13 * l;
        if (PHON(1) && IN(pb + 0)) { LC();
            unsigned char* ws = WSP();
            if (PHON(15) && l == 1) ph_scan(C, (const float*)(ws + WS_LOGF), (float*)(ws + WS_CUM));
            REP(1) {
            __syncthreads();
            int kk = D / 2; OPAQ(kk);
            pg8::Gemm g{(const bf16*)(ws + WS_XB8), (const bf16*)(ws + (l == 0 ? WS_WMI : WS_WFI)), T, 3 * D, kk}; pg8::StaticOrder S; S.init(T, 3 * D, C.G, (int)blockIdx.x);
            EpiQKV E{(bf16*)(ws + WS_Q), (size_t)(WS_K - WS_Q) / 2, C2, (unsigned*)(ws + WS_CTL) + CW_NORM + l * 256, l == 0 ? (float*)(ws + WS_CTL) + CW_KSUM : nullptr};
            pg8::gemm_phase<EpiQKV, pg8::StaticOrder, true, true, false, true>(C.lds, g, S, E, C.tid);
            }
            SEAM(pb + 0);
        }
        if (l == 0) {
            if (PHON(3) && IN(pb + 2)) { LC(); unsigned char* ws = WSP(); REP(3) ph_select(C, (const bf16*)(ws + WS_Q), (const float*)(ws + WS_CTL) + CW_KSUM, (unsigned*)(ws + WS_CTL) + (rep_ ? 133120 : CW_MCNT), (unsigned*)(ws + (rep_ ? WS_PARTO : WS_MLIST))); SEAM(pb + 2); }
            if (PHON(4) && IN(pb + 3)) { LC(); unsigned char* ws = WSP();
                const int uw = 1, usb = C.vcu, per = C.G;
                REP(4) ph_moba_part(C, (const bf16*)(ws + WS_Q), (const bf16*)(ws + WS_K), (const bf16*)(ws + WS_V), PIN(1), (const unsigned*)(ws + WS_CTL) + CW_MCNT, (const unsigned*)(ws + WS_MLIST), (bf16*)(ws + WS_PARTO), (float*)(ws + WS_PARTML), uw, usb, per); SEAM(pb + 3); }
            if (PHON(5) && IN(pb + 4)) { LC(); unsigned char* ws = WSP(); REP(5) ph_moba_own(C, (const bf16*)(ws + WS_Q), (const bf16*)(ws + WS_K), (const bf16*)(ws + WS_V), PIN(1), (const bf16*)(ws + WS_PARTO), (const float*)(ws + WS_PARTML), ws + WS_O); SEAM(pb + 4); }
        } else {
            if (PHON(6) && IN(pb + 4)) { LC(); unsigned char* ws = WSP();
                REP(6) ph_fox(C, (const bf16*)(ws + WS_Q), (const bf16*)(ws + WS_K), (const bf16*)(ws + WS_V), (const float*)(ws + WS_CUM), (const unsigned*)(ws + WS_CTL) + CW_NORM + 256, ws + WS_O, (unsigned*)(ws + WS_CTL) + CW_FOXQ + rep_ * 64); SEAM(pb + 4); }
        }
        if (PHON(7) && IN(pb + 5)) { LC();
            unsigned char* ws = WSP();
            REP(7) {
            __syncthreads();
            int kk = D / 2; OPAQ(kk);
            pg8::Gemm g{(const bf16*)(ws + WS_O), (const bf16*)(ws + (l == 0 ? WS_WMO : WS_WFO)), T, D, kk}; PlainOrder<4> S{C.vcu, C.G, (T / 256) * 4};
            pg8::EpiBf16<0> E{(bf16*)(ws + WS_Z), D, nullptr, D, 0, 1.f / (OQ_SCALE * WQ_SCALE)};
            pg8::gemm_phase<pg8::EpiBf16<0>, PlainOrder<4>, true, true, false, true>(C.lds, g, S, E, C.tid);
            }
            SEAM(pb + 5);
        }
        if (PHON(8) && IN(pb + 6)) { LC(); unsigned char* ws = WSP(); REP(8) ph_ln1(C, PIN(0), l == 0 ? nullptr : (const bf16*)(ws + WS_XRES), (const bf16*)(ws + WS_Z), PIN(7) + l * D, PIN(8) + l * D, (bf16*)(ws + WS_AR), ws + WS_XB8); SEAM(pb + 6); }
        if (PHON(9) && IN(pb + 7)) { LC();
            __syncthreads();
            REP(16) if (PHON(16)) { __syncthreads(); unsigned char* ws = WSP(); int kk = 1536; OPAQ(kk);
              pg8::Gemm g{(const bf16*)(ws + WS_AR), (const bf16*)(ws + WS_WR) + (size_t)l * (512 * 1536), 2 * T, 512, kk}; RouterOrder S{C.vcu, C.G}; EpiF32<true> E{(float*)(ws + WS_LOGP), nullptr, NE, 0.f};
              pg8::gemm_phase<EpiF32<true>, RouterOrder, true, true>(C.lds, g, S, E, C.tid); }
            __syncthreads();
            REP(17) if (PHON(17)) { __syncthreads(); unsigned char* ws = WSP(); int kk = D / 2; OPAQ(kk);
              pg8::Gemm g{(const bf16*)(ws + WS_XB8), (const bf16*)(ws + WS_WSGU + (size_t)l * (512 * 1024)), T, 512, kk}; PlainOrder<2> S{C.vcu, C.G, (T / 256) * 2}; EpiSwiGLU<true> E{ws + WS_ACTSH, nullptr};
              pg8::gemm_phase<EpiSwiGLU<true>, PlainOrder<2>, true, true, false, true>(C.lds, g, S, E, C.tid); }
            SEAM(pb + 7);
        }
        if (PHON(10) && IN(pb + 8)) { LC(); unsigned char* ws = WSP(); REP(10) ph_route(C, (const float*)(ws + WS_LOGP), PIN(12) + l * NE, (int*)(ws + WS_TOPI), (float*)(ws + WS_GATE), (unsigned*)(ws + WS_CTL) + (rep_ ? 131072 : CW_ECNT) + l * NE); SEAM(pb + 8); }
        if (PHON(11) && IN(pb + 9)) { LC(); unsigned char* ws = WSP(); REP(11) { if (rep_) xcd_barrier(bar); ph_scatter(C, (const unsigned*)(ws + WS_CTL) + CW_ECNT + l * NE, (unsigned*)(ws + WS_CTL) + (rep_ ? 132096 : CW_ECUR) + l * NE, (const int*)(ws + WS_TOPI), (const float*)(ws + WS_GATE), (const bf16*)(ws + WS_XB8),
                                                                            (int*)(ws + WS_SLOTOF), (int*)(ws + WS_TOKOF), (float*)(ws + WS_GSLOT), (bf16*)(ws + WS_HS)); } SEAM(pb + 9); }
        if (PHON(12) && IN(pb + 10)) { LC();
            unsigned char* ws = WSP();
            build_tpre(C, (const unsigned*)(ws + WS_CTL) + CW_ECNT + l * NE);
            REP(12) {
            __syncthreads();
            int kk = D / 2; OPAQ(kk);
            pg8::Gemm g{(const bf16*)(ws + WS_XB8), (const bf16*)(ws + WS_WEGU), NSLOT_MAX, NE * 512, kk, (const int*)(ws + WS_TOKOF)}; ExpertOrder<1> S{C.vcu, C.G, (const LAS int*)(C.lds + TPRE_OFF)}; EpiSwiGLU<true> E{ws + WS_ACT, (const float*)(ws + WS_GSLOT)};
            pg8::gemm_phase<EpiSwiGLU<true>, ExpertOrder<1>, true, true, true, true>(C.lds, g, S, E, C.tid);
            }
            SEAM(pb + 10);
        }
        if (PHON(13) && IN(pb + 11)) { LC();
            { unsigned char* ws = WSP(); build_tpre(C, (const unsigned*)(ws + WS_CTL) + CW_ECNT + l * NE); }
            REP(18) if (PHON(18)) { __syncthreads(); unsigned char* ws = WSP(); int kk = DE / 2; OPAQ(kk);
              pg8::Gemm g{(const bf16*)(ws + WS_ACT), (const bf16*)(ws + WS_WEDN), NSLOT_MAX, NE * 1024, kk}; ExpertOrder<2> S{C.vcu, C.G, (const LAS int*)(C.lds + TPRE_OFF)}; EpiDown<true> E{(unsigned char*)(ws + WS_HS)};
              pg8::gemm_phase<EpiDown<true>, ExpertOrder<2>, true, true, false, true>(C.lds, g, S, E, C.tid); }
            __syncthreads();
            REP(19) if (PHON(19)) { __syncthreads(); unsigned char* ws = WSP(); int kk = DE / 2; OPAQ(kk);
              pg8::Gemm g{(const bf16*)(ws + WS_ACTSH), (const bf16*)(ws + WS_WSDN + (size_t)l * (1024 * 256)), T, D, kk}; PlainOrder<4> S{C.vcu, C.G, (T / 256) * 4}; EpiDown<true> E{(unsigned char*)(ws + WS_HS) + (size_t)NSLOT_MAX * 1024};
              pg8::gemm_phase<EpiDown<true>, PlainOrder<4>, true, true, false, true>(C.lds, g, S, E, C.tid); }
            SEAM(pb + 11);
        }
        if (PHON(14) && IN(pb + 12)) { LC();
            REP(14) { unsigned char* ws = WSP();
              ph_combine(C, (const bf16*)(ws + WS_AR), (const unsigned char*)(ws + WS_HS), (const int*)(ws + WS_SLOTOF), PIN(9) + l * D, PIN(10) + l * D, (bf16*)(ws + WS_XRES), ws + WS_XB8, l == 1 ? (float*)ldptr(PTAB, 19) : nullptr,
                         PIN(4), PIN(5), l == 0 ? (float*)(ws + WS_LOGF) : nullptr); }
            if (l == 0) { unsigned char* ws = WSP(); __syncthreads(); conv_experts(C, PIN(13), PIN(14), PIN(15), 1, ws + WS_WEGU, ws + WS_WEDN, C.vcu, C.G); }
            SEAM(pb + 12);
        }
    }
#undef IN
#undef SEAM
#undef PIN
#undef WSP
#undef OPAQ
#undef REP
#undef NREP
}
}

extern "C" void kernel_launch(void* const* d_in, const int* in_sizes, int n_in, void* d_out, int out_size, void* d_ws, size_t ws_size, hipStream_t stream) {
    using namespace mk;
    static int grid = 0;
    if (grid == 0) {
        if (n_in != 19 || in_sizes[0] != T * D || out_size != T * D || ws_size < WS_END) { fprintf(stderr, "kernel_launch: unexpected problem shape (n_in %d, in0 %d, out %d, ws %zu < %zu)\n", n_in, n_in > 0 ? in_sizes[0] : -1, out_size, ws_size, (size_t)WS_END); grid = -1; return; }
        int dev = 0, cus = 0, per_cu = 0;
        if (hipGetDevice(&dev) != hipSuccess || hipDeviceGetAttribute(&cus, hipDeviceAttributeMultiprocessorCount, dev) != hipSuccess) { grid = -1; return; }
        if (hipFuncSetAttribute((const void*)mk_fwd, hipFuncAttributeMaxDynamicSharedMemorySize, LDS_BYTES) != hipSuccess) { fprintf(stderr, "kernel_launch: hipFuncSetAttribute failed\n"); grid = -1; return; }
        if (hipOccupancyMaxActiveBlocksPerMultiprocessor(&per_cu, (const void*)mk_fwd, NTHR, LDS_BYTES) != hipSuccess || per_cu < 1) fprintf(stderr, "kernel_launch: occupancy query reports %d\n", per_cu);
        (void)hipGetLastError();
        grid = cus;
    }
    if (grid < 0) return;
    if (hipMemsetAsync((char*)d_ws + WS_CTL, 0, CTL_ZERO_BYTES, stream) != hipSuccess) return;
    Args a{};
    for (int i = 0; i < 19; ++i) a.in[i] = (const float*)d_in[i];
    a.out = (float*)d_out; a.ws = (unsigned char*)d_ws;
#if MK_MULTI
    for (int p = 0; p < NPH; ++p) {
        if (p == 2 || (p >= 15 && p <= 17)) continue;
        a.ph_lo = p; a.ph_hi = p + 1;
        hipLaunchKernelGGL(mk_fwd, dim3(grid), dim3(NTHR), LDS_BYTES, stream, a);
    }
#else
    a.ph_lo = 0; a.ph_hi = NPH;
    hipLaunchKernelGGL(mk_fwd, dim3(grid), dim3(NTHR), LDS_BYTES, stream, a);
#endif
    const hipError_t le = hipPeekAtLastError();
    if (le != hipSuccess) fprintf(stderr, "kernel_launch: launch failed: %s\n", hipGetErrorName(le));
}
```

```cpp
#include <hip/hip_runtime.h>
#include <cstdio>
#include <cstdint>
namespace pg8 {
#define PG8_LAS __attribute__((address_space(3)))
typedef unsigned short bf16_t;
typedef short bf16x8 __attribute__((ext_vector_type(8)));
typedef float f32x4 __attribute__((ext_vector_type(4)));
typedef unsigned u32x4 __attribute__((ext_vector_type(4)));
typedef int i32x4 __attribute__((ext_vector_type(4)));
typedef int i32x8 __attribute__((ext_vector_type(8)));
__device__ __forceinline__ i32x8 cat8(bf16x8 a, bf16x8 b) { return __builtin_shufflevector(__builtin_bit_cast(i32x4, a), __builtin_bit_cast(i32x4, b), 0, 1, 2, 3, 4, 5, 6, 7); }
constexpr int BM = 256, BK = 64, HALF = 128, HTB = HALF * BK * 2  , STAGE_BYTES = 8 * HTB, NXCD = 8, WGM = 8;

__host__ __device__ __forceinline__ int lds_byte(int r, int c) { const int st = (r >> 4) * 2 + (c >> 5), rr = r & 15, cc = c & 31, ob = rr * 64 + cc * 2; return st * 1024 + (ob ^ (((ob >> 9) & 1) << 5)); }
__host__ __device__ __forceinline__ void stage_rc(int b, int& R, int& C) { const int st = b / 1024, sb = b % 1024, swz = sb ^ (((sb >> 9) & 1) << 5); R = (st >> 1) * 16 + swz / 64; C = (st & 1) * 32 + (swz % 64) / 2; }
__host__ __device__ __forceinline__ int perm32(int rho) { const int n = rho >> 4, i = rho & 15; return 8 * (i >> 2) + 4 * n + (i & 3); }

struct Unit { int pm, pn; int hf = 0; };
struct Gemm { const bf16_t* A; const bf16_t* Bt; int M, N, K; const int* arow = nullptr; };

struct StaticOrder {
    int nM, nN, nwg, G, c;
    __host__ __device__ void init(int M, int N, int G_, int c_) { nM = M / BM; nN = N / BM; nwg = nM * nN; G = G_; c = c_; }
    __host__ __device__ bool next(int i, Unit& u) const {
        const long L = (long)i * G + c; if (L >= nwg) return false;
        int wgid = (int)L; { const int q = nwg / NXCD, r = nwg % NXCD, xcd = wgid % NXCD, off = wgid / NXCD; wgid = (xcd < r ? xcd * (q + 1) : r * (q + 1) + (xcd - r) * q) + off; }
        const int nig = WGM * nN, gid = wgid / nig, fm = gid * WGM, gsz = (nM - fm) < WGM ? (nM - fm) : WGM;
        u.pm = fm + ((wgid % nig) % gsz); u.pn = (wgid % nig) / gsz; return true;
    }
    __device__ __forceinline__ void a_ready(const Unit&) const {}
    __device__ __forceinline__ void done(const Unit&) const {}
};

__device__ __forceinline__ unsigned cvt_pk_bf16(float lo, float hi) { unsigned r; asm volatile("v_cvt_pk_bf16_f32 %0, %1, %2" : "=v"(r) : "v"(lo), "v"(hi)); return r; }
typedef float f32x2 __attribute__((ext_vector_type(2)));
__device__ __forceinline__ f32x2 gelu_pk(f32x2 v) {
    const f32x2 av = __builtin_elementwise_abs(v), d = av * 0.2316418882f + 1.0f;
    f32x2 t; t.x = __builtin_amdgcn_rcpf(d.x); t.y = __builtin_amdgcn_rcpf(d.y);
    f32x2 q = t * 0.5307027145f + (-0.7265760135f); q = q * t + 0.7107068705f; q = q * t + (-0.142248368f); q = q * t + 0.127414796f; q = q * t;
    const f32x2 s = (v * v) * (-0.72134752044f);
    f32x2 e; e.x = __builtin_amdgcn_exp2f(s.x); e.y = __builtin_amdgcn_exp2f(s.y);
    const f32x2 m = v * (q * e), r = v - m;
    f32x2 o; o.x = v.x < 0.f ? m.x : r.x; o.y = v.y < 0.f ? m.y : r.y; return o;
}

template <int ACT  > struct EpiBf16 {
    static constexpr bool PERM = true, AFTER_DRAIN = false; static_assert(ACT == 0 || ACT == 1, "EpiBf16: ACT is 0 (none) or 1 (gelu_pk)");
    bf16_t* O; int ldc; const float* bias; int split_cols; size_t split_stride; float scale0;
    __device__ __forceinline__ void operator()(const f32x4 (&acc)[2][2][4][2], const Unit& u, int wr, int wc, int fr, int fq) const {
        const int row0 = u.pm * BM + wr * 64 + fr; int colt = u.pn * BM; bf16_t* base = O;
        float sc = 1.f; if (split_cols) { const int t = colt / split_cols; base += (size_t)t * split_stride; colt -= t * split_cols; if (t == 0) sc = scale0; }
        const int col0 = colt + wc * 32 + 8 * fq, bcol0 = u.pn * BM + wc * 32 + 8 * fq;
        f32x4 bv[2][2];
#pragma unroll
        for (int bj = 0; bj < 2; ++bj)
#pragma unroll
            for (int n = 0; n < 2; ++n) bv[bj][n] = bias ? *(const f32x4*)(bias + bcol0 + bj * HALF + 4 * n) : (f32x4){0.f, 0.f, 0.f, 0.f};
#pragma unroll
        for (int ai = 0; ai < 2; ++ai)
#pragma unroll
            for (int m = 0; m < 4; ++m) { bf16_t* rowp = base + (size_t)(row0 + ai * HALF + m * 16) * ldc + col0;
#pragma unroll
                for (int bj = 0; bj < 2; ++bj) { f32x4 v0 = acc[ai][bj][m][0] + bv[bj][0], v1 = acc[ai][bj][m][1] + bv[bj][1];
                    if (ACT == 1) { f32x2 a = gelu_pk((f32x2){v0[0], v0[1]}), b = gelu_pk((f32x2){v0[2], v0[3]}), c = gelu_pk((f32x2){v1[0], v1[1]}), d = gelu_pk((f32x2){v1[2], v1[3]});
                        v0 = (f32x4){a.x, a.y, b.x, b.y}; v1 = (f32x4){c.x, c.y, d.x, d.y}; }
                    v0 = v0 * sc; v1 = v1 * sc; u32x4 w; w.x = cvt_pk_bf16(v0[0], v0[1]); w.y = cvt_pk_bf16(v0[2], v0[3]); w.z = cvt_pk_bf16(v1[0], v1[1]); w.w = cvt_pk_bf16(v1[2], v1[3]);
                    *(u32x4*)(rowp + bj * HALF) = w; } }
    }
};
template <class Epi, class Sched, bool ALIGN_EPI = false, bool SP2 = false, bool GATHER = false, bool F8 = false>
__device__ __forceinline__ void gemm_phase(PG8_LAS unsigned char* lds, const Gemm g, const Sched& S, const Epi& E, const int tid_in) {
    const int tid = tid_in,
              wid = __builtin_amdgcn_readfirstlane(tid >> 6), lane = tid & 63, wr = wid >> 2, wc = wid & 3, fr = lane & 15, fq = lane >> 4;
    const int K = g.K, nt = K / BK;
    unsigned voffA[2], voffB[2], voffA1[2], nvA0[2], nvA1[2]; int gR[2], gC[2];
#pragma unroll
    for (int i = 0; i < 2; ++i) { int R, C; stage_rc(tid * 16 + i * 8192, R, C); const int Rb = Epi::PERM ? ((R & ~31) + perm32(R & 31)) : R;
        voffA[i] = (unsigned)(R * K + C) * 2u; voffB[i] = (unsigned)(Rb * K + C) * 2u; voffA1[i] = voffA[i]; nvA0[i] = voffA[i]; nvA1[i] = voffA[i]; gR[i] = R; gC[i] = C; }
    const size_t kstep = (size_t)(BK * 2);
    const size_t hstep = (size_t)HALF * K * 2;
    const size_t tstep = 2 * hstep;
    const unsigned ldsw = (unsigned)wid * 1024u;
    const unsigned ldsu = (unsigned)__builtin_amdgcn_readfirstlane((int)((unsigned)(uintptr_t)lds + ldsw));
    const int aoff = lds_byte(wr * 64 + fr, fq * 8), boff = lds_byte(wc * 32 + fr, fq * 8);
#define PG8_SA(b, h) (((b) * 2 + (h)) * HTB)
#define PG8_SB(b, h) ((4 + (b) * 2 + (h)) * HTB)
#define PG8_DMA(sbase, vo, ldsdst) do { unsigned keep_; asm volatile("s_mov_b32 %0, m0\n\ts_mov_b32 m0, %3\n\ts_nop 0\n\tglobal_load_lds_dwordx4 %1, %2\n\ts_mov_b32 m0, %0" : "=&s"(keep_) : "v"(vo), "s"(sbase), "s"(ldsdst) : "memory"); } while (0)
#define PG8_STAGE(bufoff, gbase, voff) do { _Pragma("unroll") for (int _i = 0; _i < 2; ++_i) PG8_DMA((const char*)(gbase), (voff)[_i], ldsu + (unsigned)((bufoff) + _i * 8192)); } while (0)
#define PG8_GROW(dst0, dst1, pm_) do { if constexpr (GATHER) { _Pragma("unroll") for (int _i = 0; _i < 2; ++_i) { const int r0_ = g.arow[(pm_) * 256 + gR[_i]], r1_ = g.arow[(pm_) * 256 + 128 + gR[_i]]; \
        dst0[_i] = (unsigned)(r0_ * K + gC[_i]) * 2u; dst1[_i] = (unsigned)(r1_ * K + gC[_i]) * 2u; } } } while (0)
#define PG8_STAGE_A(bufoff, h, koff, nx) do { if constexpr (GATHER) { _Pragma("unroll") for (int _i = 0; _i < 2; ++_i) { const unsigned vo_ = (nx) ? ((h) ? nvA1[_i] : nvA0[_i]) : ((h) ? voffA1[_i] : voffA[_i]); \
        PG8_DMA((const char*)g.A + (koff), vo_, ldsu + (unsigned)((bufoff) + _i * 8192)); } } \
    else { PG8_STAGE(bufoff, ((nx) ? nA : cA) + (koff) + ((h) ? hstep : 0), voffA); } } while (0)
#define PG8_LDA(dst, b, h) do { _Pragma("unroll") for (int m = 0; m < 4; ++m) _Pragma("unroll") for (int k = 0; k < 2; ++k) dst[m][k] = *(const PG8_LAS bf16x8*)(lds + PG8_SA(b, h) + aoff + m * 2048 + k * 1024); } while (0)
#define PG8_LDB(dst, b, h) do { _Pragma("unroll") for (int n = 0; n < 2; ++n) _Pragma("unroll") for (int k = 0; k < 2; ++k) dst[n][k] = *(const PG8_LAS bf16x8*)(lds + PG8_SB(b, h) + boff + n * 2048 + k * 1024); } while (0)
#define PG8_MMA(ai, bj, At, Bt) do { __builtin_amdgcn_s_setprio(1); _Pragma("unroll") for (int m = 0; m < 4; ++m) _Pragma("unroll") for (int n = 0; n < 2; ++n) { \
        if constexpr (F8) acc[ai][bj][m][n] = __builtin_amdgcn_mfma_scale_f32_16x16x128_f8f6f4(cat8(Bt[n][0], Bt[n][1]), cat8(At[m][0], At[m][1]), acc[ai][bj][m][n], 0, 0, 0, 0, 0, 0); \
        else { _Pragma("unroll") for (int k = 0; k < 2; ++k) acc[ai][bj][m][n] = __builtin_amdgcn_mfma_f32_16x16x32_bf16(Bt[n][k], At[m][k], acc[ai][bj][m][n], 0, 0, 0); } } __builtin_amdgcn_s_setprio(0); } while (0)
#define PG8_WAIT_V(n) asm volatile("s_waitcnt vmcnt(" #n ")" ::: "memory")
#define PG8_WAIT_L(n) asm volatile("s_waitcnt lgkmcnt(" #n ")" ::: "memory")
#define PG8_BAR __builtin_amdgcn_s_barrier()
#define PG8_SCHED __builtin_amdgcn_sched_barrier(0)
    Unit cur, nxt; int ui = 0;
    if (!S.next(0, cur)) return;
    f32x4 acc[2][2][4][2];
    float zz = 0.f; asm volatile("" : "+v"(zz));
#pragma unroll
    for (int a = 0; a < 2; ++a)
#pragma unroll
        for (int b = 0; b < 2; ++b)
#pragma unroll
            for (int m = 0; m < 4; ++m)
#pragma unroll
                for (int n = 0; n < 2; ++n) acc[a][b][m][n] = (f32x4){zz, zz, zz, zz};
    bf16x8 At[4][2], B0[2][2], B1[2][2];
    const char* cA = (const char*)g.A + (size_t)cur.pm * tstep; const char* cB = (const char*)g.Bt + (size_t)cur.pn * tstep;
    S.a_ready(cur);
    PG8_GROW(voffA, voffA1, cur.pm);
    const char* nA = cA; const char* nB = cB;
    if constexpr (SP2) {
        PG8_STAGE(PG8_SB(0, 0), cB, voffB); PG8_STAGE(PG8_SB(0, 1), cB + hstep, voffB); PG8_STAGE_A(PG8_SA(0, 0), 0, 0, false); PG8_STAGE_A(PG8_SA(0, 1), 1, 0, false);
        if (wr == 1) PG8_BAR;
        PG8_WAIT_V(2); PG8_BAR;
        PG8_STAGE(PG8_SB(1, 0), cB + kstep, voffB); PG8_STAGE_A(PG8_SA(1, 0), 0, kstep, false); PG8_STAGE(PG8_SB(1, 1), cB + hstep + kstep, voffB);
        PG8_WAIT_V(6); PG8_BAR;
    } else {
        PG8_STAGE(PG8_SB(0, 0), cB, voffB); PG8_STAGE(PG8_SA(0, 0), cA, voffA); PG8_STAGE(PG8_SB(0, 1), cB + hstep, voffB); PG8_STAGE(PG8_SA(0, 1), cA + hstep, voffA);
        if (wr == 1) PG8_BAR;
        PG8_WAIT_V(4); PG8_BAR;
        PG8_STAGE(PG8_SB(1, 0), cB + kstep, voffB); PG8_STAGE(PG8_SA(1, 0), cA + kstep, voffA); PG8_STAGE(PG8_SB(1, 1), cB + hstep + kstep, voffB);
        PG8_WAIT_V(6); PG8_BAR;
    }
    for (;;) {
        const bool has_next = S.next(ui + 1, nxt);
        nA = has_next ? (const char*)g.A + (size_t)nxt.pm * tstep : cA; nB = has_next ? (const char*)g.Bt + (size_t)nxt.pn * tstep : cB;
        if constexpr (GATHER) { if (has_next) PG8_GROW(nvA0, nvA1, nxt.pm); else { _Pragma("unroll") for (int _i = 0; _i < 2; ++_i) { nvA0[_i] = voffA[_i]; nvA1[_i] = voffA1[_i]; } } }
        for (int t = 0; t < nt; t += 2) {
            const bool last = (t == nt - 2);
            const size_t ko1 = (size_t)(t + 1) * kstep, ko2 = last ? 0 : (size_t)(t + 2) * kstep, ko3 = ko2 + kstep;
            const char* b2 = last ? nB : cB + (size_t)(t + 2) * kstep;
            const char* b3 = b2 + kstep;
            if (last && has_next) S.a_ready(nxt);
            if constexpr (SP2) {
            PG8_LDB(B0, 0, 0); PG8_LDB(B1, 0, 1); PG8_SCHED; PG8_LDA(At, 0, 0); PG8_STAGE_A(PG8_SA(1, 1), 1, ko1, false);
            PG8_WAIT_V(8); PG8_WAIT_L(0); PG8_BAR; PG8_MMA(0, 0, At, B0); PG8_MMA(0, 1, At, B1); PG8_BAR; PG8_SCHED;
            PG8_LDA(At, 0, 1); PG8_STAGE(PG8_SB(0, 0), b2, voffB); PG8_STAGE(PG8_SB(0, 1), b2 + hstep, voffB); PG8_STAGE_A(PG8_SA(0, 0), 0, ko2, last);
            PG8_WAIT_V(8); PG8_WAIT_L(0); PG8_BAR; if (!cur.hf) { PG8_MMA(1, 0, At, B0); PG8_MMA(1, 1, At, B1); } PG8_BAR; PG8_SCHED;
            PG8_LDB(B0, 1, 0); PG8_LDB(B1, 1, 1); PG8_SCHED; PG8_LDA(At, 1, 0); PG8_STAGE_A(PG8_SA(0, 1), 1, ko2, last);
            PG8_WAIT_V(8); PG8_WAIT_L(0); PG8_BAR; PG8_MMA(0, 0, At, B0); PG8_MMA(0, 1, At, B1); PG8_BAR; PG8_SCHED;
            PG8_LDA(At, 1, 1); PG8_STAGE(PG8_SB(1, 0), b3, voffB); PG8_STAGE(PG8_SB(1, 1), b3 + hstep, voffB); PG8_STAGE_A(PG8_SA(1, 0), 0, ko3, last);
            PG8_WAIT_V(8); PG8_WAIT_L(0); PG8_BAR; if (!cur.hf) { PG8_MMA(1, 0, At, B0); PG8_MMA(1, 1, At, B1); } PG8_BAR; PG8_SCHED;
            } else {
            const char* a1 = cA + ko1; const char* a2 = (last ? nA : cA) + ko2; const char* a3 = a2 + kstep;
            PG8_LDB(B0, 0, 0); PG8_SCHED; PG8_LDA(At, 0, 0); PG8_STAGE(PG8_SA(1, 1), a1 + hstep, voffA);
            PG8_WAIT_L(8); PG8_BAR; PG8_WAIT_L(0); PG8_MMA(0, 0, At, B0); PG8_BAR; PG8_SCHED;
            PG8_LDB(B1, 0, 1); PG8_STAGE(PG8_SB(0, 0), b2, voffB);
            PG8_BAR; PG8_WAIT_L(0); PG8_MMA(0, 1, At, B1); PG8_BAR;
            PG8_LDA(At, 0, 1); PG8_STAGE(PG8_SA(0, 0), a2, voffA);
            PG8_BAR; PG8_WAIT_L(0); PG8_MMA(1, 0, At, B0); PG8_BAR; PG8_SCHED;
            PG8_STAGE(PG8_SB(0, 1), b2 + hstep, voffB);
            PG8_WAIT_V(6); PG8_BAR; PG8_MMA(1, 1, At, B1); PG8_BAR;
            PG8_LDB(B0, 1, 0); PG8_SCHED; PG8_LDA(At, 1, 0); PG8_STAGE(PG8_SA(0, 1), a2 + hstep, voffA);
            PG8_WAIT_L(8); PG8_BAR; PG8_WAIT_L(0); PG8_MMA(0, 0, At, B0); PG8_BAR; PG8_SCHED;
            PG8_LDB(B1, 1, 1); PG8_STAGE(PG8_SB(1, 0), b3, voffB);
            PG8_BAR; PG8_WAIT_L(0); PG8_MMA(0, 1, At, B1); PG8_BAR;
            PG8_LDA(At, 1, 1); PG8_STAGE(PG8_SA(1, 0), a3, voffA);
            PG8_BAR; PG8_WAIT_L(0); PG8_MMA(1, 0, At, B0); PG8_BAR; PG8_SCHED;
            PG8_STAGE(PG8_SB(1, 1), b3 + hstep, voffB);
            PG8_WAIT_V(6); PG8_BAR; PG8_MMA(1, 1, At, B1); PG8_BAR;
            }
        }
        if constexpr (ALIGN_EPI) { if (wr == 0) PG8_BAR; }
        if constexpr (!Epi::AFTER_DRAIN) { E(acc, cur, wr, wc, fr, fq); S.done(cur); }
        if (!has_next) break;
        zz = 0.f; asm volatile("" : "+v"(zz));
#pragma unroll
        for (int a = 0; a < 2; ++a)
#pragma unroll
            for (int b = 0; b < 2; ++b)
#pragma unroll
                for (int m = 0; m < 4; ++m)
#pragma unroll
                    for (int n = 0; n < 2; ++n) acc[a][b][m][n] = (f32x4){zz, zz, zz, zz};
        cur = nxt; cA = nA; cB = nB; ++ui;
        if constexpr (GATHER) { _Pragma("unroll") for (int _i = 0; _i < 2; ++_i) { voffA[_i] = nvA0[_i]; voffA1[_i] = nvA1[_i]; } }
        if constexpr (ALIGN_EPI) { if (wr == 1) PG8_BAR; }
    }
    PG8_WAIT_V(0);
    if constexpr (!ALIGN_EPI) { if (wr == 0) PG8_BAR; }
    PG8_BAR;
    if constexpr (Epi::AFTER_DRAIN) { E.fused(acc, cur, wr, wc, fr, fq, lds, wid, lane); S.done(cur); }
#undef PG8_SA
#undef PG8_SB
#undef PG8_STAGE
#undef PG8_DMA
#undef PG8_STAGE_A
#undef PG8_GROW
#undef PG8_LDA
#undef PG8_LDB
#undef PG8_MMA
#undef PG8_WAIT_V
#undef PG8_WAIT_L
#undef PG8_BAR
#undef PG8_SCHED
}
}
#define GAS __attribute__((address_space(1)))
#define LAS __attribute__((address_space(3)))
typedef unsigned short bf16;
typedef unsigned v4u __attribute__((ext_vector_type(4)));
typedef float f32x4 __attribute__((ext_vector_type(4)));
typedef short bf16x8 __attribute__((ext_vector_type(8)));
typedef GAS unsigned gu32;
typedef GAS unsigned long long gu64;
#define RLX_AGENT __ATOMIC_RELAXED, __HIP_MEMORY_SCOPE_AGENT
#define LDS_WAIT() asm volatile("s_waitcnt lgkmcnt(0)" ::: "memory")
#define VM_WAIT() asm volatile("s_waitcnt vmcnt(0)" ::: "memory")
__device__ __forceinline__ int lane_now() { int l; asm volatile("v_mbcnt_lo_u32_b32 %0, -1, 0\n\tv_mbcnt_hi_u32_b32 %0, -1, %0" : "=v"(l)); return l; }
__device__ __forceinline__ int shfl_xor_l(int v, int o) { return __builtin_amdgcn_ds_bpermute((lane_now() ^ o) << 2, v); }
__device__ __forceinline__ unsigned shfl_xor_l(unsigned v, int o) { return (unsigned)shfl_xor_l((int)v, o); }
__device__ __forceinline__ float shfl_xor_l(float v, int o) { return __builtin_bit_cast(float, shfl_xor_l(__builtin_bit_cast(int, v), o)); }
__device__ __forceinline__ int shfl_up_l(int v, int o) { const int l = lane_now(), s = l - o; return __builtin_amdgcn_ds_bpermute((s < 0 ? l : s) << 2, v); }
__device__ __forceinline__ float shfl_up_l(float v, int o) { return __builtin_bit_cast(float, shfl_up_l(__builtin_bit_cast(int, v), o)); }
#define __shfl_xor(v, o) shfl_xor_l((v), (o))
#define __shfl_up(v, o) shfl_up_l((v), (o))
__device__ __forceinline__ unsigned long long rt() { return __builtin_amdgcn_s_memrealtime(); }
__device__ __forceinline__ unsigned f2bf(float f) { unsigned u = __builtin_bit_cast(unsigned, f); return (u + 0x7fffu + ((u >> 16) & 1u)) >> 16; }
__device__ __forceinline__ unsigned pk2(float lo, float hi) { return f2bf(lo) | (f2bf(hi) << 16); }

#define XB_TMO      128
#define XB_XCNT(j)  (256  + 64 * (j))
#define XB_XSUB(j)  (1280 + 64 * (j))
#define XB_XGEN(j)  (2304 + 64 * (j))
#define XB_TOP      3328
#define XB_TOPGEN   3392
#define XCD_BAR_WORDS 3456
#define XB_SPIN_CAP (1u << 18)

__device__ __forceinline__ unsigned xb_ld(unsigned* p)              { return __hip_atomic_load(p, __ATOMIC_RELAXED, __HIP_MEMORY_SCOPE_AGENT); }
__device__ __forceinline__ unsigned xb_add(unsigned* p, unsigned v) { return __hip_atomic_fetch_add(p, v, __ATOMIC_RELAXED, __HIP_MEMORY_SCOPE_AGENT); }
__device__ __forceinline__ unsigned xb_xcc_id() { return (unsigned)__builtin_amdgcn_s_getreg((3 << 11) | 20) & 0xFu; }
#define XB_SPIN(cond, bar) do { unsigned _sp = 0; while (cond) { __builtin_amdgcn_s_sleep(1); \
    if ((++_sp & 255u) == 0u) { if (xb_ld(&(bar)[XB_TMO])) break; if (_sp > XB_SPIN_CAP) { atomicAdd(&(bar)[XB_TMO], 1u); break; } } } } while (0)

struct XcdBarrier {
    unsigned* bar; unsigned x;
    volatile LAS unsigned* st;
};

__device__ __forceinline__ XcdBarrier xcd_barrier_post(unsigned* bar, volatile LAS unsigned* st) {
    XcdBarrier b; b.bar = bar; b.x = xb_xcc_id(); b.st = st;
    if (threadIdx.x == 0) (void)xb_add(&bar[XB_XCNT(b.x)], 1u);
    return b;
}
__device__ __forceinline__ void xcd_barrier_complete(unsigned* bar, unsigned x, unsigned& nloc, unsigned& nx) {
    const unsigned G = gridDim.x * gridDim.y * gridDim.z;
    unsigned sum, cnt, mine, sp = 0u;
    for (;;) {
        sum = 0u; cnt = 0u; mine = 0u;
#pragma unroll
        for (unsigned j = 0; j < 16; ++j) { const unsigned c = xb_ld(&bar[XB_XCNT(j)]); sum += c; cnt += (c > 0u) ? 1u : 0u; mine = (j == x) ? c : mine; }
        if (sum == G) break;
        __builtin_amdgcn_s_sleep(1);
        if ((++sp & 255u) == 0u) { if (xb_ld(&bar[XB_TMO])) break; if (sp > XB_SPIN_CAP) { atomicAdd(&bar[XB_TMO], 1u); break; } }
    }
    nloc = mine > 0u ? mine : 1u; nx = cnt > 0u ? cnt : 1u;
}

__device__ __forceinline__ void xcd_barrier(const XcdBarrier& b) {
    asm volatile("s_waitcnt vmcnt(0)" ::: "memory");
    __syncthreads();
    if (threadIdx.x == 0) {
        unsigned* bar = b.bar;
        __builtin_amdgcn_s_waitcnt(0);
        unsigned nloc = b.st[0], nx = b.st[1];
        if (nloc == 0u) { xcd_barrier_complete(bar, b.x, nloc, nx); b.st[0] = nloc; b.st[1] = nx; }
        const unsigned old = xb_add(&bar[XB_XSUB(b.x)], 1u);
        const unsigned gen = old / nloc;
        if (old + 1u == (gen + 1u) * nloc) {
            __builtin_amdgcn_fence(__ATOMIC_RELEASE, "agent");
            asm volatile("s_waitcnt vmcnt(0)" ::: "memory");
            const unsigned og = xb_add(&bar[XB_TOP], 1u);
            const unsigned tg = og / nx;
            if (og + 1u == (tg + 1u) * nx) xb_add(&bar[XB_TOPGEN], 1u);
            else XB_SPIN(xb_ld(&bar[XB_TOPGEN]) == tg, bar);
            __builtin_amdgcn_fence(__ATOMIC_ACQUIRE, "agent");
            xb_add(&bar[XB_XGEN(b.x)], 1u);
            asm volatile("s_waitcnt vmcnt(0)" ::: "memory");
        } else {
            XB_SPIN(xb_ld(&bar[XB_XGEN(b.x)]) == gen, bar);
            __builtin_amdgcn_fence(__ATOMIC_ACQUIRE, "agent");
            asm volatile("s_waitcnt vmcnt(0)" ::: "memory");
        }
    }
    __syncthreads();
}
namespace mk {
typedef float f32x16 __attribute__((ext_vector_type(16)));
typedef float f32x2 __attribute__((ext_vector_type(2)));
typedef short s16x4 __attribute__((ext_vector_type(4)));
typedef unsigned u32x2 __attribute__((ext_vector_type(2)));
typedef unsigned u32x4 __attribute__((ext_vector_type(4)));

constexpr int NWAVES = 8, NTHR = 512;
constexpr int BATCH = 4, SEQ = 8192, D = 1024, H = 16, HD = 64, T = BATCH * SEQ;
constexpr int NE = 256, TOPK = 8, DE = 256, NGRP = 8, GRPSZ = 32;
constexpr int NBLK = SEQ / 256;
constexpr int NSLOT_MAX = 327680;
constexpr float LN_EPS = 1e-5f;
constexpr float DN_ALPHA = 1.4142135623730951f;
constexpr float ROUTED_SCALE = 2.5f;
constexpr float LOG2E = 1.4426950408889634f;
constexpr float C2 = 0.125f * LOG2E;
constexpr float XQ_SCALE = 16.f, WQ_SCALE = 256.f, AQ_SCALE = 64.f, OQ_SCALE = 64.f, F8_MAX = 448.f;
constexpr float GS_FOLD = AQ_SCALE / (XQ_SCALE * WQ_SCALE);
constexpr int FOXW = 3 * D + H;

constexpr size_t MiB = 1u << 20;
constexpr size_t WS_CTL = 0, CTL_ZERO_BYTES = 1 * MiB;
constexpr size_t WS_WMI = 2 * MiB;
constexpr size_t WS_WMO = 8 * MiB;
constexpr size_t WS_WFI = 10 * MiB;
constexpr size_t WS_WFO = 16 * MiB;
constexpr size_t WS_WR = 18 * MiB;
constexpr size_t WS_WSGU = 21 * MiB;
constexpr size_t WS_WSDN = 23 * MiB;
constexpr size_t WS_WEGU = 24 * MiB;
constexpr size_t WS_WEDN = 280 * MiB;
constexpr size_t WS_XRES = 408 * MiB;
constexpr size_t WS_Z = 536 * MiB;
constexpr size_t WS_XB8 = 600 * MiB;
constexpr size_t WS_XB = 664 * MiB;
constexpr size_t WS_AR = 728 * MiB;
constexpr size_t WS_LOGP = 920 * MiB;
constexpr size_t WS_ACTSH = 984 * MiB;
constexpr size_t WS_TOPI = 1000 * MiB;
constexpr size_t WS_GATE = 1001 * MiB;
constexpr size_t WS_SLOTOF = 1002 * MiB;
constexpr size_t WS_TOKOF = 1003 * MiB;
constexpr size_t WS_GSLOT = 1005 * MiB;
constexpr size_t WS_KMEAN = 1008 * MiB;
constexpr size_t WS_LOGF = 1009 * MiB;
constexpr size_t WS_CUM = 1011 * MiB;
constexpr size_t WS_OVL = 1016 * MiB;
constexpr size_t WS_Q = WS_OVL, WS_K = WS_OVL + 64 * MiB, WS_V = WS_OVL + 128 * MiB, WS_O = WS_OVL + 192 * MiB;
constexpr size_t WS_MLIST = WS_OVL + 256 * MiB;
constexpr size_t WS_PARTO = WS_OVL + 288 * MiB;
constexpr size_t WS_PARTML = WS_OVL + 480 * MiB;
constexpr size_t WS_HS = WS_OVL;
constexpr size_t WS_ACT = WS_OVL + 640 * MiB;
constexpr size_t WS_END = WS_OVL + 800 * MiB;
static_assert(WS_END <= 2048 * MiB, "d_ws map");
static_assert(WS_PARTML + (size_t)T * H * 3 * 2 * 4 <= WS_END, "attention overlay");
constexpr int MLIST_PER_BH = 256 * 496;
constexpr int CW_BAR = 4096;
constexpr int CW_MCNT = 16384;
constexpr int CW_ECNT = 20480;
constexpr int CW_ECUR = 21504;
constexpr int CW_FOXQ = 24576;
constexpr int CW_KSUM = 131072;
constexpr int CW_NORM = 24832;
constexpr int RING_BYTES = 131072, LDSCTL_OFF = 155648, MISC_OFF = LDSCTL_OFF + 320, TPRE_OFF = LDSCTL_OFF + 1024, PTAB_OFF = LDSCTL_OFF + 4096, LDS_BYTES = 163840;
typedef __bf16 bf16x2_t __attribute__((ext_vector_type(2)));
__device__ __forceinline__ unsigned cvtpk(float lo, float hi) { f32x2 v = {lo, hi}; bf16x2_t b = __builtin_convertvector(v, bf16x2_t); return __builtin_bit_cast(unsigned, b); }
__device__ __forceinline__ float bf2f(unsigned b) { return __uint_as_float(b << 16); }
__device__ __forceinline__ float bflo(unsigned w) { return __uint_as_float(w << 16); }
__device__ __forceinline__ float bfhi(unsigned w) { return __uint_as_float(w & 0xffff0000u); }
__device__ __forceinline__ float wave_sum(float v) {
#pragma unroll
    for (int o = 1; o < 64; o <<= 1) v += __shfl_xor(v, o);
    return v;
}
__device__ __forceinline__ unsigned sort_key(float x) { const unsigned b = __float_as_uint(x); return b ^ ((unsigned)((int)b >> 31) | 0x80000000u); }
__device__ __forceinline__ int crow(int r, int hi) { return (r & 3) + 8 * (r >> 2) + 4 * hi; }
__device__ __forceinline__ s16x4 vtr(const LAS unsigned char* p) { typedef short v4i16_t __attribute__((ext_vector_type(4))); return __builtin_bit_cast(s16x4, __builtin_amdgcn_ds_read_tr16_b64_v4i16((LAS v4i16_t*)p)); }

__device__ __forceinline__ unsigned long long ldptr(const LAS unsigned long long* tab, int i) { const unsigned long long v = tab[i]; const unsigned lo = __builtin_amdgcn_readfirstlane((unsigned)v), hi = __builtin_amdgcn_readfirstlane((unsigned)(v >> 32)); return ((unsigned long long)hi << 32) | lo; }

struct Ctx {
    LAS unsigned char* lds;
    int tid, lane, wave, vcu, G;
};

template <bool LO> __device__ __forceinline__ void tr_item(const float* src, size_t ld, bf16* dst, size_t dpitch, LAS float* scr, int lane) {
#pragma unroll 8
    for (int i = 0; i < 32; ++i) { const int kk = 2 * i + (lane >> 5); scr[kk * 33 + (lane & 31)] = src[(size_t)kk * ld + (lane & 31)]; }
    LDS_WAIT(); asm volatile("" ::: "memory");
    const int c = lane & 7;
#pragma unroll
    for (int j = 0; j < 4; ++j) { const int n = (lane >> 3) + 8 * j; const LAS float* s = scr + (8 * c) * 33 + n;
        float v[8];
#pragma unroll
        for (int i = 0; i < 8; ++i) { v[i] = s[i * 33]; if (LO) v[i] = v[i] - bf2f(f2bf(v[i])); }
        v4u o; o.x = pk2(v[0], v[1]); o.y = pk2(v[2], v[3]); o.z = pk2(v[4], v[5]); o.w = pk2(v[6], v[7]);
        *(GAS v4u*)(dst + (size_t)n * dpitch + 8 * c) = o; }
    LDS_WAIT(); asm volatile("" ::: "memory");
}

__device__ __forceinline__ void tr_item64(const float* src, size_t ld, bf16* dst0, size_t rstride, LAS unsigned char* scr, int lane) {
    float v[64];
    const GAS float* p = (const GAS float*)src + lane;
#pragma unroll
    for (int k = 0; k < 64; ++k) v[k] = p[(size_t)k * ld];
#pragma unroll
    for (int c = 0; c < 8; ++c) { v4u o; o.x = cvtpk(v[8 * c], v[8 * c + 1]); o.y = cvtpk(v[8 * c + 2], v[8 * c + 3]); o.z = cvtpk(v[8 * c + 4], v[8 * c + 5]); o.w = cvtpk(v[8 * c + 6], v[8 * c + 7]);
        *(LAS v4u*)(scr + lane * 144 + c * 16) = o; }
    LDS_WAIT(); asm volatile("" ::: "memory");
#pragma unroll
    for (int i = 0; i < 8; ++i) { const int row = 8 * i + (lane >> 3), c = lane & 7; const v4u o = *(const LAS v4u*)(scr + row * 144 + c * 16);
        *(GAS v4u*)(dst0 + (size_t)row * rstride + 8 * c) = o; }
    LDS_WAIT(); asm volatile("" ::: "memory");
}
__device__ __forceinline__ unsigned pk4_f8(float a, float b, float c, float d) {
    a = __builtin_amdgcn_fmed3f(a, -F8_MAX, F8_MAX); b = __builtin_amdgcn_fmed3f(b, -F8_MAX, F8_MAX); c = __builtin_amdgcn_fmed3f(c, -F8_MAX, F8_MAX); d = __builtin_amdgcn_fmed3f(d, -F8_MAX, F8_MAX);
    unsigned w = 0u; w = (unsigned)__builtin_amdgcn_cvt_pk_fp8_f32(a, b, (int)w, false); w = (unsigned)__builtin_amdgcn_cvt_pk_fp8_f32(c, d, (int)w, true); return w;
}
__device__ __forceinline__ void tr_item_f8(const float* src, size_t ld, unsigned char* dst0, size_t rstride, LAS unsigned char* scr, int lane) {
#pragma unroll 1
    for (int h = 0; h < 2; ++h) {
        float v[64];
        const GAS float* p = (const GAS float*)src + lane + (size_t)(64 * h) * ld;
#pragma unroll
        for (int k = 0; k < 64; ++k) v[k] = __builtin_nontemporal_load(p + (size_t)k * ld);
#pragma unroll
        for (int c = 0; c < 4; ++c) { v4u o;
            o.x = pk4_f8(v[16 * c] * WQ_SCALE, v[16 * c + 1] * WQ_SCALE, v[16 * c + 2] * WQ_SCALE, v[16 * c + 3] * WQ_SCALE); o.y = pk4_f8(v[16 * c + 4] * WQ_SCALE, v[16 * c + 5] * WQ_SCALE, v[16 * c + 6] * WQ_SCALE, v[16 * c + 7] * WQ_SCALE);
            o.z = pk4_f8(v[16 * c + 8] * WQ_SCALE, v[16 * c + 9] * WQ_SCALE, v[16 * c + 10] * WQ_SCALE, v[16 * c + 11] * WQ_SCALE); o.w = pk4_f8(v[16 * c + 12] * WQ_SCALE, v[16 * c + 13] * WQ_SCALE, v[16 * c + 14] * WQ_SCALE, v[16 * c + 15] * WQ_SCALE);
            *(LAS v4u*)(scr + lane * 144 + h * 64 + c * 16) = o; }
    }
    LDS_WAIT(); asm volatile("" ::: "memory");
#pragma unroll
    for (int i = 0; i < 8; ++i) { const int row = 8 * i + (lane >> 3), c = lane & 7; const v4u o = *(const LAS v4u*)(scr + row * 144 + c * 16);
        *(GAS v4u*)(dst0 + (size_t)row * rstride + 16 * c) = o; }
    LDS_WAIT(); asm volatile("" ::: "memory");
}
__device__ __forceinline__ void conv_experts(const Ctx& C, const float* wg, const float* wu, const float* wd, int l, unsigned char* WEGU, unsigned char* WEDN, int part, int nparts) {
    const int gw = part * NWAVES + C.wave, NGW = nparts * NWAVES, lane = C.lane;
    LAS unsigned char* scr = C.lds + C.wave * 9216;
    constexpr int IG = NE * 8 * 4;
    constexpr int IDN = NE * 2 * 16;
    for (int it = gw; it < 2 * IG + IDN; it += NGW) {
        if (it < 2 * IG) {
            const int up = it >= IG, r = it - up * IG, e = r >> 5, kb = (r >> 2) & 7, nb = r & 3, n0 = 64 * nb;
            const float* src = (up ? wu : wg) + ((size_t)(l * NE + e) * 1024 + 128 * kb) * 256 + 64 * nb;
            unsigned char* dst = WEGU + ((size_t)e * 512 + (n0 >> 7) * 256 + up * 128 + (n0 & 127)) * 1024 + 128 * kb;
            tr_item_f8(src, 256, dst, 1024, scr, lane);
        } else {
            const int r = it - 2 * IG, e = r >> 5, kb = (r >> 4) & 1, nb = r & 15;
            const float* src = wd + ((size_t)(l * NE + e) * 256 + 128 * kb) * 1024 + 64 * nb;
            unsigned char* dst = WEDN + ((size_t)e * 1024 + 64 * nb) * 256 + 128 * kb;
            tr_item_f8(src, 1024, dst, 256, scr, lane);
        }
    }
}

struct SmallW {
    const float *moba_in, *moba_out, *fox_in, *fox_out, *w_router, *ws_gate, *ws_up, *ws_down;
    unsigned char *WMI, *WFI, *WMO, *WFO, *WSGU, *WSDN;
    bf16 *WR;
};
__device__ __forceinline__ void conv_small(const Ctx& C, const SmallW& W) {
    LAS float* scr = (LAS float*)(C.lds + C.wave * 16384);
    const int gw = C.vcu * NWAVES + C.wave, NGW = C.G * NWAVES;
    constexpr int I_IN = 8 * 48  , I_OUT = 8 * 16, I_R = 16 * 8, I_SG = 8 * 4, I_SD = 2 * 16;
    constexpr int NIT = 2 * I_IN + 2 * I_OUT + 2 * (3 * I_R) + 2 * (2 * I_SG + I_SD);
    for (int it = gw; it < NIT; it += NGW) {
        int r = it;
        if (r < I_IN) { const int kb = r / 48, nb = r % 48; tr_item_f8(W.moba_in + (size_t)(128 * kb) * 3072 + 64 * nb, 3072, W.WMI + (size_t)(64 * nb) * 1024 + 128 * kb, 1024, (LAS unsigned char*)scr, C.lane); continue; } r -= I_IN;
        if (r < I_IN) { const int kb = r / 48, nb = r % 48; tr_item_f8(W.fox_in + (size_t)(128 * kb) * FOXW + 64 * nb, FOXW, W.WFI + (size_t)(64 * nb) * 1024 + 128 * kb, 1024, (LAS unsigned char*)scr, C.lane); continue; } r -= I_IN;
        if (r < I_OUT) { const int kb = r >> 4, nb = r & 15; tr_item_f8(W.moba_out + (size_t)(128 * kb) * 1024 + 64 * nb, 1024, W.WMO + (size_t)(64 * nb) * 1024 + 128 * kb, 1024, (LAS unsigned char*)scr, C.lane); continue; } r -= I_OUT;
        if (r < I_OUT) { const int kb = r >> 4, nb = r & 15; tr_item_f8(W.fox_out + (size_t)(128 * kb) * 1024 + 64 * nb, 1024, W.WFO + (size_t)(64 * nb) * 1024 + 128 * kb, 1024, (LAS unsigned char*)scr, C.lane); continue; } r -= I_OUT;
        if (r < 6 * I_R) {
            const int l = r / (3 * I_R), q = (r % (3 * I_R)) / I_R, s = r % I_R, kb = s >> 3, nb = s & 7;
            const float* src = W.w_router + ((size_t)l * 1024 + 64 * kb) * 256 + 32 * nb;
            bf16* base = W.WR + (size_t)l * (512 * 1536) + (size_t)(32 * nb) * 1536;
            if (q == 0) tr_item<false>(src, 256, base + 64 * kb, 1536, scr, C.lane);
            else if (q == 1) { if (kb < 8) tr_item<false>(src, 256, base + 1024 + 64 * kb, 1536, scr, C.lane); else tr_item<false>(src, 256, base + (size_t)256 * 1536 + 64 * (kb - 8), 1536, scr, C.lane); }
            else tr_item<true>(src, 256, base + (size_t)256 * 1536 + 512 + 64 * kb, 1536, scr, C.lane);
            continue; } r -= 6 * I_R;
        {
            constexpr int PER = 2 * I_SG + I_SD; const int l = r / PER; int s = r % PER;
            if (s < 2 * I_SG) { const int up = s >= I_SG; s -= up * I_SG; const int kb = s >> 2, nb = s & 3, n0 = 64 * nb;
                const float* src = (up ? W.ws_up : W.ws_gate) + ((size_t)l * 1024 + 128 * kb) * 256 + n0;
                tr_item_f8(src, 256, W.WSGU + (size_t)l * (512 * 1024) + (size_t)((n0 >> 7) * 256 + up * 128 + (n0 & 127)) * 1024 + 128 * kb, 1024, (LAS unsigned char*)scr, C.lane); }
            else { s -= 2 * I_SG; const int kb = s >> 4, nb = s & 15;
                tr_item_f8(W.ws_down + ((size_t)l * 256 + 128 * kb) * 1024 + 64 * nb, 1024, W.WSDN + (size_t)l * (1024 * 256) + (size_t)(64 * nb) * 256 + 128 * kb, 256, (LAS unsigned char*)scr, C.lane); }
        }
    }
}
__device__ __forceinline__ void to_f8_rows(const Ctx& C, const float* x, unsigned char* xb8) {
    const size_t n16 = (size_t)T * D / 16;
    for (size_t i = (size_t)C.vcu * NTHR + C.tid; i < n16; i += (size_t)C.G * NTHR) {
        const f32x4 a = *(const GAS f32x4*)(x + 16 * i) * XQ_SCALE, b = *(const GAS f32x4*)(x + 16 * i + 4) * XQ_SCALE, c = *(const GAS f32x4*)(x + 16 * i + 8) * XQ_SCALE, d = *(const GAS f32x4*)(x + 16 * i + 12) * XQ_SCALE;
        v4u o; o.x = pk4_f8(a.x, a.y, a.z, a.w); o.y = pk4_f8(b.x, b.y, b.z, b.w); o.z = pk4_f8(c.x, c.y, c.z, c.w); o.w = pk4_f8(d.x, d.y, d.z, d.w);
        *(GAS v4u*)(xb8 + 16 * i) = o;
    }
}

template <bool COL0> struct EpiF32 {
    static constexpr bool PERM = false, AFTER_DRAIN = false;
    float* out; const float* base; int ldc; float alpha;
    __device__ __forceinline__ void operator()(const pg8::f32x4 (&acc)[2][2][4][2], const pg8::Unit& u, int wr, int wc, int fr, int fq) const {
        const int row0 = u.pm * 256 + wr * 64 + fr, col0 = (COL0 ? 0 : u.pn * 256) + wc * 32 + 4 * fq;
#pragma unroll
        for (int ai = 0; ai < 2; ++ai)
#pragma unroll
            for (int m = 0; m < 4; ++m) { const size_t off = (size_t)(row0 + ai * 128 + m * 16) * ldc + col0;
#pragma unroll
                for (int bj = 0; bj < 2; ++bj)
#pragma unroll
                    for (int n = 0; n < 2; ++n) { f32x4 v = acc[ai][bj][m][n];
                        if (base) { const f32x4 b = *(const GAS f32x4*)(base + off + bj * 128 + n * 16); v = v + b * alpha; }
                        *(GAS f32x4*)(out + off + bj * 128 + n * 16) = v; } }
    }
};
struct EpiQKV {
    static constexpr bool PERM = true, AFTER_DRAIN = false;
    bf16* Qb; size_t split_stride; float scale0; unsigned* norms;
    float* ksum;
    __device__ __forceinline__ void operator()(const pg8::f32x4 (&acc)[2][2][4][2], const pg8::Unit& u, int wr, int wc, int fr, int fq) const {
        asm volatile("" : "+v"(fr), "+v"(fq));
        const int t = u.pn >> 2, colt = (u.pn & 3) * 256;
        constexpr float IS = 1.f / (XQ_SCALE * WQ_SCALE);
        bf16* base = Qb + (size_t)t * split_stride; const float sc = (t == 0 ? scale0 : 1.f) * IS;
        const int row0 = u.pm * 256 + wr * 64 + fr, col0 = colt + wc * 32 + 8 * fq;
        float nmax[2] = {0.f, 0.f};
#pragma unroll
        for (int ai = 0; ai < 2; ++ai)
#pragma unroll
            for (int m = 0; m < 4; ++m) { bf16* rowp = base + (size_t)(row0 + ai * 128 + m * 16) * D + col0;
#pragma unroll
                for (int bj = 0; bj < 2; ++bj) { const f32x4 v0 = acc[ai][bj][m][0] * sc, v1 = acc[ai][bj][m][1] * sc;
                    v4u w; w.x = cvtpk(v0[0], v0[1]); w.y = cvtpk(v0[2], v0[3]); w.z = cvtpk(v1[0], v1[1]); w.w = cvtpk(v1[2], v1[3]);
                    *(GAS v4u*)(rowp + bj * 128) = w;
                    if (t < 2) { float ss = (v0[0] * v0[0] + v0[1] * v0[1]) + (v0[2] * v0[2] + v0[3] * v0[3]) + (v1[0] * v1[0] + v1[1] * v1[1]) + (v1[2] * v1[2] + v1[3] * v1[3]);
                        ss += __shfl_xor(ss, 16); ss += __shfl_xor(ss, 32); nmax[bj] = fmaxf(nmax[bj], ss); } } }
        if (t == 1 && ksum) {
#pragma unroll
            for (int bj = 0; bj < 2; ++bj)
#pragma unroll
                for (int n = 0; n < 2; ++n) { f32x4 cs = (f32x4){0.f, 0.f, 0.f, 0.f};
#pragma unroll
                    for (int ai = 0; ai < 2; ++ai)
#pragma unroll
                        for (int m = 0; m < 4; ++m) cs = cs + acc[ai][bj][m][n];
#pragma unroll
                    for (int i = 0; i < 4; ++i) { float v = cs[i];
#pragma unroll
                        for (int o = 1; o < 16; o <<= 1) v += __shfl_xor(v, o);
                        if (fr == 0) (void)__hip_atomic_fetch_add(ksum + (size_t)u.pm * D + colt + bj * 128 + wc * 32 + 8 * fq + 4 * n + i, v * IS, __ATOMIC_RELAXED, __HIP_MEMORY_SCOPE_AGENT); } }
        }
        if (t < 2) {
#pragma unroll
            for (int bj = 0; bj < 2; ++bj) { float v = nmax[bj];
#pragma unroll
                for (int o = 1; o < 16; o <<= 1) v = fmaxf(v, __shfl_xor(v, o));
                const int head = (u.pn & 3) * 4 + 2 * bj + (wc >> 1), b = u.pm >> 5;
                if (fr == 0 && fq == 0) (void)__hip_atomic_fetch_max(norms + ((b * 16 + head) * 2 + t) * 2 + (wc & 1), __float_as_uint(v * 1.01f), __ATOMIC_RELAXED, __HIP_MEMORY_SCOPE_AGENT); }
        }
    }
};
template <bool F8> struct EpiSwiGLU {
    static constexpr bool PERM = true, AFTER_DRAIN = false;
    void* actp; const float* rowscale;
    __device__ __forceinline__ void operator()(const pg8::f32x4 (&acc)[2][2][4][2], const pg8::Unit& u, int wr, int wc, int fr, int fq) const {
        asm volatile("" : "+v"(fr), "+v"(fq));
        const int row0 = u.pm * 256 + wr * 64 + fr, col0 = (u.pn & 1) * 128 + wc * 32 + 8 * fq;
        const int ln = fr + 16 * fq, src4 = ((ln >> 2) + 16 * (ln & 3)) << 2, srow0 = u.pm * 256 + wr * 64 + (ln >> 2), scol0 = (u.pn & 1) * 128 + wc * 32 + 8 * (ln & 3);
        constexpr float IS = F8 ? 1.f / (XQ_SCALE * WQ_SCALE) : 1.f;
#pragma unroll
        for (int ai = 0; ai < 2; ++ai) if (ai == 0 || !u.hf)
#pragma unroll
            for (int m = 0; m < 4; ++m) { const int row = row0 + ai * 128 + m * 16; const float rs = rowscale ? rowscale[row] : (F8 ? GS_FOLD : 1.f);
                float o[8];
#pragma unroll
                for (int n = 0; n < 2; ++n)
#pragma unroll
                    for (int i = 0; i < 4; ++i) { const float g = acc[ai][0][m][n][i] * IS, up = acc[ai][1][m][n][i];
                        const float sg = g * __builtin_amdgcn_rcpf(1.f + __builtin_amdgcn_exp2f(-g * LOG2E)); o[4 * n + i] = sg * up * rs; }
                if constexpr (F8) { u32x2 w; w.x = pk4_f8(o[0], o[1], o[2], o[3]); w.y = pk4_f8(o[4], o[5], o[6], o[7]);
                    w.x = (unsigned)__builtin_amdgcn_ds_bpermute(src4, (int)w.x); w.y = (unsigned)__builtin_amdgcn_ds_bpermute(src4, (int)w.y);
                    *(GAS u32x2*)((unsigned char*)actp + (size_t)(srow0 + ai * 128 + m * 16) * 256 + scol0) = w; }
                else { v4u w; w.x = cvtpk(o[0], o[1]); w.y = cvtpk(o[2], o[3]); w.z = cvtpk(o[4], o[5]); w.w = cvtpk(o[6], o[7]);
                    *(GAS v4u*)((bf16*)actp + (size_t)row * 256 + col0) = w; } }
    }
};
constexpr float SO_SCALE = 64.f, SO_INV = 1.f / 64.f;
template <bool F8> struct EpiDown {
    static constexpr bool PERM = true, AFTER_DRAIN = false;
    static constexpr float sc = F8 ? SO_SCALE / (AQ_SCALE * WQ_SCALE) : SO_SCALE;
    unsigned char* out;
    __device__ __forceinline__ void operator()(const pg8::f32x4 (&acc)[2][2][4][2], const pg8::Unit& u, int wr, int wc, int fr, int fq) const {
        const int ln = fr + 16 * fq, src4 = ((ln >> 2) + 16 * (ln & 3)) << 2, fr2 = ln >> 2, fq2 = ln & 3;
        const int row0 = u.pm * 256 + wr * 64 + fr2, col0 = (u.pn & 3) * 256 + wc * 32 + 8 * fq2;
#pragma unroll
        for (int ai = 0; ai < 2; ++ai) if (ai == 0 || !u.hf)
#pragma unroll
            for (int m = 0; m < 4; ++m) { unsigned char* rowp = out + (size_t)(row0 + ai * 128 + m * 16) * 1024 + col0;
#pragma unroll
                for (int bj = 0; bj < 2; ++bj) { const f32x4 v0 = acc[ai][bj][m][0] * sc, v1 = acc[ai][bj][m][1] * sc;
                    u32x2 w; w.x = 0u; w.y = 0u;
                    w.x = __builtin_amdgcn_cvt_pk_fp8_f32(v0[0], v0[1], w.x, false); w.x = __builtin_amdgcn_cvt_pk_fp8_f32(v0[2], v0[3], w.x, true);
                    w.y = __builtin_amdgcn_cvt_pk_fp8_f32(v1[0], v1[1], w.y, false); w.y = __builtin_amdgcn_cvt_pk_fp8_f32(v1[2], v1[3], w.y, true);
                    w.x = (unsigned)__builtin_amdgcn_ds_bpermute(src4, (int)w.x); w.y = (unsigned)__builtin_amdgcn_ds_bpermute(src4, (int)w.y);
                    *(GAS u32x2*)(rowp + bj * 128) = w; } }
    }
};
template <int NN> struct PlainOrder {
    int vcu, G, nunits;
    __device__ __forceinline__ bool next(int i, pg8::Unit& u) const { const int idx = vcu + i * G; if (idx >= nunits) return false;
        u.pm = __builtin_amdgcn_readfirstlane(idx / NN); u.pn = __builtin_amdgcn_readfirstlane(idx % NN);
        int z = 0; asm volatile("" : "+s"(z)); u.hf = z;
        return true; }
    __device__ __forceinline__ void a_ready(const pg8::Unit&) const {}
    __device__ __forceinline__ void done(const pg8::Unit&) const {}
};
struct RouterOrder {
    int vcu, G;
    __device__ __forceinline__ bool next(int i, pg8::Unit& u) const { const int idx = vcu + i * G; if (idx >= 256) return false; u.pm = idx; u.pn = idx >> 7; return true; }
    __device__ __forceinline__ void a_ready(const pg8::Unit&) const {}
    __device__ __forceinline__ void done(const pg8::Unit&) const {}
};
template <int SH> struct ExpertOrder {
    int vcu, G; const LAS int* tpre;
    __device__ __forceinline__ bool next(int i, pg8::Unit& u) const {
        const int idx = vcu + i * G, ti = idx >> SH; if (ti >= tpre[NE]) return false;
        int lo = 0, hi = NE;
#pragma unroll
        for (int s = 0; s < 8; ++s) { const int mid = (lo + hi) >> 1; if (tpre[mid] <= ti) lo = mid; else hi = mid; }
        u.pm = __builtin_amdgcn_readfirstlane(ti); u.pn = __builtin_amdgcn_readfirstlane((lo << SH) + (idx & ((1 << SH) - 1)));
        u.hf = __builtin_amdgcn_readfirstlane((tpre[272 + lo] - 256 * (ti - tpre[lo])) <= 128 ? 1 : 0); return true;
    }
    __device__ __forceinline__ void a_ready(const pg8::Unit&) const {}
    __device__ __forceinline__ void done(const pg8::Unit&) const {}
};
__device__ __forceinline__ void build_tpre(const Ctx& C, const unsigned* ecnt) {
    LAS int* tpre = (LAS int*)(C.lds + TPRE_OFF);
    __syncthreads();
    int v = 0;
    if (C.tid < NE) { const int c = (int)__hip_atomic_load(ecnt + C.tid, __ATOMIC_RELAXED, __HIP_MEMORY_SCOPE_AGENT); v = (c + 255) >> 8; tpre[272 + C.tid] = c; }
    int inc = v;
#pragma unroll
    for (int o = 1; o < 64; o <<= 1) { const int t = __shfl_up(inc, o); if (C.lane >= o) inc += t; }
    if (C.tid < NE && C.lane == 63) tpre[260 + C.wave] = inc;
    __syncthreads();
    if (C.tid < NE) { int base = 0; for (int w = 0; w < C.wave; ++w) base += tpre[260 + w]; tpre[C.tid + 1] = base + inc; if (C.tid == 0) tpre[0] = 0; }
    __syncthreads();
}
struct AttnAcc { float m; f32x16 o0, o1, la; };
#define MFMA32(a, b, c) __builtin_amdgcn_mfma_f32_32x32x16_bf16((a), (b), (c), 0, 0, 0)
constexpr float NEG_INF = -__builtin_inff();

__device__ __forceinline__ void glds16(const void* gsrc, unsigned lds_dst) { unsigned keep;
    asm volatile("s_mov_b32 %0, m0\n\ts_mov_b32 m0, %2\n\ts_nop 0\n\tglobal_load_lds_dwordx4 %1, off\n\ts_mov_b32 m0, %0" : "=&s"(keep) : "v"(gsrc), "s"(lds_dst) : "memory"); }
__device__ __forceinline__ void glds4(const void* gsrc, unsigned lds_dst) { unsigned keep;
    asm volatile("s_mov_b32 %0, m0\n\ts_mov_b32 m0, %2\n\ts_nop 0\n\tglobal_load_lds_dword %1, off\n\ts_mov_b32 m0, %0" : "=&s"(keep) : "v"(gsrc), "s"(lds_dst) : "memory"); }
__device__ __forceinline__ unsigned lds_addr(const LAS unsigned char* p) { return (unsigned)__builtin_amdgcn_readfirstlane((int)(unsigned)(uintptr_t)p); }
__device__ __forceinline__ void dma_tile(const bf16* Kg, const bf16* Vg, LAS unsigned char* Ks, LAS unsigned char* Vs, int wave, int lane) {
    glds16(Kg + (size_t)lane * D + wave * 8, lds_addr(Ks + wave * 1024));
    glds16(Vg + (size_t)(16 * (wave & 3) + (lane >> 2)) * D + (wave >> 2) * 32 + (lane & 3) * 8, lds_addr(Vs + wave * 1024));
}
__device__ __forceinline__ void load_q(bf16x8 (&qr)[4], const bf16* Qrow, int hi) {
#pragma unroll
    for (int d0 = 0; d0 < 4; ++d0) qr[d0] = *(const GAS bf16x8*)(Qrow + d0 * 16 + hi * 8);
}
template <class Bias> __device__ __forceinline__ void qk_tile(f32x16& p0, f32x16& p1, const bf16x8 (&qr)[4], const LAS unsigned char* Ks, int r32, int hi, const Bias& B) {
    __builtin_amdgcn_sched_barrier(0);
    B.init(p0, p1, hi);
    const LAS unsigned char* kb = Ks + hi * 1024 + r32 * 16;
    bf16x8 kf[8];
#pragma unroll
    for (int d0 = 0; d0 < 4; ++d0) { kf[2 * d0] = *(const LAS bf16x8*)(kb + d0 * 2048); kf[2 * d0 + 1] = *(const LAS bf16x8*)(kb + d0 * 2048 + 512); }
    __builtin_amdgcn_sched_barrier(0);
#pragma unroll
    for (int d0 = 0; d0 < 4; ++d0) { p0 = MFMA32(kf[2 * d0], qr[d0], p0); p1 = MFMA32(kf[2 * d0 + 1], qr[d0], p1); }
    B.mask(p0, p1, hi);
    __builtin_amdgcn_sched_barrier(0);
}
constexpr float ATT_THR = 8.f;
__device__ __forceinline__ float half_max(float m) { auto rr = __builtin_amdgcn_permlane32_swap(__float_as_uint(m), __float_as_uint(m), false, false); return fmaxf(__uint_as_float(rr[0]), __uint_as_float(rr[1])); }
__device__ __forceinline__ void attn_rescale(AttnAcc& A, float rm) {
    const bool need = rm > A.m + ATT_THR;
    if (__any(need)) {
        const float mn = need ? rm : A.m, f = __builtin_amdgcn_exp2f(A.m - mn);
        A.la[0] *= f;
#pragma unroll
        for (int r = 0; r < 16; ++r) { A.o0[r] *= f; A.o1[r] *= f; }
        A.m = mn;
    }
}
__device__ __forceinline__ void softmax_pv(AttnAcc& A, f32x16& p0, f32x16& p1, const LAS unsigned char* Vs, int hi, int lane) {
    __builtin_amdgcn_sched_barrier(0);
    const LAS unsigned char* vb = Vs + ((lane >> 4) & 1) * 32 + (lane & 3) * 8 + (4 * hi + ((lane & 15) >> 2)) * 64;
    s16x4 vt[16];
#pragma unroll
    for (int ks = 0; ks < 4; ++ks) { vt[4 * ks] = vtr(vb + ks * 1024); vt[4 * ks + 1] = vtr(vb + ks * 1024 + 512); vt[4 * ks + 2] = vtr(vb + (4 + ks) * 1024); vt[4 * ks + 3] = vtr(vb + (4 + ks) * 1024 + 512); }
    __builtin_amdgcn_sched_barrier(0);
    float rm = fmaxf(p0[0], p1[0]);
#pragma unroll
    for (int r = 1; r < 16; ++r) rm = fmaxf(fmaxf(rm, p0[r]), p1[r]);
    rm = half_max(rm);
    attn_rescale(A, rm);
    const float mn = A.m;
#pragma unroll
    for (int r = 0; r < 16; ++r) { p0[r] = __builtin_amdgcn_exp2f(p0[r] - mn); p1[r] = __builtin_amdgcn_exp2f(p1[r] - mn); }
    v4u pw[4];
#pragma unroll
    for (int s = 0; s < 2; ++s) {
        pw[s].x = cvtpk(p0[8 * s + 0], p0[8 * s + 1]); pw[s].y = cvtpk(p0[8 * s + 2], p0[8 * s + 3]); pw[s].z = cvtpk(p0[8 * s + 4], p0[8 * s + 5]); pw[s].w = cvtpk(p0[8 * s + 6], p0[8 * s + 7]);
        pw[2 + s].x = cvtpk(p1[8 * s + 0], p1[8 * s + 1]); pw[2 + s].y = cvtpk(p1[8 * s + 2], p1[8 * s + 3]); pw[2 + s].z = cvtpk(p1[8 * s + 4], p1[8 * s + 5]); pw[2 + s].w = cvtpk(p1[8 * s + 6], p1[8 * s + 7]);
    }
    const bf16x8 ones = {(short)0x3F80, (short)0x3F80, (short)0x3F80, (short)0x3F80, (short)0x3F80, (short)0x3F80, (short)0x3F80, (short)0x3F80};
#pragma unroll
    for (int ks = 0; ks < 4; ++ks) {
        const bf16x8 pa = __builtin_bit_cast(bf16x8, pw[ks]);
        const s16x4 a0 = vt[4 * ks], a1 = vt[4 * ks + 1], b0 = vt[4 * ks + 2], b1 = vt[4 * ks + 3];
        const bf16x8 v0 = {a0[0], a0[1], a0[2], a0[3], a1[0], a1[1], a1[2], a1[3]}, v1 = {b0[0], b0[1], b0[2], b0[3], b1[0], b1[1], b1[2], b1[3]};
        A.o0 = MFMA32(v0, pa, A.o0); A.o1 = MFMA32(v1, pa, A.o1); A.la = MFMA32(ones, pa, A.la);
    }
    __builtin_amdgcn_sched_barrier(0);
}
__device__ __forceinline__ void acc_init(AttnAcc& A) {
    A.m = NEG_INF;
    float z = 0.f; asm volatile("" : "+v"(z));
#pragma unroll
    for (int r = 0; r < 16; ++r) { A.o0[r] = z; A.o1[r] = z; A.la[r] = z; }
}
#define ATT_SB() __builtin_amdgcn_sched_barrier(0)
template <class Bias> __device__ __forceinline__ void attn_step(AttnAcc& A, f32x16& pc0, f32x16& pc1, f32x16& pn0, f32x16& pn1, const bf16x8 (&qr)[4],
                                                               const LAS unsigned char* Kn, const LAS unsigned char* Vc, int r32, int hi, int lane, const Bias& Bn, const bool doNext) {
    ATT_SB();
    if (doNext) Bn.init(pn0, pn1, hi);
    const LAS unsigned char* kb = Kn + hi * 1024 + r32 * 16;
    bf16x8 ka[4], kc[4];
#pragma unroll
    for (int d0 = 0; d0 < 2; ++d0) { ka[2 * d0] = *(const LAS bf16x8*)(kb + d0 * 2048); ka[2 * d0 + 1] = *(const LAS bf16x8*)(kb + d0 * 2048 + 512); }
    ATT_SB();
    float ra = fmaxf(fmaxf(pc0[0], pc0[1]), fmaxf(pc0[2], pc0[3]));
    if (doNext) pn0 = MFMA32(ka[0], qr[0], pn0);
    ra = fmaxf(fmaxf(ra, pc1[0]), pc1[1]); ra = fmaxf(fmaxf(ra, pc1[2]), pc1[3]); ATT_SB();
    if (doNext) pn1 = MFMA32(ka[1], qr[0], pn1);
#pragma unroll
    for (int d0 = 2; d0 < 4; ++d0) { kc[2 * d0 - 4] = *(const LAS bf16x8*)(kb + d0 * 2048); kc[2 * d0 - 3] = *(const LAS bf16x8*)(kb + d0 * 2048 + 512); }
    ra = fmaxf(fmaxf(ra, pc0[4]), pc0[5]); ra = fmaxf(fmaxf(ra, pc0[6]), pc0[7]); ra = fmaxf(fmaxf(ra, pc1[4]), pc1[5]); ra = fmaxf(fmaxf(ra, pc1[6]), pc1[7]); ATT_SB();
    if (doNext) pn0 = MFMA32(ka[2], qr[1], pn0);
    ra = fmaxf(fmaxf(ra, pc0[8]), pc0[9]); ra = fmaxf(fmaxf(ra, pc0[10]), pc0[11]); ra = fmaxf(fmaxf(ra, pc1[8]), pc1[9]); ra = fmaxf(fmaxf(ra, pc1[10]), pc1[11]); ATT_SB();
    if (doNext) pn1 = MFMA32(ka[3], qr[1], pn1);
    ra = fmaxf(fmaxf(ra, pc0[12]), pc0[13]); ra = fmaxf(fmaxf(ra, pc0[14]), pc0[15]); ra = fmaxf(fmaxf(ra, pc1[12]), pc1[13]); ra = fmaxf(fmaxf(ra, pc1[14]), pc1[15]);
    ra = half_max(ra); ATT_SB();
    attn_rescale(A, ra);
    const float mn = A.m;
    ATT_SB();
    const LAS unsigned char* vb = Vc + ((lane >> 4) & 1) * 32 + (lane & 3) * 8 + (4 * hi + ((lane & 15) >> 2)) * 64;
    s16x4 vt[16];
    v4u pw[4];
#define ATT_VRD(ks) do { vt[4 * (ks)] = vtr(vb + (ks) * 1024); vt[4 * (ks) + 1] = vtr(vb + (ks) * 1024 + 512); vt[4 * (ks) + 2] = vtr(vb + (4 + (ks)) * 1024); vt[4 * (ks) + 3] = vtr(vb + (4 + (ks)) * 1024 + 512); } while (0)
#define ATT_EXP4(P, c) do { _Pragma("unroll") for (int i_ = 0; i_ < 4; ++i_) P[4 * (c) + i_] = __builtin_amdgcn_exp2f(P[4 * (c) + i_] - mn); } while (0)
    ATT_VRD(0); ATT_VRD(1); ATT_SB();
    if (doNext) pn0 = MFMA32(kc[0], qr[2], pn0); ATT_EXP4(pc0, 0); ATT_EXP4(pc0, 1);
    pw[0].x = cvtpk(pc0[0], pc0[1]); pw[0].y = cvtpk(pc0[2], pc0[3]); pw[0].z = cvtpk(pc0[4], pc0[5]); pw[0].w = cvtpk(pc0[6], pc0[7]); ATT_SB();
    if (doNext) pn1 = MFMA32(kc[1], qr[2], pn1); ATT_EXP4(pc0, 2); ATT_EXP4(pc0, 3);
    pw[1].x = cvtpk(pc0[8], pc0[9]); pw[1].y = cvtpk(pc0[10], pc0[11]); pw[1].z = cvtpk(pc0[12], pc0[13]); pw[1].w = cvtpk(pc0[14], pc0[15]); ATT_SB();
    ATT_VRD(2); ATT_VRD(3); ATT_SB();
    if (doNext) pn0 = MFMA32(kc[2], qr[3], pn0); ATT_EXP4(pc1, 0); ATT_EXP4(pc1, 1);
    pw[2].x = cvtpk(pc1[0], pc1[1]); pw[2].y = cvtpk(pc1[2], pc1[3]); pw[2].z = cvtpk(pc1[4], pc1[5]); pw[2].w = cvtpk(pc1[6], pc1[7]); ATT_SB();
    if (doNext) pn1 = MFMA32(kc[3], qr[3], pn1); ATT_EXP4(pc1, 2); ATT_EXP4(pc1, 3);
    pw[3].x = cvtpk(pc1[8], pc1[9]); pw[3].y = cvtpk(pc1[10], pc1[11]); pw[3].z = cvtpk(pc1[12], pc1[13]); pw[3].w = cvtpk(pc1[14], pc1[15]); ATT_SB();
#undef ATT_EXP4
#undef ATT_VRD
    if (doNext) Bn.mask(pn0, pn1, hi);
    ATT_SB();
    const bf16x8 ones = {(short)0x3F80, (short)0x3F80, (short)0x3F80, (short)0x3F80, (short)0x3F80, (short)0x3F80, (short)0x3F80, (short)0x3F80};
#pragma unroll
    for (int ks = 0; ks < 4; ++ks) {
        const bf16x8 pa = __builtin_bit_cast(bf16x8, pw[ks]);
        const s16x4 a0 = vt[4 * ks], a1 = vt[4 * ks + 1], b0 = vt[4 * ks + 2], b1 = vt[4 * ks + 3];
        const bf16x8 v0 = {a0[0], a0[1], a0[2], a0[3], a1[0], a1[1], a1[2], a1[3]}, v1 = {b0[0], b0[1], b0[2], b0[3], b1[0], b1[1], b1[2], b1[3]};
        A.o0 = MFMA32(v0, pa, A.o0); A.o1 = MFMA32(v1, pa, A.o1); A.la = MFMA32(ones, pa, A.la);
    }
    ATT_SB();
}

template <class Bias> __device__ __forceinline__ void attn_step3(AttnAcc& A, f32x16& pc0, f32x16& pc1, f32x16& pn0, f32x16& pn1, const v4u (&pwp)[4], v4u (&pw)[4], const bf16x8 (&qr)[4],
        const LAS unsigned char* Kn, const LAS unsigned char* Vp, int r32, int hi, int lane, const Bias& Bn, const bool doCur) {
    const bf16x8 ones = {(short)0x3F80, (short)0x3F80, (short)0x3F80, (short)0x3F80, (short)0x3F80, (short)0x3F80, (short)0x3F80, (short)0x3F80};
    const LAS unsigned char* kb = Kn + hi * 1024 + r32 * 16;
    const LAS unsigned char* vb = Vp + ((lane >> 4) & 1) * 32 + (lane & 3) * 8 + (4 * hi + ((lane & 15) >> 2)) * 64;
    bf16x8 ka[2], kc[2]; s16x4 va[4], vc[4], vd[4], ve[4];
#define ATT_VRD(dst, ks) do { dst[0] = vtr(vb + (ks) * 1024); dst[1] = vtr(vb + (ks) * 1024 + 512); dst[2] = vtr(vb + (4 + (ks)) * 1024); dst[3] = vtr(vb + (4 + (ks)) * 1024 + 512); } while (0)
#define ATT_V0(v) ((bf16x8){v[0][0], v[0][1], v[0][2], v[0][3], v[1][0], v[1][1], v[1][2], v[1][3]})
#define ATT_V1(v) ((bf16x8){v[2][0], v[2][1], v[2][2], v[2][3], v[3][0], v[3][1], v[3][2], v[3][3]})
#define ATT_PA(k) __builtin_bit_cast(bf16x8, pwp[k])
#define ATT_PIN(x) asm volatile("" : "+v"(x))
    ATT_SB();
    Bn.init(pn0, pn1, hi);
    ka[0] = *(const LAS bf16x8*)(kb); ka[1] = *(const LAS bf16x8*)(kb + 512); kc[0] = *(const LAS bf16x8*)(kb + 2048); kc[1] = *(const LAS bf16x8*)(kb + 2560);
    ATT_VRD(va, 0);
    ATT_SB();
    float ra = fmaxf(fmaxf(pc0[0], pc0[1]), fmaxf(pc0[2], pc0[3]));
    pn0 = MFMA32(ka[0], qr[0], pn0);
    A.o0 = MFMA32(ATT_V0(va), ATT_PA(0), A.o0);
    ra = fmaxf(fmaxf(ra, pc1[0]), pc1[1]); ra = fmaxf(fmaxf(ra, pc1[2]), pc1[3]); ra = fmaxf(fmaxf(ra, pc0[4]), pc0[5]); ra = fmaxf(fmaxf(ra, pc0[6]), pc0[7]); ATT_PIN(ra);
    ATT_VRD(vc, 1);
    ATT_SB();
    pn1 = MFMA32(ka[1], qr[0], pn1);
    A.o1 = MFMA32(ATT_V1(va), ATT_PA(0), A.o1);
    ra = fmaxf(fmaxf(ra, pc1[4]), pc1[5]); ra = fmaxf(fmaxf(ra, pc1[6]), pc1[7]); ra = fmaxf(fmaxf(ra, pc0[8]), pc0[9]); ra = fmaxf(fmaxf(ra, pc0[10]), pc0[11]); ATT_PIN(ra);
    ka[0] = *(const LAS bf16x8*)(kb + 4096); ka[1] = *(const LAS bf16x8*)(kb + 4608);
    ATT_SB();
    pn0 = MFMA32(kc[0], qr[1], pn0);
    A.la = MFMA32(ones, ATT_PA(0), A.la); A.o0 = MFMA32(ATT_V0(vc), ATT_PA(1), A.o0);
    ATT_VRD(vd, 2);
    ra = fmaxf(fmaxf(ra, pc1[8]), pc1[9]); ra = fmaxf(fmaxf(ra, pc1[10]), pc1[11]); ra = fmaxf(fmaxf(ra, pc0[12]), pc0[13]); ra = fmaxf(fmaxf(ra, pc0[14]), pc0[15]); ATT_PIN(ra); ATT_SB();
    pn1 = MFMA32(kc[1], qr[1], pn1);
    A.o1 = MFMA32(ATT_V1(vc), ATT_PA(1), A.o1); A.la = MFMA32(ones, ATT_PA(1), A.la);
    ATT_VRD(ve, 3);
    kc[0] = *(const LAS bf16x8*)(kb + 6144); kc[1] = *(const LAS bf16x8*)(kb + 6656);
    ra = fmaxf(fmaxf(ra, pc1[12]), pc1[13]); ra = fmaxf(fmaxf(ra, pc1[14]), pc1[15]); ra = half_max(ra);
    const bool need = doCur && (ra > A.m + ATT_THR);
    float mn = need ? ra : A.m; const float fr = __builtin_amdgcn_exp2f(A.m - mn); ATT_PIN(mn);
    ATT_SB();
#define ATT_EXP4(P, c) do { _Pragma("unroll") for (int i_ = 0; i_ < 4; ++i_) P[4 * (c) + i_] = __builtin_amdgcn_exp2f(P[4 * (c) + i_] - mn); } while (0)
    pn0 = MFMA32(ka[0], qr[2], pn0);
    A.o0 = MFMA32(ATT_V0(vd), ATT_PA(2), A.o0);
    { ATT_EXP4(pc0, 0); ATT_EXP4(pc0, 1); pw[0].x = cvtpk(pc0[0], pc0[1]); pw[0].y = cvtpk(pc0[2], pc0[3]); pw[0].z = cvtpk(pc0[4], pc0[5]); pw[0].w = cvtpk(pc0[6], pc0[7]); ATT_PIN(pw[0]); }
    ATT_SB();
    pn1 = MFMA32(ka[1], qr[2], pn1);
    A.o1 = MFMA32(ATT_V1(vd), ATT_PA(2), A.o1);
    { ATT_EXP4(pc0, 2); ATT_EXP4(pc0, 3); pw[1].x = cvtpk(pc0[8], pc0[9]); pw[1].y = cvtpk(pc0[10], pc0[11]); pw[1].z = cvtpk(pc0[12], pc0[13]); pw[1].w = cvtpk(pc0[14], pc0[15]); ATT_PIN(pw[1]); }
    ATT_SB();
    pn0 = MFMA32(kc[0], qr[3], pn0);
    A.la = MFMA32(ones, ATT_PA(2), A.la); A.o0 = MFMA32(ATT_V0(ve), ATT_PA(3), A.o0);
    { ATT_EXP4(pc1, 0); ATT_EXP4(pc1, 1); pw[2].x = cvtpk(pc1[0], pc1[1]); pw[2].y = cvtpk(pc1[2], pc1[3]); pw[2].z = cvtpk(pc1[4], pc1[5]); pw[2].w = cvtpk(pc1[6], pc1[7]); ATT_PIN(pw[2]); }
    ATT_SB();
    pn1 = MFMA32(kc[1], qr[3], pn1);
    A.o1 = MFMA32(ATT_V1(ve), ATT_PA(3), A.o1); A.la = MFMA32(ones, ATT_PA(3), A.la);
    { ATT_EXP4(pc1, 2); ATT_EXP4(pc1, 3); pw[3].x = cvtpk(pc1[8], pc1[9]); pw[3].y = cvtpk(pc1[10], pc1[11]); pw[3].z = cvtpk(pc1[12], pc1[13]); pw[3].w = cvtpk(pc1[14], pc1[15]); ATT_PIN(pw[3]); }
    ATT_SB();
#undef ATT_EXP4
#undef ATT_VRD
#undef ATT_V0
#undef ATT_V1
#undef ATT_PA
#undef ATT_PIN
    Bn.mask(pn0, pn1, hi);
    if (__any(need)) {
        A.la[0] *= fr;
#pragma unroll
        for (int r = 0; r < 16; ++r) { A.o0[r] *= fr; A.o1[r] *= fr; }
    }
    A.m = mn;
    ATT_SB();
}

__device__ __forceinline__ void store_o(bf16* op, const AttnAcc& A, float inv, int hi) {
#pragma unroll
    for (int g = 0; g < 4; ++g) {
        u32x2 w0, w1; w0.x = cvtpk(A.o0[4 * g] * inv, A.o0[4 * g + 1] * inv); w0.y = cvtpk(A.o0[4 * g + 2] * inv, A.o0[4 * g + 3] * inv);
        w1.x = cvtpk(A.o1[4 * g] * inv, A.o1[4 * g + 1] * inv); w1.y = cvtpk(A.o1[4 * g + 2] * inv, A.o1[4 * g + 3] * inv);
        *(GAS u32x2*)(op + 8 * g + 4 * hi) = w0; *(GAS u32x2*)(op + 32 + 8 * g + 4 * hi) = w1; }
}

__device__ __forceinline__ void store_o8(unsigned char* op, const AttnAcc& A, float inv, int hi) {
    const float s = inv * OQ_SCALE;
#pragma unroll
    for (int g = 0; g < 4; ++g) {
        *(GAS unsigned*)(op + 8 * g + 4 * hi) = pk4_f8(A.o0[4 * g] * s, A.o0[4 * g + 1] * s, A.o0[4 * g + 2] * s, A.o0[4 * g + 3] * s);
        *(GAS unsigned*)(op + 32 + 8 * g + 4 * hi) = pk4_f8(A.o1[4 * g] * s, A.o1[4 * g + 1] * s, A.o1[4 * g + 2] * s, A.o1[4 * g + 3] * s); }
}

__device__ __forceinline__ int rel_bucket(int n) {
    if (n < 16) return n;
    int b = 16;
    b += (n >= 19); b += (n >= 21); b += (n >= 24); b += (n >= 27); b += (n >= 31); b += (n >= 35); b += (n >= 40); b += (n >= 46);
    b += (n >= 52); b += (n >= 59); b += (n >= 67); b += (n >= 77); b += (n >= 87); b += (n >= 99); b += (n >= 113);
    return b;
}
__device__ __forceinline__ void build_relb(const Ctx& C, const float* rel_bias, LAS float* relb) {
    for (int i = C.tid; i < H * 128; i += NTHR) { const int h = i >> 7, n = i & 127; relb[i] = rel_bias[rel_bucket(n) * H + h] * LOG2E; }
}
struct MobaBias {
    const LAS float* relb; int qpos, kpos0; bool lookup, causal; float cbias;
    __device__ __forceinline__ void init(f32x16& p0, f32x16& p1, int hi) const {
        if (lookup) {
            int dbase = qpos - kpos0 - 4 * hi; asm volatile("" : "+v"(dbase));
#pragma unroll
            for (int r = 0; r < 16; ++r) { const int d0 = dbase - ((r & 3) + 8 * (r >> 2)), d1 = d0 - 32;
                const int i0 = d0 < 0 ? 0 : (d0 > 127 ? 127 : d0), i1 = d1 < 0 ? 0 : (d1 > 127 ? 127 : d1);
                p0[r] = relb[i0]; p1[r] = relb[i1];
                if ((r & 3) == 3) __builtin_amdgcn_sched_barrier(0); }
        } else {
#pragma unroll
            for (int r = 0; r < 16; ++r) { p0[r] = cbias; p1[r] = cbias; }
        }
    }
    __device__ __forceinline__ void mask(f32x16& p0, f32x16& p1, int hi) const {
        if (causal) {
            int d = qpos - kpos0 - 4 * hi; asm volatile("" : "+v"(d));
#pragma unroll
            for (int r = 0; r < 16; ++r) { const int c = (r & 3) + 8 * (r >> 2); if (c > d) p0[r] = NEG_INF; if (c + 32 > d) p1[r] = NEG_INF; }
        }
    }
};
struct FoxBias {
    const LAS float* cb; int qrel, krel0; bool causal;
    __device__ __forceinline__ void init(f32x16& p0, f32x16& p1, int hi) const {
#pragma unroll
        for (int g = 0; g < 4; ++g) { const f32x4 c0 = *(const LAS f32x4*)(cb + 8 * g + 4 * hi), c1 = *(const LAS f32x4*)(cb + 32 + 8 * g + 4 * hi);
#pragma unroll
            for (int i = 0; i < 4; ++i) { p0[4 * g + i] = c0[i]; p1[4 * g + i] = c1[i]; } }
    }
    __device__ __forceinline__ void mask(f32x16& p0, f32x16& p1, int hi) const {
        if (causal) {
            int d = qrel - krel0 - 4 * hi; asm volatile("" : "+v"(d));
#pragma unroll
            for (int r = 0; r < 16; ++r) { const int c = (r & 3) + 8 * (r >> 2); if (c > d) p0[r] = NEG_INF; if (c + 32 > d) p1[r] = NEG_INF; }
        }
    }
};

__device__ __forceinline__ int mlist_off(int j) { return 256 * (31 * j - (j * (j - 1)) / 2); }
#define INS3(s_, j_) do { const float s__ = (s_); const int j__ = (j_); \
    if (s__ > sv0 || (s__ == sv0 && j__ < sel0)) { sv2 = sv1; sel2 = sel1; sv1 = sv0; sel1 = sel0; sv0 = s__; sel0 = j__; } \
    else if (s__ > sv1 || (s__ == sv1 && j__ < sel1)) { sv2 = sv1; sel2 = sel1; sv1 = s__; sel1 = j__; } \
    else if (s__ > sv2 || (s__ == sv2 && j__ < sel2)) { sv2 = s__; sel2 = j__; } } while (0)
__device__ __forceinline__ void ph_select(const Ctx& C, const bf16* Q, const float* ksum, unsigned* mcnt, unsigned* mlist) {
    LAS float* km = (LAS float*)C.lds;
    LAS unsigned* lcnt = (LAS unsigned*)(C.lds + 8192);
    const int lane = C.lane, wave = C.wave, r32 = lane & 31, hi = lane >> 5;
    for (int u = C.vcu; u < BATCH * H * 31; u += C.G) {
        const int bh = u / 31, own = 1 + u % 31, b = bh >> 4, h = bh & 15;
        __syncthreads();
        for (int i = C.tid; i < 32 * 64; i += NTHR) km[i] = ksum[(size_t)(b * NBLK + (i >> 6)) * D + h * 64 + (i & 63)];
        if (C.tid < 64) lcnt[C.tid] = 0u;
        bf16x8 qr[4]; load_q(qr, Q + (size_t)(b * SEQ + own * 256 + wave * 32 + r32) * D + h * 64, hi);
        __syncthreads();
        f32x16 sc; { float z = 0.f; asm volatile("" : "+v"(z));
#pragma unroll
        for (int r = 0; r < 16; ++r) sc[r] = z; }
#pragma unroll
        for (int d0 = 0; d0 < 4; ++d0) {
            const f32x4 x0 = *(const LAS f32x4*)(km + r32 * 64 + 16 * d0 + 8 * hi), x1 = *(const LAS f32x4*)(km + r32 * 64 + 16 * d0 + 8 * hi + 4);
            v4u wh, wl; wh.x = cvtpk(x0.x, x0.y); wh.y = cvtpk(x0.z, x0.w); wh.z = cvtpk(x1.x, x1.y); wh.w = cvtpk(x1.z, x1.w);
            wl.x = cvtpk(x0.x - bflo(wh.x), x0.y - bfhi(wh.x)); wl.y = cvtpk(x0.z - bflo(wh.y), x0.w - bfhi(wh.y)); wl.z = cvtpk(x1.x - bflo(wh.z), x1.y - bfhi(wh.z)); wl.w = cvtpk(x1.z - bflo(wh.w), x1.w - bfhi(wh.w));
            sc = MFMA32(__builtin_bit_cast(bf16x8, wh), qr[d0], sc); sc = MFMA32(__builtin_bit_cast(bf16x8, wl), qr[d0], sc);
        }
        float sv0 = NEG_INF, sv1 = NEG_INF, sv2 = NEG_INF; int sel0 = 64, sel1 = 64, sel2 = 64;
#pragma unroll
        for (int r = 0; r < 16; ++r) { const int j = (r & 3) + 8 * (r >> 2) + 4 * hi; if (j < own) INS3(sc[r], j); }
        {
            const float pv0 = __shfl_xor(sv0, 32), pv1 = __shfl_xor(sv1, 32), pv2 = __shfl_xor(sv2, 32);
            const int p0 = __shfl_xor(sel0, 32), p1 = __shfl_xor(sel1, 32), p2 = __shfl_xor(sel2, 32);
            if (p0 < 64) INS3(pv0, p0);
            if (p1 < 64) INS3(pv1, p1);
            if (p2 < 64) INS3(pv2, p2); }
        const int nv = own < 3 ? own : 3; int rk0 = 0, rk1 = 0, rk2 = 0;
        if (hi == 0) {
            rk0 = (int)__hip_atomic_fetch_add(&lcnt[sel0], 1u, __ATOMIC_RELAXED, __HIP_MEMORY_SCOPE_WORKGROUP);
            if (nv > 1) rk1 = (int)__hip_atomic_fetch_add(&lcnt[sel1], 1u, __ATOMIC_RELAXED, __HIP_MEMORY_SCOPE_WORKGROUP);
            if (nv > 2) rk2 = (int)__hip_atomic_fetch_add(&lcnt[sel2], 1u, __ATOMIC_RELAXED, __HIP_MEMORY_SCOPE_WORKGROUP);
        }
        __syncthreads();
        if (C.tid < 32) { const unsigned c = lcnt[C.tid]; if (c) lcnt[32 + C.tid] = __hip_atomic_fetch_add(mcnt + bh * 32 + C.tid, c, __ATOMIC_RELAXED, __HIP_MEMORY_SCOPE_AGENT); }
        __syncthreads();
        if (hi == 0) {
            unsigned* lst = mlist + (size_t)bh * MLIST_PER_BH; const unsigned tl = (unsigned)(own * 256 + wave * 32 + r32);
            lst[mlist_off(sel0) + lcnt[32 + sel0] + rk0] = tl;
            if (nv > 1) lst[mlist_off(sel1) + lcnt[32 + sel1] + rk1] = tl | (1u << 16);
            if (nv > 2) lst[mlist_off(sel2) + lcnt[32 + sel2] + rk2] = tl | (2u << 16);
        }
    }
}
constexpr int RELB_OFF = 131072;
constexpr int PRE_OFF = 139264;
constexpr int UINFO_OFF = 147456;
static_assert(PRE_OFF + 2080 * 4 <= LDSCTL_OFF && UINFO_OFF + 64 <= LDSCTL_OFF && 4 * 33280 <= UINFO_OFF, "attention LDS map");

__device__ __forceinline__ int part_next(int u, int uw, int usb, int per) { const int k = (u - usb) % per; return (k + 1 < uw) ? u + 1 : u - k + per; }
__device__ __forceinline__ void ph_moba_part(const Ctx& C, const bf16* Q, const bf16* K, const bf16* V, const float* rel_bias, const unsigned* mcnt, const unsigned* mlist, bf16* parto, float* partml, const int uw, const int usb, const int per) {
    if (C.wave >= 4) __builtin_amdgcn_s_setprio(1);
    LAS float* relb = (LAS float*)(C.lds + RELB_OFF);
    LAS int* pre = (LAS int*)(C.lds + PRE_OFF);
    const int lane = C.lane, wave = C.wave, r32 = lane & 31, hi = lane >> 5;
    __syncthreads();
    build_relb(C, rel_bias, relb);
    {   int v[4], s = 0;
#pragma unroll
        for (int i = 0; i < 4; ++i) { v[i] = (int)((__hip_atomic_load(mcnt + 4 * C.tid + i, __ATOMIC_RELAXED, __HIP_MEMORY_SCOPE_AGENT) + 255u) >> 8); s += v[i]; }
        int inc = s;
#pragma unroll
        for (int o = 1; o < 64; o <<= 1) { const int t = __shfl_up(inc, o); if (lane >= o) inc += t; }
        if (lane == 63) pre[2056 + wave] = inc;
        __syncthreads();
        int base = 0; for (int w = 0; w < wave; ++w) base += pre[2056 + w];
        const int ex = base + inc - s;
        pre[4 * C.tid] = ex; pre[4 * C.tid + 1] = ex + v[0]; pre[4 * C.tid + 2] = ex + v[0] + v[1]; pre[4 * C.tid + 3] = ex + v[0] + v[1] + v[2];
        if (C.tid == NTHR - 1) pre[2048] = ex + s;
        __syncthreads();
    }
    const int total = pre[2048];
    int u = usb, cur = 0, idx = 0;
    if (u < total) {
        int lo = 0, hi_ = 2048;
#pragma unroll
        for (int s = 0; s < 11; ++s) { const int mid = (lo + hi_) >> 1; if (pre[mid] <= u) lo = mid; else hi_ = mid; }
        idx = lo;
        const int bh = idx >> 5, j = idx & 31, b = bh >> 4, h = bh & 15;
        const bf16* Kg = K + (size_t)(b * SEQ + j * 256) * D + h * 64; const bf16* Vg = V + (size_t)(b * SEQ + j * 256) * D + h * 64;
#pragma unroll
        for (int t4 = 0; t4 < 4; ++t4) dma_tile(Kg + (size_t)t4 * 64 * D, Vg + (size_t)t4 * 64 * D, C.lds + t4 * 8192, C.lds + 32768 + t4 * 8192, wave, lane);
    }
    unsigned ent = 0u, ent_n = 0u; bool valid = false, valid_n = false;
    if (u < total) { const int bh = idx >> 5, j = idx & 31, chunk = u - pre[idx]; const int n = (int)__hip_atomic_load(mcnt + idx, __ATOMIC_RELAXED, __HIP_MEMORY_SCOPE_AGENT);
        const int i = chunk * 256 + wave * 32 + r32; valid = i < n; ent = mlist[(size_t)bh * MLIST_PER_BH + mlist_off(j) + (valid ? i : chunk * 256)]; }
    while (u < total) {
        const int bh = idx >> 5, j = idx & 31, b = bh >> 4, h = bh & 15;
        const int tl = (int)(ent & 0xffffu), slot = (int)(ent >> 16);
        bf16x8 qr[4]; load_q(qr, Q + (size_t)(b * SEQ + tl) * D + h * 64, hi);
        LAS unsigned char* Ks = C.lds + cur * 65536; LAS unsigned char* Vs = Ks + 32768;
        VM_WAIT(); __syncthreads();
        const int un = u + per; int nidx = 0;
        if (un < total) {
            int lo = 0, hi_ = 2048;
#pragma unroll
            for (int s = 0; s < 11; ++s) { const int mid = (lo + hi_) >> 1; if (pre[mid] <= un) lo = mid; else hi_ = mid; }
            nidx = lo;
            const int nbh = nidx >> 5, nj = nidx & 31, nb = nbh >> 4, nh = nbh & 15;
            const bf16* Kg = K + (size_t)(nb * SEQ + nj * 256) * D + nh * 64; const bf16* Vg = V + (size_t)(nb * SEQ + nj * 256) * D + nh * 64;
            LAS unsigned char* Kn = C.lds + (cur ^ 1) * 65536;
#pragma unroll
            for (int t4 = 0; t4 < 4; ++t4) dma_tile(Kg + (size_t)t4 * 64 * D, Vg + (size_t)t4 * 64 * D, Kn + t4 * 8192, Kn + 32768 + t4 * 8192, wave, lane);
            const int nchunk = un - pre[nidx], nn = (int)__hip_atomic_load(mcnt + nidx, __ATOMIC_RELAXED, __HIP_MEMORY_SCOPE_AGENT), ni = nchunk * 256 + wave * 32 + r32;
            valid_n = ni < nn; ent_n = mlist[(size_t)nbh * MLIST_PER_BH + mlist_off(nj) + (valid_n ? ni : nchunk * 256)];
        }
        AttnAcc A;
        const bool lk = __any((tl - (j * 256 + 255)) < 128) != 0;
        MobaBias B{relb + h * 128, tl, j * 256, lk, false, relb[h * 128 + 127]};
        f32x16 a0, a1, b0, b1;
        acc_init(A); B.kpos0 = j * 256;
        if (__any(valid)) {
        qk_tile(a0, a1, qr, Ks, r32, hi, B);
#pragma unroll 1
        for (int tp = 0; tp < 4; tp += 2) {
            B.kpos0 = j * 256 + 64 * (tp + 1); attn_step(A, a0, a1, b0, b1, qr, Ks + (tp + 1) * 8192, Vs + tp * 8192, r32, hi, lane, B, true);
            B.kpos0 = j * 256 + 64 * (tp + 2); attn_step(A, b0, b1, a0, a1, qr, Ks + ((tp + 2) & 3) * 8192, Vs + (tp + 1) * 8192, r32, hi, lane, B, tp == 0);
        }
        }
        const float lt = A.la[0], inv = 1.f / lt;
        if (valid) {
            const size_t rowi = ((size_t)(b * SEQ + tl) * H + h) * 3 + slot;
            store_o(parto + rowi * 64, A, inv, hi);
            if (hi == 0) *(GAS f32x2*)(partml + rowi * 2) = (f32x2){A.m, lt};
        }
        u = un; idx = nidx; cur ^= 1; ent = ent_n; valid = valid_n;
    }
    __builtin_amdgcn_s_setprio(0);
}
__device__ __forceinline__ void ph_moba_own(const Ctx& C, const bf16* Q, const bf16* K, const bf16* V, const float* rel_bias, const bf16* parto, const float* partml, unsigned char* O) {
    if (C.wave >= 4) __builtin_amdgcn_s_setprio(1);
    LAS float* relb = (LAS float*)(C.lds + RELB_OFF);
    const int lane = C.lane, wave = C.wave, r32 = lane & 31, hi = lane >> 5;
    __syncthreads();
    build_relb(C, rel_bias, relb);
    constexpr int NU = BATCH * H * NBLK;
    int u = C.vcu, cur = 0;
    if (u < NU) {
        const int bh = u >> 5, own = u & 31, b = bh >> 4, h = bh & 15;
        const bf16* Kg = K + (size_t)(b * SEQ + own * 256) * D + h * 64; const bf16* Vg = V + (size_t)(b * SEQ + own * 256) * D + h * 64;
#pragma unroll
        for (int t4 = 0; t4 < 4; ++t4) dma_tile(Kg + (size_t)t4 * 64 * D, Vg + (size_t)t4 * 64 * D, C.lds + t4 * 8192, C.lds + 32768 + t4 * 8192, wave, lane);
    }
    while (u < NU) {
        const int bh = u >> 5, own = u & 31, b = bh >> 4, h = bh & 15;
        const int qblk = wave < 4 ? wave : 11 - wave;
        const int tl = own * 256 + qblk * 32 + r32;
        bf16x8 qr[4]; load_q(qr, Q + (size_t)(b * SEQ + tl) * D + h * 64, hi);
        const int nv = own < 3 ? own : 3;
        const size_t rowi = ((size_t)(b * SEQ + tl) * H + h) * 3;
        LAS unsigned char* Ks = C.lds + cur * 65536; LAS unsigned char* Vs = Ks + 32768;
        VM_WAIT(); __syncthreads();
        const int un = u + C.G;
        if (un < NU) {
            const int nbh = un >> 5, nown = un & 31, nb = nbh >> 4, nh = nbh & 15;
            const bf16* Kg = K + (size_t)(nb * SEQ + nown * 256) * D + nh * 64; const bf16* Vg = V + (size_t)(nb * SEQ + nown * 256) * D + nh * 64;
            LAS unsigned char* Kn = C.lds + (cur ^ 1) * 65536;
#pragma unroll
            for (int t4 = 0; t4 < 4; ++t4) dma_tile(Kg + (size_t)t4 * 64 * D, Vg + (size_t)t4 * 64 * D, Kn + t4 * 8192, Kn + 32768 + t4 * 8192, wave, lane);
        }
        AttnAcc A; acc_init(A);
        const int tlast = qblk >> 1;
        MobaBias B{relb + h * 128, tl, own * 256, true, tlast == 0, 0.f};
        f32x16 a0, a1, b0, b1;
        qk_tile(a0, a1, qr, Ks, r32, hi, B);
#pragma unroll 1
        for (int tp = 0; tp < 4; tp += 2) {
            if (tp <= tlast) { B.kpos0 = own * 256 + 64 * (tp + 1); B.causal = (tp + 1 == tlast); attn_step(A, a0, a1, b0, b1, qr, Ks + (tp + 1) * 8192, Vs + tp * 8192, r32, hi, lane, B, tp + 1 <= tlast); }
            if (tp + 1 <= tlast) { B.kpos0 = own * 256 + 64 * (tp + 2); B.causal = (tp + 2 == tlast); attn_step(A, b0, b1, a0, a1, qr, Ks + ((tp + 2) & 3) * 8192, Vs + (tp + 1) * 8192, r32, hi, lane, B, tp + 2 <= tlast); }
        }
        const float lt = A.la[0];
        float mi[3], li[3];
#pragma unroll
        for (int i = 0; i < 3; ++i) { mi[i] = NEG_INF; li[i] = 0.f; if (i < nv) { const f32x2 ml = *(const GAS f32x2*)(partml + (rowi + i) * 2); mi[i] = ml.x; li[i] = ml.y; } }
        float M = A.m;
#pragma unroll
        for (int i = 0; i < 3; ++i) M = fmaxf(M, mi[i]);
        const float w0 = __builtin_amdgcn_exp2f(A.m - M); float den = w0 * lt;
#pragma unroll
        for (int r = 0; r < 16; ++r) { A.o0[r] *= w0; A.o1[r] *= w0; }
#pragma unroll
        for (int i = 0; i < 3; ++i) if (i < nv) {
            const float wi = li[i] * __builtin_amdgcn_exp2f(mi[i] - M); den += wi;
            const bf16* po = parto + (rowi + i) * 64;
#pragma unroll
            for (int g = 0; g < 4; ++g) { const u32x2 a = *(const GAS u32x2*)(po + 8 * g + 4 * hi), c = *(const GAS u32x2*)(po + 32 + 8 * g + 4 * hi);
                A.o0[4 * g] += wi * bflo(a.x); A.o0[4 * g + 1] += wi * bfhi(a.x); A.o0[4 * g + 2] += wi * bflo(a.y); A.o0[4 * g + 3] += wi * bfhi(a.y);
                A.o1[4 * g] += wi * bflo(c.x); A.o1[4 * g + 1] += wi * bfhi(c.x); A.o1[4 * g + 2] += wi * bflo(c.y); A.o1[4 * g + 3] += wi * bfhi(c.y); }
        }
        store_o8(O + (size_t)(b * SEQ + tl) * D + h * 64, A, 1.f / den, hi);
        u = un; cur ^= 1;
    }
    __builtin_amdgcn_s_setprio(0);
}

__device__ __forceinline__ void ph_scan(const Ctx& C, const float* logf, float* ncum) {
    LAS float* wt = (LAS float*)C.lds;
    for (int bh = C.vcu; bh < BATCH * H; bh += C.G) {
        const int b = bh >> 4, h = bh & 15;
        float v[16], s = 0.f;
#pragma unroll
        for (int i = 0; i < 16; ++i) { v[i] = logf[(size_t)(b * SEQ + C.tid * 16 + i) * H + h]; s += v[i]; }
        float inc = s;
#pragma unroll
        for (int o = 1; o < 64; o <<= 1) { const float t = __shfl_up(inc, o); if (C.lane >= o) inc += t; }
        __syncthreads();
        if (C.lane == 63) wt[C.wave] = inc;
        __syncthreads();
        float run = inc - s; for (int w = 0; w < C.wave; ++w) run += wt[w];
#pragma unroll
        for (int i = 0; i < 16; ++i) { run += v[i]; ncum[(size_t)bh * SEQ + C.tid * 16 + i] = -run * LOG2E; }
    }
}
__device__ __forceinline__ void ph_fox(const Ctx& C, const bf16* Q, const bf16* K, const bf16* V, const float* ncum, const unsigned* norms, unsigned char* O, unsigned* qctr) {
    if (C.wave >= 4) __builtin_amdgcn_s_setprio(1);
    constexpr int GB = 33280;
    LAS int* uinfo = (LAS int*)(C.lds + UINFO_OFF);
    const int lane = C.lane, wave = C.wave, r32 = lane & 31, hi = lane >> 5;
    for (;;) {
        __syncthreads();
        if (C.tid == 0) { uinfo[0] = (int)__hip_atomic_fetch_add(qctr, 1u, __ATOMIC_RELAXED, __HIP_MEMORY_SCOPE_AGENT); uinfo[1] = 0; uinfo[2] = 0; uinfo[3] = -1; }
        __syncthreads();
        const int idx = uinfo[0];
        if (idx >= BATCH * H * NBLK) break;
        const int qb = 31 - (idx >> 6), bh = idx & 63, b = bh >> 4, h = bh & 15, NT = 4 * (qb + 1);
        const float* ng = ncum + (size_t)bh * SEQ; const float nref = ng[qb * 256];
        const int qblk = wave < 4 ? wave : 11 - wave;
        const int qrel = qblk * 32 + r32;
        bf16x8 qr[4]; load_q(qr, Q + (size_t)(b * SEQ + qb * 256 + qrel) * D + h * 64, hi);
        {   float q2 = 0.f;
#pragma unroll
            for (int d0 = 0; d0 < 4; ++d0)
#pragma unroll
                for (int i = 0; i < 8; ++i) { const float x = bf2f((unsigned)(unsigned short)qr[d0][i]); q2 += x * x; }
            q2 += __shfl_xor(q2, 32);
#pragma unroll
            for (int o = 1; o < 32; o <<= 1) q2 = fmaxf(q2, __shfl_xor(q2, o));
            if (lane == 0) (void)__hip_atomic_fetch_max((LAS unsigned*)&uinfo[2], __float_as_uint(q2), __ATOMIC_RELAXED, __HIP_MEMORY_SCOPE_WORKGROUP);
            bf16x8 kr[4]; load_q(kr, K + (size_t)(b * SEQ + qb * 256 + qrel) * D + h * 64, hi);
            float sq = 0.f;
#pragma unroll
            for (int d0 = 0; d0 < 4; ++d0)
#pragma unroll
                for (int i = 0; i < 8; ++i) sq += bf2f((unsigned)(unsigned short)qr[d0][i]) * bf2f((unsigned)(unsigned short)kr[d0][i]);
            sq += __shfl_xor(sq, 32);
#pragma unroll
            for (int o = 1; o < 32; o <<= 1) sq = fminf(sq, __shfl_xor(sq, o));
            if (lane == 0) (void)__hip_atomic_fetch_min((LAS unsigned*)&uinfo[3], sort_key(sq), __ATOMIC_RELAXED, __HIP_MEMORY_SCOPE_WORKGROUP); }
        __syncthreads();
        {   const float qn2 = __uint_as_float((unsigned)uinfo[2]), qa = __uint_as_float(norms[bh * 4 + 0]), qb2 = __uint_as_float(norms[bh * 4 + 1]), ka = __uint_as_float(norms[bh * 4 + 2]), kb2 = __uint_as_float(norms[bh * 4 + 3]);
            const unsigned mk = (unsigned)uinfo[3]; const float smin = __uint_as_float((mk & 0x80000000u) ? (mk ^ 0x80000000u) : ~mk) - 0.05f;
            const float smax = sqrtf(fminf(qn2, qa + qb2)) * sqrtf(ka + kb2) * 1.02f;
            const float thr = smax - fmaxf(smin, -smax) + 40.f;
            if (C.tid < 128) { const bool skip = (C.tid < NT) && (ng[(C.tid < NT ? C.tid : 0) * 64 + 63] - nref < -thr); const int c = __popcll(__ballot(skip)); if (lane == 0 && c) (void)__hip_atomic_fetch_add(&uinfo[1], c, __ATOMIC_RELAXED, __HIP_MEMORY_SCOPE_WORKGROUP); } }
        __syncthreads();
        const int t0 = uinfo[1], tf = t0 & ~1, g0 = t0 >> 1, NG = NT >> 1, tmax = 4 * qb + (qblk >> 1);
        const bf16* Kg = K + (size_t)(b * SEQ) * D + h * 64; const bf16* Vg = V + (size_t)(b * SEQ) * D + h * 64;
#define FOX_DMA(g) do { LAS unsigned char* sb_ = C.lds + ((g) & 3) * GB; \
            dma_tile(Kg + (size_t)(2 * (g)) * 64 * D, Vg + (size_t)(2 * (g)) * 64 * D, sb_, sb_ + 16384, wave, lane); \
            dma_tile(Kg + (size_t)(2 * (g) + 1) * 64 * D, Vg + (size_t)(2 * (g) + 1) * 64 * D, sb_ + 8192, sb_ + 24576, wave, lane); \
            if (wave < 2) glds4(ng + (2 * (g) + wave) * 64 + lane, lds_addr(sb_ + 32768 + wave * 256)); } while (0)
        FOX_DMA(g0);
        if (g0 + 1 < NG) FOX_DMA(g0 + 1);
        VM_WAIT(); __syncthreads();
        AttnAcc A; acc_init(A);
        f32x16 a0, a1, b0, b1; v4u wa[4], wb[4];
        FoxBias B{nullptr, qrel, 0, false};
#define FOX_SETB(t) do { const LAS unsigned char* sb_ = C.lds + (((t) >> 1) & 3) * GB; B.cb = (const LAS float*)(sb_ + 32768 + ((t) & 1) * 256); B.krel0 = (t) * 64 - qb * 256; B.causal = (t) >= 4 * qb; } while (0)
#define FOX_KS(t) (C.lds + (((t) >> 1) & 3) * GB + ((t) & 1) * 8192)
#define FOX_VS(t) (C.lds + (((t) >> 1) & 3) * GB + 16384 + ((t) & 1) * 8192)
#define FOX_STEP(C0, C1, N0, N1, WP, WN, t) do { FOX_SETB((t) + 1); \
            attn_step3(A, C0, C1, N0, N1, WP, WN, qr, FOX_KS((t) + 1), FOX_VS((t) > tf ? (t) - 1 : (t)), r32, hi, lane, B, (t) <= tmax); } while (0)
#pragma unroll
        for (int k_ = 0; k_ < 4; ++k_) { wa[k_] = (v4u){0u, 0u, 0u, 0u}; wb[k_] = (v4u){0u, 0u, 0u, 0u}; }
        if (tf <= tmax) { FOX_SETB(tf); qk_tile(a0, a1, qr, FOX_KS(tf), r32, hi, B); }
#pragma unroll 1
        for (int g = g0; g <= NG; ++g) {
            const int ta = 2 * g, tb = ta + 1;
            if (g + 2 < NG) FOX_DMA(g + 2);
            if (ta <= tmax + 1) FOX_STEP(a0, a1, b0, b1, wb, wa, ta);
            if (tb <= tmax + 1 && g < NG) FOX_STEP(b0, b1, a0, a1, wa, wb, tb);
            VM_WAIT(); __syncthreads();
        }
#undef FOX_DMA
#undef FOX_SETB
#undef FOX_KS
#undef FOX_VS
#undef FOX_STEP
        const float lt = A.la[0];
        store_o8(O + (size_t)(b * SEQ + qb * 256 + qrel) * D + h * 64, A, 1.f / lt, hi);
    }
    __builtin_amdgcn_s_setprio(0);
}
__device__ __forceinline__ void ln_stats(f32x4 (&v)[4], float& rstd) {
    float s = 0.f;
#pragma unroll
    for (int j = 0; j < 4; ++j) s += (v[j].x + v[j].y) + (v[j].z + v[j].w);
    const float mean = wave_sum(s) * (1.f / D); float s2 = 0.f;
#pragma unroll
    for (int j = 0; j < 4; ++j) { v[j] = v[j] - mean; s2 += (v[j].x * v[j].x + v[j].y * v[j].y) + (v[j].z * v[j].z + v[j].w * v[j].w); }
    rstd = 1.f / sqrtf(wave_sum(s2) * (1.f / D) + LN_EPS);
}
__device__ __forceinline__ void ph_ln1(const Ctx& C, const float* xin, const bf16* xin16, const bf16* y, const float* g, const float* bta, bf16* AR, unsigned char* xb8) {
    const int gw = C.vcu * NWAVES + C.wave, NGW = C.G * NWAVES, lane = C.lane;
    f32x4 gv[4], bv[4];
#pragma unroll
    for (int j = 0; j < 4; ++j) { gv[j] = *(const GAS f32x4*)(g + 4 * lane + 256 * j); bv[j] = *(const GAS f32x4*)(bta + 4 * lane + 256 * j); }
    u32x2 wn[4], zn16[4]; f32x4 zn32[4];
    {   const GAS u32x2* yr = (const GAS u32x2*)(y + (size_t)gw * D) + lane;
#pragma unroll
        for (int j = 0; j < 4; ++j) wn[j] = yr[64 * j];
        if (xin16) { const GAS u32x2* zr = (const GAS u32x2*)(xin16 + (size_t)gw * D) + lane;
#pragma unroll
            for (int j = 0; j < 4; ++j) zn16[j] = zr[64 * j];
        } else { const GAS f32x4* zr = (const GAS f32x4*)(xin + (size_t)gw * D) + lane;
#pragma unroll
            for (int j = 0; j < 4; ++j) zn32[j] = zr[64 * j]; } }
    for (int t = gw; t < T; t += NGW) {
        f32x4 v[4];
        const int tn = t + NGW < T ? t + NGW : t;
        const GAS u32x2* yr = (const GAS u32x2*)(y + (size_t)tn * D) + lane;
        if (xin16) { const GAS u32x2* zr = (const GAS u32x2*)(xin16 + (size_t)tn * D) + lane;
#pragma unroll
            for (int j = 0; j < 4; ++j) { const u32x2 w = wn[j], z = zn16[j]; v[j] = (f32x4){bflo(z.x), bfhi(z.x), bflo(z.y), bfhi(z.y)} * DN_ALPHA + (f32x4){bflo(w.x), bfhi(w.x), bflo(w.y), bfhi(w.y)}; }
#pragma unroll
            for (int j = 0; j < 4; ++j) { wn[j] = yr[64 * j]; zn16[j] = zr[64 * j]; }
        } else { const GAS f32x4* zr = (const GAS f32x4*)(xin + (size_t)tn * D) + lane;
#pragma unroll
            for (int j = 0; j < 4; ++j) { const u32x2 w = wn[j]; v[j] = zn32[j] * DN_ALPHA + (f32x4){bflo(w.x), bfhi(w.x), bflo(w.y), bfhi(w.y)}; }
#pragma unroll
            for (int j = 0; j < 4; ++j) { wn[j] = yr[64 * j]; zn32[j] = zr[64 * j]; } }
        float rstd; ln_stats(v, rstd);
#pragma unroll
        for (int j = 0; j < 4; ++j) {
            const f32x4 y = v[j] * rstd * gv[j] + bv[j]; const int d = 4 * lane + 256 * j;
            u32x2 hw; hw.x = cvtpk(y.x, y.y); hw.y = cvtpk(y.z, y.w);
            u32x2 lw; lw.x = cvtpk(y.x - bflo(hw.x), y.y - bfhi(hw.x)); lw.y = cvtpk(y.z - bflo(hw.y), y.w - bfhi(hw.y));
            *(GAS unsigned*)(xb8 + (size_t)t * D + d) = pk4_f8(y.x * XQ_SCALE, y.y * XQ_SCALE, y.z * XQ_SCALE, y.w * XQ_SCALE);
            *(GAS u32x2*)(AR + (size_t)t * 1536 + d) = hw;
            *(GAS u32x2*)(AR + (size_t)(T + t) * 1536 + 512 + d) = hw;
            if (j < 2) *(GAS u32x2*)(AR + (size_t)t * 1536 + 1024 + d) = lw; else *(GAS u32x2*)(AR + (size_t)(T + t) * 1536 + (d - 512)) = lw;
        }
    }
}
__device__ __forceinline__ int below(unsigned long long mask) { return (int)__builtin_amdgcn_mbcnt_hi((unsigned)(mask >> 32), __builtin_amdgcn_mbcnt_lo((unsigned)mask, 0u)); }
__device__ __forceinline__ void ph_route(const Ctx& C, const float* logp, const float* rbias, int* topi, float* gate, unsigned* ecnt) {
    LAS unsigned* hist = (LAS unsigned*)C.lds;
    const int gw = C.vcu * NWAVES + C.wave, NGW = C.G * NWAVES, lane = C.lane;
    __syncthreads();
    if (C.tid < NE) hist[C.tid] = 0u;
    __syncthreads();
    const f32x4 rb = *(const GAS f32x4*)(rbias + 4 * lane);
    f32x4 an = *(const GAS f32x4*)(logp + (size_t)gw * NE + 4 * lane), bn = *(const GAS f32x4*)(logp + (size_t)(T + gw) * NE + 4 * lane);
    for (int t = gw; t < T; t += NGW) {
        const f32x4 a = an, b2 = bn;
        { const int tn = t + NGW < T ? t + NGW : t; an = *(const GAS f32x4*)(logp + (size_t)tn * NE + 4 * lane); bn = *(const GAS f32x4*)(logp + (size_t)(T + tn) * NE + 4 * lane); }
        float s[4], c[4];
#pragma unroll
        for (int i = 0; i < 4; ++i) { const float lg = a[i] + b2[i]; s[i] = 1.f / (1.f + __builtin_amdgcn_exp2f(-lg * LOG2E)); c[i] = s[i] + rb[i]; }
        float m1 = fmaxf(c[0], c[1]), m2 = fminf(c[0], c[1]);
        { const float x = c[2]; const float n1 = fmaxf(m1, x); m2 = fmaxf(m2, fminf(m1, x)); m1 = n1; }
        { const float x = c[3]; const float n1 = fmaxf(m1, x); m2 = fmaxf(m2, fminf(m1, x)); m1 = n1; }
#pragma unroll
        for (int o = 1; o < 8; o <<= 1) { const float o1 = __shfl_xor(m1, o), o2 = __shfl_xor(m2, o); const float n1 = fmaxf(m1, o1), n2 = fmaxf(fminf(m1, o1), fmaxf(m2, o2)); m1 = n1; m2 = n2; }
        const float gs = m1 + m2; const int mygrp = lane >> 3; int rk = 0;
#pragma unroll
        for (int g2 = 0; g2 < NGRP; ++g2) { const float og = __uint_as_float((unsigned)__builtin_amdgcn_readlane((int)__float_as_uint(gs), 8 * g2)); rk += (og > gs || (og == gs && g2 < mygrp)) ? 1 : 0; }
        unsigned k[4];
#pragma unroll
        for (int i = 0; i < 4; ++i) k[i] = rk < 4 ? sort_key(c[i]) : 0u;
        unsigned thr = 0u;
#pragma unroll 1
        for (int b = 31; b >= 0; --b) {
            const unsigned cand = thr | (1u << b);
            const int cnt = __popcll(__ballot(k[0] >= cand)) + __popcll(__ballot(k[1] >= cand)) + __popcll(__ballot(k[2] >= cand)) + __popcll(__ballot(k[3] >= cand));
            if (cnt >= TOPK) thr = cand;
        }
        unsigned long long gm[4], em[4]; int ngt = 0;
#pragma unroll
        for (int i = 0; i < 4; ++i) { gm[i] = __ballot(k[i] > thr); em[i] = __ballot(k[i] == thr); ngt += __popcll(gm[i]); }
        const int need = TOPK - ngt;
        int eqb = below(em[0]) + below(em[1]) + below(em[2]) + below(em[3]);
        bool sel[4];
#pragma unroll
        for (int i = 0; i < 4; ++i) { const bool eq = k[i] == thr; sel[i] = (k[i] > thr) || (eq && eqb < need); eqb += eq ? 1 : 0; }
        unsigned long long sm[4]; float wpart = 0.f;
#pragma unroll
        for (int i = 0; i < 4; ++i) { sm[i] = __ballot(sel[i]); wpart += sel[i] ? s[i] : 0.f; }
        const float wsum = wave_sum(wpart);
        int pos = below(sm[0]) + below(sm[1]) + below(sm[2]) + below(sm[3]);
#pragma unroll
        for (int i = 0; i < 4; ++i) if (sel[i]) { gate[(size_t)t * TOPK + pos] = s[i] / wsum * ROUTED_SCALE;
            const unsigned rk = __hip_atomic_fetch_add(&hist[4 * lane + i], 1u, __ATOMIC_RELAXED, __HIP_MEMORY_SCOPE_WORKGROUP);
            topi[(size_t)t * TOPK + pos] = (4 * lane + i) | (int)(rk << 8); ++pos; }
    }
    __syncthreads();
    if (C.tid < NE) { const unsigned c = hist[C.tid]; hist[NE + C.tid] = c ? __hip_atomic_fetch_add(ecnt + C.tid, c, __ATOMIC_RELAXED, __HIP_MEMORY_SCOPE_AGENT) : 0u; }
}
__device__ __forceinline__ void ph_scatter(const Ctx& C, const unsigned* ecnt, unsigned* ecur, const int* topi, const float* gate, const bf16* xb, int* slotof, int* tokof, float* gslot, bf16* HS) {
    build_tpre(C, ecnt);
    const LAS int* tpre = (const LAS int*)(C.lds + TPRE_OFF);
    const LAS unsigned* wgbase = (const LAS unsigned*)C.lds + NE;
    const int gw = C.vcu * NWAVES + C.wave, NGW = C.G * NWAVES;
    for (int n = C.lane >> 3; gw + n * NGW < T; n += 8) {
        const int t = gw + n * NGW;
        { const int i = t * TOPK + (C.lane & 7); const int v = topi[i], e = v & 255, rk = v >> 8;
            const int slot = tpre[e] * 256 + (int)wgbase[e] + rk; tokof[slot] = t; gslot[slot] = gate[i] * GS_FOLD; slotof[i] = slot; }
    }
    for (int e = C.vcu; e < NE; e += C.G) {
        const int cnt = (int)__hip_atomic_load(ecnt + e, __ATOMIC_RELAXED, __HIP_MEMORY_SCOPE_AGENT), s0 = tpre[e] * 256 + cnt, s1 = tpre[e + 1] * 256;
        for (int s = s0 + C.tid; s < s1; s += NTHR) { gslot[s] = 0.f; tokof[s] = 0; }
    }
}
__device__ __forceinline__ float log_sigmoid(float z) {
    const float e = __builtin_amdgcn_exp2f(-fabsf(z) * LOG2E);
    const float l1p = e < 0.015625f ? e * (1.f - e * (0.5f - e * 0.33333334f)) : __builtin_amdgcn_logf(1.f + e) * 0.6931471805599453f;
    return fminf(z, 0.f) - l1p;
}
__device__ __forceinline__ void ph_combine(const Ctx& C, const bf16* x1hi, const unsigned char* SO, const int* slotof, const float* g, const float* bta, bf16* xres, unsigned char* xb8, float* dout,
                                           const float* fox_in, const float* fox_bf, float* logf) {
    const int gw = C.vcu * NWAVES + C.wave, NGW = C.G * NWAVES, lane = C.lane;
    LAS float* wfT = (LAS float*)C.lds;
    __syncthreads();
    if (logf) { for (int i = C.tid; i < D * H; i += NTHR) { const int d = i >> 4, h = i & 15; wfT[h * D + d] = fox_in[(size_t)d * FOXW + 3 * D + h]; } }
    __syncthreads();
    f32x4 gv[4], bv[4];
#pragma unroll
    for (int j = 0; j < 4; ++j) { gv[j] = *(const GAS f32x4*)(g + 4 * lane + 256 * j); bv[j] = *(const GAS f32x4*)(bta + 4 * lane + 256 * j); }
    int sl_n = lane < TOPK ? slotof[(size_t)gw * TOPK + lane] : 0;
    for (int t = gw; t < T; t += NGW) {
        const GAS u32x2* zr = (const GAS u32x2*)(x1hi + (size_t)t * 1536) + lane;
        f32x4 v[4];
#pragma unroll
        for (int j = 0; j < 4; ++j) { const u32x2 z = zr[64 * j]; v[j] = (f32x4){bflo(z.x), bfhi(z.x), bflo(z.y), bfhi(z.y)} * DN_ALPHA; }
        const int sl = sl_n; { const int tn = t + NGW < T ? t + NGW : t; sl_n = lane < TOPK ? slotof[(size_t)tn * TOPK + lane] : 0; }
        f32x4 rs[4];
#pragma unroll
        for (int j = 0; j < 4; ++j) rs[j] = (f32x4){0.f, 0.f, 0.f, 0.f};
#pragma unroll
        for (int k = 0; k < TOPK; ++k) { const int sk = __builtin_amdgcn_readlane(sl, k); const unsigned char* row = SO + (size_t)sk * D + 4 * lane;
#pragma unroll
            for (int j = 0; j < 4; ++j) { const unsigned w = *(const GAS unsigned*)(row + 256 * j); const f32x2 lo2 = __builtin_amdgcn_cvt_pk_f32_fp8(w, false), hi2 = __builtin_amdgcn_cvt_pk_f32_fp8(w, true);
                rs[j].x += lo2.x; rs[j].y += lo2.y; rs[j].z += hi2.x; rs[j].w += hi2.y; } }
        {   const unsigned char* row = SO + (size_t)(NSLOT_MAX + t) * D + 4 * lane;
#pragma unroll
            for (int j = 0; j < 4; ++j) { const unsigned w = *(const GAS unsigned*)(row + 256 * j); const f32x2 lo2 = __builtin_amdgcn_cvt_pk_f32_fp8(w, false), hi2 = __builtin_amdgcn_cvt_pk_f32_fp8(w, true);
                rs[j].x += lo2.x; rs[j].y += lo2.y; rs[j].z += hi2.x; rs[j].w += hi2.y; } }
#pragma unroll
        for (int j = 0; j < 4; ++j) v[j] = v[j] + rs[j] * SO_INV;
        float rstd; ln_stats(v, rstd);
        f32x4 y[4];
#pragma unroll
        for (int j = 0; j < 4; ++j) {
            y[j] = v[j] * rstd * gv[j] + bv[j]; const int d = 4 * lane + 256 * j;
            if (dout) *(GAS f32x4*)(dout + (size_t)t * D + d) = y[j];
            else { u32x2 hw; hw.x = cvtpk(y[j].x, y[j].y); hw.y = cvtpk(y[j].z, y[j].w); *(GAS u32x2*)(xres + (size_t)t * D + d) = hw;
                *(GAS unsigned*)(xb8 + (size_t)t * D + d) = pk4_f8(y[j].x * XQ_SCALE, y[j].y * XQ_SCALE, y[j].z * XQ_SCALE, y[j].w * XQ_SCALE); }
        }
        if (logf) {
            float acc[16];
#pragma unroll
            for (int h = 0; h < 16; ++h) { float a = 0.f;
#pragma unroll
                for (int j = 0; j < 4; ++j) { const f32x4 w = *(const LAS f32x4*)(wfT + h * D + 4 * lane + 256 * j); a += y[j].x * w.x; a += y[j].y * w.y; a += y[j].z * w.z; a += y[j].w * w.w; }
                acc[h] = a; }
            float a8[8], a4[4], a2[2], a1;
            { const bool bit = (lane >> 5) & 1;
#pragma unroll
              for (int i = 0; i < 8; ++i) { const float send = bit ? acc[i] : acc[i + 8]; const float recv = __shfl_xor(send, 32); a8[i] = (bit ? acc[i + 8] : acc[i]) + recv; } }
            { const bool bit = (lane >> 4) & 1;
#pragma unroll
              for (int i = 0; i < 4; ++i) { const float send = bit ? a8[i] : a8[i + 4]; const float recv = __shfl_xor(send, 16); a4[i] = (bit ? a8[i + 4] : a8[i]) + recv; } }
            { const bool bit = (lane >> 3) & 1;
#pragma unroll
              for (int i = 0; i < 2; ++i) { const float send = bit ? a4[i] : a4[i + 2]; const float recv = __shfl_xor(send, 8); a2[i] = (bit ? a4[i + 2] : a4[i]) + recv; } }
            { const bool bit = (lane >> 2) & 1; const float send = bit ? a2[0] : a2[1]; const float recv = __shfl_xor(send, 4); a1 = (bit ? a2[1] : a2[0]) + recv; }
            a1 += __shfl_xor(a1, 2); a1 += __shfl_xor(a1, 1);
            const int hh = ((lane >> 5) & 1) * 8 + ((lane >> 4) & 1) * 4 + ((lane >> 3) & 1) * 2 + ((lane >> 2) & 1);
            if ((lane & 3) == 0) logf[(size_t)t * H + hh] = log_sigmoid(a1 + fox_bf[hh]);
        }
    }
}
#ifndef MK_MULTI
#define MK_MULTI 0
#endif
constexpr int NPH = 27;
struct Args { const float* in[19]; float* out; unsigned char* ws; int ph_lo, ph_hi; };

__global__ void __launch_bounds__(NTHR, 2) mk_fwd(Args args) {
    extern __shared__ __attribute__((aligned(16))) unsigned char lds_raw[];
    Ctx C;
    C.lds = (LAS unsigned char*)lds_raw;
    C.tid = threadIdx.x; C.lane = C.tid & 63; C.wave = __builtin_amdgcn_readfirstlane(C.tid >> 6);
    C.G = gridDim.x; { const int bx = blockIdx.x; C.vcu = (C.G % 8 == 0) ? (bx % 8) * (C.G / 8) + bx / 8 : bx; }
    LAS unsigned long long* PTAB = (LAS unsigned long long*)(C.lds + PTAB_OFF);
    if (C.tid == 0) {
#pragma unroll
        for (int i = 0; i < 19; ++i) PTAB[i] = (unsigned long long)(uintptr_t)args.in[i];
        PTAB[19] = (unsigned long long)(uintptr_t)args.out; PTAB[20] = (unsigned long long)(uintptr_t)args.ws;
    }
    for (int u = C.tid; u < (PTAB_OFF - LDSCTL_OFF) / 4; u += NTHR) ((LAS unsigned*)(C.lds + LDSCTL_OFF))[u] = 0u;
    __syncthreads();
#define PIN(i) ((const float*)ldptr(PTAB, (i)))
#define WSP() ((unsigned char*)ldptr(PTAB, 20))
    XcdBarrier bar; bar.bar = (unsigned*)(args.ws + WS_CTL) + CW_BAR; bar.x = 0; bar.st = nullptr;
    if (!MK_MULTI) bar = xcd_barrier_post((unsigned*)(args.ws + WS_CTL) + CW_BAR, (volatile LAS unsigned*)(C.lds + MISC_OFF) + 8);
    const int lo = args.ph_lo, hi = args.ph_hi;
#ifndef MK_PH_MASK
#define MK_PH_MASK 0xFFFFFFFFu
#endif
#define PHON(b) (((MK_PH_MASK) >> (b)) & 1u)
#ifndef MK_DUP_MASK
#define MK_DUP_MASK 0u
#endif
#define NREP(b) ((((MK_DUP_MASK) >> (b)) & 1u) ? 2 : 1)
#define REP(b) _Pragma("unroll 1") for (int rep_ = 0; rep_ < NREP(b); ++rep_)
#define IN(k) (lo <= (k) && (k) < hi)
#define SEAM(k) do { if ((k) + 1 < hi) { asm volatile("" : "+s"(bar.bar)); xcd_barrier(bar); if (NREP(23) == 2) xcd_barrier(bar); } } while (0)
#define OPAQ(v) asm volatile("" : "+s"(v))
#define LC() do { int l_; asm volatile("v_mbcnt_lo_u32_b32 %0, -1, 0\n\tv_mbcnt_hi_u32_b32 %0, -1, %0" : "=v"(l_)); C.lane = l_; C.tid = C.wave * 64 + l_; } while (0)

    if (PHON(0) && IN(0)) { LC();
        unsigned char* ws = WSP();
        SmallW W{PIN(2), PIN(3), PIN(4), PIN(6), PIN(11), PIN(16), PIN(17), PIN(18),
                 ws + WS_WMI, ws + WS_WFI, ws + WS_WMO, ws + WS_WFO, ws + WS_WSGU, ws + WS_WSDN, (bf16*)(ws + WS_WR)};
        REP(21) conv_small(C, W);
        REP(22) to_f8_rows(C, PIN(0), ws + WS_XB8);
        __syncthreads();
        REP(0) conv_experts(C, PIN(13), PIN(14), PIN(15), 0, ws + WS_WEGU, ws + WS_WEDN, C.vcu, C.G);
        SEAM(0);
    }
#pragma unroll 1
    for (int l = 0; l < 2; ++l) {
        const int pb = 1 + 13 * l;
        if (PHON(1) && IN(pb + 0)) { LC();
            unsigned char* ws = WSP();
            if (PHON(15) && l == 1) ph_scan(C, (const float*)(ws + WS_LOGF), (float*)(ws + WS_CUM));
            REP(1) {
            __syncthreads();
            int kk = D / 2; OPAQ(kk);
            pg8::Gemm g{(const bf16*)(ws + WS_XB8), (const bf16*)(ws + (l == 0 ? WS_WMI : WS_WFI)), T, 3 * D, kk}; pg8::StaticOrder S; S.init(T, 3 * D, C.G, (int)blockIdx.x);
            EpiQKV E{(bf16*)(ws + WS_Q), (size_t)(WS_K - WS_Q) / 2, C2, (unsigned*)(ws + WS_CTL) + CW_NORM + l * 256, l == 0 ? (float*)(ws + WS_CTL) + CW_KSUM : nullptr};
            pg8::gemm_phase<EpiQKV, pg8::StaticOrder, true, true, false, true>(C.lds, g, S, E, C.tid);
            }
            SEAM(pb + 0);
        }
        if (l == 0) {
            if (PHON(3) && IN(pb + 2)) { LC(); unsigned char* ws = WSP(); REP(3) ph_select(C, (const bf16*)(ws + WS_Q), (const float*)(ws + WS_CTL) + CW_KSUM, (unsigned*)(ws + WS_CTL) + (rep_ ? 133120 : CW_MCNT), (unsigned*)(ws + (rep_ ? WS_PARTO : WS_MLIST))); SEAM(pb + 2); }
            if (PHON(4) && IN(pb + 3)) { LC(); unsigned char* ws = WSP();
                const int uw = 1, usb = C.vcu, per = C.G;
                REP(4) ph_moba_part(C, (const bf16*)(ws + WS_Q), (const bf16*)(ws + WS_K), (const bf16*)(ws + WS_V), PIN(1), (const unsigned*)(ws + WS_CTL) + CW_MCNT, (const unsigned*)(ws + WS_MLIST), (bf16*)(ws + WS_PARTO), (float*)(ws + WS_PARTML), uw, usb, per); SEAM(pb + 3); }
            if (PHON(5) && IN(pb + 4)) { LC(); unsigned char* ws = WSP(); REP(5) ph_moba_own(C, (const bf16*)(ws + WS_Q), (const bf16*)(ws + WS_K), (const bf16*)(ws + WS_V), PIN(1), (const bf16*)(ws + WS_PARTO), (const float*)(ws + WS_PARTML), ws + WS_O); SEAM(pb + 4); }
        } else {
            if (PHON(6) && IN(pb + 4)) { LC(); unsigned char* ws = WSP();
                REP(6) ph_fox(C, (const bf16*)(ws + WS_Q), (const bf16*)(ws + WS_K), (const bf16*)(ws + WS_V), (const float*)(ws + WS_CUM), (const unsigned*)(ws + WS_CTL) + CW_NORM + 256, ws + WS_O, (unsigned*)(ws + WS_CTL) + CW_FOXQ + rep_ * 64); SEAM(pb + 4); }
        }
        if (PHON(7) && IN(pb + 5)) { LC();
            unsigned char* ws = WSP();
            REP(7) {
            __syncthreads();
            int kk = D / 2; OPAQ(kk);
            pg8::Gemm g{(const bf16*)(ws + WS_O), (const bf16*)(ws + (l == 0 ? WS_WMO : WS_WFO)), T, D, kk}; PlainOrder<4> S{C.vcu, C.G, (T / 256) * 4};
            pg8::EpiBf16<0> E{(bf16*)(ws + WS_Z), D, nullptr, D, 0, 1.f / (OQ_SCALE * WQ_SCALE)};
            pg8::gemm_phase<pg8::EpiBf16<0>, PlainOrder<4>, true, true, false, true>(C.lds, g, S, E, C.tid);
            }
            SEAM(pb + 5);
        }
        if (PHON(8) && IN(pb + 6)) { LC(); unsigned char* ws = WSP(); REP(8) ph_ln1(C, PIN(0), l == 0 ? nullptr : (const bf16*)(ws + WS_XRES), (const bf16*)(ws + WS_Z), PIN(7) + l * D, PIN(8) + l * D, (bf16*)(ws + WS_AR), ws + WS_XB8); SEAM(pb + 6); }
        if (PHON(9) && IN(pb + 7)) { LC();
            __syncthreads();
            REP(16) if (PHON(16)) { __syncthreads(); unsigned char* ws = WSP(); int kk = 1536; OPAQ(kk);
              pg8::Gemm g{(const bf16*)(ws + WS_AR), (const bf16*)(ws + WS_WR) + (size_t)l * (512 * 1536), 2 * T, 512, kk}; RouterOrder S{C.vcu, C.G}; EpiF32<true> E{(float*)(ws + WS_LOGP), nullptr, NE, 0.f};
              pg8::gemm_phase<EpiF32<true>, RouterOrder, true, true>(C.lds, g, S, E, C.tid); }
            __syncthreads();
            REP(17) if (PHON(17)) { __syncthreads(); unsigned char* ws = WSP(); int kk = D / 2; OPAQ(kk);
              pg8::Gemm g{(const bf16*)(ws + WS_XB8), (const bf16*)(ws + WS_WSGU + (size_t)l * (512 * 1024)), T, 512, kk}; PlainOrder<2> S{C.vcu, C.G, (T / 256) * 2}; EpiSwiGLU<true> E{ws + WS_ACTSH, nullptr};
              pg8::gemm_phase<EpiSwiGLU<true>, PlainOrder<2>, true, true, false, true>(C.lds, g, S, E, C.tid); }
            SEAM(pb + 7);
        }
        if (PHON(10) && IN(pb + 8)) { LC(); unsigned char* ws = WSP(); REP(10) ph_route(C, (const float*)(ws + WS_LOGP), PIN(12) + l * NE, (int*)(ws + WS_TOPI), (float*)(ws + WS_GATE), (unsigned*)(ws + WS_CTL) + (rep_ ? 131072 : CW_ECNT) + l * NE); SEAM(pb + 8); }
        if (PHON(11) && IN(pb + 9)) { LC(); unsigned char* ws = WSP(); REP(11) { if (rep_) xcd_barrier(bar); ph_scatter(C, (const unsigned*)(ws + WS_CTL) + CW_ECNT + l * NE, (unsigned*)(ws + WS_CTL) + (rep_ ? 132096 : CW_ECUR) + l * NE, (const int*)(ws + WS_TOPI), (const float*)(ws + WS_GATE), (const bf16*)(ws + WS_XB8),
                                                                            (int*)(ws + WS_SLOTOF), (int*)(ws + WS_TOKOF), (float*)(ws + WS_GSLOT), (bf16*)(ws + WS_HS)); } SEAM(pb + 9); }
        if (PHON(12) && IN(pb + 10)) { LC();
            unsigned char* ws = WSP();
            build_tpre(C, (const unsigned*)(ws + WS_CTL) + CW_ECNT + l * NE);
            REP(12) {
            __syncthreads();
            int kk = D / 2; OPAQ(kk);
            pg8::Gemm g{(const bf16*)(ws + WS_XB8), (const bf16*)(ws + WS_WEGU), NSLOT_MAX, NE * 512, kk, (const int*)(ws + WS_TOKOF)}; ExpertOrder<1> S{C.vcu, C.G, (const LAS int*)(C.lds + TPRE_OFF)}; EpiSwiGLU<true> E{ws + WS_ACT, (const float*)(ws + WS_GSLOT)};
            pg8::gemm_phase<EpiSwiGLU<true>, ExpertOrder<1>, true, true, true, true>(C.lds, g, S, E, C.tid);
            }
            SEAM(pb + 10);
        }
        if (PHON(13) && IN(pb + 11)) { LC();
            { unsigned char* ws = WSP(); build_tpre(C, (const unsigned*)(ws + WS_CTL) + CW_ECNT + l * NE); }
            REP(18) if (PHON(18)) { __syncthreads(); unsigned char* ws = WSP(); int kk = DE / 2; OPAQ(kk);
              pg8::Gemm g{(const bf16*)(ws + WS_ACT), (const bf16*)(ws + WS_WEDN), NSLOT_MAX, NE * 1024, kk}; ExpertOrder<2> S{C.vcu, C.G, (const LAS int*)(C.lds + TPRE_OFF)}; EpiDown<true> E{(unsigned char*)(ws + WS_HS)};
              pg8::gemm_phase<EpiDown<true>, ExpertOrder<2>, true, true, false, true>(C.lds, g, S, E, C.tid); }
            __syncthreads();
            REP(19) if (PHON(19)) { __syncthreads(); unsigned char* ws = WSP(); int kk = DE / 2; OPAQ(kk);
              pg8::Gemm g{(const bf16*)(ws + WS_ACTSH), (const bf16*)(ws + WS_WSDN + (size_t)l * (1024 * 256)), T, D, kk}; PlainOrder<4> S{C.vcu, C.G, (T / 256) * 4}; EpiDown<true> E{(unsigned char*)(ws + WS_HS) + (size_t)NSLOT_MAX * 1024};
              pg8::gemm_phase<EpiDown<true>, PlainOrder<4>, true, true, false, true>(C.lds, g, S, E, C.tid); }
            SEAM(pb + 11);
        }
        if (PHON(14) && IN(pb + 12)) { LC();
            REP(14) { unsigned char* ws = WSP();
              ph_combine(C, (const bf16*)(ws + WS_AR), (const unsigned char*)(ws + WS_HS), (const int*)(ws + WS_SLOTOF), PIN(9) + l * D, PIN(10) + l * D, (bf16*)(ws + WS_XRES), ws + WS_XB8, l == 1 ? (float*)ldptr(PTAB, 19) : nullptr,
                         PIN(4), PIN(5), l == 0 ? (float*)(ws + WS_LOGF) : nullptr); }
            if (l == 0) { unsigned char* ws = WSP(); __syncthreads(); conv_experts(C, PIN(13), PIN(14), PIN(15), 1, ws + WS_WEGU, ws + WS_WEDN, C.vcu, C.G); }
            SEAM(pb + 12);
        }
    }
#undef IN
#undef SEAM
#undef PIN
#undef WSP
#undef OPAQ
#undef REP
#undef NREP
}
}

extern "C" void kernel_launch(void* const* d_in, const int* in_sizes, int n_in, void* d_out, int out_size, void* d_ws, size_t ws_size, hipStream_t stream) {
    using namespace mk;
    static int grid = 0;
    if (grid == 0) {
        if (n_in != 19 || in_sizes[0] != T * D || out_size != T * D || ws_size < WS_END) { fprintf(stderr, "kernel_launch: unexpected problem shape (n_in %d, in0 %d, out %d, ws %zu < %zu)\n", n_in, n_in > 0 ? in_sizes[0] : -1, out_size, ws_size, (size_t)WS_END); grid = -1; return; }
        int dev = 0, cus = 0, per_cu = 0;
        if (hipGetDevice(&dev) != hipSuccess || hipDeviceGetAttribute(&cus, hipDeviceAttributeMultiprocessorCount, dev) != hipSuccess) { grid = -1; return; }
        if (hipFuncSetAttribute((const void*)mk_fwd, hipFuncAttributeMaxDynamicSharedMemorySize, LDS_BYTES) != hipSuccess) { fprintf(stderr, "kernel_launch: hipFuncSetAttribute failed\n"); grid = -1; return; }
        if (hipOccupancyMaxActiveBlocksPerMultiprocessor(&per_cu, (const void*)mk_fwd, NTHR, LDS_BYTES) != hipSuccess || per_cu < 1) fprintf(stderr, "kernel_launch: occupancy query reports %d\n", per_cu);
        (void)hipGetLastError();
        grid = cus;
    }
    if (grid < 0) return;
    if (hipMemsetAsync((char*)d_ws + WS_CTL, 0, CTL_ZERO_BYTES, stream) != hipSuccess) return;
    Args a{};
    for (int i = 0; i < 19; ++i) a.in[i] = (const float*)d_in[i];
    a.out = (float*)d_out; a.ws = (unsigned char*)d_ws;
#if MK_MULTI
    for (int p = 0; p < NPH; ++p) {
        if (p == 2 || (p >= 15 && p <= 17)) continue;
        a.ph_lo = p; a.ph_hi = p + 1;
        hipLaunchKernelGGL(mk_fwd, dim3(grid), dim3(NTHR), LDS_BYTES, stream, a);
    }
#else
    a.ph_lo = 0; a.ph_hi = NPH;
    hipLaunchKernelGGL(mk_fwd, dim3(grid), dim3(NTHR), LDS_BYTES, stream, a);
#endif
    const hipError_t le = hipPeekAtLastError();
    if (le != hipSuccess) fprintf(stderr, "kernel_launch: launch failed: %s\n", hipGetErrorName(le));
}
```

```cpp
#include <hip/hip_runtime.h>
#include <cstdio>
#include <cstdint>
namespace pg8 {
#define PG8_LAS __attribute__((address_space(3)))
typedef unsigned short bf16_t;
typedef short bf16x8 __attribute__((ext_vector_type(8)));
typedef float f32x4 __attribute__((ext_vector_type(4)));
typedef unsigned u32x4 __attribute__((ext_vector_type(4)));
typedef int i32x4 __attribute__((ext_vector_type(4)));
typedef int i32x8 __attribute__((ext_vector_type(8)));
__device__ __forceinline__ i32x8 cat8(bf16x8 a, bf16x8 b) { return __builtin_shufflevector(__builtin_bit_cast(i32x4, a), __builtin_bit_cast(i32x4, b), 0, 1, 2, 3, 4, 5, 6, 7); }
constexpr int BM = 256, BK = 64, HALF = 128, HTB = HALF * BK * 2  , STAGE_BYTES = 8 * HTB, NXCD = 8, WGM = 8;

__host__ __device__ __forceinline__ int lds_byte(int r, int c) { const int st = (r >> 4) * 2 + (c >> 5), rr = r & 15, cc = c & 31, ob = rr * 64 + cc * 2; return st * 1024 + (ob ^ (((ob >> 9) & 1) << 5)); }
__host__ __device__ __forceinline__ void stage_rc(int b, int& R, int& C) { const int st = b / 1024, sb = b % 1024, swz = sb ^ (((sb >> 9) & 1) << 5); R = (st >> 1) * 16 + swz / 64; C = (st & 1) * 32 + (swz % 64) / 2; }
__host__ __device__ __forceinline__ int perm32(int rho) { const int n = rho >> 4, i = rho & 15; return 8 * (i >> 2) + 4 * n + (i & 3); }

struct Unit { int pm, pn; int hf = 0; };
struct Gemm { const bf16_t* A; const bf16_t* Bt; int M, N, K; const int* arow = nullptr; };

struct StaticOrder {
    int nM, nN, nwg, G, c;
    __host__ __device__ void init(int M, int N, int G_, int c_) { nM = M / BM; nN = N / BM; nwg = nM * nN; G = G_; c = c_; }
    __host__ __device__ bool next(int i, Unit& u) const {
        const long L = (long)i * G + c; if (L >= nwg) return false;
        int wgid = (int)L; { const int q = nwg / NXCD, r = nwg % NXCD, xcd = wgid % NXCD, off = wgid / NXCD; wgid = (xcd < r ? xcd * (q + 1) : r * (q + 1) + (xcd - r) * q) + off; }
        const int nig = WGM * nN, gid = wgid / nig, fm = gid * WGM, gsz = (nM - fm) < WGM ? (nM - fm) : WGM;
        u.pm = fm + ((wgid % nig) % gsz); u.pn = (wgid % nig) / gsz; return true;
    }
    __device__ __forceinline__ void a_ready(const Unit&) const {}
    __device__ __forceinline__ void done(const Unit&) const {}
};

__device__ __forceinline__ unsigned cvt_pk_bf16(float lo, float hi) { unsigned r; asm volatile("v_cvt_pk_bf16_f32 %0, %1, %2" : "=v"(r) : "v"(lo), "v"(hi)); return r; }
typedef float f32x2 __attribute__((ext_vector_type(2)));
__device__ __forceinline__ f32x2 gelu_pk(f32x2 v) {
    const f32x2 av = __builtin_elementwise_abs(v), d = av * 0.2316418882f + 1.0f;
    f32x2 t; t.x = __builtin_amdgcn_rcpf(d.x); t.y = __builtin_amdgcn_rcpf(d.y);
    f32x2 q = t * 0.5307027145f + (-0.7265760135f); q = q * t + 0.7107068705f; q = q * t + (-0.142248368f); q = q * t + 0.127414796f; q = q * t;
    const f32x2 s = (v * v) * (-0.72134752044f);
    f32x2 e; e.x = __builtin_amdgcn_exp2f(s.x); e.y = __builtin_amdgcn_exp2f(s.y);
    const f32x2 m = v * (q * e), r = v - m;
    f32x2 o; o.x = v.x < 0.f ? m.x : r.x; o.y = v.y < 0.f ? m.y : r.y; return o;
}

template <int ACT  > struct EpiBf16 {
    static constexpr bool PERM = true, AFTER_DRAIN = false; static_assert(ACT == 0 || ACT == 1, "EpiBf16: ACT is 0 (none) or 1 (gelu_pk)");
    bf16_t* O; int ldc; const float* bias; int split_cols; size_t split_stride; float scale0;
    __device__ __forceinline__ void operator()(const f32x4 (&acc)[2][2][4][2], const Unit& u, int wr, int wc, int fr, int fq) const {
        const int row0 = u.pm * BM + wr * 64 + fr; int colt = u.pn * BM; bf16_t* base = O;
        float sc = 1.f; if (split_cols) { const int t = colt / split_cols; base += (size_t)t * split_stride; colt -= t * split_cols; if (t == 0) sc = scale0; }
        const int col0 = colt + wc * 32 + 8 * fq, bcol0 = u.pn * BM + wc * 32 + 8 * fq;
        f32x4 bv[2][2];
#pragma unroll
        for (int bj = 0; bj < 2; ++bj)
#pragma unroll
            for (int n = 0; n < 2; ++n) bv[bj][n] = bias ? *(const f32x4*)(bias + bcol0 + bj * HALF + 4 * n) : (f32x4){0.f, 0.f, 0.f, 0.f};
#pragma unroll
        for (int ai = 0; ai < 2; ++ai)
#pragma unroll
            for (int m = 0; m < 4; ++m) { bf16_t* rowp = base + (size_t)(row0 + ai * HALF + m * 16) * ldc + col0;
#pragma unroll
                for (int bj = 0; bj < 2; ++bj) { f32x4 v0 = acc[ai][bj][m][0] + bv[bj][0], v1 = acc[ai][bj][m][1] + bv[bj][1];
                    if (ACT == 1) { f32x2 a = gelu_pk((f32x2){v0[0], v0[1]}), b = gelu_pk((f32x2){v0[2], v0[3]}), c = gelu_pk((f32x2){v1[0], v1[1]}), d = gelu_pk((f32x2){v1[2], v1[3]});
                        v0 = (f32x4){a.x, a.y, b.x, b.y}; v1 = (f32x4){c.x, c.y, d.x, d.y}; }
                    v0 = v0 * sc; v1 = v1 * sc; u32x4 w; w.x = cvt_pk_bf16(v0[0], v0[1]); w.y = cvt_pk_bf16(v0[2], v0[3]); w.z = cvt_pk_bf16(v1[0], v1[1]); w.w = cvt_pk_bf16(v1[2], v1[3]);
                    *(u32x4*)(rowp + bj * HALF) = w; } }
    }
};
template <class Epi, class Sched, bool ALIGN_EPI = false, bool SP2 = false, bool GATHER = false, bool F8 = false>
__device__ __forceinline__ void gemm_phase(PG8_LAS unsigned char* lds, const Gemm g, const Sched& S, const Epi& E, const int tid_in) {
    const int tid = tid_in,
              wid = __builtin_amdgcn_readfirstlane(tid >> 6), lane = tid & 63, wr = wid >> 2, wc = wid & 3, fr = lane & 15, fq = lane >> 4;
    const int K = g.K, nt = K / BK;
    unsigned voffA[2], voffB[2], voffA1[2], nvA0[2], nvA1[2]; int gR[2], gC[2];
#pragma unroll
    for (int i = 0; i < 2; ++i) { int R, C; stage_rc(tid * 16 + i * 8192, R, C); const int Rb = Epi::PERM ? ((R & ~31) + perm32(R & 31)) : R;
        voffA[i] = (unsigned)(R * K + C) * 2u; voffB[i] = (unsigned)(Rb * K + C) * 2u; voffA1[i] = voffA[i]; nvA0[i] = voffA[i]; nvA1[i] = voffA[i]; gR[i] = R; gC[i] = C; }
    const size_t kstep = (size_t)(BK * 2);
    const size_t hstep = (size_t)HALF * K * 2;
    const size_t tstep = 2 * hstep;
    const unsigned ldsw = (unsigned)wid * 1024u;
    const unsigned ldsu = (unsigned)__builtin_amdgcn_readfirstlane((int)((unsigned)(uintptr_t)lds + ldsw));
    const int aoff = lds_byte(wr * 64 + fr, fq * 8), boff = lds_byte(wc * 32 + fr, fq * 8);
#define PG8_SA(b, h) (((b) * 2 + (h)) * HTB)
#define PG8_SB(b, h) ((4 + (b) * 2 + (h)) * HTB)
#define PG8_DMA(sbase, vo, ldsdst) do { unsigned keep_; asm volatile("s_mov_b32 %0, m0\n\ts_mov_b32 m0, %3\n\ts_nop 0\n\tglobal_load_lds_dwordx4 %1, %2\n\ts_mov_b32 m0, %0" : "=&s"(keep_) : "v"(vo), "s"(sbase), "s"(ldsdst) : "memory"); } while (0)
#define PG8_STAGE(bufoff, gbase, voff) do { _Pragma("unroll") for (int _i = 0; _i < 2; ++_i) PG8_DMA((const char*)(gbase), (voff)[_i], ldsu + (unsigned)((bufoff) + _i * 8192)); } while (0)
#define PG8_GROW(dst0, dst1, pm_) do { if constexpr (GATHER) { _Pragma("unroll") for (int _i = 0; _i < 2; ++_i) { const int r0_ = g.arow[(pm_) * 256 + gR[_i]], r1_ = g.arow[(pm_) * 256 + 128 + gR[_i]]; \
        dst0[_i] = (unsigned)(r0_ * K + gC[_i]) * 2u; dst1[_i] = (unsigned)(r1_ * K + gC[_i]) * 2u; } } } while (0)
#define PG8_STAGE_A(bufoff, h, koff, nx) do { if constexpr (GATHER) { _Pragma("unroll") for (int _i = 0; _i < 2; ++_i) { const unsigned vo_ = (nx) ? ((h) ? nvA1[_i] : nvA0[_i]) : ((h) ? voffA1[_i] : voffA[_i]); \
        PG8_DMA((const char*)g.A + (koff), vo_, ldsu + (unsigned)((bufoff) + _i * 8192)); } } \
    else { PG8_STAGE(bufoff, ((nx) ? nA : cA) + (koff) + ((h) ? hstep : 0), voffA); } } while (0)
#define PG8_LDA(dst, b, h) do { _Pragma("unroll") for (int m = 0; m < 4; ++m) _Pragma("unroll") for (int k = 0; k < 2; ++k) dst[m][k] = *(const PG8_LAS bf16x8*)(lds + PG8_SA(b, h) + aoff + m * 2048 + k * 1024); } while (0)
#define PG8_LDB(dst, b, h) do { _Pragma("unroll") for (int n = 0; n < 2; ++n) _Pragma("unroll") for (int k = 0; k < 2; ++k) dst[n][k] = *(const PG8_LAS bf16x8*)(lds + PG8_SB(b, h) + boff + n * 2048 + k * 1024); } while (0)
#define PG8_MMA(ai, bj, At, Bt) do { __builtin_amdgcn_s_setprio(1); _Pragma("unroll") for (int m = 0; m < 4; ++m) _Pragma("unroll") for (int n = 0; n < 2; ++n) { \
        if constexpr (F8) acc[ai][bj][m][n] = __builtin_amdgcn_mfma_scale_f32_16x16x128_f8f6f4(cat8(Bt[n][0], Bt[n][1]), cat8(At[m][0], At[m][1]), acc[ai][bj][m][n], 0, 0, 0, 0, 0, 0); \
        else { _Pragma("unroll") for (int k = 0; k < 2; ++k) acc[ai][bj][m][n] = __builtin_amdgcn_mfma_f32_16x16x32_bf16(Bt[n][k], At[m][k], acc[ai][bj][m][n], 0, 0, 0); } } __builtin_amdgcn_s_setprio(0); } while (0)
#define PG8_WAIT_V(n) asm volatile("s_waitcnt vmcnt(" #n ")" ::: "memory")
#define PG8_WAIT_L(n) asm volatile("s_waitcnt lgkmcnt(" #n ")" ::: "memory")
#define PG8_BAR __builtin_amdgcn_s_barrier()
#define PG8_SCHED __builtin_amdgcn_sched_barrier(0)
    Unit cur, nxt; int ui = 0;
    if (!S.next(0, cur)) return;
    f32x4 acc[2][2][4][2];
    float zz = 0.f; asm volatile("" : "+v"(zz));
#pragma unroll
    for (int a = 0; a < 2; ++a)
#pragma unroll
        for (int b = 0; b < 2; ++b)
#pragma unroll
            for (int m = 0; m < 4; ++m)
#pragma unroll
                for (int n = 0; n < 2; ++n) acc[a][b][m][n] = (f32x4){zz, zz, zz, zz};
    bf16x8 At[4][2], B0[2][2], B1[2][2];
    const char* cA = (const char*)g.A + (size_t)cur.pm * tstep; const char* cB = (const char*)g.Bt + (size_t)cur.pn * tstep;
    S.a_ready(cur);
    PG8_GROW(voffA, voffA1, cur.pm);
    const char* nA = cA; const char* nB = cB;
    if constexpr (SP2) {
        PG8_STAGE(PG8_SB(0, 0), cB, voffB); PG8_STAGE(PG8_SB(0, 1), cB + hstep, voffB); PG8_STAGE_A(PG8_SA(0, 0), 0, 0, false); PG8_STAGE_A(PG8_SA(0, 1), 1, 0, false);
        if (wr == 1) PG8_BAR;
        PG8_WAIT_V(2); PG8_BAR;
        PG8_STAGE(PG8_SB(1, 0), cB + kstep, voffB); PG8_STAGE_A(PG8_SA(1, 0), 0, kstep, false); PG8_STAGE(PG8_SB(1, 1), cB + hstep + kstep, voffB);
        PG8_WAIT_V(6); PG8_BAR;
    } else {
        PG8_STAGE(PG8_SB(0, 0), cB, voffB); PG8_STAGE(PG8_SA(0, 0), cA, voffA); PG8_STAGE(PG8_SB(0, 1), cB + hstep, voffB); PG8_STAGE(PG8_SA(0, 1), cA + hstep, voffA);
        if (wr == 1) PG8_BAR;
        PG8_WAIT_V(4); PG8_BAR;
        PG8_STAGE(PG8_SB(1, 0), cB + kstep, voffB); PG8_STAGE(PG8_SA(1, 0), cA + kstep, voffA); PG8_STAGE(PG8_SB(1, 1), cB + hstep + kstep, voffB);
        PG8_WAIT_V(6); PG8_BAR;
    }
    for (;;) {
        const bool has_next = S.next(ui + 1, nxt);
        nA = has_next ? (const char*)g.A + (size_t)nxt.pm * tstep : cA; nB = has_next ? (const char*)g.Bt + (size_t)nxt.pn * tstep : cB;
        if constexpr (GATHER) { if (has_next) PG8_GROW(nvA0, nvA1, nxt.pm); else { _Pragma("unroll") for (int _i = 0; _i < 2; ++_i) { nvA0[_i] = voffA[_i]; nvA1[_i] = voffA1[_i]; } } }
        for (int t = 0; t < nt; t += 2) {
            const bool last = (t == nt - 2);
            const size_t ko1 = (size_t)(t + 1) * kstep, ko2 = last ? 0 : (size_t)(t + 2) * kstep, ko3 = ko2 + kstep;
            const char* b2 = last ? nB : cB + (size_t)(t + 2) * kstep;
            const char* b3 = b2 + kstep;
            if (last && has_next) S.a_ready(nxt);
            if constexpr (SP2) {
            PG8_LDB(B0, 0, 0); PG8_LDB(B1, 0, 1); PG8_SCHED; PG8_LDA(At, 0, 0); PG8_STAGE_A(PG8_SA(1, 1), 1, ko1, false);
            PG8_WAIT_V(8); PG8_WAIT_L(0); PG8_BAR; PG8_MMA(0, 0, At, B0); PG8_MMA(0, 1, At, B1); PG8_BAR; PG8_SCHED;
            PG8_LDA(At, 0, 1); PG8_STAGE(PG8_SB(0, 0), b2, voffB); PG8_STAGE(PG8_SB(0, 1), b2 + hstep, voffB); PG8_STAGE_A(PG8_SA(0, 0), 0, ko2, last);
            PG8_WAIT_V(8); PG8_WAIT_L(0); PG8_BAR; if (!cur.hf) { PG8_MMA(1, 0, At, B0); PG8_MMA(1, 1, At, B1); } PG8_BAR; PG8_SCHED;
            PG8_LDB(B0, 1, 0); PG8_LDB(B1, 1, 1); PG8_SCHED; PG8_LDA(At, 1, 0); PG8_STAGE_A(PG8_SA(0, 1), 1, ko2, last);
            PG8_WAIT_V(8); PG8_WAIT_L(0); PG8_BAR; PG8_MMA(0, 0, At, B0); PG8_MMA(0, 1, At, B1); PG8_BAR; PG8_SCHED;
            PG8_LDA(At, 1, 1); PG8_STAGE(PG8_SB(1, 0), b3, voffB); PG8_STAGE(PG8_SB(1, 1), b3 + hstep, voffB); PG8_STAGE_A(PG8_SA(1, 0), 0, ko3, last);
            PG8_WAIT_V(8); PG8_WAIT_L(0); PG8_BAR; if (!cur.hf) { PG8_MMA(1, 0, At, B0); PG8_MMA(1, 1, At, B1); } PG8_BAR; PG8_SCHED;
            } else {
            const char* a1 = cA + ko1; const char* a2 = (last ? nA : cA) + ko2; const char* a3 = a2 + kstep;
            PG8_LDB(B0, 0, 0); PG8_SCHED; PG8_LDA(At, 0, 0); PG8_STAGE(PG8_SA(1, 1), a1 + hstep, voffA);
            PG8_WAIT_L(8); PG8_BAR; PG8_WAIT_L(0); PG8_MMA(0, 0, At, B0); PG8_BAR; PG8_SCHED;
            PG8_LDB(B1, 0, 1); PG8_STAGE(PG8_SB(0, 0), b2, voffB);
            PG8_BAR; PG8_WAIT_L(0); PG8_MMA(0, 1, At, B1); PG8_BAR;
            PG8_LDA(At, 0, 1); PG8_STAGE(PG8_SA(0, 0), a2, voffA);
            PG8_BAR; PG8_WAIT_L(0); PG8_MMA(1, 0, At, B0); PG8_BAR; PG8_SCHED;
            PG8_STAGE(PG8_SB(0, 1), b2 + hstep, voffB);
            PG8_WAIT_V(6); PG8_BAR; PG8_MMA(1, 1, At, B1); PG8_BAR;
            PG8_LDB(B0, 1, 0); PG8_SCHED; PG8_LDA(At, 1, 0); PG8_STAGE(PG8_SA(0, 1), a2 + hstep, voffA);
            PG8_WAIT_L(8); PG8_BAR; PG8_WAIT_L(0); PG8_MMA(0, 0, At, B0); PG8_BAR; PG8_SCHED;
            PG8_LDB(B1, 1, 1); PG8_STAGE(PG8_SB(1, 0), b3, voffB);
            PG8_BAR; PG8_WAIT_L(0); PG8_MMA(0, 1, At, B1); PG8_BAR;
            PG8_LDA(At, 1, 1); PG8_STAGE(PG8_SA(1, 0), a3, voffA);
            PG8_BAR; PG8_WAIT_L(0); PG8_MMA(1, 0, At, B0); PG8_BAR; PG8_SCHED;
            PG8_STAGE(PG8_SB(1, 1), b3 + hstep, voffB);
            PG8_WAIT_V(6); PG8_BAR; PG8_MMA(1, 1, At, B1); PG8_BAR;
            }
        }
        if constexpr (ALIGN_EPI) { if (wr == 0) PG8_BAR; }
        if constexpr (!Epi::AFTER_DRAIN) { E(acc, cur, wr, wc, fr, fq); S.done(cur); }
        if (!has_next) break;
        zz = 0.f; asm volatile("" : "+v"(zz));
#pragma unroll
        for (int a = 0; a < 2; ++a)
#pragma unroll
            for (int b = 0; b < 2; ++b)
#pragma unroll
                for (int m = 0; m < 4; ++m)
#pragma unroll
                    for (int n = 0; n < 2; ++n) acc[a][b][m][n] = (f32x4){zz, zz, zz, zz};
        cur = nxt; cA = nA; cB = nB; ++ui;
        if constexpr (GATHER) { _Pragma("unroll") for (int _i = 0; _i < 2; ++_i) { voffA[_i] = nvA0[_i]; voffA1[_i] = nvA1[_i]; } }
        if constexpr (ALIGN_EPI) { if (wr == 1) PG8_BAR; }
    }
    PG8_WAIT_V(0);
    if constexpr (!ALIGN_EPI) { if (wr == 0) PG8_BAR; }
    PG8_BAR;
    if constexpr (Epi::AFTER_DRAIN) { E.fused(acc, cur, wr, wc, fr, fq, lds, wid, lane); S.done(cur); }
#undef PG8_SA
#undef PG8_SB
#undef PG8_STAGE
#undef PG8_DMA
#undef PG8_STAGE_A
#undef PG8_GROW
#undef PG8_LDA
#undef PG8_LDB
#undef PG8_MMA
#undef PG8_WAIT_V
#undef PG8_WAIT_L
#undef PG8_BAR
#undef PG8_SCHED
}
}
#define GAS __attribute__((address_space(1)))
#define LAS __attribute__((address_space(3)))
typedef unsigned short bf16;
typedef unsigned v4u __attribute__((ext_vector_type(4)));
typedef float f32x4 __attribute__((ext_vector_type(4)));
typedef short bf16x8 __attribute__((ext_vector_type(8)));
typedef GAS unsigned gu32;
typedef GAS unsigned long long gu64;
#define RLX_AGENT __ATOMIC_RELAXED, __HIP_MEMORY_SCOPE_AGENT
#define LDS_WAIT() asm volatile("s_waitcnt lgkmcnt(0)" ::: "memory")
#define VM_WAIT() asm volatile("s_waitcnt vmcnt(0)" ::: "memory")
__device__ __forceinline__ int lane_now() { int l; asm volatile("v_mbcnt_lo_u32_b32 %0, -1, 0\n\tv_mbcnt_hi_u32_b32 %0, -1, %0" : "=v"(l)); return l; }
__device__ __forceinline__ int shfl_xor_l(int v, int o) { return __builtin_amdgcn_ds_bpermute((lane_now() ^ o) << 2, v); }
__device__ __forceinline__ unsigned shfl_xor_l(unsigned v, int o) { return (unsigned)shfl_xor_l((int)v, o); }
__device__ __forceinline__ float shfl_xor_l(float v, int o) { return __builtin_bit_cast(float, shfl_xor_l(__builtin_bit_cast(int, v), o)); }
__device__ __forceinline__ int shfl_up_l(int v, int o) { const int l = lane_now(), s = l - o; return __builtin_amdgcn_ds_bpermute((s < 0 ? l : s) << 2, v); }
__device__ __forceinline__ float shfl_up_l(float v, int o) { return __builtin_bit_cast(float, shfl_up_l(__builtin_bit_cast(int, v), o)); }
#define __shfl_xor(v, o) shfl_xor_l((v), (o))
#define __shfl_up(v, o) shfl_up_l((v), (o))
__device__ __forceinline__ unsigned long long rt() { return __builtin_amdgcn_s_memrealtime(); }
__device__ __forceinline__ unsigned f2bf(float f) { unsigned u = __builtin_bit_cast(unsigned, f); return (u + 0x7fffu + ((u >> 16) & 1u)) >> 16; }
__device__ __forceinline__ unsigned pk2(float lo, float hi) { return f2bf(lo) | (f2bf(hi) << 16); }

#define XB_TMO      128
#define XB_XCNT(j)  (256  + 64 * (j))
#define XB_XSUB(j)  (1280 + 64 * (j))
#define XB_XGEN(j)  (2304 + 64 * (j))
#define XB_TOP      3328
#define XB_TOPGEN   3392
#define XCD_BAR_WORDS 3456
#define XB_SPIN_CAP (1u << 18)

__device__ __forceinline__ unsigned xb_ld(unsigned* p)              { return __hip_atomic_load(p, __ATOMIC_RELAXED, __HIP_MEMORY_SCOPE_AGENT); }
__device__ __forceinline__ unsigned xb_add(unsigned* p, unsigned v) { return __hip_atomic_fetch_add(p, v, __ATOMIC_RELAXED, __HIP_MEMORY_SCOPE_AGENT); }
__device__ __forceinline__ unsigned xb_xcc_id() { return (unsigned)__builtin_amdgcn_s_getreg((3 << 11) | 20) & 0xFu; }
#define XB_SPIN(cond, bar) do { unsigned _sp = 0; while (cond) { __builtin_amdgcn_s_sleep(1); \
    if ((++_sp & 255u) == 0u) { if (xb_ld(&(bar)[XB_TMO])) break; if (_sp > XB_SPIN_CAP) { atomicAdd(&(bar)[XB_TMO], 1u); break; } } } } while (0)

struct XcdBarrier {
    unsigned* bar; unsigned x;
    volatile LAS unsigned* st;
};

__device__ __forceinline__ XcdBarrier xcd_barrier_post(unsigned* bar, volatile LAS unsigned* st) {
    XcdBarrier b; b.bar = bar; b.x = xb_xcc_id(); b.st = st;
    if (threadIdx.x == 0) (void)xb_add(&bar[XB_XCNT(b.x)], 1u);
    return b;
}
__device__ __forceinline__ void xcd_barrier_complete(unsigned* bar, unsigned x, unsigned& nloc, unsigned& nx) {
    const unsigned G = gridDim.x * gridDim.y * gridDim.z;
    unsigned sum, cnt, mine, sp = 0u;
    for (;;) {
        sum = 0u; cnt = 0u; mine = 0u;
#pragma unroll
        for (unsigned j = 0; j < 16; ++j) { const unsigned c = xb_ld(&bar[XB_XCNT(j)]); sum += c; cnt += (c > 0u) ? 1u : 0u; mine = (j == x) ? c : mine; }
        if (sum == G) break;
        __builtin_amdgcn_s_sleep(1);
        if ((++sp & 255u) == 0u) { if (xb_ld(&bar[XB_TMO])) break; if (sp > XB_SPIN_CAP) { atomicAdd(&bar[XB_TMO], 1u); break; } }
    }
    nloc = mine > 0u ? mine : 1u; nx = cnt > 0u ? cnt : 1u;
}

__device__ __forceinline__ void xcd_barrier(const XcdBarrier& b) {
    asm volatile("s_waitcnt vmcnt(0)" ::: "memory");
    __syncthreads();
    if (threadIdx.x == 0) {
        unsigned* bar = b.bar;
        __builtin_amdgcn_s_waitcnt(0);
        unsigned nloc = b.st[0], nx = b.st[1];
        if (nloc == 0u) { xcd_barrier_complete(bar, b.x, nloc, nx); b.st[0] = nloc; b.st[1] = nx; }
        const unsigned old = xb_add(&bar[XB_XSUB(b.x)], 1u);
        const unsigned gen = old / nloc;
        if (old + 1u == (gen + 1u) * nloc) {
            __builtin_amdgcn_fence(__ATOMIC_RELEASE, "agent");
            asm volatile("s_waitcnt vmcnt(0)" ::: "memory");
            const unsigned og = xb_add(&bar[XB_TOP], 1u);
            const unsigned tg = og / nx;
            if (og + 1u == (tg + 1u) * nx) xb_add(&bar[XB_TOPGEN], 1u);
            else XB_SPIN(xb_ld(&bar[XB_TOPGEN]) == tg, bar);
            __builtin_amdgcn_fence(__ATOMIC_ACQUIRE, "agent");
            xb_add(&bar[XB_XGEN(b.x)], 1u);
            asm volatile("s_waitcnt vmcnt(0)" ::: "memory");
        } else {
            XB_SPIN(xb_ld(&bar[XB_XGEN(b.x)]) == gen, bar);
            __builtin_amdgcn_fence(__ATOMIC_ACQUIRE, "agent");
            asm volatile("s_waitcnt vmcnt(0)" ::: "memory");
        }
    }
    __syncthreads();
}
namespace mk {
typedef float f32x16 __attribute__((ext_vector_type(16)));
typedef float f32x2 __attribute__((ext_vector_type(2)));
typedef short s16x4 __attribute__((ext_vector_type(4)));
typedef unsigned u32x2 __attribute__((ext_vector_type(2)));
typedef unsigned u32x4 __attribute__((ext_vector_type(4)));

constexpr int NWAVES = 8, NTHR = 512;
constexpr int BATCH = 4, SEQ = 8192, D = 1024, H = 16, HD = 64, T = BATCH * SEQ;
constexpr int NE = 256, TOPK = 8, DE = 256, NGRP = 8, GRPSZ = 32;
constexpr int NBLK = SEQ / 256;
constexpr int NSLOT_MAX = 327680;
constexpr float LN_EPS = 1e-5f;
constexpr float DN_ALPHA = 1.4142135623730951f;
constexpr float ROUTED_SCALE = 2.5f;
constexpr float LOG2E = 1.4426950408889634f;
constexpr float C2 = 0.125f * LOG2E;
constexpr float XQ_SCALE = 16.f, WQ_SCALE = 256.f, AQ_SCALE = 64.f, OQ_SCALE = 64.f, F8_MAX = 448.f;
constexpr float GS_FOLD = AQ_SCALE / (XQ_SCALE * WQ_SCALE);
constexpr int FOXW = 3 * D + H;

constexpr size_t MiB = 1u << 20;
constexpr size_t WS_CTL = 0, CTL_ZERO_BYTES = 1 * MiB;
constexpr size_t WS_WMI = 2 * MiB;
constexpr size_t WS_WMO = 8 * MiB;
constexpr size_t WS_WFI = 10 * MiB;
constexpr size_t WS_WFO = 16 * MiB;
constexpr size_t WS_WR = 18 * MiB;
constexpr size_t WS_WSGU = 21 * MiB;
constexpr size_t WS_WSDN = 23 * MiB;
constexpr size_t WS_WEGU = 24 * MiB;
constexpr size_t WS_WEDN = 280 * MiB;
constexpr size_t WS_XRES = 408 * MiB;
constexpr size_t WS_Z = 536 * MiB;
constexpr size_t WS_XB8 = 600 * MiB;
constexpr size_t WS_XB = 664 * MiB;
constexpr size_t WS_AR = 728 * MiB;
constexpr size_t WS_LOGP = 920 * MiB;
constexpr size_t WS_ACTSH = 984 * MiB;
constexpr size_t WS_TOPI = 1000 * MiB;
constexpr size_t WS_GATE = 1001 * MiB;
constexpr size_t WS_SLOTOF = 1002 * MiB;
constexpr size_t WS_TOKOF = 1003 * MiB;
constexpr size_t WS_GSLOT = 1005 * MiB;
constexpr size_t WS_KMEAN = 1008 * MiB;
constexpr size_t WS_LOGF = 1009 * MiB;
constexpr size_t WS_CUM = 1011 * MiB;
constexpr size_t WS_OVL = 1016 * MiB;
constexpr size_t WS_Q = WS_OVL, WS_K = WS_OVL + 64 * MiB, WS_V = WS_OVL + 128 * MiB, WS_O = WS_OVL + 192 * MiB;
constexpr size_t WS_MLIST = WS_OVL + 256 * MiB;
constexpr size_t WS_PARTO = WS_OVL + 288 * MiB;
constexpr size_t WS_PARTML = WS_OVL + 480 * MiB;
constexpr size_t WS_HS = WS_OVL;
constexpr size_t WS_ACT = WS_OVL + 640 * MiB;
constexpr size_t WS_END = WS_OVL + 800 * MiB;
static_assert(WS_END <= 2048 * MiB, "d_ws map");
static_assert(WS_PARTML + (size_t)T * H * 3 * 2 * 4 <= WS_END, "attention overlay");
constexpr int MLIST_PER_BH = 256 * 496;
constexpr int CW_BAR = 4096;
constexpr int CW_MCNT = 16384;
constexpr int CW_ECNT = 20480;
constexpr int CW_ECUR = 21504;
constexpr int CW_FOXQ = 24576;
constexpr int CW_KSUM = 131072;
constexpr int CW_NORM = 24832;
constexpr int RING_BYTES = 131072, LDSCTL_OFF = 155648, MISC_OFF = LDSCTL_OFF + 320, TPRE_OFF = LDSCTL_OFF + 1024, PTAB_OFF = LDSCTL_OFF + 4096, LDS_BYTES = 163840;
typedef __bf16 bf16x2_t __attribute__((ext_vector_type(2)));
__device__ __forceinline__ unsigned cvtpk(float lo, float hi) { f32x2 v = {lo, hi}; bf16x2_t b = __builtin_convertvector(v, bf16x2_t); return __builtin_bit_cast(unsigned, b); }
__device__ __forceinline__ float bf2f(unsigned b) { return __uint_as_float(b << 16); }
__device__ __forceinline__ float bflo(unsigned w) { return __uint_as_float(w << 16); }
__device__ __forceinline__ float bfhi(unsigned w) { return __uint_as_float(w & 0xffff0000u); }
__device__ __forceinline__ float wave_sum(float v) {
#pragma unroll
    for (int o = 1; o < 64; o <<= 1) v += __shfl_xor(v, o);
    return v;
}
__device__ __forceinline__ unsigned sort_key(float x) { const unsigned b = __float_as_uint(x); return b ^ ((unsigned)((int)b >> 31) | 0x80000000u); }
__device__ __forceinline__ int crow(int r, int hi) { return (r & 3) + 8 * (r >> 2) + 4 * hi; }
__device__ __forceinline__ s16x4 vtr(const LAS unsigned char* p) { typedef short v4i16_t __attribute__((ext_vector_type(4))); return __builtin_bit_cast(s16x4, __builtin_amdgcn_ds_read_tr16_b64_v4i16((LAS v4i16_t*)p)); }

__device__ __forceinline__ unsigned long long ldptr(const LAS unsigned long long* tab, int i) { const unsigned long long v = tab[i]; const unsigned lo = __builtin_amdgcn_readfirstlane((unsigned)v), hi = __builtin_amdgcn_readfirstlane((unsigned)(v >> 32)); return ((unsigned long long)hi << 32) | lo; }

struct Ctx {
    LAS unsigned char* lds;
    int tid, lane, wave, vcu, G;
};

template <bool LO> __device__ __forceinline__ void tr_item(const float* src, size_t ld, bf16* dst, size_t dpitch, LAS float* scr, int lane) {
#pragma unroll 8
    for (int i = 0; i < 32; ++i) { const int kk = 2 * i + (lane >> 5); scr[kk * 33 + (lane & 31)] = src[(size_t)kk * ld + (lane & 31)]; }
    LDS_WAIT(); asm volatile("" ::: "memory");
    const int c = lane & 7;
#pragma unroll
    for (int j = 0; j < 4; ++j) { const int n = (lane >> 3) + 8 * j; const LAS float* s = scr + (8 * c) * 33 + n;
        float v[8];
#pragma unroll
        for (int i = 0; i < 8; ++i) { v[i] = s[i * 33]; if (LO) v[i] = v[i] - bf2f(f2bf(v[i])); }
        v4u o; o.x = pk2(v[0], v[1]); o.y = pk2(v[2], v[3]); o.z = pk2(v[4], v[5]); o.w = pk2(v[6], v[7]);
        *(GAS v4u*)(dst + (size_t)n * dpitch + 8 * c) = o; }
    LDS_WAIT(); asm volatile("" ::: "memory");
}

__device__ __forceinline__ void tr_item64(const float* src, size_t ld, bf16* dst0, size_t rstride, LAS unsigned char* scr, int lane) {
    float v[64];
    const GAS float* p = (const GAS float*)src + lane;
#pragma unroll
    for (int k = 0; k < 64; ++k) v[k] = p[(size_t)k * ld];
#pragma unroll
    for (int c = 0; c < 8; ++c) { v4u o; o.x = cvtpk(v[8 * c], v[8 * c + 1]); o.y = cvtpk(v[8 * c + 2], v[8 * c + 3]); o.z = cvtpk(v[8 * c + 4], v[8 * c + 5]); o.w = cvtpk(v[8 * c + 6], v[8 * c + 7]);
        *(LAS v4u*)(scr + lane * 144 + c * 16) = o; }
    LDS_WAIT(); asm volatile("" ::: "memory");
#pragma unroll
    for (int i = 0; i < 8; ++i) { const int row = 8 * i + (lane >> 3), c = lane & 7; const v4u o = *(const LAS v4u*)(scr + row * 144 + c * 16);
        *(GAS v4u*)(dst0 + (size_t)row * rstride + 8 * c) = o; }
    LDS_WAIT(); asm volatile("" ::: "memory");
}
__device__ __forceinline__ unsigned pk4_f8(float a, float b, float c, float d) {
    a = __builtin_amdgcn_fmed3f(a, -F8_MAX, F8_MAX); b = __builtin_amdgcn_fmed3f(b, -F8_MAX, F8_MAX); c = __builtin_amdgcn_fmed3f(c, -F8_MAX, F8_MAX); d = __builtin_amdgcn_fmed3f(d, -F8_MAX, F8_MAX);
    unsigned w = 0u; w = (unsigned)__builtin_amdgcn_cvt_pk_fp8_f32(a, b, (int)w, false); w = (unsigned)__builtin_amdgcn_cvt_pk_fp8_f32(c, d, (int)w, true); return w;
}
__device__ __forceinline__ void tr_item_f8(const float* src, size_t ld, unsigned char* dst0, size_t rstride, LAS unsigned char* scr, int lane) {
#pragma unroll 1
    for (int h = 0; h < 2; ++h) {
        float v[64];
        const GAS float* p = (const GAS float*)src + lane + (size_t)(64 * h) * ld;
#pragma unroll
        for (int k = 0; k < 64; ++k) v[k] = __builtin_nontemporal_load(p + (size_t)k * ld);
#pragma unroll
        for (int c = 0; c < 4; ++c) { v4u o;
            o.x = pk4_f8(v[16 * c] * WQ_SCALE, v[16 * c + 1] * WQ_SCALE, v[16 * c + 2] * WQ_SCALE, v[16 * c + 3] * WQ_SCALE); o.y = pk4_f8(v[16 * c + 4] * WQ_SCALE, v[16 * c + 5] * WQ_SCALE, v[16 * c + 6] * WQ_SCALE, v[16 * c + 7] * WQ_SCALE);
            o.z = pk4_f8(v[16 * c + 8] * WQ_SCALE, v[16 * c + 9] * WQ_SCALE, v[16 * c + 10] * WQ_SCALE, v[16 * c + 11] * WQ_SCALE); o.w = pk4_f8(v[16 * c + 12] * WQ_SCALE, v[16 * c + 13] * WQ_SCALE, v[16 * c + 14] * WQ_SCALE, v[16 * c + 15] * WQ_SCALE);
            *(LAS v4u*)(scr + lane * 144 + h * 64 + c * 16) = o; }
    }
    LDS_WAIT(); asm volatile("" ::: "memory");
#pragma unroll
    for (int i = 0; i < 8; ++i) { const int row = 8 * i + (lane >> 3), c = lane & 7; const v4u o = *(const LAS v4u*)(scr + row * 144 + c * 16);
        *(GAS v4u*)(dst0 + (size_t)row * rstride + 16 * c) = o; }
    LDS_WAIT(); asm volatile("" ::: "memory");
}
__device__ __forceinline__ void conv_experts(const Ctx& C, const float* wg, const float* wu, const float* wd, int l, unsigned char* WEGU, unsigned char* WEDN, int part, int nparts) {
    const int gw = part * NWAVES + C.wave, NGW = nparts * NWAVES, lane = C.lane;
    LAS unsigned char* scr = C.lds + C.wave * 9216;
    constexpr int IG = NE * 8 * 4;
    constexpr int IDN = NE * 2 * 16;
    for (int it = gw; it < 2 * IG + IDN; it += NGW) {
        if (it < 2 * IG) {
            const int up = it >= IG, r = it - up * IG, e = r >> 5, kb = (r >> 2) & 7, nb = r & 3, n0 = 64 * nb;
            const float* src = (up ? wu : wg) + ((size_t)(l * NE + e) * 1024 + 128 * kb) * 256 + 64 * nb;
            unsigned char* dst = WEGU + ((size_t)e * 512 + (n0 >> 7) * 256 + up * 128 + (n0 & 127)) * 1024 + 128 * kb;
            tr_item_f8(src, 256, dst, 1024, scr, lane);
        } else {
            const int r = it - 2 * IG, e = r >> 5, kb = (r >> 4) & 1, nb = r & 15;
            const float* src = wd + ((size_t)(l * NE + e) * 256 + 128 * kb) * 1024 + 64 * nb;
            unsigned char* dst = WEDN + ((size_t)e * 1024 + 64 * nb) * 256 + 128 * kb;
            tr_item_f8(src, 1024, dst, 256, scr, lane);
        }
    }
}

struct SmallW {
    const float *moba_in, *moba_out, *fox_in, *fox_out, *w_router, *ws_gate, *ws_up, *ws_down;
    unsigned char *WMI, *WFI, *WMO, *WFO, *WSGU, *WSDN;
    bf16 *WR;
};
__device__ __forceinline__ void conv_small(const Ctx& C, const SmallW& W) {
    LAS float* scr = (LAS float*)(C.lds + C.wave * 16384);
    const int gw = C.vcu * NWAVES + C.wave, NGW = C.G * NWAVES;
    constexpr int I_IN = 8 * 48  , I_OUT = 8 * 16, I_R = 16 * 8, I_SG = 8 * 4, I_SD = 2 * 16;
    constexpr int NIT = 2 * I_IN + 2 * I_OUT + 2 * (3 * I_R) + 2 * (2 * I_SG + I_SD);
    for (int it = gw; it < NIT; it += NGW) {
        int r = it;
        if (r < I_IN) { const int kb = r / 48, nb = r % 48; tr_item_f8(W.moba_in + (size_t)(128 * kb) * 3072 + 64 * nb, 3072, W.WMI + (size_t)(64 * nb) * 1024 + 128 * kb, 1024, (LAS unsigned char*)scr, C.lane); continue; } r -= I_IN;
        if (r < I_IN) { const int kb = r / 48, nb = r % 48; tr_item_f8(W.fox_in + (size_t)(128 * kb) * FOXW + 64 * nb, FOXW, W.WFI + (size_t)(64 * nb) * 1024 + 128 * kb, 1024, (LAS unsigned char*)scr, C.lane); continue; } r -= I_IN;
        if (r < I_OUT) { const int kb = r >> 4, nb = r & 15; tr_item_f8(W.moba_out + (size_t)(128 * kb) * 1024 + 64 * nb, 1024, W.WMO + (size_t)(64 * nb) * 1024 + 128 * kb, 1024, (LAS unsigned char*)scr, C.lane); continue; } r -= I_OUT;
        if (r < I_OUT) { const int kb = r >> 4, nb = r & 15; tr_item_f8(W.fox_out + (size_t)(128 * kb) * 1024 + 64 * nb, 1024, W.WFO + (size_t)(64 * nb) * 1024 + 128 * kb, 1024, (LAS unsigned char*)scr, C.lane); continue; } r -= I_OUT;
        if (r < 6 * I_R) {
            const int l = r / (3 * I_R), q = (r % (3 * I_R)) / I_R, s = r % I_R, kb = s >> 3, nb = s & 7;
            const float* src = W.w_router + ((size_t)l * 1024 + 64 * kb) * 256 + 32 * nb;
            bf16* base = W.WR + (size_t)l * (512 * 1536) + (size_t)(32 * nb) * 1536;
            if (q == 0) tr_item<false>(src, 256, base + 64 * kb, 1536, scr, C.lane);
            else if (q == 1) { if (kb < 8) tr_item<false>(src, 256, base + 1024 + 64 * kb, 1536, scr, C.lane); else tr_item<false>(src, 256, base + (size_t)256 * 1536 + 64 * (kb - 8), 1536, scr, C.lane); }
            else tr_item<true>(src, 256, base + (size_t)256 * 1536 + 512 + 64 * kb, 1536, scr, C.lane);
            continue; } r -= 6 * I_R;
        {
            constexpr int PER = 2 * I_SG + I_SD; const int l = r / PER; int s = r % PER;
            if (s < 2 * I_SG) { const int up = s >= I_SG; s -= up * I_SG; const int kb = s >> 2, nb = s & 3, n0 = 64 * nb;
                const float* src = (up ? W.ws_up : W.ws_gate) + ((size_t)l * 1024 + 128 * kb) * 256 + n0;
                tr_item_f8(src, 256, W.WSGU + (size_t)l * (512 * 1024) + (size_t)((n0 >> 7) * 256 + up * 128 + (n0 & 127)) * 1024 + 128 * kb, 1024, (LAS unsigned char*)scr, C.lane); }
            else { s -= 2 * I_SG; const int kb = s >> 4, nb = s & 15;
                tr_item_f8(W.ws_down + ((size_t)l * 256 + 128 * kb) * 1024 + 64 * nb, 1024, W.WSDN + (size_t)l * (1024 * 256) + (size_t)(64 * nb) * 256 + 128 * kb, 256, (LAS unsigned char*)scr, C.lane); }
        }
    }
}
__device__ __forceinline__ void to_f8_rows(const Ctx& C, const float* x, unsigned char* xb8) {
    const size_t n16 = (size_t)T * D / 16;
    for (size_t i = (size_t)C.vcu * NTHR + C.tid; i < n16; i += (size_t)C.G * NTHR) {
        const f32x4 a = *(const GAS f32x4*)(x + 16 * i) * XQ_SCALE, b = *(const GAS f32x4*)(x + 16 * i + 4) * XQ_SCALE, c = *(const GAS f32x4*)(x + 16 * i + 8) * XQ_SCALE, d = *(const GAS f32x4*)(x + 16 * i + 12) * XQ_SCALE;
        v4u o; o.x = pk4_f8(a.x, a.y, a.z, a.w); o.y = pk4_f8(b.x, b.y, b.z, b.w); o.z = pk4_f8(c.x, c.y, c.z, c.w); o.w = pk4_f8(d.x, d.y, d.z, d.w);
        *(GAS v4u*)(xb8 + 16 * i) = o;
    }
}

template <bool COL0> struct EpiF32 {
    static constexpr bool PERM = false, AFTER_DRAIN = false;
    float* out; const float* base; int ldc; float alpha;
    __device__ __forceinline__ void operator()(const pg8::f32x4 (&acc)[2][2][4][2], const pg8::Unit& u, int wr, int wc, int fr, int fq) const {
        const int row0 = u.pm * 256 + wr * 64 + fr, col0 = (COL0 ? 0 : u.pn * 256) + wc * 32 + 4 * fq;
#pragma unroll
        for (int ai = 0; ai < 2; ++ai)
#pragma unroll
            for (int m = 0; m < 4; ++m) { const size_t off = (size_t)(row0 + ai * 128 + m * 16) * ldc + col0;
#pragma unroll
                for (int bj = 0; bj < 2; ++bj)
#pragma unroll
                    for (int n = 0; n < 2; ++n) { f32x4 v = acc[ai][bj][m][n];
                        if (base) { const f32x4 b = *(const GAS f32x4*)(base + off + bj * 128 + n * 16); v = v + b * alpha; }
                        *(GAS f32x4*)(out + off + bj * 128 + n * 16) = v; } }
    }
};
struct EpiQKV {
    static constexpr bool PERM = true, AFTER_DRAIN = false;
    bf16* Qb; size_t split_stride; float scale0; unsigned* norms;
    float* ksum;
    __device__ __forceinline__ void operator()(const pg8::f32x4 (&acc)[2][2][4][2], const pg8::Unit& u, int wr, int wc, int fr, int fq) const {
        asm volatile("" : "+v"(fr), "+v"(fq));
        const int t = u.pn >> 2, colt = (u.pn & 3) * 256;
        constexpr float IS = 1.f / (XQ_SCALE * WQ_SCALE);
        bf16* base = Qb + (size_t)t * split_stride; const float sc = (t == 0 ? scale0 : 1.f) * IS;
        const int row0 = u.pm * 256 + wr * 64 + fr, col0 = colt + wc * 32 + 8 * fq;
        float nmax[2] = {0.f, 0.f};
#pragma unroll
        for (int ai = 0; ai < 2; ++ai)
#pragma unroll
            for (int m = 0; m < 4; ++m) { bf16* rowp = base + (size_t)(row0 + ai * 128 + m * 16) * D + col0;
#pragma unroll
                for (int bj = 0; bj < 2; ++bj) { const f32x4 v0 = acc[ai][bj][m][0] * sc, v1 = acc[ai][bj][m][1] * sc;
                    v4u w; w.x = cvtpk(v0[0], v0[1]); w.y = cvtpk(v0[2], v0[3]); w.z = cvtpk(v1[0], v1[1]); w.w = cvtpk(v1[2], v1[3]);
                    *(GAS v4u*)(rowp + bj * 128) = w;
                    if (t < 2) { float ss = (v0[0] * v0[0] + v0[1] * v0[1]) + (v0[2] * v0[2] + v0[3] * v0[3]) + (v1[0] * v1[0] + v1[1] * v1[1]) + (v1[2] * v1[2] + v1[3] * v1[3]);
                        ss += __shfl_xor(ss, 16); ss += __shfl_xor(ss, 32); nmax[bj] = fmaxf(nmax[bj], ss); } } }
        if (t == 1 && ksum) {
#pragma unroll
            for (int bj = 0; bj < 2; ++bj)
#pragma unroll
                for (int n = 0; n < 2; ++n) { f32x4 cs = (f32x4){0.f, 0.f, 0.f, 0.f};
#pragma unroll
                    for (int ai = 0; ai < 2; ++ai)
#pragma unroll
                        for (int m = 0; m < 4; ++m) cs = cs + acc[ai][bj][m][n];
#pragma unroll
                    for (int i = 0; i < 4; ++i) { float v = cs[i];
#pragma unroll
                        for (int o = 1; o < 16; o <<= 1) v += __shfl_xor(v, o);
                        if (fr == 0) (void)__hip_atomic_fetch_add(ksum + (size_t)u.pm * D + colt + bj * 128 + wc * 32 + 8 * fq + 4 * n + i, v * IS, __ATOMIC_RELAXED, __HIP_MEMORY_SCOPE_AGENT); } }
        }
        if (t < 2) {
#pragma unroll
            for (int bj = 0; bj < 2; ++bj) { float v = nmax[bj];
#pragma unroll
                for (int o = 1; o < 16; o <<= 1) v = fmaxf(v, __shfl_xor(v, o));
                const int head = (u.pn & 3) * 4 + 2 * bj + (wc >> 1), b = u.pm >> 5;
                if (fr == 0 && fq == 0) (void)__hip_atomic_fetch_max(norms + ((b * 16 + head) * 2 + t) * 2 + (wc & 1), __float_as_uint(v * 1.01f), __ATOMIC_RELAXED, __HIP_MEMORY_SCOPE_AGENT); }
        }
    }
};
template <bool F8> struct EpiSwiGLU {
    static constexpr bool PERM = true, AFTER_DRAIN = false;
    void* actp; const float* rowscale;
    __device__ __forceinline__ void operator()(const pg8::f32x4 (&acc)[2][2][4][2], const pg8::Unit& u, int wr, int wc, int fr, int fq) const {
        asm volatile("" : "+v"(fr), "+v"(fq));
        const int row0 = u.pm * 256 + wr * 64 + fr, col0 = (u.pn & 1) * 128 + wc * 32 + 8 * fq;
        const int ln = fr + 16 * fq, src4 = ((ln >> 2) + 16 * (ln & 3)) << 2, srow0 = u.pm * 256 + wr * 64 + (ln >> 2), scol0 = (u.pn & 1) * 128 + wc * 32 + 8 * (ln & 3);
        constexpr float IS = F8 ? 1.f / (XQ_SCALE * WQ_SCALE) : 1.f;
#pragma unroll
        for (int ai = 0; ai < 2; ++ai) if (ai == 0 || !u.hf)
#pragma unroll
            for (int m = 0; m < 4; ++m) { const int row = row0 + ai * 128 + m * 16; const float rs = rowscale ? rowscale[row] : (F8 ? GS_FOLD : 1.f);
                float o[8];
#pragma unroll
                for (int n = 0; n < 2; ++n)
#pragma unroll
                    for (int i = 0; i < 4; ++i) { const float g = acc[ai][0][m][n][i] * IS, up = acc[ai][1][m][n][i];
                        const float sg = g * __builtin_amdgcn_rcpf(1.f + __builtin_amdgcn_exp2f(-g * LOG2E)); o[4 * n + i] = sg * up * rs; }
                if constexpr (F8) { u32x2 w; w.x = pk4_f8(o[0], o[1], o[2], o[3]); w.y = pk4_f8(o[4], o[5], o[6], o[7]);
                    w.x = (unsigned)__builtin_amdgcn_ds_bpermute(src4, (int)w.x); w.y = (unsigned)__builtin_amdgcn_ds_bpermute(src4, (int)w.y);
                    *(GAS u32x2*)((unsigned char*)actp + (size_t)(srow0 + ai * 128 + m * 16) * 256 + scol0) = w; }
                else { v4u w; w.x = cvtpk(o[0], o[1]); w.y = cvtpk(o[2], o[3]); w.z = cvtpk(o[4], o[5]); w.w = cvtpk(o[6], o[7]);
                    *(GAS v4u*)((bf16*)actp + (size_t)row * 256 + col0) = w; } }
    }
};
constexpr float SO_SCALE = 64.f, SO_INV = 1.f / 64.f;
template <bool F8> struct EpiDown {
    static constexpr bool PERM = true, AFTER_DRAIN = false;
    static constexpr float sc = F8 ? SO_SCALE / (AQ_SCALE * WQ_SCALE) : SO_SCALE;
    unsigned char* out;
    __device__ __forceinline__ void operator()(const pg8::f32x4 (&acc)[2][2][4][2], const pg8::Unit& u, int wr, int wc, int fr, int fq) const {
        const int ln = fr + 16 * fq, src4 = ((ln >> 2) + 16 * (ln & 3)) << 2, fr2 = ln >> 2, fq2 = ln & 3;
        const int row0 = u.pm * 256 + wr * 64 + fr2, col0 = (u.pn & 3) * 256 + wc * 32 + 8 * fq2;
#pragma unroll
        for (int ai = 0; ai < 2; ++ai) if (ai == 0 || !u.hf)
#pragma unroll
            for (int m = 0; m < 4; ++m) { unsigned char* rowp = out + (size_t)(row0 + ai * 128 + m * 16) * 1024 + col0;
#pragma unroll
                for (int bj = 0; bj < 2; ++bj) { const f32x4 v0 = acc[ai][bj][m][0] * sc, v1 = acc[ai][bj][m][1] * sc;
                    u32x2 w; w.x = 0u; w.y = 0u;
                    w.x = __builtin_amdgcn_cvt_pk_fp8_f32(v0[0], v0[1], w.x, false); w.x = __builtin_amdgcn_cvt_pk_fp8_f32(v0[2], v0[3], w.x, true);
                    w.y = __builtin_amdgcn_cvt_pk_fp8_f32(v1[0], v1[1], w.y, false); w.y = __builtin_amdgcn_cvt_pk_fp8_f32(v1[2], v1[3], w.y, true);
                    w.x = (unsigned)__builtin_amdgcn_ds_bpermute(src4, (int)w.x); w.y = (unsigned)__builtin_amdgcn_ds_bpermute(src4, (int)w.y);
                    *(GAS u32x2*)(rowp + bj * 128) = w; } }
    }
};
template <int NN> struct PlainOrder {
    int vcu, G, nunits;
    __device__ __forceinline__ bool next(int i, pg8::Unit& u) const { const int idx = vcu + i * G; if (idx >= nunits) return false;
        u.pm = __builtin_amdgcn_readfirstlane(idx / NN); u.pn = __builtin_amdgcn_readfirstlane(idx % NN);
        int z = 0; asm volatile("" : "+s"(z)); u.hf = z;
        return true; }
    __device__ __forceinline__ void a_ready(const pg8::Unit&) const {}
    __device__ __forceinline__ void done(const pg8::Unit&) const {}
};
struct RouterOrder {
    int vcu, G;
    __device__ __forceinline__ bool next(int i, pg8::Unit& u) const { const int idx = vcu + i * G; if (idx >= 256) return false; u.pm = idx; u.pn = idx >> 7; return true; }
    __device__ __forceinline__ void a_ready(const pg8::Unit&) const {}
    __device__ __forceinline__ void done(const pg8::Unit&) const {}
};
template <int SH> struct ExpertOrder {
    int vcu, G; const LAS int* tpre;
    __device__ __forceinline__ bool next(int i, pg8::Unit& u) const {
        const int idx = vcu + i * G, ti = idx >> SH; if (ti >= tpre[NE]) return false;
        int lo = 0, hi = NE;
#pragma unroll
        for (int s = 0; s < 8; ++s) { const int mid = (lo + hi) >> 1; if (tpre[mid] <= ti) lo = mid; else hi = mid; }
        u.pm = __builtin_amdgcn_readfirstlane(ti); u.pn = __builtin_amdgcn_readfirstlane((lo << SH) + (idx & ((1 << SH) - 1)));
        u.hf = __builtin_amdgcn_readfirstlane((tpre[272 + lo] - 256 * (ti - tpre[lo])) <= 128 ? 1 : 0); return true;
    }
    __device__ __forceinline__ void a_ready(const pg8::Unit&) const {}
    __device__ __forceinline__ void done(const pg8::Unit&) const {}
};
__device__ __forceinline__ void build_tpre(const Ctx& C, const unsigned* ecnt) {
    LAS int* tpre = (LAS int*)(C.lds + TPRE_OFF);
    __syncthreads();
    int v = 0;
    if (C.tid < NE) { const int c = (int)__hip_atomic_load(ecnt + C.tid, __ATOMIC_RELAXED, __HIP_MEMORY_SCOPE_AGENT); v = (c + 255) >> 8; tpre[272 + C.tid] = c; }
    int inc = v;
#pragma unroll
    for (int o = 1; o < 64; o <<= 1) { const int t = __shfl_up(inc, o); if (C.lane >= o) inc += t; }
    if (C.tid < NE && C.lane == 63) tpre[260 + C.wave] = inc;
    __syncthreads();
    if (C.tid < NE) { int base = 0; for (int w = 0; w < C.wave; ++w) base += tpre[260 + w]; tpre[C.tid + 1] = base + inc; if (C.tid == 0) tpre[0] = 0; }
    __syncthreads();
}
struct AttnAcc { float m; f32x16 o0, o1, la; };
#define MFMA32(a, b, c) __builtin_amdgcn_mfma_f32_32x32x16_bf16((a), (b), (c), 0, 0, 0)
constexpr float NEG_INF = -__builtin_inff();

__device__ __forceinline__ void glds16(const void* gsrc, unsigned lds_dst) { unsigned keep;
    asm volatile("s_mov_b32 %0, m0\n\ts_mov_b32 m0, %2\n\ts_nop 0\n\tglobal_load_lds_dwordx4 %1, off\n\ts_mov_b32 m0, %0" : "=&s"(keep) : "v"(gsrc), "s"(lds_dst) : "memory"); }
__device__ __forceinline__ void glds4(const void* gsrc, unsigned lds_dst) { unsigned keep;
    asm volatile("s_mov_b32 %0, m0\n\ts_mov_b32 m0, %2\n\ts_nop 0\n\tglobal_load_lds_dword %1, off\n\ts_mov_b32 m0, %0" : "=&s"(keep) : "v"(gsrc), "s"(lds_dst) : "memory"); }
__device__ __forceinline__ unsigned lds_addr(const LAS unsigned char* p) { return (unsigned)__builtin_amdgcn_readfirstlane((int)(unsigned)(uintptr_t)p); }
__device__ __forceinline__ void dma_tile(const bf16* Kg, const bf16* Vg, LAS unsigned char* Ks, LAS unsigned char* Vs, int wave, int lane) {
    glds16(Kg + (size_t)lane * D + wave * 8, lds_addr(Ks + wave * 1024));
    glds16(Vg + (size_t)(16 * (wave & 3) + (lane >> 2)) * D + (wave >> 2) * 32 + (lane & 3) * 8, lds_addr(Vs + wave * 1024));
}
__device__ __forceinline__ void load_q(bf16x8 (&qr)[4], const bf16* Qrow, int hi) {
#pragma unroll
    for (int d0 = 0; d0 < 4; ++d0) qr[d0] = *(const GAS bf16x8*)(Qrow + d0 * 16 + hi * 8);
}
template <class Bias> __device__ __forceinline__ void qk_tile(f32x16& p0, f32x16& p1, const bf16x8 (&qr)[4], const LAS unsigned char* Ks, int r32, int hi, const Bias& B) {
    __builtin_amdgcn_sched_barrier(0);
    B.init(p0, p1, hi);
    const LAS unsigned char* kb = Ks + hi * 1024 + r32 * 16;
    bf16x8 kf[8];
#pragma unroll
    for (int d0 = 0; d0 < 4; ++d0) { kf[2 * d0] = *(const LAS bf16x8*)(kb + d0 * 2048); kf[2 * d0 + 1] = *(const LAS bf16x8*)(kb + d0 * 2048 + 512); }
    __builtin_amdgcn_sched_barrier(0);
#pragma unroll
    for (int d0 = 0; d0 < 4; ++d0) { p0 = MFMA32(kf[2 * d0], qr[d0], p0); p1 = MFMA32(kf[2 * d0 + 1], qr[d0], p1); }
    B.mask(p0, p1, hi);
    __builtin_amdgcn_sched_barrier(0);
}
constexpr float ATT_THR = 8.f;
__device__ __forceinline__ float half_max(float m) { auto rr = __builtin_amdgcn_permlane32_swap(__float_as_uint(m), __float_as_uint(m), false, false); return fmaxf(__uint_as_float(rr[0]), __uint_as_float(rr[1])); }
__device__ __forceinline__ void attn_rescale(AttnAcc& A, float rm) {
    const bool need = rm > A.m + ATT_THR;
    if (__any(need)) {
        const float mn = need ? rm : A.m, f = __builtin_amdgcn_exp2f(A.m - mn);
        A.la[0] *= f;
#pragma unroll
        for (int r = 0; r < 16; ++r) { A.o0[r] *= f; A.o1[r] *= f; }
        A.m = mn;
    }
}
__device__ __forceinline__ void softmax_pv(AttnAcc& A, f32x16& p0, f32x16& p1, const LAS unsigned char* Vs, int hi, int lane) {
    __builtin_amdgcn_sched_barrier(0);
    const LAS unsigned char* vb = Vs + ((lane >> 4) & 1) * 32 + (lane & 3) * 8 + (4 * hi + ((lane & 15) >> 2)) * 64;
    s16x4 vt[16];
#pragma unroll
    for (int ks = 0; ks < 4; ++ks) { vt[4 * ks] = vtr(vb + ks * 1024); vt[4 * ks + 1] = vtr(vb + ks * 1024 + 512); vt[4 * ks + 2] = vtr(vb + (4 + ks) * 1024); vt[4 * ks + 3] = vtr(vb + (4 + ks) * 1024 + 512); }
    __builtin_amdgcn_sched_barrier(0);
    float rm = fmaxf(p0[0], p1[0]);
#pragma unroll
    for (int r = 1; r < 16; ++r) rm = fmaxf(fmaxf(rm, p0[r]), p1[r]);
    rm = half_max(rm);
    attn_rescale(A, rm);
    const float mn = A.m;
#pragma unroll
    for (int r = 0; r < 16; ++r) { p0[r] = __builtin_amdgcn_exp2f(p0[r] - mn); p1[r] = __builtin_amdgcn_exp2f(p1[r] - mn); }
    v4u pw[4];
#pragma unroll
    for (int s = 0; s < 2; ++s) {
        pw[s].x = cvtpk(p0[8 * s + 0], p0[8 * s + 1]); pw[s].y = cvtpk(p0[8 * s + 2], p0[8 * s + 3]); pw[s].z = cvtpk(p0[8 * s + 4], p0[8 * s + 5]); pw[s].w = cvtpk(p0[8 * s + 6], p0[8 * s + 7]);
        pw[2 + s].x = cvtpk(p1[8 * s + 0], p1[8 * s + 1]); pw[2 + s].y = cvtpk(p1[8 * s + 2], p1[8 * s + 3]); pw[2 + s].z = cvtpk(p1[8 * s + 4], p1[8 * s + 5]); pw[2 + s].w = cvtpk(p1[8 * s + 6], p1[8 * s + 7]);
    }
    const bf16x8 ones = {(short)0x3F80, (short)0x3F80, (short)0x3F80, (short)0x3F80, (short)0x3F80, (short)0x3F80, (short)0x3F80, (short)0x3F80};
#pragma unroll
    for (int ks = 0; ks < 4; ++ks) {
        const bf16x8 pa = __builtin_bit_cast(bf16x8, pw[ks]);
        const s16x4 a0 = vt[4 * ks], a1 = vt[4 * ks + 1], b0 = vt[4 * ks + 2], b1 = vt[4 * ks + 3];
        const bf16x8 v0 = {a0[0], a0[1], a0[2], a0[3], a1[0], a1[1], a1[2], a1[3]}, v1 = {b0[0], b0[1], b0[2], b0[3], b1[0], b1[1], b1[2], b1[3]};
        A.o0 = MFMA32(v0, pa, A.o0); A.o1 = MFMA32(v1, pa, A.o1); A.la = MFMA32(ones, pa, A.la);
    }
    __builtin_amdgcn_sched_barrier(0);
}
__device__ __forceinline__ void acc_init(AttnAcc& A) {
    A.m = NEG_INF;
    float z = 0.f; asm volatile("" : "+v"(z));
#pragma unroll
    for (int r = 0; r < 16; ++r) { A.o0[r] = z; A.o1[r] = z; A.la[r] = z; }
}
#define ATT_SB() __builtin_amdgcn_sched_barrier(0)
template <class Bias> __device__ __forceinline__ void attn_step(AttnAcc& A, f32x16& pc0, f32x16& pc1, f32x16& pn0, f32x16& pn1, const bf16x8 (&qr)[4],
                                                               const LAS unsigned char* Kn, const LAS unsigned char* Vc, int r32, int hi, int lane, const Bias& Bn, const bool doNext) {
    ATT_SB();
    if (doNext) Bn.init(pn0, pn1, hi);
    const LAS unsigned char* kb = Kn + hi * 1024 + r32 * 16;
    bf16x8 ka[4], kc[4];
#pragma unroll
    for (int d0 = 0; d0 < 2; ++d0) { ka[2 * d0] = *(const LAS bf16x8*)(kb + d0 * 2048); ka[2 * d0 + 1] = *(const LAS bf16x8*)(kb + d0 * 2048 + 512); }
    ATT_SB();
    float ra = fmaxf(fmaxf(pc0[0], pc0[1]), fmaxf(pc0[2], pc0[3]));
    if (doNext) pn0 = MFMA32(ka[0], qr[0], pn0);
    ra = fmaxf(fmaxf(ra, pc1[0]), pc1[1]); ra = fmaxf(fmaxf(ra, pc1[2]), pc1[3]); ATT_SB();
    if (doNext) pn1 = MFMA32(ka[1], qr[0], pn1);
#pragma unroll
    for (int d0 = 2; d0 < 4; ++d0) { kc[2 * d0 - 4] = *(const LAS bf16x8*)(kb + d0 * 2048); kc[2 * d0 - 3] = *(const LAS bf16x8*)(kb + d0 * 2048 + 512); }
    ra = fmaxf(fmaxf(ra, pc0[4]), pc0[5]); ra = fmaxf(fmaxf(ra, pc0[6]), pc0[7]); ra = fmaxf(fmaxf(ra, pc1[4]), pc1[5]); ra = fmaxf(fmaxf(ra, pc1[6]), pc1[7]); ATT_SB();
    if (doNext) pn0 = MFMA32(ka[2], qr[1], pn0);
    ra = fmaxf(fmaxf(ra, pc0[8]), pc0[9]); ra = fmaxf(fmaxf(ra, pc0[10]), pc0[11]); ra = fmaxf(fmaxf(ra, pc1[8]), pc1[9]); ra = fmaxf(fmaxf(ra, pc1[10]), pc1[11]); ATT_SB();
    if (doNext) pn1 = MFMA32(ka[3], qr[1], pn1);
    ra = fmaxf(fmaxf(ra, pc0[12]), pc0[13]); ra = fmaxf(fmaxf(ra, pc0[14]), pc0[15]); ra = fmaxf(fmaxf(ra, pc1[12]), pc1[13]); ra = fmaxf(fmaxf(ra, pc1[14]), pc1[15]);
    ra = half_max(ra); ATT_SB();
    attn_rescale(A, ra);
    const float mn = A.m;
    ATT_SB();
    const LAS unsigned char* vb = Vc + ((lane >> 4) & 1) * 32 + (lane & 3) * 8 + (4 * hi + ((lane & 15) >> 2)) * 64;
    s16x4 vt[16];
    v4u pw[4];
#define ATT_VRD(ks) do { vt[4 * (ks)] = vtr(vb + (ks) * 1024); vt[4 * (ks) + 1] = vtr(vb + (ks) * 1024 + 512); vt[4 * (ks) + 2] = vtr(vb + (4 + (ks)) * 1024); vt[4 * (ks) + 3] = vtr(vb + (4 + (ks)) * 1024 + 512); } while (0)
#define ATT_EXP4(P, c) do { _Pragma("unroll") for (int i_ = 0; i_ < 4; ++i_) P[4 * (c) + i_] = __builtin_amdgcn_exp2f(P[4 * (c) + i_] - mn); } while (0)
    ATT_VRD(0); ATT_VRD(1); ATT_SB();
    if (doNext) pn0 = MFMA32(kc[0], qr[2], pn0); ATT_EXP4(pc0, 0); ATT_EXP4(pc0, 1);
    pw[0].x = cvtpk(pc0[0], pc0[1]); pw[0].y = cvtpk(pc0[2], pc0[3]); pw[0].z = cvtpk(pc0[4], pc0[5]); pw[0].w = cvtpk(pc0[6], pc0[7]); ATT_SB();
    if (doNext) pn1 = MFMA32(kc[1], qr[2], pn1); ATT_EXP4(pc0, 2); ATT_EXP4(pc0, 3);
    pw[1].x = cvtpk(pc0[8], pc0[9]); pw[1].y = cvtpk(pc0[10], pc0[11]); pw[1].z = cvtpk(pc0[12], pc0[13]); pw[1].w = cvtpk(pc0[14], pc0[15]); ATT_SB();
    ATT_VRD(2); ATT_VRD(3); ATT_SB();
    if (doNext) pn0 = MFMA32(kc[2], qr[3], pn0); ATT_EXP4(pc1, 0); ATT_EXP4(pc1, 1);
    pw[2].x = cvtpk(pc1[0], pc1[1]); pw[2].y = cvtpk(pc1[2], pc1[3]); pw[2].z = cvtpk(pc1[4], pc1[5]); pw[2].w = cvtpk(pc1[6], pc1[7]); ATT_SB();
    if (doNext) pn1 = MFMA32(kc[3], qr[3], pn1); ATT_EXP4(pc1, 2); ATT_EXP4(pc1, 3);
    pw[3].x = cvtpk(pc1[8], pc1[9]); pw[3].y = cvtpk(pc1[10], pc1[11]); pw[3].z = cvtpk(pc1[12], pc1[13]); pw[3].w = cvtpk(pc1[14], pc1[15]); ATT_SB();
#undef ATT_EXP4
#undef ATT_VRD
    if (doNext) Bn.mask(pn0, pn1, hi);
    ATT_SB();
    const bf16x8 ones = {(short)0x3F80, (short)0x3F80, (short)0x3F80, (short)0x3F80, (short)0x3F80, (short)0x3F80, (short)0x3F80, (short)0x3F80};
#pragma unroll
    for (int ks = 0; ks < 4; ++ks) {
        const bf16x8 pa = __builtin_bit_cast(bf16x8, pw[ks]);
        const s16x4 a0 = vt[4 * ks], a1 = vt[4 * ks + 1], b0 = vt[4 * ks + 2], b1 = vt[4 * ks + 3];
        const bf16x8 v0 = {a0[0], a0[1], a0[2], a0[3], a1[0], a1[1], a1[2], a1[3]}, v1 = {b0[0], b0[1], b0[2], b0[3], b1[0], b1[1], b1[2], b1[3]};
        A.o0 = MFMA32(v0, pa, A.o0); A.o1 = MFMA32(v1, pa, A.o1); A.la = MFMA32(ones, pa, A.la);
    }
    ATT_SB();
}

template <class Bias> __device__ __forceinline__ void attn_step3(AttnAcc& A, f32x16& pc0, f32x16& pc1, f32x16& pn0, f32x16& pn1, const v4u (&pwp)[4], v4u (&pw)[4], const bf16x8 (&qr)[4],
        const LAS unsigned char* Kn, const LAS unsigned char* Vp, int r32, int hi, int lane, const Bias& Bn, const bool doCur) {
    const bf16x8 ones = {(short)0x3F80, (short)0x3F80, (short)0x3F80, (short)0x3F80, (short)0x3F80, (short)0x3F80, (short)0x3F80, (short)0x3F80};
    const LAS unsigned char* kb = Kn + hi * 1024 + r32 * 16;
    const LAS unsigned char* vb = Vp + ((lane >> 4) & 1) * 32 + (lane & 3) * 8 + (4 * hi + ((lane & 15) >> 2)) * 64;
    bf16x8 ka[2], kc[2]; s16x4 va[4], vc[4], vd[4], ve[4];
#define ATT_VRD(dst, ks) do { dst[0] = vtr(vb + (ks) * 1024); dst[1] = vtr(vb + (ks) * 1024 + 512); dst[2] = vtr(vb + (4 + (ks)) * 1024); dst[3] = vtr(vb + (4 + (ks)) * 1024 + 512); } while (0)
#define ATT_V0(v) ((bf16x8){v[0][0], v[0][1], v[0][2], v[0][3], v[1][0], v[1][1], v[1][2], v[1][3]})
#define ATT_V1(v) ((bf16x8){v[2][0], v[2][1], v[2][2], v[2][3], v[3][0], v[3][1], v[3][2], v[3][3]})
#define ATT_PA(k) __builtin_bit_cast(bf16x8, pwp[k])
#define ATT_PIN(x) asm volatile("" : "+v"(x))
    ATT_SB();
    Bn.init(pn0, pn1, hi);
    ka[0] = *(const LAS bf16x8*)(kb); ka[1] = *(const LAS bf16x8*)(kb + 512); kc[0] = *(const LAS bf16x8*)(kb + 2048); kc[1] = *(const LAS bf16x8*)(kb + 2560);
    ATT_VRD(va, 0);
    ATT_SB();
    float ra = fmaxf(fmaxf(pc0[0], pc0[1]), fmaxf(pc0[2], pc0[3]));
    pn0 = MFMA32(ka[0], qr[0], pn0);
    A.o0 = MFMA32(ATT_V0(va), ATT_PA(0), A.o0);
    ra = fmaxf(fmaxf(ra, pc1[0]), pc1[1]); ra = fmaxf(fmaxf(ra, pc1[2]), pc1[3]); ra = fmaxf(fmaxf(ra, pc0[4]), pc0[5]); ra = fmaxf(fmaxf(ra, pc0[6]), pc0[7]); ATT_PIN(ra);
    ATT_VRD(vc, 1);
    ATT_SB();
    pn1 = MFMA32(ka[1], qr[0], pn1);
    A.o1 = MFMA32(ATT_V1(va), ATT_PA(0), A.o1);
    ra = fmaxf(fmaxf(ra, pc1[4]), pc1[5]); ra = fmaxf(fmaxf(ra, pc1[6]), pc1[7]); ra = fmaxf(fmaxf(ra, pc0[8]), pc0[9]); ra = fmaxf(fmaxf(ra, pc0[10]), pc0[11]); ATT_PIN(ra);
    ka[0] = *(const LAS bf16x8*)(kb + 4096); ka[1] = *(const LAS bf16x8*)(kb + 4608);
    ATT_SB();
    pn0 = MFMA32(kc[0], qr[1], pn0);
    A.la = MFMA32(ones, ATT_PA(0), A.la); A.o0 = MFMA32(ATT_V0(vc), ATT_PA(1), A.o0);
    ATT_VRD(vd, 2);
    ra = fmaxf(fmaxf(ra, pc1[8]), pc1[9]); ra = fmaxf(fmaxf(ra, pc1[10]), pc1[11]); ra = fmaxf(fmaxf(ra, pc0[12]), pc0[13]); ra = fmaxf(fmaxf(ra, pc0[14]), pc0[15]); ATT_PIN(ra); ATT_SB();
    pn1 = MFMA32(kc[1], qr[1], pn1);
    A.o1 = MFMA32(ATT_V1(vc), ATT_PA(1), A.o1); A.la = MFMA32(ones, ATT_PA(1), A.la);
    ATT_VRD(ve, 3);
    kc[0] = *(const LAS bf16x8*)(kb + 6144); kc[1] = *(const LAS bf16x8*)(kb + 6656);
    ra = fmaxf(fmaxf(ra, pc1[12]), pc1[13]); ra = fmaxf(fmaxf(ra, pc1[14]), pc1[15]); ra = half_max(ra);
    const bool need = doCur && (ra > A.m + ATT_THR);
    float mn = need ? ra : A.m; const float fr = __builtin_amdgcn_exp2f(A.m - mn); ATT_PIN(mn);
    ATT_SB();
#define ATT_EXP4(P, c) do { _Pragma("unroll") for (int i_ = 0; i_ < 4; ++i_) P[4 * (c) + i_] = __builtin_amdgcn_exp2f(P[4 * (c) + i_] - mn); } while (0)
    pn0 = MFMA32(ka[0], qr[2], pn0);
    A.o0 = MFMA32(ATT_V0(vd), ATT_PA(2), A.o0);
    { ATT_EXP4(pc0, 0); ATT_EXP4(pc0, 1); pw[0].x = cvtpk(pc0[0], pc0[1]); pw[0].y = cvtpk(pc0[2], pc0[3]); pw[0].z = cvtpk(pc0[4], pc0[5]); pw[0].w = cvtpk(pc0[6], pc0[7]); ATT_PIN(pw[0]); }
    ATT_SB();
    pn1 = MFMA32(ka[1], qr[2], pn1);
    A.o1 = MFMA32(ATT_V1(vd), ATT_PA(2), A.o1);
    { ATT_EXP4(pc0, 2); ATT_EXP4(pc0, 3); pw[1].x = cvtpk(pc0[8], pc0[9]); pw[1].y = cvtpk(pc0[10], pc0[11]); pw[1].z = cvtpk(pc0[12], pc0[13]); pw[1].w = cvtpk(pc0[14], pc0[15]); ATT_PIN(pw[1]); }
    ATT_SB();
    pn0 = MFMA32(kc[0], qr[3], pn0);
    A.la = MFMA32(ones, ATT_PA(2), A.la); A.o0 = MFMA32(ATT_V0(ve), ATT_PA(3), A.o0);
    { ATT_EXP4(pc1, 0); ATT_EXP4(pc1, 1); pw[2].x = cvtpk(pc1[0], pc1[1]); pw[2].y = cvtpk(pc1[2], pc1[3]); pw[2].z = cvtpk(pc1[4], pc1[5]); pw[2].w = cvtpk(pc1[6], pc1[7]); ATT_PIN(pw[2]); }
    ATT_SB();
    pn1 = MFMA32(kc[1], qr[3], pn1);
    A.o1 = MFMA32(ATT_V1(ve), ATT_PA(3), A.o1); A.la = MFMA32(ones, ATT_PA(3), A.la);
    { ATT_EXP4(pc1, 2); ATT_EXP4(pc1, 3); pw[3].x = cvtpk(pc1[8], pc1[9]); pw[3].y = cvtpk(pc1[10], pc1[11]); pw[3].z = cvtpk(pc1[12], pc1[13]); pw[3].w = cvtpk(pc1[14], pc1[15]); ATT_PIN(pw[3]); }
    ATT_SB();
#undef ATT_EXP4
#undef ATT_VRD
#undef ATT_V0
#undef ATT_V1
#undef ATT_PA
#undef ATT_PIN
    Bn.mask(pn0, pn1, hi);
    if (__any(need)) {
        A.la[0] *= fr;
#pragma unroll
        for (int r = 0; r < 16; ++r) { A.o0[r] *= fr; A.o1[r] *= fr; }
    }
    A.m = mn;
    ATT_SB();
}

__device__ __forceinline__ void swap32(unsigned x, unsigned y, unsigned& r0, unsigned& r1) { auto rr = __builtin_amdgcn_permlane32_swap(x, y, false, false); r0 = rr[0]; r1 = rr[1]; }
__device__ __forceinline__ void store_o(bf16* op, const AttnAcc& A, float inv, int hi) {
#pragma unroll
    for (int p = 0; p < 2; ++p) {
#pragma unroll
        for (int s = 0; s < 2; ++s) { const f32x16& o = s ? A.o1 : A.o0; const int g0 = 2 * p, g1 = 2 * p + 1;
            const unsigned xa = cvtpk(o[4 * g0] * inv, o[4 * g0 + 1] * inv), xb = cvtpk(o[4 * g0 + 2] * inv, o[4 * g0 + 3] * inv), ya = cvtpk(o[4 * g1] * inv, o[4 * g1 + 1] * inv), yb = cvtpk(o[4 * g1 + 2] * inv, o[4 * g1 + 3] * inv);
            unsigned w0, w1, w2, w3; swap32(xa, ya, w0, w2); swap32(xb, yb, w1, w3); v4u w; w.x = w0; w.y = w1; w.z = w2; w.w = w3;
            *(GAS v4u*)(op + 32 * s + 16 * p + 8 * hi) = w; } }
}

__device__ __forceinline__ void store_o8(unsigned char* op, const AttnAcc& A, float inv, int hi) {
    const float sc = inv * OQ_SCALE;
#pragma unroll
    for (int p = 0; p < 2; ++p) {
#pragma unroll
        for (int s = 0; s < 2; ++s) { const f32x16& o = s ? A.o1 : A.o0; const int g0 = 2 * p, g1 = 2 * p + 1;
            const unsigned x = pk4_f8(o[4 * g0] * sc, o[4 * g0 + 1] * sc, o[4 * g0 + 2] * sc, o[4 * g0 + 3] * sc), y = pk4_f8(o[4 * g1] * sc, o[4 * g1 + 1] * sc, o[4 * g1 + 2] * sc, o[4 * g1 + 3] * sc);
            unsigned w0, w1; swap32(x, y, w0, w1); u32x2 w; w.x = w0; w.y = w1;
            *(GAS u32x2*)(op + 32 * s + 16 * p + 8 * hi) = w; } }
}

__device__ __forceinline__ int rel_bucket(int n) {
    if (n < 16) return n;
    int b = 16;
    b += (n >= 19); b += (n >= 21); b += (n >= 24); b += (n >= 27); b += (n >= 31); b += (n >= 35); b += (n >= 40); b += (n >= 46);
    b += (n >= 52); b += (n >= 59); b += (n >= 67); b += (n >= 77); b += (n >= 87); b += (n >= 99); b += (n >= 113);
    return b;
}
__device__ __forceinline__ void build_relb(const Ctx& C, const float* rel_bias, LAS float* relb) {
    for (int i = C.tid; i < H * 128; i += NTHR) { const int h = i >> 7, n = i & 127; relb[i] = rel_bias[rel_bucket(n) * H + h] * LOG2E; }
}
struct MobaBias {
    const LAS float* relb; int qpos, kpos0; bool lookup, causal; float cbias;
    __device__ __forceinline__ void init(f32x16& p0, f32x16& p1, int hi) const {
        if (lookup) {
            int dbase = qpos - kpos0 - 4 * hi; asm volatile("" : "+v"(dbase));
#pragma unroll
            for (int r = 0; r < 16; ++r) { const int d0 = dbase - ((r & 3) + 8 * (r >> 2)), d1 = d0 - 32;
                const int i0 = d0 < 0 ? 0 : (d0 > 127 ? 127 : d0), i1 = d1 < 0 ? 0 : (d1 > 127 ? 127 : d1);
                p0[r] = relb[i0]; p1[r] = relb[i1];
                if ((r & 3) == 3) __builtin_amdgcn_sched_barrier(0); }
        } else {
#pragma unroll
            for (int r = 0; r < 16; ++r) { p0[r] = cbias; p1[r] = cbias; }
        }
    }
    __device__ __forceinline__ void mask(f32x16& p0, f32x16& p1, int hi) const {
        if (causal) {
            int d = qpos - kpos0 - 4 * hi; asm volatile("" : "+v"(d));
#pragma unroll
            for (int r = 0; r < 16; ++r) { const int c = (r & 3) + 8 * (r >> 2); if (c > d) p0[r] = NEG_INF; if (c + 32 > d) p1[r] = NEG_INF; }
        }
    }
};
struct FoxBias {
    const LAS float* cb; int qrel, krel0; bool causal;
    __device__ __forceinline__ void init(f32x16& p0, f32x16& p1, int hi) const {
#pragma unroll
        for (int g = 0; g < 4; ++g) { const f32x4 c0 = *(const LAS f32x4*)(cb + 8 * g + 4 * hi), c1 = *(const LAS f32x4*)(cb + 32 + 8 * g + 4 * hi);
#pragma unroll
            for (int i = 0; i < 4; ++i) { p0[4 * g + i] = c0[i]; p1[4 * g + i] = c1[i]; } }
    }
    __device__ __forceinline__ void mask(f32x16& p0, f32x16& p1, int hi) const {
        if (causal) {
            int d = qrel - krel0 - 4 * hi; asm volatile("" : "+v"(d));
#pragma unroll
            for (int r = 0; r < 16; ++r) { const int c = (r & 3) + 8 * (r >> 2); if (c > d) p0[r] = NEG_INF; if (c + 32 > d) p1[r] = NEG_INF; }
        }
    }
};

__device__ __forceinline__ int mlist_off(int j) { return 256 * (31 * j - (j * (j - 1)) / 2); }
#define INS3(s_, j_) do { const float s__ = (s_); const int j__ = (j_); \
    if (s__ > sv0 || (s__ == sv0 && j__ < sel0)) { sv2 = sv1; sel2 = sel1; sv1 = sv0; sel1 = sel0; sv0 = s__; sel0 = j__; } \
    else if (s__ > sv1 || (s__ == sv1 && j__ < sel1)) { sv2 = sv1; sel2 = sel1; sv1 = s__; sel1 = j__; } \
    else if (s__ > sv2 || (s__ == sv2 && j__ < sel2)) { sv2 = s__; sel2 = j__; } } while (0)
__device__ __forceinline__ void ph_select(const Ctx& C, const bf16* Q, const float* ksum, unsigned* mcnt, unsigned* mlist) {
    LAS float* km = (LAS float*)C.lds;
    LAS unsigned* lcnt = (LAS unsigned*)(C.lds + 8192);
    const int lane = C.lane, wave = C.wave, r32 = lane & 31, hi = lane >> 5;
    for (int u = C.vcu; u < BATCH * H * 31; u += C.G) {
        const int bh = u / 31, own = 1 + u % 31, b = bh >> 4, h = bh & 15;
        __syncthreads();
        for (int i = C.tid; i < 32 * 64; i += NTHR) km[i] = ksum[(size_t)(b * NBLK + (i >> 6)) * D + h * 64 + (i & 63)];
        if (C.tid < 64) lcnt[C.tid] = 0u;
        bf16x8 qr[4]; load_q(qr, Q + (size_t)(b * SEQ + own * 256 + wave * 32 + r32) * D + h * 64, hi);
        __syncthreads();
        f32x16 sc; { float z = 0.f; asm volatile("" : "+v"(z));
#pragma unroll
        for (int r = 0; r < 16; ++r) sc[r] = z; }
#pragma unroll
        for (int d0 = 0; d0 < 4; ++d0) {
            const f32x4 x0 = *(const LAS f32x4*)(km + r32 * 64 + 16 * d0 + 8 * hi), x1 = *(const LAS f32x4*)(km + r32 * 64 + 16 * d0 + 8 * hi + 4);
            v4u wh, wl; wh.x = cvtpk(x0.x, x0.y); wh.y = cvtpk(x0.z, x0.w); wh.z = cvtpk(x1.x, x1.y); wh.w = cvtpk(x1.z, x1.w);
            wl.x = cvtpk(x0.x - bflo(wh.x), x0.y - bfhi(wh.x)); wl.y = cvtpk(x0.z - bflo(wh.y), x0.w - bfhi(wh.y)); wl.z = cvtpk(x1.x - bflo(wh.z), x1.y - bfhi(wh.z)); wl.w = cvtpk(x1.z - bflo(wh.w), x1.w - bfhi(wh.w));
            sc = MFMA32(__builtin_bit_cast(bf16x8, wh), qr[d0], sc); sc = MFMA32(__builtin_bit_cast(bf16x8, wl), qr[d0], sc);
        }
        float sv0 = NEG_INF, sv1 = NEG_INF, sv2 = NEG_INF; int sel0 = 64, sel1 = 64, sel2 = 64;
#pragma unroll
        for (int r = 0; r < 16; ++r) { const int j = (r & 3) + 8 * (r >> 2) + 4 * hi; if (j < own) INS3(sc[r], j); }
        {
            const float pv0 = __shfl_xor(sv0, 32), pv1 = __shfl_xor(sv1, 32), pv2 = __shfl_xor(sv2, 32);
            const int p0 = __shfl_xor(sel0, 32), p1 = __shfl_xor(sel1, 32), p2 = __shfl_xor(sel2, 32);
            if (p0 < 64) INS3(pv0, p0);
            if (p1 < 64) INS3(pv1, p1);
            if (p2 < 64) INS3(pv2, p2); }
        const int nv = own < 3 ? own : 3; int rk0 = 0, rk1 = 0, rk2 = 0;
        if (hi == 0) {
            rk0 = (int)__hip_atomic_fetch_add(&lcnt[sel0], 1u, __ATOMIC_RELAXED, __HIP_MEMORY_SCOPE_WORKGROUP);
            if (nv > 1) rk1 = (int)__hip_atomic_fetch_add(&lcnt[sel1], 1u, __ATOMIC_RELAXED, __HIP_MEMORY_SCOPE_WORKGROUP);
            if (nv > 2) rk2 = (int)__hip_atomic_fetch_add(&lcnt[sel2], 1u, __ATOMIC_RELAXED, __HIP_MEMORY_SCOPE_WORKGROUP);
        }
        __syncthreads();
        if (C.tid < 32) { const unsigned c = lcnt[C.tid]; if (c) lcnt[32 + C.tid] = __hip_atomic_fetch_add(mcnt + bh * 32 + C.tid, c, __ATOMIC_RELAXED, __HIP_MEMORY_SCOPE_AGENT); }
        __syncthreads();
        if (hi == 0) {
            unsigned* lst = mlist + (size_t)bh * MLIST_PER_BH; const unsigned tl = (unsigned)(own * 256 + wave * 32 + r32);
            lst[mlist_off(sel0) + lcnt[32 + sel0] + rk0] = tl;
            if (nv > 1) lst[mlist_off(sel1) + lcnt[32 + sel1] + rk1] = tl | (1u << 16);
            if (nv > 2) lst[mlist_off(sel2) + lcnt[32 + sel2] + rk2] = tl | (2u << 16);
        }
    }
}
constexpr int RELB_OFF = 131072;
constexpr int PRE_OFF = 139264;
constexpr int UINFO_OFF = 147456;
static_assert(PRE_OFF + 2080 * 4 <= LDSCTL_OFF && UINFO_OFF + 64 <= LDSCTL_OFF && 4 * 33280 <= UINFO_OFF, "attention LDS map");

__device__ __forceinline__ int part_next(int u, int uw, int usb, int per) { const int k = (u - usb) % per; return (k + 1 < uw) ? u + 1 : u - k + per; }
__device__ __forceinline__ void ph_moba_part(const Ctx& C, const bf16* Q, const bf16* K, const bf16* V, const float* rel_bias, const unsigned* mcnt, const unsigned* mlist, bf16* parto, float* partml, const int uw, const int usb, const int per) {
    if (C.wave >= 4) __builtin_amdgcn_s_setprio(1);
    LAS float* relb = (LAS float*)(C.lds + RELB_OFF);
    LAS int* pre = (LAS int*)(C.lds + PRE_OFF);
    const int lane = C.lane, wave = C.wave, r32 = lane & 31, hi = lane >> 5;
    __syncthreads();
    build_relb(C, rel_bias, relb);
    {   int v[4], s = 0;
#pragma unroll
        for (int i = 0; i < 4; ++i) { v[i] = (int)((__hip_atomic_load(mcnt + 4 * C.tid + i, __ATOMIC_RELAXED, __HIP_MEMORY_SCOPE_AGENT) + 255u) >> 8); s += v[i]; }
        int inc = s;
#pragma unroll
        for (int o = 1; o < 64; o <<= 1) { const int t = __shfl_up(inc, o); if (lane >= o) inc += t; }
        if (lane == 63) pre[2056 + wave] = inc;
        __syncthreads();
        int base = 0; for (int w = 0; w < wave; ++w) base += pre[2056 + w];
        const int ex = base + inc - s;
        pre[4 * C.tid] = ex; pre[4 * C.tid + 1] = ex + v[0]; pre[4 * C.tid + 2] = ex + v[0] + v[1]; pre[4 * C.tid + 3] = ex + v[0] + v[1] + v[2];
        if (C.tid == NTHR - 1) pre[2048] = ex + s;
        __syncthreads();
    }
    const int total = pre[2048];
    int u = usb, cur = 0, idx = 0;
    if (u < total) {
        int lo = 0, hi_ = 2048;
#pragma unroll
        for (int s = 0; s < 11; ++s) { const int mid = (lo + hi_) >> 1; if (pre[mid] <= u) lo = mid; else hi_ = mid; }
        idx = lo;
        const int bh = idx >> 5, j = idx & 31, b = bh >> 4, h = bh & 15;
        const bf16* Kg = K + (size_t)(b * SEQ + j * 256) * D + h * 64; const bf16* Vg = V + (size_t)(b * SEQ + j * 256) * D + h * 64;
#pragma unroll
        for (int t4 = 0; t4 < 4; ++t4) dma_tile(Kg + (size_t)t4 * 64 * D, Vg + (size_t)t4 * 64 * D, C.lds + t4 * 8192, C.lds + 32768 + t4 * 8192, wave, lane);
    }
    unsigned ent = 0u, ent_n = 0u; bool valid = false, valid_n = false;
    if (u < total) { const int bh = idx >> 5, j = idx & 31, chunk = u - pre[idx]; const int n = (int)__hip_atomic_load(mcnt + idx, __ATOMIC_RELAXED, __HIP_MEMORY_SCOPE_AGENT);
        const int i = chunk * 256 + wave * 32 + r32; valid = i < n; ent = mlist[(size_t)bh * MLIST_PER_BH + mlist_off(j) + (valid ? i : chunk * 256)]; }
    while (u < total) {
        const int bh = idx >> 5, j = idx & 31, b = bh >> 4, h = bh & 15;
        const int tl = (int)(ent & 0xffffu), slot = (int)(ent >> 16);
        bf16x8 qr[4]; load_q(qr, Q + (size_t)(b * SEQ + tl) * D + h * 64, hi);
        LAS unsigned char* Ks = C.lds + cur * 65536; LAS unsigned char* Vs = Ks + 32768;
        VM_WAIT(); __syncthreads();
        const int un = u + per; int nidx = 0;
        if (un < total) {
            int lo = 0, hi_ = 2048;
#pragma unroll
            for (int s = 0; s < 11; ++s) { const int mid = (lo + hi_) >> 1; if (pre[mid] <= un) lo = mid; else hi_ = mid; }
            nidx = lo;
            const int nbh = nidx >> 5, nj = nidx & 31, nb = nbh >> 4, nh = nbh & 15;
            const bf16* Kg = K + (size_t)(nb * SEQ + nj * 256) * D + nh * 64; const bf16* Vg = V + (size_t)(nb * SEQ + nj * 256) * D + nh * 64;
            LAS unsigned char* Kn = C.lds + (cur ^ 1) * 65536;
#pragma unroll
            for (int t4 = 0; t4 < 4; ++t4) dma_tile(Kg + (size_t)t4 * 64 * D, Vg + (size_t)t4 * 64 * D, Kn + t4 * 8192, Kn + 32768 + t4 * 8192, wave, lane);
            const int nchunk = un - pre[nidx], nn = (int)__hip_atomic_load(mcnt + nidx, __ATOMIC_RELAXED, __HIP_MEMORY_SCOPE_AGENT), ni = nchunk * 256 + wave * 32 + r32;
            valid_n = ni < nn; ent_n = mlist[(size_t)nbh * MLIST_PER_BH + mlist_off(nj) + (valid_n ? ni : nchunk * 256)];
        }
        AttnAcc A;
        const bool lk = __any((tl - (j * 256 + 255)) < 128) != 0;
        MobaBias B{relb + h * 128, tl, j * 256, lk, false, relb[h * 128 + 127]};
        f32x16 a0, a1, b0, b1;
        acc_init(A); B.kpos0 = j * 256;
        if (__any(valid)) {
        qk_tile(a0, a1, qr, Ks, r32, hi, B);
#pragma unroll 1
        for (int tp = 0; tp < 4; tp += 2) {
            B.kpos0 = j * 256 + 64 * (tp + 1); attn_step(A, a0, a1, b0, b1, qr, Ks + (tp + 1) * 8192, Vs + tp * 8192, r32, hi, lane, B, true);
            B.kpos0 = j * 256 + 64 * (tp + 2); attn_step(A, b0, b1, a0, a1, qr, Ks + ((tp + 2) & 3) * 8192, Vs + (tp + 1) * 8192, r32, hi, lane, B, tp == 0);
        }
        }
        const float lt = A.la[0], inv = 1.f / lt;
        if (valid) {
            const size_t rowi = ((size_t)(b * SEQ + tl) * H + h) * 3 + slot;
            store_o(parto + rowi * 64, A, inv, hi);
            if (hi == 0) *(GAS f32x2*)(partml + rowi * 2) = (f32x2){A.m, lt};
        }
        u = un; idx = nidx; cur ^= 1; ent = ent_n; valid = valid_n;
    }
    __builtin_amdgcn_s_setprio(0);
}
__device__ __forceinline__ void ph_moba_own(const Ctx& C, const bf16* Q, const bf16* K, const bf16* V, const float* rel_bias, const bf16* parto, const float* partml, unsigned char* O) {
    if (C.wave >= 4) __builtin_amdgcn_s_setprio(1);
    LAS float* relb = (LAS float*)(C.lds + RELB_OFF);
    const int lane = C.lane, wave = C.wave, r32 = lane & 31, hi = lane >> 5;
    __syncthreads();
    build_relb(C, rel_bias, relb);
    constexpr int NU = BATCH * H * NBLK;
    int u = C.vcu, cur = 0;
    if (u < NU) {
        const int bh = u >> 5, own = u & 31, b = bh >> 4, h = bh & 15;
        const bf16* Kg = K + (size_t)(b * SEQ + own * 256) * D + h * 64; const bf16* Vg = V + (size_t)(b * SEQ + own * 256) * D + h * 64;
#pragma unroll
        for (int t4 = 0; t4 < 4; ++t4) dma_tile(Kg + (size_t)t4 * 64 * D, Vg + (size_t)t4 * 64 * D, C.lds + t4 * 8192, C.lds + 32768 + t4 * 8192, wave, lane);
    }
    while (u < NU) {
        const int bh = u >> 5, own = u & 31, b = bh >> 4, h = bh & 15;
        const int qblk = wave < 4 ? wave : 11 - wave;
        const int tl = own * 256 + qblk * 32 + r32;
        bf16x8 qr[4]; load_q(qr, Q + (size_t)(b * SEQ + tl) * D + h * 64, hi);
        const int nv = own < 3 ? own : 3;
        const size_t rowi = ((size_t)(b * SEQ + tl) * H + h) * 3;
        LAS unsigned char* Ks = C.lds + cur * 65536; LAS unsigned char* Vs = Ks + 32768;
        VM_WAIT(); __syncthreads();
        const int un = u + C.G;
        if (un < NU) {
            const int nbh = un >> 5, nown = un & 31, nb = nbh >> 4, nh = nbh & 15;
            const bf16* Kg = K + (size_t)(nb * SEQ + nown * 256) * D + nh * 64; const bf16* Vg = V + (size_t)(nb * SEQ + nown * 256) * D + nh * 64;
            LAS unsigned char* Kn = C.lds + (cur ^ 1) * 65536;
#pragma unroll
            for (int t4 = 0; t4 < 4; ++t4) dma_tile(Kg + (size_t)t4 * 64 * D, Vg + (size_t)t4 * 64 * D, Kn + t4 * 8192, Kn + 32768 + t4 * 8192, wave, lane);
        }
        AttnAcc A; acc_init(A);
        const int tlast = qblk >> 1;
        MobaBias B{relb + h * 128, tl, own * 256, true, tlast == 0, 0.f};
        f32x16 a0, a1, b0, b1;
        qk_tile(a0, a1, qr, Ks, r32, hi, B);
#pragma unroll 1
        for (int tp = 0; tp < 4; tp += 2) {
            if (tp <= tlast) { B.kpos0 = own * 256 + 64 * (tp + 1); B.causal = (tp + 1 == tlast); attn_step(A, a0, a1, b0, b1, qr, Ks + (tp + 1) * 8192, Vs + tp * 8192, r32, hi, lane, B, tp + 1 <= tlast); }
            if (tp + 1 <= tlast) { B.kpos0 = own * 256 + 64 * (tp + 2); B.causal = (tp + 2 == tlast); attn_step(A, b0, b1, a0, a1, qr, Ks + ((tp + 2) & 3) * 8192, Vs + (tp + 1) * 8192, r32, hi, lane, B, tp + 2 <= tlast); }
        }
        const float lt = A.la[0];
        float mi[3], li[3];
#pragma unroll
        for (int i = 0; i < 3; ++i) { mi[i] = NEG_INF; li[i] = 0.f; if (i < nv) { const f32x2 ml = *(const GAS f32x2*)(partml + (rowi + i) * 2); mi[i] = ml.x; li[i] = ml.y; } }
        float M = A.m;
#pragma unroll
        for (int i = 0; i < 3; ++i) M = fmaxf(M, mi[i]);
        const float w0 = __builtin_amdgcn_exp2f(A.m - M); float den = w0 * lt;
#pragma unroll
        for (int r = 0; r < 16; ++r) { A.o0[r] *= w0; A.o1[r] *= w0; }
#pragma unroll
        for (int i = 0; i < 3; ++i) if (i < nv) {
            const float wi = li[i] * __builtin_amdgcn_exp2f(mi[i] - M); den += wi;
            const bf16* po = parto + (rowi + i) * 64;
#pragma unroll
            for (int g = 0; g < 4; ++g) { const u32x2 a = *(const GAS u32x2*)(po + 8 * g + 4 * hi), c = *(const GAS u32x2*)(po + 32 + 8 * g + 4 * hi);
                A.o0[4 * g] += wi * bflo(a.x); A.o0[4 * g + 1] += wi * bfhi(a.x); A.o0[4 * g + 2] += wi * bflo(a.y); A.o0[4 * g + 3] += wi * bfhi(a.y);
                A.o1[4 * g] += wi * bflo(c.x); A.o1[4 * g + 1] += wi * bfhi(c.x); A.o1[4 * g + 2] += wi * bflo(c.y); A.o1[4 * g + 3] += wi * bfhi(c.y); }
        }
        store_o8(O + (size_t)(b * SEQ + tl) * D + h * 64, A, 1.f / den, hi);
        u = un; cur ^= 1;
    }
    __builtin_amdgcn_s_setprio(0);
}

__device__ __forceinline__ void ph_scan(const Ctx& C, const float* logf, float* ncum) {
    LAS float* wt = (LAS float*)C.lds;
    for (int bh = C.vcu; bh < BATCH * H; bh += C.G) {
        const int b = bh >> 4, h = bh & 15;
        float v[16], s = 0.f;
#pragma unroll
        for (int i = 0; i < 16; ++i) { v[i] = logf[(size_t)(b * SEQ + C.tid * 16 + i) * H + h]; s += v[i]; }
        float inc = s;
#pragma unroll
        for (int o = 1; o < 64; o <<= 1) { const float t = __shfl_up(inc, o); if (C.lane >= o) inc += t; }
        __syncthreads();
        if (C.lane == 63) wt[C.wave] = inc;
        __syncthreads();
        float run = inc - s; for (int w = 0; w < C.wave; ++w) run += wt[w];
#pragma unroll
        for (int i = 0; i < 16; ++i) { run += v[i]; ncum[(size_t)bh * SEQ + C.tid * 16 + i] = -run * LOG2E; }
    }
}
__device__ __forceinline__ void ph_fox(const Ctx& C, const bf16* Q, const bf16* K, const bf16* V, const float* ncum, const unsigned* norms, unsigned char* O, unsigned* qctr) {
    if (C.wave >= 4) __builtin_amdgcn_s_setprio(1);
    constexpr int GB = 33280;
    LAS int* uinfo = (LAS int*)(C.lds + UINFO_OFF);
    const int lane = C.lane, wave = C.wave, r32 = lane & 31, hi = lane >> 5;
    for (;;) {
        __syncthreads();
        if (C.tid == 0) { uinfo[0] = (int)__hip_atomic_fetch_add(qctr, 1u, __ATOMIC_RELAXED, __HIP_MEMORY_SCOPE_AGENT); uinfo[1] = 0; uinfo[2] = 0; uinfo[3] = -1; }
        __syncthreads();
        const int idx = uinfo[0];
        if (idx >= BATCH * H * NBLK) break;
        const int qb = 31 - (idx >> 6), bh = idx & 63, b = bh >> 4, h = bh & 15, NT = 4 * (qb + 1);
        const float* ng = ncum + (size_t)bh * SEQ; const float nref = ng[qb * 256];
        const int qblk = wave < 4 ? wave : 11 - wave;
        const int qrel = qblk * 32 + r32;
        bf16x8 qr[4]; load_q(qr, Q + (size_t)(b * SEQ + qb * 256 + qrel) * D + h * 64, hi);
        {   float q2 = 0.f;
#pragma unroll
            for (int d0 = 0; d0 < 4; ++d0)
#pragma unroll
                for (int i = 0; i < 8; ++i) { const float x = bf2f((unsigned)(unsigned short)qr[d0][i]); q2 += x * x; }
            q2 += __shfl_xor(q2, 32);
#pragma unroll
            for (int o = 1; o < 32; o <<= 1) q2 = fmaxf(q2, __shfl_xor(q2, o));
            if (lane == 0) (void)__hip_atomic_fetch_max((LAS unsigned*)&uinfo[2], __float_as_uint(q2), __ATOMIC_RELAXED, __HIP_MEMORY_SCOPE_WORKGROUP);
            bf16x8 kr[4]; load_q(kr, K + (size_t)(b * SEQ + qb * 256 + qrel) * D + h * 64, hi);
            float sq = 0.f;
#pragma unroll
            for (int d0 = 0; d0 < 4; ++d0)
#pragma unroll
                for (int i = 0; i < 8; ++i) sq += bf2f((unsigned)(unsigned short)qr[d0][i]) * bf2f((unsigned)(unsigned short)kr[d0][i]);
            sq += __shfl_xor(sq, 32);
#pragma unroll
            for (int o = 1; o < 32; o <<= 1) sq = fminf(sq, __shfl_xor(sq, o));
            if (lane == 0) (void)__hip_atomic_fetch_min((LAS unsigned*)&uinfo[3], sort_key(sq), __ATOMIC_RELAXED, __HIP_MEMORY_SCOPE_WORKGROUP); }
        __syncthreads();
        {   const float qn2 = __uint_as_float((unsigned)uinfo[2]), qa = __uint_as_float(norms[bh * 4 + 0]), qb2 = __uint_as_float(norms[bh * 4 + 1]), ka = __uint_as_float(norms[bh * 4 + 2]), kb2 = __uint_as_float(norms[bh * 4 + 3]);
            const unsigned mk = (unsigned)uinfo[3]; const float smin = __uint_as_float((mk & 0x80000000u) ? (mk ^ 0x80000000u) : ~mk) - 0.05f;
            const float smax = sqrtf(fminf(qn2, qa + qb2)) * sqrtf(ka + kb2) * 1.02f;
            const float thr = smax - fmaxf(smin, -smax) + 40.f;
            if (C.tid < 128) { const bool skip = (C.tid < NT) && (ng[(C.tid < NT ? C.tid : 0) * 64 + 63] - nref < -thr); const int c = __popcll(__ballot(skip)); if (lane == 0 && c) (void)__hip_atomic_fetch_add(&uinfo[1], c, __ATOMIC_RELAXED, __HIP_MEMORY_SCOPE_WORKGROUP); } }
        __syncthreads();
        const int t0 = uinfo[1], tf = t0 & ~1, g0 = t0 >> 1, NG = NT >> 1, tmax = 4 * qb + (qblk >> 1);
        const bf16* Kg = K + (size_t)(b * SEQ) * D + h * 64; const bf16* Vg = V + (size_t)(b * SEQ) * D + h * 64;
#define FOX_DMA(g) do { LAS unsigned char* sb_ = C.lds + ((g) & 3) * GB; \
            dma_tile(Kg + (size_t)(2 * (g)) * 64 * D, Vg + (size_t)(2 * (g)) * 64 * D, sb_, sb_ + 16384, wave, lane); \
            dma_tile(Kg + (size_t)(2 * (g) + 1) * 64 * D, Vg + (size_t)(2 * (g) + 1) * 64 * D, sb_ + 8192, sb_ + 24576, wave, lane); \
            if (wave < 2) glds4(ng + (2 * (g) + wave) * 64 + lane, lds_addr(sb_ + 32768 + wave * 256)); } while (0)
        FOX_DMA(g0);
        if (g0 + 1 < NG) FOX_DMA(g0 + 1);
        VM_WAIT(); __syncthreads();
        AttnAcc A; acc_init(A);
        f32x16 a0, a1, b0, b1; v4u wa[4], wb[4];
        FoxBias B{nullptr, qrel, 0, false};
#define FOX_SETB(t) do { const LAS unsigned char* sb_ = C.lds + (((t) >> 1) & 3) * GB; B.cb = (const LAS float*)(sb_ + 32768 + ((t) & 1) * 256); B.krel0 = (t) * 64 - qb * 256; B.causal = (t) >= 4 * qb; } while (0)
#define FOX_KS(t) (C.lds + (((t) >> 1) & 3) * GB + ((t) & 1) * 8192)
#define FOX_VS(t) (C.lds + (((t) >> 1) & 3) * GB + 16384 + ((t) & 1) * 8192)
#define FOX_STEP(C0, C1, N0, N1, WP, WN, t) do { FOX_SETB((t) + 1); \
            attn_step3(A, C0, C1, N0, N1, WP, WN, qr, FOX_KS((t) + 1), FOX_VS((t) > tf ? (t) - 1 : (t)), r32, hi, lane, B, (t) <= tmax); } while (0)
#pragma unroll
        for (int k_ = 0; k_ < 4; ++k_) { wa[k_] = (v4u){0u, 0u, 0u, 0u}; wb[k_] = (v4u){0u, 0u, 0u, 0u}; }
        if (tf <= tmax) { FOX_SETB(tf); qk_tile(a0, a1, qr, FOX_KS(tf), r32, hi, B); }
#pragma unroll 1
        for (int g = g0; g <= NG; ++g) {
            const int ta = 2 * g, tb = ta + 1;
            if (g + 2 < NG) FOX_DMA(g + 2);
            if (ta <= tmax + 1) FOX_STEP(a0, a1, b0, b1, wb, wa, ta);
            if (tb <= tmax + 1 && g < NG) FOX_STEP(b0, b1, a0, a1, wa, wb, tb);
            VM_WAIT(); __syncthreads();
        }
#undef FOX_DMA
#undef FOX_SETB
#undef FOX_KS
#undef FOX_VS
#undef FOX_STEP
        const float lt = A.la[0];
        store_o8(O + (size_t)(b * SEQ + qb * 256 + qrel) * D + h * 64, A, 1.f / lt, hi);
    }
    __builtin_amdgcn_s_setprio(0);
}
__device__ __forceinline__ void ln_stats(f32x4 (&v)[4], float& rstd) {
    float s = 0.f;
#pragma unroll
    for (int j = 0; j < 4; ++j) s += (v[j].x + v[j].y) + (v[j].z + v[j].w);
    const float mean = wave_sum(s) * (1.f / D); float s2 = 0.f;
#pragma unroll
    for (int j = 0; j < 4; ++j) { v[j] = v[j] - mean; s2 += (v[j].x * v[j].x + v[j].y * v[j].y) + (v[j].z * v[j].z + v[j].w * v[j].w); }
    rstd = 1.f / sqrtf(wave_sum(s2) * (1.f / D) + LN_EPS);
}
__device__ __forceinline__ void ph_ln1(const Ctx& C, const float* xin, const bf16* xin16, const bf16* y, const float* g, const float* bta, bf16* AR, unsigned char* xb8) {
    const int gw = C.vcu * NWAVES + C.wave, NGW = C.G * NWAVES, lane = C.lane;
    f32x4 gv[4], bv[4];
#pragma unroll
    for (int j = 0; j < 4; ++j) { gv[j] = *(const GAS f32x4*)(g + 4 * lane + 256 * j); bv[j] = *(const GAS f32x4*)(bta + 4 * lane + 256 * j); }
    u32x2 wn[4], zn16[4]; f32x4 zn32[4];
    {   const GAS u32x2* yr = (const GAS u32x2*)(y + (size_t)gw * D) + lane;
#pragma unroll
        for (int j = 0; j < 4; ++j) wn[j] = yr[64 * j];
        if (xin16) { const GAS u32x2* zr = (const GAS u32x2*)(xin16 + (size_t)gw * D) + lane;
#pragma unroll
            for (int j = 0; j < 4; ++j) zn16[j] = zr[64 * j];
        } else { const GAS f32x4* zr = (const GAS f32x4*)(xin + (size_t)gw * D) + lane;
#pragma unroll
            for (int j = 0; j < 4; ++j) zn32[j] = zr[64 * j]; } }
    for (int t = gw; t < T; t += NGW) {
        f32x4 v[4];
        const int tn = t + NGW < T ? t + NGW : t;
        const GAS u32x2* yr = (const GAS u32x2*)(y + (size_t)tn * D) + lane;
        if (xin16) { const GAS u32x2* zr = (const GAS u32x2*)(xin16 + (size_t)tn * D) + lane;
#pragma unroll
            for (int j = 0; j < 4; ++j) { const u32x2 w = wn[j], z = zn16[j]; v[j] = (f32x4){bflo(z.x), bfhi(z.x), bflo(z.y), bfhi(z.y)} * DN_ALPHA + (f32x4){bflo(w.x), bfhi(w.x), bflo(w.y), bfhi(w.y)}; }
#pragma unroll
            for (int j = 0; j < 4; ++j) { wn[j] = yr[64 * j]; zn16[j] = zr[64 * j]; }
        } else { const GAS f32x4* zr = (const GAS f32x4*)(xin + (size_t)tn * D) + lane;
#pragma unroll
            for (int j = 0; j < 4; ++j) { const u32x2 w = wn[j]; v[j] = zn32[j] * DN_ALPHA + (f32x4){bflo(w.x), bfhi(w.x), bflo(w.y), bfhi(w.y)}; }
#pragma unroll
            for (int j = 0; j < 4; ++j) { wn[j] = yr[64 * j]; zn32[j] = zr[64 * j]; } }
        float rstd; ln_stats(v, rstd);
#pragma unroll
        for (int j = 0; j < 4; ++j) {
            const f32x4 y = v[j] * rstd * gv[j] + bv[j]; const int d = 4 * lane + 256 * j;
            u32x2 hw; hw.x = cvtpk(y.x, y.y); hw.y = cvtpk(y.z, y.w);
            u32x2 lw; lw.x = cvtpk(y.x - bflo(hw.x), y.y - bfhi(hw.x)); lw.y = cvtpk(y.z - bflo(hw.y), y.w - bfhi(hw.y));
            *(GAS unsigned*)(xb8 + (size_t)t * D + d) = pk4_f8(y.x * XQ_SCALE, y.y * XQ_SCALE, y.z * XQ_SCALE, y.w * XQ_SCALE);
            *(GAS u32x2*)(AR + (size_t)t * 1536 + d) = hw;
            *(GAS u32x2*)(AR + (size_t)(T + t) * 1536 + 512 + d) = hw;
            if (j < 2) *(GAS u32x2*)(AR + (size_t)t * 1536 + 1024 + d) = lw; else *(GAS u32x2*)(AR + (size_t)(T + t) * 1536 + (d - 512)) = lw;
        }
    }
}
__device__ __forceinline__ int below(unsigned long long mask) { return (int)__builtin_amdgcn_mbcnt_hi((unsigned)(mask >> 32), __builtin_amdgcn_mbcnt_lo((unsigned)mask, 0u)); }
__device__ __forceinline__ void ph_route(const Ctx& C, const float* logp, const float* rbias, int* topi, float* gate, unsigned* ecnt) {
    LAS unsigned* hist = (LAS unsigned*)C.lds;
    const int gw = C.vcu * NWAVES + C.wave, NGW = C.G * NWAVES, lane = C.lane;
    __syncthreads();
    if (C.tid < NE) hist[C.tid] = 0u;
    __syncthreads();
    const f32x4 rb = *(const GAS f32x4*)(rbias + 4 * lane);
    f32x4 an = *(const GAS f32x4*)(logp + (size_t)gw * NE + 4 * lane), bn = *(const GAS f32x4*)(logp + (size_t)(T + gw) * NE + 4 * lane);
    for (int t = gw; t < T; t += NGW) {
        const f32x4 a = an, b2 = bn;
        { const int tn = t + NGW < T ? t + NGW : t; an = *(const GAS f32x4*)(logp + (size_t)tn * NE + 4 * lane); bn = *(const GAS f32x4*)(logp + (size_t)(T + tn) * NE + 4 * lane); }
        float s[4], c[4];
#pragma unroll
        for (int i = 0; i < 4; ++i) { const float lg = a[i] + b2[i]; s[i] = 1.f / (1.f + __builtin_amdgcn_exp2f(-lg * LOG2E)); c[i] = s[i] + rb[i]; }
        float m1 = fmaxf(c[0], c[1]), m2 = fminf(c[0], c[1]);
        { const float x = c[2]; const float n1 = fmaxf(m1, x); m2 = fmaxf(m2, fminf(m1, x)); m1 = n1; }
        { const float x = c[3]; const float n1 = fmaxf(m1, x); m2 = fmaxf(m2, fminf(m1, x)); m1 = n1; }
#pragma unroll
        for (int o = 1; o < 8; o <<= 1) { const float o1 = __shfl_xor(m1, o), o2 = __shfl_xor(m2, o); const float n1 = fmaxf(m1, o1), n2 = fmaxf(fminf(m1, o1), fmaxf(m2, o2)); m1 = n1; m2 = n2; }
        const float gs = m1 + m2; const int mygrp = lane >> 3; int rk = 0;
#pragma unroll
        for (int g2 = 0; g2 < NGRP; ++g2) { const float og = __uint_as_float((unsigned)__builtin_amdgcn_readlane((int)__float_as_uint(gs), 8 * g2)); rk += (og > gs || (og == gs && g2 < mygrp)) ? 1 : 0; }
        unsigned k[4];
#pragma unroll
        for (int i = 0; i < 4; ++i) k[i] = rk < 4 ? sort_key(c[i]) : 0u;
        unsigned thr = 0u;
#pragma unroll 1
        for (int b = 31; b >= 0; --b) {
            const unsigned cand = thr | (1u << b);
            const int cnt = __popcll(__ballot(k[0] >= cand)) + __popcll(__ballot(k[1] >= cand)) + __popcll(__ballot(k[2] >= cand)) + __popcll(__ballot(k[3] >= cand));
            if (cnt >= TOPK) thr = cand;
        }
        unsigned long long gm[4], em[4]; int ngt = 0;
#pragma unroll
        for (int i = 0; i < 4; ++i) { gm[i] = __ballot(k[i] > thr); em[i] = __ballot(k[i] == thr); ngt += __popcll(gm[i]); }
        const int need = TOPK - ngt;
        int eqb = below(em[0]) + below(em[1]) + below(em[2]) + below(em[3]);
        bool sel[4];
#pragma unroll
        for (int i = 0; i < 4; ++i) { const bool eq = k[i] == thr; sel[i] = (k[i] > thr) || (eq && eqb < need); eqb += eq ? 1 : 0; }
        unsigned long long sm[4]; float wpart = 0.f;
#pragma unroll
        for (int i = 0; i < 4; ++i) { sm[i] = __ballot(sel[i]); wpart += sel[i] ? s[i] : 0.f; }
        const float wsum = wave_sum(wpart);
        int pos = below(sm[0]) + below(sm[1]) + below(sm[2]) + below(sm[3]);
#pragma unroll
        for (int i = 0; i < 4; ++i) if (sel[i]) { gate[(size_t)t * TOPK + pos] = s[i] / wsum * ROUTED_SCALE;
            const unsigned rk = __hip_atomic_fetch_add(&hist[4 * lane + i], 1u, __ATOMIC_RELAXED, __HIP_MEMORY_SCOPE_WORKGROUP);
            topi[(size_t)t * TOPK + pos] = (4 * lane + i) | (int)(rk << 8); ++pos; }
    }
    __syncthreads();
    if (C.tid < NE) { const unsigned c = hist[C.tid]; hist[NE + C.tid] = c ? __hip_atomic_fetch_add(ecnt + C.tid, c, __ATOMIC_RELAXED, __HIP_MEMORY_SCOPE_AGENT) : 0u; }
}
__device__ __forceinline__ void ph_scatter(const Ctx& C, const unsigned* ecnt, unsigned* ecur, const int* topi, const float* gate, const bf16* xb, int* slotof, int* tokof, float* gslot, bf16* HS) {
    build_tpre(C, ecnt);
    const LAS int* tpre = (const LAS int*)(C.lds + TPRE_OFF);
    const LAS unsigned* wgbase = (const LAS unsigned*)C.lds + NE;
    const int gw = C.vcu * NWAVES + C.wave, NGW = C.G * NWAVES;
    for (int n = C.lane >> 3; gw + n * NGW < T; n += 8) {
        const int t = gw + n * NGW;
        { const int i = t * TOPK + (C.lane & 7); const int v = topi[i], e = v & 255, rk = v >> 8;
            const int slot = tpre[e] * 256 + (int)wgbase[e] + rk; tokof[slot] = t; gslot[slot] = gate[i] * GS_FOLD; slotof[i] = slot; }
    }
    for (int e = C.vcu; e < NE; e += C.G) {
        const int cnt = (int)__hip_atomic_load(ecnt + e, __ATOMIC_RELAXED, __HIP_MEMORY_SCOPE_AGENT), s0 = tpre[e] * 256 + cnt, s1 = tpre[e + 1] * 256;
        for (int s = s0 + C.tid; s < s1; s += NTHR) { gslot[s] = 0.f; tokof[s] = 0; }
    }
}
__device__ __forceinline__ float log_sigmoid(float z) {
    const float e = __builtin_amdgcn_exp2f(-fabsf(z) * LOG2E);
    const float l1p = e < 0.015625f ? e * (1.f - e * (0.5f - e * 0.33333334f)) : __builtin_amdgcn_logf(1.f + e) * 0.6931471805599453f;
    return fminf(z, 0.f) - l1p;
}
__device__ __forceinline__ void ph_combine(const Ctx& C, const bf16* x1hi, const unsigned char* SO, const int* slotof, const float* g, const float* bta, bf16* xres, unsigned char* xb8, float* dout,
                                           const float* fox_in, const float* fox_bf, float* logf) {
    const int gw = C.vcu * NWAVES + C.wave, NGW = C.G * NWAVES, lane = C.lane;
    LAS float* wfT = (LAS float*)C.lds;
    __syncthreads();
    if (logf) { for (int i = C.tid; i < D * H; i += NTHR) { const int d = i >> 4, h = i & 15; wfT[h * D + d] = fox_in[(size_t)d * FOXW + 3 * D + h]; } }
    __syncthreads();
    f32x4 gv[4], bv[4];
#pragma unroll
    for (int j = 0; j < 4; ++j) { gv[j] = *(const GAS f32x4*)(g + 4 * lane + 256 * j); bv[j] = *(const GAS f32x4*)(bta + 4 * lane + 256 * j); }
    int sl_n = lane < TOPK ? slotof[(size_t)gw * TOPK + lane] : 0;
    for (int t = gw; t < T; t += NGW) {
        const GAS u32x2* zr = (const GAS u32x2*)(x1hi + (size_t)t * 1536) + lane;
        f32x4 v[4];
#pragma unroll
        for (int j = 0; j < 4; ++j) { const u32x2 z = zr[64 * j]; v[j] = (f32x4){bflo(z.x), bfhi(z.x), bflo(z.y), bfhi(z.y)} * DN_ALPHA; }
        const int sl = sl_n; { const int tn = t + NGW < T ? t + NGW : t; sl_n = lane < TOPK ? slotof[(size_t)tn * TOPK + lane] : 0; }
        f32x4 rs[4];
#pragma unroll
        for (int j = 0; j < 4; ++j) rs[j] = (f32x4){0.f, 0.f, 0.f, 0.f};
#pragma unroll
        for (int k = 0; k < TOPK; ++k) { const int sk = __builtin_amdgcn_readlane(sl, k); const unsigned char* row = SO + (size_t)sk * D + 4 * lane;
#pragma unroll
            for (int j = 0; j < 4; ++j) { const unsigned w = *(const GAS unsigned*)(row + 256 * j); const f32x2 lo2 = __builtin_amdgcn_cvt_pk_f32_fp8(w, false), hi2 = __builtin_amdgcn_cvt_pk_f32_fp8(w, true);
                rs[j].x += lo2.x; rs[j].y += lo2.y; rs[j].z += hi2.x; rs[j].w += hi2.y; } }
        {   const unsigned char* row = SO + (size_t)(NSLOT_MAX + t) * D + 4 * lane;
#pragma unroll
            for (int j = 0; j < 4; ++j) { const unsigned w = *(const GAS unsigned*)(row + 256 * j); const f32x2 lo2 = __builtin_amdgcn_cvt_pk_f32_fp8(w, false), hi2 = __builtin_amdgcn_cvt_pk_f32_fp8(w, true);
                rs[j].x += lo2.x; rs[j].y += lo2.y; rs[j].z += hi2.x; rs[j].w += hi2.y; } }
#pragma unroll
        for (int j = 0; j < 4; ++j) v[j] = v[j] + rs[j] * SO_INV;
        float rstd; ln_stats(v, rstd);
        f32x4 y[4];
#pragma unroll
        for (int j = 0; j < 4; ++j) {
            y[j] = v[j] * rstd * gv[j] + bv[j]; const int d = 4 * lane + 256 * j;
            if (dout) *(GAS f32x4*)(dout + (size_t)t * D + d) = y[j];
            else { u32x2 hw; hw.x = cvtpk(y[j].x, y[j].y); hw.y = cvtpk(y[j].z, y[j].w); *(GAS u32x2*)(xres + (size_t)t * D + d) = hw;
                *(GAS unsigned*)(xb8 + (size_t)t * D + d) = pk4_f8(y[j].x * XQ_SCALE, y[j].y * XQ_SCALE, y[j].z * XQ_SCALE, y[j].w * XQ_SCALE); }
        }
        if (logf) {
            float acc[16];
#pragma unroll
            for (int h = 0; h < 16; ++h) { float a = 0.f;
#pragma unroll
                for (int j = 0; j < 4; ++j) { const f32x4 w = *(const LAS f32x4*)(wfT + h * D + 4 * lane + 256 * j); a += y[j].x * w.x; a += y[j].y * w.y; a += y[j].z * w.z; a += y[j].w * w.w; }
                acc[h] = a; }
            float a8[8], a4[4], a2[2], a1;
            { const bool bit = (lane >> 5) & 1;
#pragma unroll
              for (int i = 0; i < 8; ++i) { const float send = bit ? acc[i] : acc[i + 8]; const float recv = __shfl_xor(send, 32); a8[i] = (bit ? acc[i + 8] : acc[i]) + recv; } }
            { const bool bit = (lane >> 4) & 1;
#pragma unroll
              for (int i = 0; i < 4; ++i) { const float send = bit ? a8[i] : a8[i + 4]; const float recv = __shfl_xor(send, 16); a4[i] = (bit ? a8[i + 4] : a8[i]) + recv; } }
            { const bool bit = (lane >> 3) & 1;
#pragma unroll
              for (int i = 0; i < 2; ++i) { const float send = bit ? a4[i] : a4[i + 2]; const float recv = __shfl_xor(send, 8); a2[i] = (bit ? a4[i + 2] : a4[i]) + recv; } }
            { const bool bit = (lane >> 2) & 1; const float send = bit ? a2[0] : a2[1]; const float recv = __shfl_xor(send, 4); a1 = (bit ? a2[1] : a2[0]) + recv; }
            a1 += __shfl_xor(a1, 2); a1 += __shfl_xor(a1, 1);
            const int hh = ((lane >> 5) & 1) * 8 + ((lane >> 4) & 1) * 4 + ((lane >> 3) & 1) * 2 + ((lane >> 2) & 1);
            if ((lane & 3) == 0) logf[(size_t)t * H + hh] = log_sigmoid(a1 + fox_bf[hh]);
        }
    }
}
#ifndef MK_MULTI
#define MK_MULTI 0
#endif
constexpr int NPH = 27;
struct Args { const float* in[19]; float* out; unsigned char* ws; int ph_lo, ph_hi; };

__global__ void __launch_bounds__(NTHR, 2) mk_fwd(Args args) {
    extern __shared__ __attribute__((aligned(16))) unsigned char lds_raw[];
    Ctx C;
    C.lds = (LAS unsigned char*)lds_raw;
    C.tid = threadIdx.x; C.lane = C.tid & 63; C.wave = __builtin_amdgcn_readfirstlane(C.tid >> 6);
    C.G = gridDim.x; { const int bx = blockIdx.x; C.vcu = (C.G % 8 == 0) ? (bx % 8) * (C.G / 8) + bx / 8 : bx; }
    LAS unsigned long long* PTAB = (LAS unsigned long long*)(C.lds + PTAB_OFF);
    if (C.tid == 0) {
#pragma unroll
        for (int i = 0; i < 19; ++i) PTAB[i] = (unsigned long long)(uintptr_t)args.in[i];
        PTAB[19] = (unsigned long long)(uintptr_t)args.out; PTAB[20] = (unsigned long long)(uintptr_t)args.ws;
    }
    for (int u = C.tid; u < (PTAB_OFF - LDSCTL_OFF) / 4; u += NTHR) ((LAS unsigned*)(C.lds + LDSCTL_OFF))[u] = 0u;
    __syncthreads();
#define PIN(i) ((const float*)ldptr(PTAB, (i)))
#define WSP() ((unsigned char*)ldptr(PTAB, 20))
    XcdBarrier bar; bar.bar = (unsigned*)(args.ws + WS_CTL) + CW_BAR; bar.x = 0; bar.st = nullptr;
    if (!MK_MULTI) bar = xcd_barrier_post((unsigned*)(args.ws + WS_CTL) + CW_BAR, (volatile LAS unsigned*)(C.lds + MISC_OFF) + 8);
    const int lo = args.ph_lo, hi = args.ph_hi;
#ifndef MK_PH_MASK
#define MK_PH_MASK 0xFFFFFFFFu
#endif
#define PHON(b) (((MK_PH_MASK) >> (b)) & 1u)
#ifndef MK_DUP_MASK
#define MK_DUP_MASK 0u
#endif
#define NREP(b) ((((MK_DUP_MASK) >> (b)) & 1u) ? 2 : 1)
#define REP(b) _Pragma("unroll 1") for (int rep_ = 0; rep_ < NREP(b); ++rep_)
#define IN(k) (lo <= (k) && (k) < hi)
#define SEAM(k) do { if ((k) + 1 < hi) { asm volatile("" : "+s"(bar.bar)); xcd_barrier(bar); if (NREP(23) == 2) xcd_barrier(bar); } } while (0)
#define OPAQ(v) asm volatile("" : "+s"(v))
#define LC() do { int l_; asm volatile("v_mbcnt_lo_u32_b32 %0, -1, 0\n\tv_mbcnt_hi_u32_b32 %0, -1, %0" : "=v"(l_)); C.lane = l_; C.tid = C.wave * 64 + l_; } while (0)

    if (PHON(0) && IN(0)) { LC();
        unsigned char* ws = WSP();
        SmallW W{PIN(2), PIN(3), PIN(4), PIN(6), PIN(11), PIN(16), PIN(17), PIN(18),
                 ws + WS_WMI, ws + WS_WFI, ws + WS_WMO, ws + WS_WFO, ws + WS_WSGU, ws + WS_WSDN, (bf16*)(ws + WS_WR)};
        REP(21) conv_small(C, W);
        REP(22) to_f8_rows(C, PIN(0), ws + WS_XB8);
        __syncthreads();
        REP(0) conv_experts(C, PIN(13), PIN(14), PIN(15), 0, ws + WS_WEGU, ws + WS_WEDN, C.vcu, C.G);
        SEAM(0);
    }
#pragma unroll 1
    for (int l = 0; l < 2; ++l) {
        const int pb = 1 + 13 * l;
        if (PHON(1) && IN(pb + 0)) { LC();
            unsigned char* ws = WSP();
            if (PHON(15) && l == 1) ph_scan(C, (const float*)(ws + WS_LOGF), (float*)(ws + WS_CUM));
            REP(1) {
            __syncthreads();
            int kk = D / 2; OPAQ(kk);
            pg8::Gemm g{(const bf16*)(ws + WS_XB8), (const bf16*)(ws + (l == 0 ? WS_WMI : WS_WFI)), T, 3 * D, kk}; pg8::StaticOrder S; S.init(T, 3 * D, C.G, (int)blockIdx.x);
            EpiQKV E{(bf16*)(ws + WS_Q), (size_t)(WS_K - WS_Q) / 2, C2, (unsigned*)(ws + WS_CTL) + CW_NORM + l * 256, l == 0 ? (float*)(ws + WS_CTL) + CW_KSUM : nullptr};
            pg8::gemm_phase<EpiQKV, pg8::StaticOrder, true, true, false, true>(C.lds, g, S, E, C.tid);
            }
            SEAM(pb + 0);
        }
        if (l == 0) {
            if (PHON(3) && IN(pb + 2)) { LC(); unsigned char* ws = WSP(); REP(3) ph_select(C, (const bf16*)(ws + WS_Q), (const float*)(ws + WS_CTL) + CW_KSUM, (unsigned*)(ws + WS_CTL) + (rep_ ? 133120 : CW_MCNT), (unsigned*)(ws + (rep_ ? WS_PARTO : WS_MLIST))); SEAM(pb + 2); }
            if (PHON(4) && IN(pb + 3)) { LC(); unsigned char* ws = WSP();
                const int uw = 1, usb = C.vcu, per = C.G;
                REP(4) ph_moba_part(C, (const bf16*)(ws + WS_Q), (const bf16*)(ws + WS_K), (const bf16*)(ws + WS_V), PIN(1), (const unsigned*)(ws + WS_CTL) + CW_MCNT, (const unsigned*)(ws + WS_MLIST), (bf16*)(ws + WS_PARTO), (float*)(ws + WS_PARTML), uw, usb, per); SEAM(pb + 3); }
            if (PHON(5) && IN(pb + 4)) { LC(); unsigned char* ws = WSP(); REP(5) ph_moba_own(C, (const bf16*)(ws + WS_Q), (const bf16*)(ws + WS_K), (const bf16*)(ws + WS_V), PIN(1), (const bf16*)(ws + WS_PARTO), (const float*)(ws + WS_PARTML), ws + WS_O); SEAM(pb + 4); }
        } else {
            if (PHON(6) && IN(pb + 4)) { LC(); unsigned char* ws = WSP();
                REP(6) ph_fox(C, (const bf16*)(ws + WS_Q), (const bf16*)(ws + WS_K), (const bf16*)(ws + WS_V), (const float*)(ws + WS_CUM), (const unsigned*)(ws + WS_CTL) + CW_NORM + 256, ws + WS_O, (unsigned*)(ws + WS_CTL) + CW_FOXQ + rep_ * 64); SEAM(pb + 4); }
        }
        if (PHON(7) && IN(pb + 5)) { LC();
            unsigned char* ws = WSP();
            REP(7) {
            __syncthreads();
            int kk = D / 2; OPAQ(kk);
            pg8::Gemm g{(const bf16*)(ws + WS_O), (const bf16*)(ws + (l == 0 ? WS_WMO : WS_WFO)), T, D, kk}; PlainOrder<4> S{C.vcu, C.G, (T / 256) * 4};
            pg8::EpiBf16<0> E{(bf16*)(ws + WS_Z), D, nullptr, D, 0, 1.f / (OQ_SCALE * WQ_SCALE)};
            pg8::gemm_phase<pg8::EpiBf16<0>, PlainOrder<4>, true, true, false, true>(C.lds, g, S, E, C.tid);
            }
            SEAM(pb + 5);
        }
        if (PHON(8) && IN(pb + 6)) { LC(); unsigned char* ws = WSP(); REP(8) ph_ln1(C, PIN(0), l == 0 ? nullptr : (const bf16*)(ws + WS_XRES), (const bf16*)(ws + WS_Z), PIN(7) + l * D, PIN(8) + l * D, (bf16*)(ws + WS_AR), ws + WS_XB8); SEAM(pb + 6); }
        if (PHON(9) && IN(pb + 7)) { LC();
            __syncthreads();
            REP(16) if (PHON(16)) { __syncthreads(); unsigned char* ws = WSP(); int kk = 1536; OPAQ(kk);
              pg8::Gemm g{(const bf16*)(ws + WS_AR), (const bf16*)(ws + WS_WR) + (size_t)l * (512 * 1536), 2 * T, 512, kk}; RouterOrder S{C.vcu, C.G}; EpiF32<true> E{(float*)(ws + WS_LOGP), nullptr, NE, 0.f};
              pg8::gemm_phase<EpiF32<true>, RouterOrder, true, true>(C.lds, g, S, E, C.tid); }
            __syncthreads();
            REP(17) if (PHON(17)) { __syncthreads(); unsigned char* ws = WSP(); int kk = D / 2; OPAQ(kk);
              pg8::Gemm g{(const bf16*)(ws + WS_XB8), (const bf16*)(ws + WS_WSGU + (size_t)l * (512 * 1024)), T, 512, kk}; PlainOrder<2> S{C.vcu, C.G, (T / 256) * 2}; EpiSwiGLU<true> E{ws + WS_ACTSH, nullptr};
              pg8::gemm_phase<EpiSwiGLU<true>, PlainOrder<2>, true, true, false, true>(C.lds, g, S, E, C.tid); }
            SEAM(pb + 7);
        }
        if (PHON(10) && IN(pb + 8)) { LC(); unsigned char* ws = WSP(); REP(10) ph_route(C, (const float*)(ws + WS_LOGP), PIN(12) + l * NE, (int*)(ws + WS_TOPI), (float*)(ws + WS_GATE), (unsigned*)(ws + WS_CTL) + (rep_ ? 131072 : CW_ECNT) + l * NE); SEAM(pb + 8); }
        if (PHON(11) && IN(pb + 9)) { LC(); unsigned char* ws = WSP(); REP(11) { if (rep_) xcd_barrier(bar); ph_scatter(C, (const unsigned*)(ws + WS_CTL) + CW_ECNT + l * NE, (unsigned*)(ws + WS_CTL) + (rep_ ? 132096 : CW_ECUR) + l * NE, (const int*)(ws + WS_TOPI), (const float*)(ws + WS_GATE), (const bf16*)(ws + WS_XB8),
                                                                            (int*)(ws + WS_SLOTOF), (int*)(ws + WS_TOKOF), (float*)(ws + WS_GSLOT), (bf16*)(ws + WS_HS)); } SEAM(pb + 9); }
        if (PHON(12) && IN(pb + 10)) { LC();
            unsigned char* ws = WSP();
            build_tpre(C, (const unsigned*)(ws + WS_CTL) + CW_ECNT + l * NE);
            REP(12) {
            __syncthreads();
            int kk = D / 2; OPAQ(kk);
            pg8::Gemm g{(const bf16*)(ws + WS_XB8), (const bf16*)(ws + WS_WEGU), NSLOT_MAX, NE * 512, kk, (const int*)(ws + WS_TOKOF)}; ExpertOrder<1> S{C.vcu, C.G, (const LAS int*)(C.lds + TPRE_OFF)}; EpiSwiGLU<true> E{ws + WS_ACT, (const float*)(ws + WS_GSLOT)};
            pg8::gemm_phase<EpiSwiGLU<true>, ExpertOrder<1>, true, true, true, true>(C.lds, g, S, E, C.tid);
            }
            SEAM(pb + 10);
        }
        if (PHON(13) && IN(pb + 11)) { LC();
            { unsigned char* ws = WSP(); build_tpre(C, (const unsigned*)(ws + WS_CTL) + CW_ECNT + l * NE); }
            REP(18) if (PHON(18)) { __syncthreads(); unsigned char* ws = WSP(); int kk = DE / 2; OPAQ(kk);
              pg8::Gemm g{(const bf16*)(ws + WS_ACT), (const bf16*)(ws + WS_WEDN), NSLOT_MAX, NE * 1024, kk}; ExpertOrder<2> S{C.vcu, C.G, (const LAS int*)(C.lds + TPRE_OFF)}; EpiDown<true> E{(unsigned char*)(ws + WS_HS)};
              pg8::gemm_phase<EpiDown<true>, ExpertOrder<2>, true, true, false, true>(C.lds, g, S, E, C.tid); }
            __syncthreads();
            REP(19) if (PHON(19)) { __syncthreads(); unsigned char* ws = WSP(); int kk = DE / 2; OPAQ(kk);
              pg8::Gemm g{(const bf16*)(ws + WS_ACTSH), (const bf16*)(ws + WS_WSDN + (size_t)l * (1024 * 256)), T, D, kk}; PlainOrder<4> S{C.vcu, C.G, (T / 256) * 4}; EpiDown<true> E{(unsigned char*)(ws + WS_HS) + (size_t)NSLOT_MAX * 1024};
              pg8::gemm_phase<EpiDown<true>, PlainOrder<4>, true, true, false, true>(C.lds, g, S, E, C.tid); }
            SEAM(pb + 11);
        }
        if (PHON(14) && IN(pb + 12)) { LC();
            REP(14) { unsigned char* ws = WSP();
              ph_combine(C, (const bf16*)(ws + WS_AR), (const unsigned char*)(ws + WS_HS), (const int*)(ws + WS_SLOTOF), PIN(9) + l * D, PIN(10) + l * D, (bf16*)(ws + WS_XRES), ws + WS_XB8, l == 1 ? (float*)ldptr(PTAB, 19) : nullptr,
                         PIN(4), PIN(5), l == 0 ? (float*)(ws + WS_LOGF) : nullptr); }
            if (l == 0) { unsigned char* ws = WSP(); __syncthreads(); conv_experts(C, PIN(13), PIN(14), PIN(15), 1, ws + WS_WEGU, ws + WS_WEDN, C.vcu, C.G); }
            SEAM(pb + 12);
        }
    }
#undef IN
#undef SEAM
#undef PIN
#undef WSP
#undef OPAQ
#undef REP
#undef NREP
}
}

extern "C" void kernel_launch(void* const* d_in, const int* in_sizes, int n_in, void* d_out, int out_size, void* d_ws, size_t ws_size, hipStream_t stream) {
    using namespace mk;
    static int grid = 0;
    if (grid == 0) {
        if (n_in != 19 || in_sizes[0] != T * D || out_size != T * D || ws_size < WS_END) { fprintf(stderr, "kernel_launch: unexpected problem shape (n_in %d, in0 %d, out %d, ws %zu < %zu)\n", n_in, n_in > 0 ? in_sizes[0] : -1, out_size, ws_size, (size_t)WS_END); grid = -1; return; }
        int dev = 0, cus = 0, per_cu = 0;
        if (hipGetDevice(&dev) != hipSuccess || hipDeviceGetAttribute(&cus, hipDeviceAttributeMultiprocessorCount, dev) != hipSuccess) { grid = -1; return; }
        if (hipFuncSetAttribute((const void*)mk_fwd, hipFuncAttributeMaxDynamicSharedMemorySize, LDS_BYTES) != hipSuccess) { fprintf(stderr, "kernel_launch: hipFuncSetAttribute failed\n"); grid = -1; return; }
        if (hipOccupancyMaxActiveBlocksPerMultiprocessor(&per_cu, (const void*)mk_fwd, NTHR, LDS_BYTES) != hipSuccess || per_cu < 1) fprintf(stderr, "kernel_launch: occupancy query reports %d\n", per_cu);
        (void)hipGetLastError();
        grid = cus;
    }
    if (grid < 0) return;
    if (hipMemsetAsync((char*)d_ws + WS_CTL, 0, CTL_ZERO_BYTES, stream) != hipSuccess) return;
    Args a{};
    for (int i = 0; i < 19; ++i) a.in[i] = (const float*)d_in[i];
    a.out = (float*)d_out; a.ws = (unsigned char*)d_ws;
#if MK_MULTI
    for (int p = 0; p < NPH; ++p) {
        if (p == 2 || (p >= 15 && p <= 17)) continue;
        a.ph_lo = p; a.ph_hi = p + 1;
        hipLaunchKernelGGL(mk_fwd, dim3(grid), dim3(NTHR), LDS_BYTES, stream, a);
    }
#else
    a.ph_lo = 0; a.ph_hi = NPH;
    hipLaunchKernelGGL(mk_fwd, dim3(grid), dim3(NTHR), LDS_BYTES, stream, a);
#endif
    const hipError_t le = hipPeekAtLastError();
    if (le != hipSuccess) fprintf(stderr, "kernel_launch: launch failed: %s\n", hipGetErrorName(le));
}
```

```cpp
#include <hip/hip_runtime.h>
#include <cstdio>
#include <cstdint>
namespace pg8 {
#define PG8_LAS __attribute__((address_space(3)))
typedef unsigned short bf16_t;
typedef short bf16x8 __attribute__((ext_vector_type(8)));
typedef float f32x4 __attribute__((ext_vector_type(4)));
typedef unsigned u32x4 __attribute__((ext_vector_type(4)));
typedef int i32x4 __attribute__((ext_vector_type(4)));
typedef int i32x8 __attribute__((ext_vector_type(8)));
__device__ __forceinline__ i32x8 cat8(bf16x8 a, bf16x8 b) { return __builtin_shufflevector(__builtin_bit_cast(i32x4, a), __builtin_bit_cast(i32x4, b), 0, 1, 2, 3, 4, 5, 6, 7); }
constexpr int BM = 256, BK = 64, HALF = 128, HTB = HALF * BK * 2  , STAGE_BYTES = 8 * HTB, NXCD = 8, WGM = 8;

__host__ __device__ __forceinline__ int lds_byte(int r, int c) { const int st = (r >> 4) * 2 + (c >> 5), rr = r & 15, cc = c & 31, ob = rr * 64 + cc * 2; return st * 1024 + (ob ^ (((ob >> 9) & 1) << 5)); }
__host__ __device__ __forceinline__ void stage_rc(int b, int& R, int& C) { const int st = b / 1024, sb = b % 1024, swz = sb ^ (((sb >> 9) & 1) << 5); R = (st >> 1) * 16 + swz / 64; C = (st & 1) * 32 + (swz % 64) / 2; }
__host__ __device__ __forceinline__ int perm32(int rho) { const int n = rho >> 4, i = rho & 15; return 8 * (i >> 2) + 4 * n + (i & 3); }

struct Unit { int pm, pn; int hf = 0; };
struct Gemm { const bf16_t* A; const bf16_t* Bt; int M, N, K; const int* arow = nullptr; };

struct StaticOrder {
    int nM, nN, nwg, G, c;
    __host__ __device__ void init(int M, int N, int G_, int c_) { nM = M / BM; nN = N / BM; nwg = nM * nN; G = G_; c = c_; }
    __host__ __device__ bool next(int i, Unit& u) const {
        const long L = (long)i * G + c; if (L >= nwg) return false;
        int wgid = (int)L; { const int q = nwg / NXCD, r = nwg % NXCD, xcd = wgid % NXCD, off = wgid / NXCD; wgid = (xcd < r ? xcd * (q + 1) : r * (q + 1) + (xcd - r) * q) + off; }
        const int nig = WGM * nN, gid = wgid / nig, fm = gid * WGM, gsz = (nM - fm) < WGM ? (nM - fm) : WGM;
        u.pm = fm + ((wgid % nig) % gsz); u.pn = (wgid % nig) / gsz; return true;
    }
    __device__ __forceinline__ void a_ready(const Unit&) const {}
    __device__ __forceinline__ void done(const Unit&) const {}
};

__device__ __forceinline__ unsigned cvt_pk_bf16(float lo, float hi) { unsigned r; asm volatile("v_cvt_pk_bf16_f32 %0, %1, %2" : "=v"(r) : "v"(lo), "v"(hi)); return r; }
typedef float f32x2 __attribute__((ext_vector_type(2)));
__device__ __forceinline__ f32x2 gelu_pk(f32x2 v) {
    const f32x2 av = __builtin_elementwise_abs(v), d = av * 0.2316418882f + 1.0f;
    f32x2 t; t.x = __builtin_amdgcn_rcpf(d.x); t.y = __builtin_amdgcn_rcpf(d.y);
    f32x2 q = t * 0.5307027145f + (-0.7265760135f); q = q * t + 0.7107068705f; q = q * t + (-0.142248368f); q = q * t + 0.127414796f; q = q * t;
    const f32x2 s = (v * v) * (-0.72134752044f);
    f32x2 e; e.x = __builtin_amdgcn_exp2f(s.x); e.y = __builtin_amdgcn_exp2f(s.y);
    const f32x2 m = v * (q * e), r = v - m;
    f32x2 o; o.x = v.x < 0.f ? m.x : r.x; o.y = v.y < 0.f ? m.y : r.y; return o;
}

template <int ACT  > struct EpiBf16 {
    static constexpr bool PERM = true, AFTER_DRAIN = false; static_assert(ACT == 0 || ACT == 1, "EpiBf16: ACT is 0 (none) or 1 (gelu_pk)");
    bf16_t* O; int ldc; const float* bias; int split_cols; size_t split_stride; float scale0;
    __device__ __forceinline__ void operator()(const f32x4 (&acc)[2][2][4][2], const Unit& u, int wr, int wc, int fr, int fq) const {
        const int row0 = u.pm * BM + wr * 64 + fr; int colt = u.pn * BM; bf16_t* base = O;
        float sc = 1.f; if (split_cols) { const int t = colt / split_cols; base += (size_t)t * split_stride; colt -= t * split_cols; if (t == 0) sc = scale0; }
        const int col0 = colt + wc * 32 + 8 * fq, bcol0 = u.pn * BM + wc * 32 + 8 * fq;
        f32x4 bv[2][2];
#pragma unroll
        for (int bj = 0; bj < 2; ++bj)
#pragma unroll
            for (int n = 0; n < 2; ++n) bv[bj][n] = bias ? *(const f32x4*)(bias + bcol0 + bj * HALF + 4 * n) : (f32x4){0.f, 0.f, 0.f, 0.f};
#pragma unroll
        for (int ai = 0; ai < 2; ++ai)
#pragma unroll
            for (int m = 0; m < 4; ++m) { bf16_t* rowp = base + (size_t)(row0 + ai * HALF + m * 16) * ldc + col0;
#pragma unroll
                for (int bj = 0; bj < 2; ++bj) { f32x4 v0 = acc[ai][bj][m][0] + bv[bj][0], v1 = acc[ai][bj][m][1] + bv[bj][1];
                    if (ACT == 1) { f32x2 a = gelu_pk((f32x2){v0[0], v0[1]}), b = gelu_pk((f32x2){v0[2], v0[3]}), c = gelu_pk((f32x2){v1[0], v1[1]}), d = gelu_pk((f32x2){v1[2], v1[3]});
                        v0 = (f32x4){a.x, a.y, b.x, b.y}; v1 = (f32x4){c.x, c.y, d.x, d.y}; }
                    v0 = v0 * sc; v1 = v1 * sc; u32x4 w; w.x = cvt_pk_bf16(v0[0], v0[1]); w.y = cvt_pk_bf16(v0[2], v0[3]); w.z = cvt_pk_bf16(v1[0], v1[1]); w.w = cvt_pk_bf16(v1[2], v1[3]);
                    *(u32x4*)(rowp + bj * HALF) = w; } }
    }
};
template <class Epi, class Sched, bool ALIGN_EPI = false, bool SP2 = false, bool GATHER = false, bool F8 = false>
__device__ __forceinline__ void gemm_phase(PG8_LAS unsigned char* lds, const Gemm g, const Sched& S, const Epi& E, const int tid_in) {
    const int tid = tid_in,
              wid = __builtin_amdgcn_readfirstlane(tid >> 6), lane = tid & 63, wr = wid >> 2, wc = wid & 3, fr = lane & 15, fq = lane >> 4;
    const int K = g.K, nt = K / BK;
    unsigned voffA[2], voffB[2], voffA1[2], nvA0[2], nvA1[2]; int gR[2], gC[2];
#pragma unroll
    for (int i = 0; i < 2; ++i) { int R, C; stage_rc(tid * 16 + i * 8192, R, C); const int Rb = Epi::PERM ? ((R & ~31) + perm32(R & 31)) : R;
        voffA[i] = (unsigned)(R * K + C) * 2u; voffB[i] = (unsigned)(Rb * K + C) * 2u; voffA1[i] = voffA[i]; nvA0[i] = voffA[i]; nvA1[i] = voffA[i]; gR[i] = R; gC[i] = C; }
    const size_t kstep = (size_t)(BK * 2);
    const size_t hstep = (size_t)HALF * K * 2;
    const size_t tstep = 2 * hstep;
    const unsigned ldsw = (unsigned)wid * 1024u;
    const unsigned ldsu = (unsigned)__builtin_amdgcn_readfirstlane((int)((unsigned)(uintptr_t)lds + ldsw));
    const int aoff = lds_byte(wr * 64 + fr, fq * 8), boff = lds_byte(wc * 32 + fr, fq * 8);
#define PG8_SA(b, h) (((b) * 2 + (h)) * HTB)
#define PG8_SB(b, h) ((4 + (b) * 2 + (h)) * HTB)
#define PG8_DMA(sbase, vo, ldsdst) do { unsigned keep_; asm volatile("s_mov_b32 %0, m0\n\ts_mov_b32 m0, %3\n\ts_nop 0\n\tglobal_load_lds_dwordx4 %1, %2\n\ts_mov_b32 m0, %0" : "=&s"(keep_) : "v"(vo), "s"(sbase), "s"(ldsdst) : "memory"); } while (0)
#define PG8_STAGE(bufoff, gbase, voff) do { _Pragma("unroll") for (int _i = 0; _i < 2; ++_i) PG8_DMA((const char*)(gbase), (voff)[_i], ldsu + (unsigned)((bufoff) + _i * 8192)); } while (0)
#define PG8_GROW(dst0, dst1, pm_) do { if constexpr (GATHER) { _Pragma("unroll") for (int _i = 0; _i < 2; ++_i) { const int r0_ = g.arow[(pm_) * 256 + gR[_i]], r1_ = g.arow[(pm_) * 256 + 128 + gR[_i]]; \
        dst0[_i] = (unsigned)(r0_ * K + gC[_i]) * 2u; dst1[_i] = (unsigned)(r1_ * K + gC[_i]) * 2u; } } } while (0)
#define PG8_STAGE_A(bufoff, h, koff, nx) do { if constexpr (GATHER) { _Pragma("unroll") for (int _i = 0; _i < 2; ++_i) { const unsigned vo_ = (nx) ? ((h) ? nvA1[_i] : nvA0[_i]) : ((h) ? voffA1[_i] : voffA[_i]); \
        PG8_DMA((const char*)g.A + (koff), vo_, ldsu + (unsigned)((bufoff) + _i * 8192)); } } \
    else { PG8_STAGE(bufoff, ((nx) ? nA : cA) + (koff) + ((h) ? hstep : 0), voffA); } } while (0)
#define PG8_LDA(dst, b, h) do { _Pragma("unroll") for (int m = 0; m < 4; ++m) _Pragma("unroll") for (int k = 0; k < 2; ++k) dst[m][k] = *(const PG8_LAS bf16x8*)(lds + PG8_SA(b, h) + aoff + m * 2048 + k * 1024); } while (0)
#define PG8_LDB(dst, b, h) do { _Pragma("unroll") for (int n = 0; n < 2; ++n) _Pragma("unroll") for (int k = 0; k < 2; ++k) dst[n][k] = *(const PG8_LAS bf16x8*)(lds + PG8_SB(b, h) + boff + n * 2048 + k * 1024); } while (0)
#define PG8_MMA(ai, bj, At, Bt) do { __builtin_amdgcn_s_setprio(1); _Pragma("unroll") for (int m = 0; m < 4; ++m) _Pragma("unroll") for (int n = 0; n < 2; ++n) { \
        if constexpr (F8) acc[ai][bj][m][n] = __builtin_amdgcn_mfma_scale_f32_16x16x128_f8f6f4(cat8(Bt[n][0], Bt[n][1]), cat8(At[m][0], At[m][1]), acc[ai][bj][m][n], 0, 0, 0, 0, 0, 0); \
        else { _Pragma("unroll") for (int k = 0; k < 2; ++k) acc[ai][bj][m][n] = __builtin_amdgcn_mfma_f32_16x16x32_bf16(Bt[n][k], At[m][k], acc[ai][bj][m][n], 0, 0, 0); } } __builtin_amdgcn_s_setprio(0); } while (0)
#define PG8_WAIT_V(n) asm volatile("s_waitcnt vmcnt(" #n ")" ::: "memory")
#define PG8_WAIT_L(n) asm volatile("s_waitcnt lgkmcnt(" #n ")" ::: "memory")
#define PG8_BAR __builtin_amdgcn_s_barrier()
#define PG8_SCHED __builtin_amdgcn_sched_barrier(0)
    Unit cur, nxt; int ui = 0;
    if (!S.next(0, cur)) return;
    f32x4 acc[2][2][4][2];
    float zz = 0.f; asm volatile("" : "+v"(zz));
#pragma unroll
    for (int a = 0; a < 2; ++a)
#pragma unroll
        for (int b = 0; b < 2; ++b)
#pragma unroll
            for (int m = 0; m < 4; ++m)
#pragma unroll
                for (int n = 0; n < 2; ++n) acc[a][b][m][n] = (f32x4){zz, zz, zz, zz};
    bf16x8 At[4][2], B0[2][2], B1[2][2];
    const char* cA = (const char*)g.A + (size_t)cur.pm * tstep; const char* cB = (const char*)g.Bt + (size_t)cur.pn * tstep;
    S.a_ready(cur);
    PG8_GROW(voffA, voffA1, cur.pm);
    const char* nA = cA; const char* nB = cB;
    if constexpr (SP2) {
        PG8_STAGE(PG8_SB(0, 0), cB, voffB); PG8_STAGE(PG8_SB(0, 1), cB + hstep, voffB); PG8_STAGE_A(PG8_SA(0, 0), 0, 0, false); PG8_STAGE_A(PG8_SA(0, 1), 1, 0, false);
        if (wr == 1) PG8_BAR;
        PG8_WAIT_V(2); PG8_BAR;
        PG8_STAGE(PG8_SB(1, 0), cB + kstep, voffB); PG8_STAGE_A(PG8_SA(1, 0), 0, kstep, false); PG8_STAGE(PG8_SB(1, 1), cB + hstep + kstep, voffB);
        PG8_WAIT_V(6); PG8_BAR;
    } else {
        PG8_STAGE(PG8_SB(0, 0), cB, voffB); PG8_STAGE(PG8_SA(0, 0), cA, voffA); PG8_STAGE(PG8_SB(0, 1), cB + hstep, voffB); PG8_STAGE(PG8_SA(0, 1), cA + hstep, voffA);
        if (wr == 1) PG8_BAR;
        PG8_WAIT_V(4); PG8_BAR;
        PG8_STAGE(PG8_SB(1, 0), cB + kstep, voffB); PG8_STAGE(PG8_SA(1, 0), cA + kstep, voffA); PG8_STAGE(PG8_SB(1, 1), cB + hstep + kstep, voffB);
        PG8_WAIT_V(6); PG8_BAR;
    }
    for (;;) {
        const bool has_next = S.next(ui + 1, nxt);
        nA = has_next ? (const char*)g.A + (size_t)nxt.pm * tstep : cA; nB = has_next ? (const char*)g.Bt + (size_t)nxt.pn * tstep : cB;
        if constexpr (GATHER) { if (has_next) PG8_GROW(nvA0, nvA1, nxt.pm); else { _Pragma("unroll") for (int _i = 0; _i < 2; ++_i) { nvA0[_i] = voffA[_i]; nvA1[_i] = voffA1[_i]; } } }
        for (int t = 0; t < nt; t += 2) {
            const bool last = (t == nt - 2);
            const size_t ko1 = (size_t)(t + 1) * kstep, ko2 = last ? 0 : (size_t)(t + 2) * kstep, ko3 = ko2 + kstep;
            const char* b2 = last ? nB : cB + (size_t)(t + 2) * kstep;
            const char* b3 = b2 + kstep;
            if (last && has_next) S.a_ready(nxt);
            if constexpr (SP2) {
            PG8_LDB(B0, 0, 0); PG8_LDB(B1, 0, 1); PG8_SCHED; PG8_LDA(At, 0, 0); PG8_STAGE_A(PG8_SA(1, 1), 1, ko1, false);
            PG8_WAIT_V(8); PG8_WAIT_L(0); PG8_BAR; PG8_MMA(0, 0, At, B0); PG8_MMA(0, 1, At, B1); PG8_BAR; PG8_SCHED;
            PG8_LDA(At, 0, 1); PG8_STAGE(PG8_SB(0, 0), b2, voffB); PG8_STAGE(PG8_SB(0, 1), b2 + hstep, voffB); PG8_STAGE_A(PG8_SA(0, 0), 0, ko2, last);
            PG8_WAIT_V(8); PG8_WAIT_L(0); PG8_BAR; if (!cur.hf) { PG8_MMA(1, 0, At, B0); PG8_MMA(1, 1, At, B1); } PG8_BAR; PG8_SCHED;
            PG8_LDB(B0, 1, 0); PG8_LDB(B1, 1, 1); PG8_SCHED; PG8_LDA(At, 1, 0); PG8_STAGE_A(PG8_SA(0, 1), 1, ko2, last);
            PG8_WAIT_V(8); PG8_WAIT_L(0); PG8_BAR; PG8_MMA(0, 0, At, B0); PG8_MMA(0, 1, At, B1); PG8_BAR; PG8_SCHED;
            PG8_LDA(At, 1, 1); PG8_STAGE(PG8_SB(1, 0), b3, voffB); PG8_STAGE(PG8_SB(1, 1), b3 + hstep, voffB); PG8_STAGE_A(PG8_SA(1, 0), 0, ko3, last);
            PG8_WAIT_V(8); PG8_WAIT_L(0); PG8_BAR; if (!cur.hf) { PG8_MMA(1, 0, At, B0); PG8_MMA(1, 1, At, B1); } PG8_BAR; PG8_SCHED;
            } else {
            const char* a1 = cA + ko1; const char* a2 = (last ? nA : cA) + ko2; const char* a3 = a2 + kstep;
            PG8_LDB(B0, 0, 0); PG8_SCHED; PG8_LDA(At, 0, 0); PG8_STAGE(PG8_SA(1, 1), a1 + hstep, voffA);
            PG8_WAIT_L(8); PG8_BAR; PG8_WAIT_L(0); PG8_MMA(0, 0, At, B0); PG8_BAR; PG8_SCHED;
            PG8_LDB(B1, 0, 1); PG8_STAGE(PG8_SB(0, 0), b2, voffB);
            PG8_BAR; PG8_WAIT_L(0); PG8_MMA(0, 1, At, B1); PG8_BAR;
            PG8_LDA(At, 0, 1); PG8_STAGE(PG8_SA(0, 0), a2, voffA);
            PG8_BAR; PG8_WAIT_L(0); PG8_MMA(1, 0, At, B0); PG8_BAR; PG8_SCHED;
            PG8_STAGE(PG8_SB(0, 1), b2 + hstep, voffB);
            PG8_WAIT_V(6); PG8_BAR; PG8_MMA(1, 1, At, B1); PG8_BAR;
            PG8_LDB(B0, 1, 0); PG8_SCHED; PG8_LDA(At, 1, 0); PG8_STAGE(PG8_SA(0, 1), a2 + hstep, voffA);
            PG8_WAIT_L(8); PG8_BAR; PG8_WAIT_L(0); PG8_MMA(0, 0, At, B0); PG8_BAR; PG8_SCHED;
            PG8_LDB(B1, 1, 1); PG8_STAGE(PG8_SB(1, 0), b3, voffB);
            PG8_BAR; PG8_WAIT_L(0); PG8_MMA(0, 1, At, B1); PG8_BAR;
            PG8_LDA(At, 1, 1); PG8_STAGE(PG8_SA(1, 0), a3, voffA);
            PG8_BAR; PG8_WAIT_L(0); PG8_MMA(1, 0, At, B0); PG8_BAR; PG8_SCHED;
            PG8_STAGE(PG8_SB(1, 1), b3 + hstep, voffB);
            PG8_WAIT_V(6); PG8_BAR; PG8_MMA(1, 1, At, B1); PG8_BAR;
            }
        }
        if constexpr (ALIGN_EPI) { if (wr == 0) PG8_BAR; }
        if constexpr (!Epi::AFTER_DRAIN) { E(acc, cur, wr, wc, fr, fq); S.done(cur); }
        if (!has_next) break;
        zz = 0.f; asm volatile("" : "+v"(zz));
#pragma unroll
        for (int a = 0; a < 2; ++a)
#pragma unroll
            for (int b = 0; b < 2; ++b)
#pragma unroll
                for (int m = 0; m < 4; ++m)
#pragma unroll
                    for (int n = 0; n < 2; ++n) acc[a][b][m][n] = (f32x4){zz, zz, zz, zz};
        cur = nxt; cA = nA; cB = nB; ++ui;
        if constexpr (GATHER) { _Pragma("unroll") for (int _i = 0; _i < 2; ++_i) { voffA[_i] = nvA0[_i]; voffA1[_i] = nvA1[_i]; } }
        if constexpr (ALIGN_EPI) { if (wr == 1) PG8_BAR; }
    }
    PG8_WAIT_V(0);
    if constexpr (!ALIGN_EPI) { if (wr == 0) PG8_BAR; }
    PG8_BAR;
    if constexpr (Epi::AFTER_DRAIN) { E.fused(acc, cur, wr, wc, fr, fq, lds, wid, lane); S.done(cur); }
#undef PG8_SA
#undef PG8_SB
#undef PG8_STAGE
#undef PG8_DMA
#undef PG8_STAGE_A
#undef PG8_GROW
#undef PG8_LDA
#undef PG8_LDB
#undef PG8_MMA
#undef PG8_WAIT_V
#undef PG8_WAIT_L
#undef PG8_BAR
#undef PG8_SCHED
}
}
#define GAS __attribute__((address_space(1)))
#define LAS __attribute__((address_space(3)))
typedef unsigned short bf16;
typedef unsigned v4u __attribute__((ext_vector_type(4)));
typedef float f32x4 __attribute__((ext_vector_type(4)));
typedef short bf16x8 __attribute__((ext_vector_type(8)));
typedef GAS unsigned gu32;
typedef GAS unsigned long long gu64;
#define RLX_AGENT __ATOMIC_RELAXED, __HIP_MEMORY_SCOPE_AGENT
#define LDS_WAIT() asm volatile("s_waitcnt lgkmcnt(0)" ::: "memory")
#define VM_WAIT() asm volatile("s_waitcnt vmcnt(0)" ::: "memory")
__device__ __forceinline__ int lane_now() { int l; asm volatile("v_mbcnt_lo_u32_b32 %0, -1, 0\n\tv_mbcnt_hi_u32_b32 %0, -1, %0" : "=v"(l)); return l; }
__device__ __forceinline__ int shfl_xor_l(int v, int o) { return __builtin_amdgcn_ds_bpermute((lane_now() ^ o) << 2, v); }
__device__ __forceinline__ unsigned shfl_xor_l(unsigned v, int o) { return (unsigned)shfl_xor_l((int)v, o); }
__device__ __forceinline__ float shfl_xor_l(float v, int o) { return __builtin_bit_cast(float, shfl_xor_l(__builtin_bit_cast(int, v), o)); }
__device__ __forceinline__ int shfl_up_l(int v, int o) { const int l = lane_now(), s = l - o; return __builtin_amdgcn_ds_bpermute((s < 0 ? l : s) << 2, v); }
__device__ __forceinline__ float shfl_up_l(float v, int o) { return __builtin_bit_cast(float, shfl_up_l(__builtin_bit_cast(int, v), o)); }
#define __shfl_xor(v, o) shfl_xor_l((v), (o))
#define __shfl_up(v, o) shfl_up_l((v), (o))
__device__ __forceinline__ unsigned long long rt() { return __builtin_amdgcn_s_memrealtime(); }
__device__ __forceinline__ unsigned f2bf(float f) { unsigned u = __builtin_bit_cast(unsigned, f); return (u + 0x7fffu + ((u >> 16) & 1u)) >> 16; }
__device__ __forceinline__ unsigned pk2(float lo, float hi) { return f2bf(lo) | (f2bf(hi) << 16); }

#define XB_TMO      128
#define XB_XCNT(j)  (256  + 64 * (j))
#define XB_XSUB(j)  (1280 + 64 * (j))
#define XB_XGEN(j)  (2304 + 64 * (j))
#define XB_TOP      3328
#define XB_TOPGEN   3392
#define XCD_BAR_WORDS 3456
#define XB_SPIN_CAP (1u << 18)

__device__ __forceinline__ unsigned xb_ld(unsigned* p)              { return __hip_atomic_load(p, __ATOMIC_RELAXED, __HIP_MEMORY_SCOPE_AGENT); }
__device__ __forceinline__ unsigned xb_add(unsigned* p, unsigned v) { return __hip_atomic_fetch_add(p, v, __ATOMIC_RELAXED, __HIP_MEMORY_SCOPE_AGENT); }
__device__ __forceinline__ unsigned xb_xcc_id() { return (unsigned)__builtin_amdgcn_s_getreg((3 << 11) | 20) & 0xFu; }
#define XB_SPIN(cond, bar) do { unsigned _sp = 0; while (cond) { __builtin_amdgcn_s_sleep(1); \
    if ((++_sp & 255u) == 0u) { if (xb_ld(&(bar)[XB_TMO])) break; if (_sp > XB_SPIN_CAP) { atomicAdd(&(bar)[XB_TMO], 1u); break; } } } } while (0)

struct XcdBarrier {
    unsigned* bar; unsigned x;
    volatile LAS unsigned* st;
};

__device__ __forceinline__ XcdBarrier xcd_barrier_post(unsigned* bar, volatile LAS unsigned* st) {
    XcdBarrier b; b.bar = bar; b.x = xb_xcc_id(); b.st = st;
    if (threadIdx.x == 0) (void)xb_add(&bar[XB_XCNT(b.x)], 1u);
    return b;
}
__device__ __forceinline__ void xcd_barrier_complete(unsigned* bar, unsigned x, unsigned& nloc, unsigned& nx) {
    const unsigned G = gridDim.x * gridDim.y * gridDim.z;
    unsigned sum, cnt, mine, sp = 0u;
    for (;;) {
        sum = 0u; cnt = 0u; mine = 0u;
#pragma unroll
        for (unsigned j = 0; j < 16; ++j) { const unsigned c = xb_ld(&bar[XB_XCNT(j)]); sum += c; cnt += (c > 0u) ? 1u : 0u; mine = (j == x) ? c : mine; }
        if (sum == G) break;
        __builtin_amdgcn_s_sleep(1);
        if ((++sp & 255u) == 0u) { if (xb_ld(&bar[XB_TMO])) break; if (sp > XB_SPIN_CAP) { atomicAdd(&bar[XB_TMO], 1u); break; } }
    }
    nloc = mine > 0u ? mine : 1u; nx = cnt > 0u ? cnt : 1u;
}

__device__ __forceinline__ void xcd_barrier(const XcdBarrier& b) {
    asm volatile("s_waitcnt vmcnt(0)" ::: "memory");
    __syncthreads();
    if (threadIdx.x == 0) {
        unsigned* bar = b.bar;
        __builtin_amdgcn_s_waitcnt(0);
        unsigned nloc = b.st[0], nx = b.st[1];
        if (nloc == 0u) { xcd_barrier_complete(bar, b.x, nloc, nx); b.st[0] = nloc; b.st[1] = nx; }
        const unsigned old = xb_add(&bar[XB_XSUB(b.x)], 1u);
        const unsigned gen = old / nloc;
        if (old + 1u == (gen + 1u) * nloc) {
            __builtin_amdgcn_fence(__ATOMIC_RELEASE, "agent");
            asm volatile("s_waitcnt vmcnt(0)" ::: "memory");
            const unsigned og = xb_add(&bar[XB_TOP], 1u);
            const unsigned tg = og / nx;
            if (og + 1u == (tg + 1u) * nx) xb_add(&bar[XB_TOPGEN], 1u);
            else XB_SPIN(xb_ld(&bar[XB_TOPGEN]) == tg, bar);
            __builtin_amdgcn_fence(__ATOMIC_ACQUIRE, "agent");
            xb_add(&bar[XB_XGEN(b.x)], 1u);
            asm volatile("s_waitcnt vmcnt(0)" ::: "memory");
        } else {
            XB_SPIN(xb_ld(&bar[XB_XGEN(b.x)]) == gen, bar);
            __builtin_amdgcn_fence(__ATOMIC_ACQUIRE, "agent");
            asm volatile("s_waitcnt vmcnt(0)" ::: "memory");
        }
    }
    __syncthreads();
}
namespace mk {
typedef float f32x16 __attribute__((ext_vector_type(16)));
typedef float f32x2 __attribute__((ext_vector_type(2)));
typedef short s16x4 __attribute__((ext_vector_type(4)));
typedef unsigned u32x2 __attribute__((ext_vector_type(2)));
typedef unsigned u32x4 __attribute__((ext_vector_type(4)));

constexpr int NWAVES = 8, NTHR = 512;
constexpr int BATCH = 4, SEQ = 8192, D = 1024, H = 16, HD = 64, T = BATCH * SEQ;
constexpr int NE = 256, TOPK = 8, DE = 256, NGRP = 8, GRPSZ = 32;
constexpr int NBLK = SEQ / 256;
constexpr int NSLOT_MAX = 327680;
constexpr float LN_EPS = 1e-5f;
constexpr float DN_ALPHA = 1.4142135623730951f;
constexpr float ROUTED_SCALE = 2.5f;
constexpr float LOG2E = 1.4426950408889634f;
constexpr float C2 = 0.125f * LOG2E;
constexpr float XQ_SCALE = 16.f, WQ_SCALE = 256.f, AQ_SCALE = 64.f, OQ_SCALE = 64.f, F8_MAX = 448.f;
constexpr float GS_FOLD = AQ_SCALE / (XQ_SCALE * WQ_SCALE);
constexpr int FOXW = 3 * D + H;

constexpr size_t MiB = 1u << 20;
constexpr size_t WS_CTL = 0, CTL_ZERO_BYTES = 1 * MiB;
constexpr size_t WS_WMI = 2 * MiB;
constexpr size_t WS_WMO = 8 * MiB;
constexpr size_t WS_WFI = 10 * MiB;
constexpr size_t WS_WFO = 16 * MiB;
constexpr size_t WS_WR = 18 * MiB;
constexpr size_t WS_WSGU = 21 * MiB;
constexpr size_t WS_WSDN = 23 * MiB;
constexpr size_t WS_WEGU = 24 * MiB;
constexpr size_t WS_WEDN = 280 * MiB;
constexpr size_t WS_XRES = 408 * MiB;
constexpr size_t WS_Z = 536 * MiB;
constexpr size_t WS_XB8 = 600 * MiB;
constexpr size_t WS_XB = 664 * MiB;
constexpr size_t WS_AR = 728 * MiB;
constexpr size_t WS_LOGP = 920 * MiB;
constexpr size_t WS_ACTSH = 984 * MiB;
constexpr size_t WS_TOPI = 1000 * MiB;
constexpr size_t WS_GATE = 1001 * MiB;
constexpr size_t WS_SLOTOF = 1002 * MiB;
constexpr size_t WS_TOKOF = 1003 * MiB;
constexpr size_t WS_GSLOT = 1005 * MiB;
constexpr size_t WS_KMEAN = 1008 * MiB;
constexpr size_t WS_LOGF = 1009 * MiB;
constexpr size_t WS_CUM = 1011 * MiB;
constexpr size_t WS_OVL = 1016 * MiB;
constexpr size_t WS_Q = WS_OVL, WS_K = WS_OVL + 64 * MiB, WS_V = WS_OVL + 128 * MiB, WS_O = WS_OVL + 192 * MiB;
constexpr size_t WS_MLIST = WS_OVL + 256 * MiB;
constexpr size_t WS_PARTO = WS_OVL + 288 * MiB;
constexpr size_t WS_PARTML = WS_OVL + 480 * MiB;
constexpr size_t WS_HS = WS_OVL;
constexpr size_t WS_ACT = WS_OVL + 640 * MiB;
constexpr size_t WS_END = WS_OVL + 800 * MiB;
static_assert(WS_END <= 2048 * MiB, "d_ws map");
static_assert(WS_PARTML + (size_t)T * H * 3 * 2 * 4 <= WS_END, "attention overlay");
constexpr int MLIST_PER_BH = 256 * 496;
constexpr int CW_BAR = 4096;
constexpr int CW_MCNT = 16384;
constexpr int CW_ECNT = 20480;
constexpr int CW_ECUR = 21504;
constexpr int CW_FOXQ = 24576;
constexpr int CW_KSUM = 131072;
constexpr int CW_NORM = 24832;
constexpr int RING_BYTES = 131072, LDSCTL_OFF = 155648, MISC_OFF = LDSCTL_OFF + 320, TPRE_OFF = LDSCTL_OFF + 1024, PTAB_OFF = LDSCTL_OFF + 4096, LDS_BYTES = 163840;
typedef __bf16 bf16x2_t __attribute__((ext_vector_type(2)));
__device__ __forceinline__ unsigned cvtpk(float lo, float hi) { f32x2 v = {lo, hi}; bf16x2_t b = __builtin_convertvector(v, bf16x2_t); return __builtin_bit_cast(unsigned, b); }
__device__ __forceinline__ float bf2f(unsigned b) { return __uint_as_float(b << 16); }
__device__ __forceinline__ float bflo(unsigned w) { return __uint_as_float(w << 16); }
__device__ __forceinline__ float bfhi(unsigned w) { return __uint_as_float(w & 0xffff0000u); }
__device__ __forceinline__ float wave_sum(float v) {
#pragma unroll
    for (int o = 1; o < 64; o <<= 1) v += __shfl_xor(v, o);
    return v;
}
__device__ __forceinline__ unsigned sort_key(float x) { const unsigned b = __float_as_uint(x); return b ^ ((unsigned)((int)b >> 31) | 0x80000000u); }
__device__ __forceinline__ int crow(int r, int hi) { return (r & 3) + 8 * (r >> 2) + 4 * hi; }
__device__ __forceinline__ s16x4 vtr(const LAS unsigned char* p) { typedef short v4i16_t __attribute__((ext_vector_type(4))); return __builtin_bit_cast(s16x4, __builtin_amdgcn_ds_read_tr16_b64_v4i16((LAS v4i16_t*)p)); }

__device__ __forceinline__ unsigned long long ldptr(const LAS unsigned long long* tab, int i) { const unsigned long long v = tab[i]; const unsigned lo = __builtin_amdgcn_readfirstlane((unsigned)v), hi = __builtin_amdgcn_readfirstlane((unsigned)(v >> 32)); return ((unsigned long long)hi << 32) | lo; }

struct Ctx {
    LAS unsigned char* lds;
    int tid, lane, wave, vcu, G;
};

template <bool LO> __device__ __forceinline__ void tr_item(const float* src, size_t ld, bf16* dst, size_t dpitch, LAS float* scr, int lane) {
#pragma unroll 8
    for (int i = 0; i < 32; ++i) { const int kk = 2 * i + (lane >> 5); scr[kk * 33 + (lane & 31)] = src[(size_t)kk * ld + (lane & 31)]; }
    LDS_WAIT(); asm volatile("" ::: "memory");
    const int c = lane & 7;
#pragma unroll
    for (int j = 0; j < 4; ++j) { const int n = (lane >> 3) + 8 * j; const LAS float* s = scr + (8 * c) * 33 + n;
        float v[8];
#pragma unroll
        for (int i = 0; i < 8; ++i) { v[i] = s[i * 33]; if (LO) v[i] = v[i] - bf2f(f2bf(v[i])); }
        v4u o; o.x = pk2(v[0], v[1]); o.y = pk2(v[2], v[3]); o.z = pk2(v[4], v[5]); o.w = pk2(v[6], v[7]);
        *(GAS v4u*)(dst + (size_t)n * dpitch + 8 * c) = o; }
    LDS_WAIT(); asm volatile("" ::: "memory");
}

__device__ __forceinline__ void tr_item64(const float* src, size_t ld, bf16* dst0, size_t rstride, LAS unsigned char* scr, int lane) {
    float v[64];
    const GAS float* p = (const GAS float*)src + lane;
#pragma unroll
    for (int k = 0; k < 64; ++k) v[k] = p[(size_t)k * ld];
#pragma unroll
    for (int c = 0; c < 8; ++c) { v4u o; o.x = cvtpk(v[8 * c], v[8 * c + 1]); o.y = cvtpk(v[8 * c + 2], v[8 * c + 3]); o.z = cvtpk(v[8 * c + 4], v[8 * c + 5]); o.w = cvtpk(v[8 * c + 6], v[8 * c + 7]);
        *(LAS v4u*)(scr + lane * 144 + c * 16) = o; }
    LDS_WAIT(); asm volatile("" ::: "memory");
#pragma unroll
    for (int i = 0; i < 8; ++i) { const int row = 8 * i + (lane >> 3), c = lane & 7; const v4u o = *(const LAS v4u*)(scr + row * 144 + c * 16);
        *(GAS v4u*)(dst0 + (size_t)row * rstride + 8 * c) = o; }
    LDS_WAIT(); asm volatile("" ::: "memory");
}
__device__ __forceinline__ unsigned pk4_f8(float a, float b, float c, float d) {
    a = __builtin_amdgcn_fmed3f(a, -F8_MAX, F8_MAX); b = __builtin_amdgcn_fmed3f(b, -F8_MAX, F8_MAX); c = __builtin_amdgcn_fmed3f(c, -F8_MAX, F8_MAX); d = __builtin_amdgcn_fmed3f(d, -F8_MAX, F8_MAX);
    unsigned w = 0u; w = (unsigned)__builtin_amdgcn_cvt_pk_fp8_f32(a, b, (int)w, false); w = (unsigned)__builtin_amdgcn_cvt_pk_fp8_f32(c, d, (int)w, true); return w;
}
__device__ __forceinline__ void tr_item_f8(const float* src, size_t ld, unsigned char* dst0, size_t rstride, LAS unsigned char* scr, int lane) {
#pragma unroll 1
    for (int h = 0; h < 2; ++h) {
        float v[64];
        const GAS float* p = (const GAS float*)src + lane + (size_t)(64 * h) * ld;
#pragma unroll
        for (int k = 0; k < 64; ++k) v[k] = __builtin_nontemporal_load(p + (size_t)k * ld);
#pragma unroll
        for (int c = 0; c < 4; ++c) { v4u o;
            o.x = pk4_f8(v[16 * c] * WQ_SCALE, v[16 * c + 1] * WQ_SCALE, v[16 * c + 2] * WQ_SCALE, v[16 * c + 3] * WQ_SCALE); o.y = pk4_f8(v[16 * c + 4] * WQ_SCALE, v[16 * c + 5] * WQ_SCALE, v[16 * c + 6] * WQ_SCALE, v[16 * c + 7] * WQ_SCALE);
            o.z = pk4_f8(v[16 * c + 8] * WQ_SCALE, v[16 * c + 9] * WQ_SCALE, v[16 * c + 10] * WQ_SCALE, v[16 * c + 11] * WQ_SCALE); o.w = pk4_f8(v[16 * c + 12] * WQ_SCALE, v[16 * c + 13] * WQ_SCALE, v[16 * c + 14] * WQ_SCALE, v[16 * c + 15] * WQ_SCALE);
            *(LAS v4u*)(scr + lane * 144 + h * 64 + c * 16) = o; }
    }
    LDS_WAIT(); asm volatile("" ::: "memory");
#pragma unroll
    for (int i = 0; i < 8; ++i) { const int row = 8 * i + (lane >> 3), c = lane & 7; const v4u o = *(const LAS v4u*)(scr + row * 144 + c * 16);
        *(GAS v4u*)(dst0 + (size_t)row * rstride + 16 * c) = o; }
    LDS_WAIT(); asm volatile("" ::: "memory");
}
__device__ __forceinline__ void conv_experts(const Ctx& C, const float* wg, const float* wu, const float* wd, int l, unsigned char* WEGU, unsigned char* WEDN, int part, int nparts) {
    const int gw = part * NWAVES + C.wave, NGW = nparts * NWAVES, lane = C.lane;
    LAS unsigned char* scr = C.lds + C.wave * 9216;
    constexpr int IG = NE * 8 * 4;
    constexpr int IDN = NE * 2 * 16;
    for (int it = gw; it < 2 * IG + IDN; it += NGW) {
        if (it < 2 * IG) {
            const int up = it >= IG, r = it - up * IG, e = r >> 5, kb = (r >> 2) & 7, nb = r & 3, n0 = 64 * nb;
            const float* src = (up ? wu : wg) + ((size_t)(l * NE + e) * 1024 + 128 * kb) * 256 + 64 * nb;
            unsigned char* dst = WEGU + ((size_t)e * 512 + (n0 >> 7) * 256 + up * 128 + (n0 & 127)) * 1024 + 128 * kb;
            tr_item_f8(src, 256, dst, 1024, scr, lane);
        } else {
            const int r = it - 2 * IG, e = r >> 5, kb = (r >> 4) & 1, nb = r & 15;
            const float* src = wd + ((size_t)(l * NE + e) * 256 + 128 * kb) * 1024 + 64 * nb;
            unsigned char* dst = WEDN + ((size_t)e * 1024 + 64 * nb) * 256 + 128 * kb;
            tr_item_f8(src, 1024, dst, 256, scr, lane);
        }
    }
}

struct SmallW {
    const float *moba_in, *moba_out, *fox_in, *fox_out, *w_router, *ws_gate, *ws_up, *ws_down;
    unsigned char *WMI, *WFI, *WMO, *WFO, *WSGU, *WSDN;
    bf16 *WR;
};
__device__ __forceinline__ void conv_small(const Ctx& C, const SmallW& W) {
    LAS float* scr = (LAS float*)(C.lds + C.wave * 16384);
    const int gw = C.vcu * NWAVES + C.wave, NGW = C.G * NWAVES;
    constexpr int I_IN = 8 * 48  , I_OUT = 8 * 16, I_R = 16 * 8, I_SG = 8 * 4, I_SD = 2 * 16;
    constexpr int NIT = 2 * I_IN + 2 * I_OUT + 2 * (3 * I_R) + 2 * (2 * I_SG + I_SD);
    for (int it = gw; it < NIT; it += NGW) {
        int r = it;
        if (r < I_IN) { const int kb = r / 48, nb = r % 48; tr_item_f8(W.moba_in + (size_t)(128 * kb) * 3072 + 64 * nb, 3072, W.WMI + (size_t)(64 * nb) * 1024 + 128 * kb, 1024, (LAS unsigned char*)scr, C.lane); continue; } r -= I_IN;
        if (r < I_IN) { const int kb = r / 48, nb = r % 48; tr_item_f8(W.fox_in + (size_t)(128 * kb) * FOXW + 64 * nb, FOXW, W.WFI + (size_t)(64 * nb) * 1024 + 128 * kb, 1024, (LAS unsigned char*)scr, C.lane); continue; } r -= I_IN;
        if (r < I_OUT) { const int kb = r >> 4, nb = r & 15; tr_item_f8(W.moba_out + (size_t)(128 * kb) * 1024 + 64 * nb, 1024, W.WMO + (size_t)(64 * nb) * 1024 + 128 * kb, 1024, (LAS unsigned char*)scr, C.lane); continue; } r -= I_OUT;
        if (r < I_OUT) { const int kb = r >> 4, nb = r & 15; tr_item_f8(W.fox_out + (size_t)(128 * kb) * 1024 + 64 * nb, 1024, W.WFO + (size_t)(64 * nb) * 1024 + 128 * kb, 1024, (LAS unsigned char*)scr, C.lane); continue; } r -= I_OUT;
        if (r < 6 * I_R) {
            const int l = r / (3 * I_R), q = (r % (3 * I_R)) / I_R, s = r % I_R, kb = s >> 3, nb = s & 7;
            const float* src = W.w_router + ((size_t)l * 1024 + 64 * kb) * 256 + 32 * nb;
            bf16* base = W.WR + (size_t)l * (512 * 1536) + (size_t)(32 * nb) * 1536;
            if (q == 0) tr_item<false>(src, 256, base + 64 * kb, 1536, scr, C.lane);
            else if (q == 1) { if (kb < 8) tr_item<false>(src, 256, base + 1024 + 64 * kb, 1536, scr, C.lane); else tr_item<false>(src, 256, base + (size_t)256 * 1536 + 64 * (kb - 8), 1536, scr, C.lane); }
            else tr_item<true>(src, 256, base + (size_t)256 * 1536 + 512 + 64 * kb, 1536, scr, C.lane);
            continue; } r -= 6 * I_R;
        {
            constexpr int PER = 2 * I_SG + I_SD; const int l = r / PER; int s = r % PER;
            if (s < 2 * I_SG) { const int up = s >= I_SG; s -= up * I_SG; const int kb = s >> 2, nb = s & 3, n0 = 64 * nb;
                const float* src = (up ? W.ws_up : W.ws_gate) + ((size_t)l * 1024 + 128 * kb) * 256 + n0;
                tr_item_f8(src, 256, W.WSGU + (size_t)l * (512 * 1024) + (size_t)((n0 >> 7) * 256 + up * 128 + (n0 & 127)) * 1024 + 128 * kb, 1024, (LAS unsigned char*)scr, C.lane); }
            else { s -= 2 * I_SG; const int kb = s >> 4, nb = s & 15;
                tr_item_f8(W.ws_down + ((size_t)l * 256 + 128 * kb) * 1024 + 64 * nb, 1024, W.WSDN + (size_t)l * (1024 * 256) + (size_t)(64 * nb) * 256 + 128 * kb, 256, (LAS unsigned char*)scr, C.lane); }
        }
    }
}
__device__ __forceinline__ void to_f8_rows(const Ctx& C, const float* x, unsigned char* xb8) {
    const size_t n16 = (size_t)T * D / 16;
    for (size_t i = (size_t)C.vcu * NTHR + C.tid; i < n16; i += (size_t)C.G * NTHR) {
        const f32x4 a = *(const GAS f32x4*)(x + 16 * i) * XQ_SCALE, b = *(const GAS f32x4*)(x + 16 * i + 4) * XQ_SCALE, c = *(const GAS f32x4*)(x + 16 * i + 8) * XQ_SCALE, d = *(const GAS f32x4*)(x + 16 * i + 12) * XQ_SCALE;
        v4u o; o.x = pk4_f8(a.x, a.y, a.z, a.w); o.y = pk4_f8(b.x, b.y, b.z, b.w); o.z = pk4_f8(c.x, c.y, c.z, c.w); o.w = pk4_f8(d.x, d.y, d.z, d.w);
        *(GAS v4u*)(xb8 + 16 * i) = o;
    }
}

template <bool COL0> struct EpiF32 {
    static constexpr bool PERM = false, AFTER_DRAIN = false;
    float* out; const float* base; int ldc; float alpha;
    __device__ __forceinline__ void operator()(const pg8::f32x4 (&acc)[2][2][4][2], const pg8::Unit& u, int wr, int wc, int fr, int fq) const {
        const int row0 = u.pm * 256 + wr * 64 + fr, col0 = (COL0 ? 0 : u.pn * 256) + wc * 32 + 4 * fq;
#pragma unroll
        for (int ai = 0; ai < 2; ++ai)
#pragma unroll
            for (int m = 0; m < 4; ++m) { const size_t off = (size_t)(row0 + ai * 128 + m * 16) * ldc + col0;
#pragma unroll
                for (int bj = 0; bj < 2; ++bj)
#pragma unroll
                    for (int n = 0; n < 2; ++n) { f32x4 v = acc[ai][bj][m][n];
                        if (base) { const f32x4 b = *(const GAS f32x4*)(base + off + bj * 128 + n * 16); v = v + b * alpha; }
                        *(GAS f32x4*)(out + off + bj * 128 + n * 16) = v; } }
    }
};
struct EpiQKV {
    static constexpr bool PERM = true, AFTER_DRAIN = false;
    bf16* Qb; size_t split_stride; float scale0; unsigned* norms;
    float* ksum;
    __device__ __forceinline__ void operator()(const pg8::f32x4 (&acc)[2][2][4][2], const pg8::Unit& u, int wr, int wc, int fr, int fq) const {
        asm volatile("" : "+v"(fr), "+v"(fq));
        const int t = u.pn >> 2, colt = (u.pn & 3) * 256;
        constexpr float IS = 1.f / (XQ_SCALE * WQ_SCALE);
        bf16* base = Qb + (size_t)t * split_stride; const float sc = (t == 0 ? scale0 : 1.f) * IS;
        const int row0 = u.pm * 256 + wr * 64 + fr, col0 = colt + wc * 32 + 8 * fq;
        float nmax[2] = {0.f, 0.f};
#pragma unroll
        for (int ai = 0; ai < 2; ++ai)
#pragma unroll
            for (int m = 0; m < 4; ++m) { bf16* rowp = base + (size_t)(row0 + ai * 128 + m * 16) * D + col0;
#pragma unroll
                for (int bj = 0; bj < 2; ++bj) { const f32x4 v0 = acc[ai][bj][m][0] * sc, v1 = acc[ai][bj][m][1] * sc;
                    v4u w; w.x = cvtpk(v0[0], v0[1]); w.y = cvtpk(v0[2], v0[3]); w.z = cvtpk(v1[0], v1[1]); w.w = cvtpk(v1[2], v1[3]);
                    *(GAS v4u*)(rowp + bj * 128) = w;
                    if (t < 2) { float ss = (v0[0] * v0[0] + v0[1] * v0[1]) + (v0[2] * v0[2] + v0[3] * v0[3]) + (v1[0] * v1[0] + v1[1] * v1[1]) + (v1[2] * v1[2] + v1[3] * v1[3]);
                        ss += __shfl_xor(ss, 16); ss += __shfl_xor(ss, 32); nmax[bj] = fmaxf(nmax[bj], ss); } } }
        if (t == 1 && ksum) {
#pragma unroll
            for (int bj = 0; bj < 2; ++bj)
#pragma unroll
                for (int n = 0; n < 2; ++n) { f32x4 cs = (f32x4){0.f, 0.f, 0.f, 0.f};
#pragma unroll
                    for (int ai = 0; ai < 2; ++ai)
#pragma unroll
                        for (int m = 0; m < 4; ++m) cs = cs + acc[ai][bj][m][n];
#pragma unroll
                    for (int i = 0; i < 4; ++i) { float v = cs[i];
#pragma unroll
                        for (int o = 1; o < 16; o <<= 1) v += __shfl_xor(v, o);
                        if (fr == 0) (void)__hip_atomic_fetch_add(ksum + (size_t)u.pm * D + colt + bj * 128 + wc * 32 + 8 * fq + 4 * n + i, v * IS, __ATOMIC_RELAXED, __HIP_MEMORY_SCOPE_AGENT); } }
        }
        if (t < 2) {
#pragma unroll
            for (int bj = 0; bj < 2; ++bj) { float v = nmax[bj];
#pragma unroll
                for (int o = 1; o < 16; o <<= 1) v = fmaxf(v, __shfl_xor(v, o));
                const int head = (u.pn & 3) * 4 + 2 * bj + (wc >> 1), b = u.pm >> 5;
                if (fr == 0 && fq == 0) (void)__hip_atomic_fetch_max(norms + ((b * 16 + head) * 2 + t) * 2 + (wc & 1), __float_as_uint(v * 1.01f), __ATOMIC_RELAXED, __HIP_MEMORY_SCOPE_AGENT); }
        }
    }
};
template <bool F8> struct EpiSwiGLU {
    static constexpr bool PERM = true, AFTER_DRAIN = false;
    void* actp; const float* rowscale;
    __device__ __forceinline__ void operator()(const pg8::f32x4 (&acc)[2][2][4][2], const pg8::Unit& u, int wr, int wc, int fr, int fq) const {
        asm volatile("" : "+v"(fr), "+v"(fq));
        const int row0 = u.pm * 256 + wr * 64 + fr, col0 = (u.pn & 1) * 128 + wc * 32 + 8 * fq;
        const int ln = fr + 16 * fq, src4 = ((ln >> 2) + 16 * (ln & 3)) << 2, srow0 = u.pm * 256 + wr * 64 + (ln >> 2), scol0 = (u.pn & 1) * 128 + wc * 32 + 8 * (ln & 3);
        constexpr float IS = F8 ? 1.f / (XQ_SCALE * WQ_SCALE) : 1.f;
#pragma unroll
        for (int ai = 0; ai < 2; ++ai) if (ai == 0 || !u.hf)
#pragma unroll
            for (int m = 0; m < 4; ++m) { const int row = row0 + ai * 128 + m * 16; const float rs = rowscale ? rowscale[row] : (F8 ? GS_FOLD : 1.f);
                float o[8];
#pragma unroll
                for (int n = 0; n < 2; ++n)
#pragma unroll
                    for (int i = 0; i < 4; ++i) { const float g = acc[ai][0][m][n][i] * IS, up = acc[ai][1][m][n][i];
                        const float sg = g * __builtin_amdgcn_rcpf(1.f + __builtin_amdgcn_exp2f(-g * LOG2E)); o[4 * n + i] = sg * up * rs; }
                if constexpr (F8) { u32x2 w; w.x = pk4_f8(o[0], o[1], o[2], o[3]); w.y = pk4_f8(o[4], o[5], o[6], o[7]);
                    w.x = (unsigned)__builtin_amdgcn_ds_bpermute(src4, (int)w.x); w.y = (unsigned)__builtin_amdgcn_ds_bpermute(src4, (int)w.y);
                    *(GAS u32x2*)((unsigned char*)actp + (size_t)(srow0 + ai * 128 + m * 16) * 256 + scol0) = w; }
                else { v4u w; w.x = cvtpk(o[0], o[1]); w.y = cvtpk(o[2], o[3]); w.z = cvtpk(o[4], o[5]); w.w = cvtpk(o[6], o[7]);
                    *(GAS v4u*)((bf16*)actp + (size_t)row * 256 + col0) = w; } }
    }
};
constexpr float SO_SCALE = 64.f, SO_INV = 1.f / 64.f;
template <bool F8> struct EpiDown {
    static constexpr bool PERM = true, AFTER_DRAIN = false;
    static constexpr float sc = F8 ? SO_SCALE / (AQ_SCALE * WQ_SCALE) : SO_SCALE;
    unsigned char* out;
    __device__ __forceinline__ void operator()(const pg8::f32x4 (&acc)[2][2][4][2], const pg8::Unit& u, int wr, int wc, int fr, int fq) const {
        const int ln = fr + 16 * fq, src4 = ((ln >> 2) + 16 * (ln & 3)) << 2, fr2 = ln >> 2, fq2 = ln & 3;
        const int row0 = u.pm * 256 + wr * 64 + fr2, col0 = (u.pn & 3) * 256 + wc * 32 + 8 * fq2;
#pragma unroll
        for (int ai = 0; ai < 2; ++ai) if (ai == 0 || !u.hf)
#pragma unroll
            for (int m = 0; m < 4; ++m) { unsigned char* rowp = out + (size_t)(row0 + ai * 128 + m * 16) * 1024 + col0;
#pragma unroll
                for (int bj = 0; bj < 2; ++bj) { const f32x4 v0 = acc[ai][bj][m][0] * sc, v1 = acc[ai][bj][m][1] * sc;
                    u32x2 w; w.x = 0u; w.y = 0u;
                    w.x = __builtin_amdgcn_cvt_pk_fp8_f32(v0[0], v0[1], w.x, false); w.x = __builtin_amdgcn_cvt_pk_fp8_f32(v0[2], v0[3], w.x, true);
                    w.y = __builtin_amdgcn_cvt_pk_fp8_f32(v1[0], v1[1], w.y, false); w.y = __builtin_amdgcn_cvt_pk_fp8_f32(v1[2], v1[3], w.y, true);
                    w.x = (unsigned)__builtin_amdgcn_ds_bpermute(src4, (int)w.x); w.y = (unsigned)__builtin_amdgcn_ds_bpermute(src4, (int)w.y);
                    *(GAS u32x2*)(rowp + bj * 128) = w; } }
    }
};
template <int NN> struct PlainOrder {
    int vcu, G, nunits;
    __device__ __forceinline__ bool next(int i, pg8::Unit& u) const { const int idx = vcu + i * G; if (idx >= nunits) return false;
        u.pm = __builtin_amdgcn_readfirstlane(idx / NN); u.pn = __builtin_amdgcn_readfirstlane(idx % NN);
        int z = 0; asm volatile("" : "+s"(z)); u.hf = z;
        return true; }
    __device__ __forceinline__ void a_ready(const pg8::Unit&) const {}
    __device__ __forceinline__ void done(const pg8::Unit&) const {}
};
struct RouterOrder {
    int vcu, G;
    __device__ __forceinline__ bool next(int i, pg8::Unit& u) const { const int idx = vcu + i * G; if (idx >= 256) return false; u.pm = idx; u.pn = idx >> 7; return true; }
    __device__ __forceinline__ void a_ready(const pg8::Unit&) const {}
    __device__ __forceinline__ void done(const pg8::Unit&) const {}
};
template <int SH> struct ExpertOrder {
    int vcu, G; const LAS int* tpre;
    __device__ __forceinline__ bool next(int i, pg8::Unit& u) const {
        const int idx = vcu + i * G, ti = idx >> SH; if (ti >= tpre[NE]) return false;
        int lo = 0, hi = NE;
#pragma unroll
        for (int s = 0; s < 8; ++s) { const int mid = (lo + hi) >> 1; if (tpre[mid] <= ti) lo = mid; else hi = mid; }
        u.pm = __builtin_amdgcn_readfirstlane(ti); u.pn = __builtin_amdgcn_readfirstlane((lo << SH) + (idx & ((1 << SH) - 1)));
        u.hf = __builtin_amdgcn_readfirstlane((tpre[272 + lo] - 256 * (ti - tpre[lo])) <= 128 ? 1 : 0); return true;
    }
    __device__ __forceinline__ void a_ready(const pg8::Unit&) const {}
    __device__ __forceinline__ void done(const pg8::Unit&) const {}
};
__device__ __forceinline__ void build_tpre(const Ctx& C, const unsigned* ecnt) {
    LAS int* tpre = (LAS int*)(C.lds + TPRE_OFF);
    __syncthreads();
    int v = 0;
    if (C.tid < NE) { const int c = (int)__hip_atomic_load(ecnt + C.tid, __ATOMIC_RELAXED, __HIP_MEMORY_SCOPE_AGENT); v = (c + 255) >> 8; tpre[272 + C.tid] = c; }
    int inc = v;
#pragma unroll
    for (int o = 1; o < 64; o <<= 1) { const int t = __shfl_up(inc, o); if (C.lane >= o) inc += t; }
    if (C.tid < NE && C.lane == 63) tpre[260 + C.wave] = inc;
    __syncthreads();
    if (C.tid < NE) { int base = 0; for (int w = 0; w < C.wave; ++w) base += tpre[260 + w]; tpre[C.tid + 1] = base + inc; if (C.tid == 0) tpre[0] = 0; }
    __syncthreads();
}
struct AttnAcc { float m; f32x16 o0, o1, la; };
#define MFMA32(a, b, c) __builtin_amdgcn_mfma_f32_32x32x16_bf16((a), (b), (c), 0, 0, 0)
constexpr float NEG_INF = -__builtin_inff();

__device__ __forceinline__ void glds16(const void* gsrc, unsigned lds_dst) { unsigned keep;
    asm volatile("s_mov_b32 %0, m0\n\ts_mov_b32 m0, %2\n\ts_nop 0\n\tglobal_load_lds_dwordx4 %1, off\n\ts_mov_b32 m0, %0" : "=&s"(keep) : "v"(gsrc), "s"(lds_dst) : "memory"); }
__device__ __forceinline__ void glds4(const void* gsrc, unsigned lds_dst) { unsigned keep;
    asm volatile("s_mov_b32 %0, m0\n\ts_mov_b32 m0, %2\n\ts_nop 0\n\tglobal_load_lds_dword %1, off\n\ts_mov_b32 m0, %0" : "=&s"(keep) : "v"(gsrc), "s"(lds_dst) : "memory"); }
__device__ __forceinline__ unsigned lds_addr(const LAS unsigned char* p) { return (unsigned)__builtin_amdgcn_readfirstlane((int)(unsigned)(uintptr_t)p); }
__device__ __forceinline__ void dma_tile(const bf16* Kg, const bf16* Vg, LAS unsigned char* Ks, LAS unsigned char* Vs, int wave, int lane) {
    glds16(Kg + (size_t)lane * D + wave * 8, lds_addr(Ks + wave * 1024));
    glds16(Vg + (size_t)(16 * (wave & 3) + (lane >> 2)) * D + (wave >> 2) * 32 + (lane & 3) * 8, lds_addr(Vs + wave * 1024));
}
__device__ __forceinline__ void load_q(bf16x8 (&qr)[4], const bf16* Qrow, int hi) {
#pragma unroll
    for (int d0 = 0; d0 < 4; ++d0) qr[d0] = *(const GAS bf16x8*)(Qrow + d0 * 16 + hi * 8);
}
template <class Bias> __device__ __forceinline__ void qk_tile(f32x16& p0, f32x16& p1, const bf16x8 (&qr)[4], const LAS unsigned char* Ks, int r32, int hi, const Bias& B) {
    __builtin_amdgcn_sched_barrier(0);
    B.init(p0, p1, hi);
    const LAS unsigned char* kb = Ks + hi * 1024 + r32 * 16;
    bf16x8 kf[8];
#pragma unroll
    for (int d0 = 0; d0 < 4; ++d0) { kf[2 * d0] = *(const LAS bf16x8*)(kb + d0 * 2048); kf[2 * d0 + 1] = *(const LAS bf16x8*)(kb + d0 * 2048 + 512); }
    __builtin_amdgcn_sched_barrier(0);
#pragma unroll
    for (int d0 = 0; d0 < 4; ++d0) { p0 = MFMA32(kf[2 * d0], qr[d0], p0); p1 = MFMA32(kf[2 * d0 + 1], qr[d0], p1); }
    B.mask(p0, p1, hi);
    __builtin_amdgcn_sched_barrier(0);
}
constexpr float ATT_THR = 8.f;
__device__ __forceinline__ float half_max(float m) { auto rr = __builtin_amdgcn_permlane32_swap(__float_as_uint(m), __float_as_uint(m), false, false); return fmaxf(__uint_as_float(rr[0]), __uint_as_float(rr[1])); }
__device__ __forceinline__ void attn_rescale(AttnAcc& A, float rm) {
    const bool need = rm > A.m + ATT_THR;
    if (__any(need)) {
        const float mn = need ? rm : A.m, f = __builtin_amdgcn_exp2f(A.m - mn);
        A.la[0] *= f;
#pragma unroll
        for (int r = 0; r < 16; ++r) { A.o0[r] *= f; A.o1[r] *= f; }
        A.m = mn;
    }
}
__device__ __forceinline__ void softmax_pv(AttnAcc& A, f32x16& p0, f32x16& p1, const LAS unsigned char* Vs, int hi, int lane) {
    __builtin_amdgcn_sched_barrier(0);
    const LAS unsigned char* vb = Vs + ((lane >> 4) & 1) * 32 + (lane & 3) * 8 + (4 * hi + ((lane & 15) >> 2)) * 64;
    s16x4 vt[16];
#pragma unroll
    for (int ks = 0; ks < 4; ++ks) { vt[4 * ks] = vtr(vb + ks * 1024); vt[4 * ks + 1] = vtr(vb + ks * 1024 + 512); vt[4 * ks + 2] = vtr(vb + (4 + ks) * 1024); vt[4 * ks + 3] = vtr(vb + (4 + ks) * 1024 + 512); }
    __builtin_amdgcn_sched_barrier(0);
    float rm = fmaxf(p0[0], p1[0]);
#pragma unroll
    for (int r = 1; r < 16; ++r) rm = fmaxf(fmaxf(rm, p0[r]), p1[r]);
    rm = half_max(rm);
    attn_rescale(A, rm);
    const float mn = A.m;
#pragma unroll
    for (int r = 0; r < 16; ++r) { p0[r] = __builtin_amdgcn_exp2f(p0[r] - mn); p1[r] = __builtin_amdgcn_exp2f(p1[r] - mn); }
    v4u pw[4];
#pragma unroll
    for (int s = 0; s < 2; ++s) {
        pw[s].x = cvtpk(p0[8 * s + 0], p0[8 * s + 1]); pw[s].y = cvtpk(p0[8 * s + 2], p0[8 * s + 3]); pw[s].z = cvtpk(p0[8 * s + 4], p0[8 * s + 5]); pw[s].w = cvtpk(p0[8 * s + 6], p0[8 * s + 7]);
        pw[2 + s].x = cvtpk(p1[8 * s + 0], p1[8 * s + 1]); pw[2 + s].y = cvtpk(p1[8 * s + 2], p1[8 * s + 3]); pw[2 + s].z = cvtpk(p1[8 * s + 4], p1[8 * s + 5]); pw[2 + s].w = cvtpk(p1[8 * s + 6], p1[8 * s + 7]);
    }
    const bf16x8 ones = {(short)0x3F80, (short)0x3F80, (short)0x3F80, (short)0x3F80, (short)0x3F80, (short)0x3F80, (short)0x3F80, (short)0x3F80};
#pragma unroll
    for (int ks = 0; ks < 4; ++ks) {
        const bf16x8 pa = __builtin_bit_cast(bf16x8, pw[ks]);
        const s16x4 a0 = vt[4 * ks], a1 = vt[4 * ks + 1], b0 = vt[4 * ks + 2], b1 = vt[4 * ks + 3];
        const bf16x8 v0 = {a0[0], a0[1], a0[2], a0[3], a1[0], a1[1], a1[2], a1[3]}, v1 = {b0[0], b0[1], b0[2], b0[3], b1[0], b1[1], b1[2], b1[3]};
        A.o0 = MFMA32(v0, pa, A.o0); A.o1 = MFMA32(v1, pa, A.o1); A.la = MFMA32(ones, pa, A.la);
    }
    __builtin_amdgcn_sched_barrier(0);
}
__device__ __forceinline__ void acc_init(AttnAcc& A) {
    A.m = NEG_INF;
    float z = 0.f; asm volatile("" : "+v"(z));
#pragma unroll
    for (int r = 0; r < 16; ++r) { A.o0[r] = z; A.o1[r] = z; A.la[r] = z; }
}
#define ATT_SB() __builtin_amdgcn_sched_barrier(0)
template <class Bias> __device__ __forceinline__ void attn_step(AttnAcc& A, f32x16& pc0, f32x16& pc1, f32x16& pn0, f32x16& pn1, const bf16x8 (&qr)[4],
                                                               const LAS unsigned char* Kn, const LAS unsigned char* Vc, int r32, int hi, int lane, const Bias& Bn, const bool doNext) {
    ATT_SB();
    if (doNext) Bn.init(pn0, pn1, hi);
    const LAS unsigned char* kb = Kn + hi * 1024 + r32 * 16;
    bf16x8 ka[4], kc[4];
#pragma unroll
    for (int d0 = 0; d0 < 2; ++d0) { ka[2 * d0] = *(const LAS bf16x8*)(kb + d0 * 2048); ka[2 * d0 + 1] = *(const LAS bf16x8*)(kb + d0 * 2048 + 512); }
    ATT_SB();
    float ra = fmaxf(fmaxf(pc0[0], pc0[1]), fmaxf(pc0[2], pc0[3]));
    if (doNext) pn0 = MFMA32(ka[0], qr[0], pn0);
    ra = fmaxf(fmaxf(ra, pc1[0]), pc1[1]); ra = fmaxf(fmaxf(ra, pc1[2]), pc1[3]); ATT_SB();
    if (doNext) pn1 = MFMA32(ka[1], qr[0], pn1);
#pragma unroll
    for (int d0 = 2; d0 < 4; ++d0) { kc[2 * d0 - 4] = *(const LAS bf16x8*)(kb + d0 * 2048); kc[2 * d0 - 3] = *(const LAS bf16x8*)(kb + d0 * 2048 + 512); }
    ra = fmaxf(fmaxf(ra, pc0[4]), pc0[5]); ra = fmaxf(fmaxf(ra, pc0[6]), pc0[7]); ra = fmaxf(fmaxf(ra, pc1[4]), pc1[5]); ra = fmaxf(fmaxf(ra, pc1[6]), pc1[7]); ATT_SB();
    if (doNext) pn0 = MFMA32(ka[2], qr[1], pn0);
    ra = fmaxf(fmaxf(ra, pc0[8]), pc0[9]); ra = fmaxf(fmaxf(ra, pc0[10]), pc0[11]); ra = fmaxf(fmaxf(ra, pc1[8]), pc1[9]); ra = fmaxf(fmaxf(ra, pc1[10]), pc1[11]); ATT_SB();
    if (doNext) pn1 = MFMA32(ka[3], qr[1], pn1);
    ra = fmaxf(fmaxf(ra, pc0[12]), pc0[13]); ra = fmaxf(fmaxf(ra, pc0[14]), pc0[15]); ra = fmaxf(fmaxf(ra, pc1[12]), pc1[13]); ra = fmaxf(fmaxf(ra, pc1[14]), pc1[15]);
    ra = half_max(ra); ATT_SB();
    attn_rescale(A, ra);
    const float mn = A.m;
    ATT_SB();
    const LAS unsigned char* vb = Vc + ((lane >> 4) & 1) * 32 + (lane & 3) * 8 + (4 * hi + ((lane & 15) >> 2)) * 64;
    s16x4 vt[16];
    v4u pw[4];
#define ATT_VRD(ks) do { vt[4 * (ks)] = vtr(vb + (ks) * 1024); vt[4 * (ks) + 1] = vtr(vb + (ks) * 1024 + 512); vt[4 * (ks) + 2] = vtr(vb + (4 + (ks)) * 1024); vt[4 * (ks) + 3] = vtr(vb + (4 + (ks)) * 1024 + 512); } while (0)
#define ATT_EXP4(P, c) do { _Pragma("unroll") for (int i_ = 0; i_ < 4; ++i_) P[4 * (c) + i_] = __builtin_amdgcn_exp2f(P[4 * (c) + i_] - mn); } while (0)
    ATT_VRD(0); ATT_VRD(1); ATT_SB();
    if (doNext) pn0 = MFMA32(kc[0], qr[2], pn0); ATT_EXP4(pc0, 0); ATT_EXP4(pc0, 1);
    pw[0].x = cvtpk(pc0[0], pc0[1]); pw[0].y = cvtpk(pc0[2], pc0[3]); pw[0].z = cvtpk(pc0[4], pc0[5]); pw[0].w = cvtpk(pc0[6], pc0[7]); ATT_SB();
    if (doNext) pn1 = MFMA32(kc[1], qr[2], pn1); ATT_EXP4(pc0, 2); ATT_EXP4(pc0, 3);
    pw[1].x = cvtpk(pc0[8], pc0[9]); pw[1].y = cvtpk(pc0[10], pc0[11]); pw[1].z = cvtpk(pc0[12], pc0[13]); pw[1].w = cvtpk(pc0[14], pc0[15]); ATT_SB();
    ATT_VRD(2); ATT_VRD(3); ATT_SB();
    if (doNext) pn0 = MFMA32(kc[2], qr[3], pn0); ATT_EXP4(pc1, 0); ATT_EXP4(pc1, 1);
    pw[2].x = cvtpk(pc1[0], pc1[1]); pw[2].y = cvtpk(pc1[2], pc1[3]); pw[2].z = cvtpk(pc1[4], pc1[5]); pw[2].w = cvtpk(pc1[6], pc1[7]); ATT_SB();
    if (doNext) pn1 = MFMA32(kc[3], qr[3], pn1); ATT_EXP4(pc1, 2); ATT_EXP4(pc1, 3);
    pw[3].x = cvtpk(pc1[8], pc1[9]); pw[3].y = cvtpk(pc1[10], pc1[11]); pw[3].z = cvtpk(pc1[12], pc1[13]); pw[3].w = cvtpk(pc1[14], pc1[15]); ATT_SB();
#undef ATT_EXP4
#undef ATT_VRD
    if (doNext) Bn.mask(pn0, pn1, hi);
    ATT_SB();
    const bf16x8 ones = {(short)0x3F80, (short)0x3F80, (short)0x3F80, (short)0x3F80, (short)0x3F80, (short)0x3F80, (short)0x3F80, (short)0x3F80};
#pragma unroll
    for (int ks = 0; ks < 4; ++ks) {
        const bf16x8 pa = __builtin_bit_cast(bf16x8, pw[ks]);
        const s16x4 a0 = vt[4 * ks], a1 = vt[4 * ks + 1], b0 = vt[4 * ks + 2], b1 = vt[4 * ks + 3];
        const bf16x8 v0 = {a0[0], a0[1], a0[2], a0[3], a1[0], a1[1], a1[2], a1[3]}, v1 = {b0[0], b0[1], b0[2], b0[3], b1[0], b1[1], b1[2], b1[3]};
        A.o0 = MFMA32(v0, pa, A.o0); A.o1 = MFMA32(v1, pa, A.o1); A.la = MFMA32(ones, pa, A.la);
    }
    ATT_SB();
}

template <class Bias> __device__ __forceinline__ void attn_step3(AttnAcc& A, f32x16& pc0, f32x16& pc1, f32x16& pn0, f32x16& pn1, const v4u (&pwp)[4], v4u (&pw)[4], const bf16x8 (&qr)[4],
        const LAS unsigned char* Kn, const LAS unsigned char* Vp, int r32, int hi, int lane, const Bias& Bn, const bool doCur) {
    const bf16x8 ones = {(short)0x3F80, (short)0x3F80, (short)0x3F80, (short)0x3F80, (short)0x3F80, (short)0x3F80, (short)0x3F80, (short)0x3F80};
    const LAS unsigned char* kb = Kn + hi * 1024 + r32 * 16;
    const LAS unsigned char* vb = Vp + ((lane >> 4) & 1) * 32 + (lane & 3) * 8 + (4 * hi + ((lane & 15) >> 2)) * 64;
    bf16x8 ka[2], kc[2]; s16x4 va[4], vc[4], vd[4], ve[4];
#define ATT_VRD(dst, ks) do { dst[0] = vtr(vb + (ks) * 1024); dst[1] = vtr(vb + (ks) * 1024 + 512); dst[2] = vtr(vb + (4 + (ks)) * 1024); dst[3] = vtr(vb + (4 + (ks)) * 1024 + 512); } while (0)
#define ATT_V0(v) ((bf16x8){v[0][0], v[0][1], v[0][2], v[0][3], v[1][0], v[1][1], v[1][2], v[1][3]})
#define ATT_V1(v) ((bf16x8){v[2][0], v[2][1], v[2][2], v[2][3], v[3][0], v[3][1], v[3][2], v[3][3]})
#define ATT_PA(k) __builtin_bit_cast(bf16x8, pwp[k])
#define ATT_PIN(x) asm volatile("" : "+v"(x))
    ATT_SB();
    Bn.init(pn0, pn1, hi);
    ka[0] = *(const LAS bf16x8*)(kb); ka[1] = *(const LAS bf16x8*)(kb + 512); kc[0] = *(const LAS bf16x8*)(kb + 2048); kc[1] = *(const LAS bf16x8*)(kb + 2560);
    ATT_VRD(va, 0);
    ATT_SB();
    float ra = fmaxf(fmaxf(pc0[0], pc0[1]), fmaxf(pc0[2], pc0[3]));
    pn0 = MFMA32(ka[0], qr[0], pn0);
    A.o0 = MFMA32(ATT_V0(va), ATT_PA(0), A.o0);
    ra = fmaxf(fmaxf(ra, pc1[0]), pc1[1]); ra = fmaxf(fmaxf(ra, pc1[2]), pc1[3]); ra = fmaxf(fmaxf(ra, pc0[4]), pc0[5]); ra = fmaxf(fmaxf(ra, pc0[6]), pc0[7]); ATT_PIN(ra);
    ATT_VRD(vc, 1);
    ATT_SB();
    pn1 = MFMA32(ka[1], qr[0], pn1);
    A.o1 = MFMA32(ATT_V1(va), ATT_PA(0), A.o1);
    ra = fmaxf(fmaxf(ra, pc1[4]), pc1[5]); ra = fmaxf(fmaxf(ra, pc1[6]), pc1[7]); ra = fmaxf(fmaxf(ra, pc0[8]), pc0[9]); ra = fmaxf(fmaxf(ra, pc0[10]), pc0[11]); ATT_PIN(ra);
    ka[0] = *(const LAS bf16x8*)(kb + 4096); ka[1] = *(const LAS bf16x8*)(kb + 4608);
    ATT_SB();
    pn0 = MFMA32(kc[0], qr[1], pn0);
    A.la = MFMA32(ones, ATT_PA(0), A.la); A.o0 = MFMA32(ATT_V0(vc), ATT_PA(1), A.o0);
    ATT_VRD(vd, 2);
    ra = fmaxf(fmaxf(ra, pc1[8]), pc1[9]); ra = fmaxf(fmaxf(ra, pc1[10]), pc1[11]); ra = fmaxf(fmaxf(ra, pc0[12]), pc0[13]); ra = fmaxf(fmaxf(ra, pc0[14]), pc0[15]); ATT_PIN(ra); ATT_SB();
    pn1 = MFMA32(kc[1], qr[1], pn1);
    A.o1 = MFMA32(ATT_V1(vc), ATT_PA(1), A.o1); A.la = MFMA32(ones, ATT_PA(1), A.la);
    ATT_VRD(ve, 3);
    kc[0] = *(const LAS bf16x8*)(kb + 6144); kc[1] = *(const LAS bf16x8*)(kb + 6656);
    ra = fmaxf(fmaxf(ra, pc1[12]), pc1[13]); ra = fmaxf(fmaxf(ra, pc1[14]), pc1[15]); ra = half_max(ra);
    const bool need = doCur && (ra > A.m + ATT_THR);
    float mn = need ? ra : A.m; const float fr = __builtin_amdgcn_exp2f(A.m - mn); ATT_PIN(mn);
    ATT_SB();
#define ATT_EXP4(P, c) do { _Pragma("unroll") for (int i_ = 0; i_ < 4; ++i_) P[4 * (c) + i_] = __builtin_amdgcn_exp2f(P[4 * (c) + i_] - mn); } while (0)
    pn0 = MFMA32(ka[0], qr[2], pn0);
    A.o0 = MFMA32(ATT_V0(vd), ATT_PA(2), A.o0);
    { ATT_EXP4(pc0, 0); ATT_EXP4(pc0, 1); pw[0].x = cvtpk(pc0[0], pc0[1]); pw[0].y = cvtpk(pc0[2], pc0[3]); pw[0].z = cvtpk(pc0[4], pc0[5]); pw[0].w = cvtpk(pc0[6], pc0[7]); ATT_PIN(pw[0]); }
    ATT_SB();
    pn1 = MFMA32(ka[1], qr[2], pn1);
    A.o1 = MFMA32(ATT_V1(vd), ATT_PA(2), A.o1);
    { ATT_EXP4(pc0, 2); ATT_EXP4(pc0, 3); pw[1].x = cvtpk(pc0[8], pc0[9]); pw[1].y = cvtpk(pc0[10], pc0[11]); pw[1].z = cvtpk(pc0[12], pc0[13]); pw[1].w = cvtpk(pc0[14], pc0[15]); ATT_PIN(pw[1]); }
    ATT_SB();
    pn0 = MFMA32(kc[0], qr[3], pn0);
    A.la = MFMA32(ones, ATT_PA(2), A.la); A.o0 = MFMA32(ATT_V0(ve), ATT_PA(3), A.o0);
    { ATT_EXP4(pc1, 0); ATT_EXP4(pc1, 1); pw[2].x = cvtpk(pc1[0], pc1[1]); pw[2].y = cvtpk(pc1[2], pc1[3]); pw[2].z = cvtpk(pc1[4], pc1[5]); pw[2].w = cvtpk(pc1[6], pc1[7]); ATT_PIN(pw[2]); }
    ATT_SB();
    pn1 = MFMA32(kc[1], qr[3], pn1);
    A.o1 = MFMA32(ATT_V1(ve), ATT_PA(3), A.o1); A.la = MFMA32(ones, ATT_PA(3), A.la);
    { ATT_EXP4(pc1, 2); ATT_EXP4(pc1, 3); pw[3].x = cvtpk(pc1[8], pc1[9]); pw[3].y = cvtpk(pc1[10], pc1[11]); pw[3].z = cvtpk(pc1[12], pc1[13]); pw[3].w = cvtpk(pc1[14], pc1[15]); ATT_PIN(pw[3]); }
    ATT_SB();
#undef ATT_EXP4
#undef ATT_VRD
#undef ATT_V0
#undef ATT_V1
#undef ATT_PA
#undef ATT_PIN
    Bn.mask(pn0, pn1, hi);
    if (__any(need)) {
        A.la[0] *= fr;
#pragma unroll
        for (int r = 0; r < 16; ++r) { A.o0[r] *= fr; A.o1[r] *= fr; }
    }
    A.m = mn;
    ATT_SB();
}

__device__ __forceinline__ void swap32(unsigned x, unsigned y, unsigned& r0, unsigned& r1) { auto rr = __builtin_amdgcn_permlane32_swap(x, y, false, false); r0 = rr[0]; r1 = rr[1]; }
__device__ __forceinline__ void store_o(bf16* op, const AttnAcc& A, float inv, int hi) {
#pragma unroll
    for (int p = 0; p < 2; ++p) {
#pragma unroll
        for (int s = 0; s < 2; ++s) { const f32x16& o = s ? A.o1 : A.o0; const int g0 = 2 * p, g1 = 2 * p + 1;
            const unsigned xa = cvtpk(o[4 * g0] * inv, o[4 * g0 + 1] * inv), xb = cvtpk(o[4 * g0 + 2] * inv, o[4 * g0 + 3] * inv), ya = cvtpk(o[4 * g1] * inv, o[4 * g1 + 1] * inv), yb = cvtpk(o[4 * g1 + 2] * inv, o[4 * g1 + 3] * inv);
            unsigned w0, w1, w2, w3; swap32(xa, ya, w0, w2); swap32(xb, yb, w1, w3); v4u w; w.x = w0; w.y = w1; w.z = w2; w.w = w3;
            *(GAS v4u*)(op + 32 * s + 16 * p + 8 * hi) = w; } }
}

__device__ __forceinline__ void store_o8(unsigned char* op, const AttnAcc& A, float inv, int hi) {
    const float sc = inv * OQ_SCALE;
#pragma unroll
    for (int p = 0; p < 2; ++p) {
#pragma unroll
        for (int s = 0; s < 2; ++s) { const f32x16& o = s ? A.o1 : A.o0; const int g0 = 2 * p, g1 = 2 * p + 1;
            const unsigned x = pk4_f8(o[4 * g0] * sc, o[4 * g0 + 1] * sc, o[4 * g0 + 2] * sc, o[4 * g0 + 3] * sc), y = pk4_f8(o[4 * g1] * sc, o[4 * g1 + 1] * sc, o[4 * g1 + 2] * sc, o[4 * g1 + 3] * sc);
            unsigned w0, w1; swap32(x, y, w0, w1); u32x2 w; w.x = w0; w.y = w1;
            *(GAS u32x2*)(op + 32 * s + 16 * p + 8 * hi) = w; } }
}

__device__ __forceinline__ int rel_bucket(int n) {
    if (n < 16) return n;
    int b = 16;
    b += (n >= 19); b += (n >= 21); b += (n >= 24); b += (n >= 27); b += (n >= 31); b += (n >= 35); b += (n >= 40); b += (n >= 46);
    b += (n >= 52); b += (n >= 59); b += (n >= 67); b += (n >= 77); b += (n >= 87); b += (n >= 99); b += (n >= 113);
    return b;
}
__device__ __forceinline__ void build_relb(const Ctx& C, const float* rel_bias, LAS float* relb) {
    for (int i = C.tid; i < H * 128; i += NTHR) { const int h = i >> 7, n = i & 127; relb[i] = rel_bias[rel_bucket(n) * H + h] * LOG2E; }
}
struct MobaBias {
    const LAS float* relb; int qpos, kpos0; bool lookup, causal; float cbias;
    __device__ __forceinline__ void init(f32x16& p0, f32x16& p1, int hi) const {
        if (lookup) {
            int dbase = qpos - kpos0 - 4 * hi; asm volatile("" : "+v"(dbase));
#pragma unroll
            for (int r = 0; r < 16; ++r) { const int d0 = dbase - ((r & 3) + 8 * (r >> 2)), d1 = d0 - 32;
                const int i0 = d0 < 0 ? 0 : (d0 > 127 ? 127 : d0), i1 = d1 < 0 ? 0 : (d1 > 127 ? 127 : d1);
                p0[r] = relb[i0]; p1[r] = relb[i1];
                if ((r & 3) == 3) __builtin_amdgcn_sched_barrier(0); }
        } else {
#pragma unroll
            for (int r = 0; r < 16; ++r) { p0[r] = cbias; p1[r] = cbias; }
        }
    }
    __device__ __forceinline__ void mask(f32x16& p0, f32x16& p1, int hi) const {
        if (causal) {
            int d = qpos - kpos0 - 4 * hi; asm volatile("" : "+v"(d));
#pragma unroll
            for (int r = 0; r < 16; ++r) { const int c = (r & 3) + 8 * (r >> 2); if (c > d) p0[r] = NEG_INF; if (c + 32 > d) p1[r] = NEG_INF; }
        }
    }
};
struct FoxBias {
    const LAS float* cb; int qrel, krel0; bool causal;
    __device__ __forceinline__ void init(f32x16& p0, f32x16& p1, int hi) const {
#pragma unroll
        for (int g = 0; g < 4; ++g) { const f32x4 c0 = *(const LAS f32x4*)(cb + 8 * g + 4 * hi), c1 = *(const LAS f32x4*)(cb + 32 + 8 * g + 4 * hi);
#pragma unroll
            for (int i = 0; i < 4; ++i) { p0[4 * g + i] = c0[i]; p1[4 * g + i] = c1[i]; } }
    }
    __device__ __forceinline__ void mask(f32x16& p0, f32x16& p1, int hi) const {
        if (causal) {
            int d = qrel - krel0 - 4 * hi; asm volatile("" : "+v"(d));
#pragma unroll
            for (int r = 0; r < 16; ++r) { const int c = (r & 3) + 8 * (r >> 2); if (c > d) p0[r] = NEG_INF; if (c + 32 > d) p1[r] = NEG_INF; }
        }
    }
};

__device__ __forceinline__ int mlist_off(int j) { return 256 * (31 * j - (j * (j - 1)) / 2); }
#define INS3(s_, j_) do { const float s__ = (s_); const int j__ = (j_); \
    if (s__ > sv0 || (s__ == sv0 && j__ < sel0)) { sv2 = sv1; sel2 = sel1; sv1 = sv0; sel1 = sel0; sv0 = s__; sel0 = j__; } \
    else if (s__ > sv1 || (s__ == sv1 && j__ < sel1)) { sv2 = sv1; sel2 = sel1; sv1 = s__; sel1 = j__; } \
    else if (s__ > sv2 || (s__ == sv2 && j__ < sel2)) { sv2 = s__; sel2 = j__; } } while (0)
__device__ __forceinline__ void ph_select(const Ctx& C, const bf16* Q, const float* ksum, unsigned* mcnt, unsigned* mlist) {
    LAS float* km = (LAS float*)C.lds;
    LAS unsigned* lcnt = (LAS unsigned*)(C.lds + 8192);
    const int lane = C.lane, wave = C.wave, r32 = lane & 31, hi = lane >> 5;
    for (int u = C.vcu; u < BATCH * H * 31; u += C.G) {
        const int bh = u / 31, own = 1 + u % 31, b = bh >> 4, h = bh & 15;
        __syncthreads();
        for (int i = C.tid; i < 32 * 64; i += NTHR) km[i] = ksum[(size_t)(b * NBLK + (i >> 6)) * D + h * 64 + (i & 63)];
        if (C.tid < 64) lcnt[C.tid] = 0u;
        bf16x8 qr[4]; load_q(qr, Q + (size_t)(b * SEQ + own * 256 + wave * 32 + r32) * D + h * 64, hi);
        __syncthreads();
        f32x16 sc; { float z = 0.f; asm volatile("" : "+v"(z));
#pragma unroll
        for (int r = 0; r < 16; ++r) sc[r] = z; }
#pragma unroll
        for (int d0 = 0; d0 < 4; ++d0) {
            const f32x4 x0 = *(const LAS f32x4*)(km + r32 * 64 + 16 * d0 + 8 * hi), x1 = *(const LAS f32x4*)(km + r32 * 64 + 16 * d0 + 8 * hi + 4);
            v4u wh, wl; wh.x = cvtpk(x0.x, x0.y); wh.y = cvtpk(x0.z, x0.w); wh.z = cvtpk(x1.x, x1.y); wh.w = cvtpk(x1.z, x1.w);
            wl.x = cvtpk(x0.x - bflo(wh.x), x0.y - bfhi(wh.x)); wl.y = cvtpk(x0.z - bflo(wh.y), x0.w - bfhi(wh.y)); wl.z = cvtpk(x1.x - bflo(wh.z), x1.y - bfhi(wh.z)); wl.w = cvtpk(x1.z - bflo(wh.w), x1.w - bfhi(wh.w));
            sc = MFMA32(__builtin_bit_cast(bf16x8, wh), qr[d0], sc); sc = MFMA32(__builtin_bit_cast(bf16x8, wl), qr[d0], sc);
        }
        float sv0 = NEG_INF, sv1 = NEG_INF, sv2 = NEG_INF; int sel0 = 64, sel1 = 64, sel2 = 64;
#pragma unroll
        for (int r = 0; r < 16; ++r) { const int j = (r & 3) + 8 * (r >> 2) + 4 * hi; if (j < own) INS3(sc[r], j); }
        {
            const float pv0 = __shfl_xor(sv0, 32), pv1 = __shfl_xor(sv1, 32), pv2 = __shfl_xor(sv2, 32);
            const int p0 = __shfl_xor(sel0, 32), p1 = __shfl_xor(sel1, 32), p2 = __shfl_xor(sel2, 32);
            if (p0 < 64) INS3(pv0, p0);
            if (p1 < 64) INS3(pv1, p1);
            if (p2 < 64) INS3(pv2, p2); }
        const int nv = own < 3 ? own : 3; int rk0 = 0, rk1 = 0, rk2 = 0;
        if (hi == 0) {
            rk0 = (int)__hip_atomic_fetch_add(&lcnt[sel0], 1u, __ATOMIC_RELAXED, __HIP_MEMORY_SCOPE_WORKGROUP);
            if (nv > 1) rk1 = (int)__hip_atomic_fetch_add(&lcnt[sel1], 1u, __ATOMIC_RELAXED, __HIP_MEMORY_SCOPE_WORKGROUP);
            if (nv > 2) rk2 = (int)__hip_atomic_fetch_add(&lcnt[sel2], 1u, __ATOMIC_RELAXED, __HIP_MEMORY_SCOPE_WORKGROUP);
        }
        __syncthreads();
        if (C.tid < 32) { const unsigned c = lcnt[C.tid]; if (c) lcnt[32 + C.tid] = __hip_atomic_fetch_add(mcnt + bh * 32 + C.tid, c, __ATOMIC_RELAXED, __HIP_MEMORY_SCOPE_AGENT); }
        __syncthreads();
        if (hi == 0) {
            unsigned* lst = mlist + (size_t)bh * MLIST_PER_BH; const unsigned tl = (unsigned)(own * 256 + wave * 32 + r32);
            lst[mlist_off(sel0) + lcnt[32 + sel0] + rk0] = tl;
            if (nv > 1) lst[mlist_off(sel1) + lcnt[32 + sel1] + rk1] = tl | (1u << 16);
            if (nv > 2) lst[mlist_off(sel2) + lcnt[32 + sel2] + rk2] = tl | (2u << 16);
        }
    }
}
constexpr int RELB_OFF = 131072;
constexpr int PRE_OFF = 139264;
constexpr int UINFO_OFF = 147456;
static_assert(PRE_OFF + 2080 * 4 <= LDSCTL_OFF && UINFO_OFF + 64 <= LDSCTL_OFF && 4 * 33280 <= UINFO_OFF, "attention LDS map");

__device__ __forceinline__ int part_next(int u, int uw, int usb, int per) { const int k = (u - usb) % per; return (k + 1 < uw) ? u + 1 : u - k + per; }
__device__ __forceinline__ void ph_moba_part(const Ctx& C, const bf16* Q, const bf16* K, const bf16* V, const float* rel_bias, const unsigned* mcnt, const unsigned* mlist, bf16* parto, float* partml, const int uw, const int usb, const int per) {
    if (C.wave >= 4) __builtin_amdgcn_s_setprio(1);
    LAS float* relb = (LAS float*)(C.lds + RELB_OFF);
    LAS int* pre = (LAS int*)(C.lds + PRE_OFF);
    const int lane = C.lane, wave = C.wave, r32 = lane & 31, hi = lane >> 5;
    __syncthreads();
    build_relb(C, rel_bias, relb);
    {   int v[4], s = 0;
#pragma unroll
        for (int i = 0; i < 4; ++i) { v[i] = (int)((__hip_atomic_load(mcnt + 4 * C.tid + i, __ATOMIC_RELAXED, __HIP_MEMORY_SCOPE_AGENT) + 255u) >> 8); s += v[i]; }
        int inc = s;
#pragma unroll
        for (int o = 1; o < 64; o <<= 1) { const int t = __shfl_up(inc, o); if (lane >= o) inc += t; }
        if (lane == 63) pre[2056 + wave] = inc;
        __syncthreads();
        int base = 0; for (int w = 0; w < wave; ++w) base += pre[2056 + w];
        const int ex = base + inc - s;
        pre[4 * C.tid] = ex; pre[4 * C.tid + 1] = ex + v[0]; pre[4 * C.tid + 2] = ex + v[0] + v[1]; pre[4 * C.tid + 3] = ex + v[0] + v[1] + v[2];
        if (C.tid == NTHR - 1) pre[2048] = ex + s;
        __syncthreads();
    }
    const int total = pre[2048];
    int u = usb, cur = 0, idx = 0;
    if (u < total) {
        int lo = 0, hi_ = 2048;
#pragma unroll
        for (int s = 0; s < 11; ++s) { const int mid = (lo + hi_) >> 1; if (pre[mid] <= u) lo = mid; else hi_ = mid; }
        idx = lo;
        const int bh = idx >> 5, j = idx & 31, b = bh >> 4, h = bh & 15;
        const bf16* Kg = K + (size_t)(b * SEQ + j * 256) * D + h * 64; const bf16* Vg = V + (size_t)(b * SEQ + j * 256) * D + h * 64;
#pragma unroll
        for (int t4 = 0; t4 < 4; ++t4) dma_tile(Kg + (size_t)t4 * 64 * D, Vg + (size_t)t4 * 64 * D, C.lds + t4 * 8192, C.lds + 32768 + t4 * 8192, wave, lane);
    }
    unsigned ent = 0u, ent_n = 0u; bool valid = false, valid_n = false;
    if (u < total) { const int bh = idx >> 5, j = idx & 31, chunk = u - pre[idx]; const int n = (int)__hip_atomic_load(mcnt + idx, __ATOMIC_RELAXED, __HIP_MEMORY_SCOPE_AGENT);
        const int i = chunk * 256 + wave * 32 + r32; valid = i < n; ent = mlist[(size_t)bh * MLIST_PER_BH + mlist_off(j) + (valid ? i : chunk * 256)]; }
    while (u < total) {
        const int bh = idx >> 5, j = idx & 31, b = bh >> 4, h = bh & 15;
        const int tl = (int)(ent & 0xffffu), slot = (int)(ent >> 16);
        bf16x8 qr[4]; load_q(qr, Q + (size_t)(b * SEQ + tl) * D + h * 64, hi);
        LAS unsigned char* Ks = C.lds + cur * 65536; LAS unsigned char* Vs = Ks + 32768;
        VM_WAIT(); __syncthreads();
        const int un = u + per; int nidx = 0;
        if (un < total) {
            int lo = 0, hi_ = 2048;
#pragma unroll
            for (int s = 0; s < 11; ++s) { const int mid = (lo + hi_) >> 1; if (pre[mid] <= un) lo = mid; else hi_ = mid; }
            nidx = lo;
            const int nbh = nidx >> 5, nj = nidx & 31, nb = nbh >> 4, nh = nbh & 15;
            const bf16* Kg = K + (size_t)(nb * SEQ + nj * 256) * D + nh * 64; const bf16* Vg = V + (size_t)(nb * SEQ + nj * 256) * D + nh * 64;
            LAS unsigned char* Kn = C.lds + (cur ^ 1) * 65536;
#pragma unroll
            for (int t4 = 0; t4 < 4; ++t4) dma_tile(Kg + (size_t)t4 * 64 * D, Vg + (size_t)t4 * 64 * D, Kn + t4 * 8192, Kn + 32768 + t4 * 8192, wave, lane);
            const int nchunk = un - pre[nidx], nn = (int)__hip_atomic_load(mcnt + nidx, __ATOMIC_RELAXED, __HIP_MEMORY_SCOPE_AGENT), ni = nchunk * 256 + wave * 32 + r32;
            valid_n = ni < nn; ent_n = mlist[(size_t)nbh * MLIST_PER_BH + mlist_off(nj) + (valid_n ? ni : nchunk * 256)];
        }
        AttnAcc A;
        const bool lk = __any((tl - (j * 256 + 255)) < 128) != 0;
        MobaBias B{relb + h * 128, tl, j * 256, lk, false, relb[h * 128 + 127]};
        f32x16 a0, a1, b0, b1;
        acc_init(A); B.kpos0 = j * 256;
        if (__any(valid)) {
        qk_tile(a0, a1, qr, Ks, r32, hi, B);
#pragma unroll 1
        for (int tp = 0; tp < 4; tp += 2) {
            B.kpos0 = j * 256 + 64 * (tp + 1); attn_step(A, a0, a1, b0, b1, qr, Ks + (tp + 1) * 8192, Vs + tp * 8192, r32, hi, lane, B, true);
            B.kpos0 = j * 256 + 64 * (tp + 2); attn_step(A, b0, b1, a0, a1, qr, Ks + ((tp + 2) & 3) * 8192, Vs + (tp + 1) * 8192, r32, hi, lane, B, tp == 0);
        }
        }
        const float lt = A.la[0], inv = 1.f / lt;
        if (valid) {
            const size_t rowi = ((size_t)(b * SEQ + tl) * H + h) * 3 + slot;
            store_o(parto + rowi * 64, A, inv, hi);
            if (hi == 0) *(GAS f32x2*)(partml + rowi * 2) = (f32x2){A.m, lt};
        }
        u = un; idx = nidx; cur ^= 1; ent = ent_n; valid = valid_n;
    }
    __builtin_amdgcn_s_setprio(0);
}
__device__ __forceinline__ void ph_moba_own(const Ctx& C, const bf16* Q, const bf16* K, const bf16* V, const float* rel_bias, const bf16* parto, const float* partml, unsigned char* O) {
    if (C.wave >= 4) __builtin_amdgcn_s_setprio(1);
    LAS float* relb = (LAS float*)(C.lds + RELB_OFF);
    const int lane = C.lane, wave = C.wave, r32 = lane & 31, hi = lane >> 5;
    __syncthreads();
    build_relb(C, rel_bias, relb);
    constexpr int NU = BATCH * H * NBLK;
    int u = C.vcu, cur = 0;
    if (u < NU) {
        const int bh = u >> 5, own = u & 31, b = bh >> 4, h = bh & 15;
        const bf16* Kg = K + (size_t)(b * SEQ + own * 256) * D + h * 64; const bf16* Vg = V + (size_t)(b * SEQ + own * 256) * D + h * 64;
#pragma unroll
        for (int t4 = 0; t4 < 4; ++t4) dma_tile(Kg + (size_t)t4 * 64 * D, Vg + (size_t)t4 * 64 * D, C.lds + t4 * 8192, C.lds + 32768 + t4 * 8192, wave, lane);
    }
    while (u < NU) {
        const int bh = u >> 5, own = u & 31, b = bh >> 4, h = bh & 15;
        const int qblk = wave < 4 ? wave : 11 - wave;
        const int tl = own * 256 + qblk * 32 + r32;
        bf16x8 qr[4]; load_q(qr, Q + (size_t)(b * SEQ + tl) * D + h * 64, hi);
        const int nv = own < 3 ? own : 3;
        const size_t rowi = ((size_t)(b * SEQ + tl) * H + h) * 3;
        LAS unsigned char* Ks = C.lds + cur * 65536; LAS unsigned char* Vs = Ks + 32768;
        VM_WAIT(); __syncthreads();
        const int un = u + C.G;
        if (un < NU) {
            const int nbh = un >> 5, nown = un & 31, nb = nbh >> 4, nh = nbh & 15;
            const bf16* Kg = K + (size_t)(nb * SEQ + nown * 256) * D + nh * 64; const bf16* Vg = V + (size_t)(nb * SEQ + nown * 256) * D + nh * 64;
            LAS unsigned char* Kn = C.lds + (cur ^ 1) * 65536;
#pragma unroll
            for (int t4 = 0; t4 < 4; ++t4) dma_tile(Kg + (size_t)t4 * 64 * D, Vg + (size_t)t4 * 64 * D, Kn + t4 * 8192, Kn + 32768 + t4 * 8192, wave, lane);
        }
        AttnAcc A; acc_init(A);
        const int tlast = qblk >> 1;
        MobaBias B{relb + h * 128, tl, own * 256, true, tlast == 0, 0.f};
        f32x16 a0, a1, b0, b1;
        qk_tile(a0, a1, qr, Ks, r32, hi, B);
#pragma unroll 1
        for (int tp = 0; tp < 4; tp += 2) {
            if (tp <= tlast) { B.kpos0 = own * 256 + 64 * (tp + 1); B.causal = (tp + 1 == tlast); attn_step(A, a0, a1, b0, b1, qr, Ks + (tp + 1) * 8192, Vs + tp * 8192, r32, hi, lane, B, tp + 1 <= tlast); }
            if (tp + 1 <= tlast) { B.kpos0 = own * 256 + 64 * (tp + 2); B.causal = (tp + 2 == tlast); attn_step(A, b0, b1, a0, a1, qr, Ks + ((tp + 2) & 3) * 8192, Vs + (tp + 1) * 8192, r32, hi, lane, B, tp + 2 <= tlast); }
        }
        const float lt = A.la[0];
        float mi[3], li[3];
#pragma unroll
        for (int i = 0; i < 3; ++i) { mi[i] = NEG_INF; li[i] = 0.f; if (i < nv) { const f32x2 ml = *(const GAS f32x2*)(partml + (rowi + i) * 2); mi[i] = ml.x; li[i] = ml.y; } }
        float M = A.m;
#pragma unroll
        for (int i = 0; i < 3; ++i) M = fmaxf(M, mi[i]);
        const float w0 = __builtin_amdgcn_exp2f(A.m - M); float den = w0 * lt;
#pragma unroll
        for (int r = 0; r < 16; ++r) { A.o0[r] *= w0; A.o1[r] *= w0; }
#pragma unroll
        for (int i = 0; i < 3; ++i) if (i < nv) {
            const float wi = li[i] * __builtin_amdgcn_exp2f(mi[i] - M); den += wi;
            const bf16* po = parto + (rowi + i) * 64;
#pragma unroll
            for (int p = 0; p < 2; ++p) {
                const v4u La = *(const GAS v4u*)(po + 16 * p + 8 * hi), Lc = *(const GAS v4u*)(po + 32 + 16 * p + 8 * hi);
                unsigned a0x, a1x, a0y, a1y, c0x, c1x, c0y, c1y;
                swap32(La.x, La.z, a0x, a1x); swap32(La.y, La.w, a0y, a1y); swap32(Lc.x, Lc.z, c0x, c1x); swap32(Lc.y, Lc.w, c0y, c1y);
                const int g0 = 2 * p, g1 = 2 * p + 1;
                A.o0[4 * g0] += wi * bflo(a0x); A.o0[4 * g0 + 1] += wi * bfhi(a0x); A.o0[4 * g0 + 2] += wi * bflo(a0y); A.o0[4 * g0 + 3] += wi * bfhi(a0y);
                A.o0[4 * g1] += wi * bflo(a1x); A.o0[4 * g1 + 1] += wi * bfhi(a1x); A.o0[4 * g1 + 2] += wi * bflo(a1y); A.o0[4 * g1 + 3] += wi * bfhi(a1y);
                A.o1[4 * g0] += wi * bflo(c0x); A.o1[4 * g0 + 1] += wi * bfhi(c0x); A.o1[4 * g0 + 2] += wi * bflo(c0y); A.o1[4 * g0 + 3] += wi * bfhi(c0y);
                A.o1[4 * g1] += wi * bflo(c1x); A.o1[4 * g1 + 1] += wi * bfhi(c1x); A.o1[4 * g1 + 2] += wi * bflo(c1y); A.o1[4 * g1 + 3] += wi * bfhi(c1y); }
        }
        store_o8(O + (size_t)(b * SEQ + tl) * D + h * 64, A, 1.f / den, hi);
        u = un; cur ^= 1;
    }
    __builtin_amdgcn_s_setprio(0);
}

__device__ __forceinline__ void ph_scan(const Ctx& C, const float* logf, float* ncum) {
    LAS float* wt = (LAS float*)C.lds;
    for (int bh = C.vcu; bh < BATCH * H; bh += C.G) {
        const int b = bh >> 4, h = bh & 15;
        float v[16], s = 0.f;
#pragma unroll
        for (int i = 0; i < 16; ++i) { v[i] = logf[(size_t)(b * SEQ + C.tid * 16 + i) * H + h]; s += v[i]; }
        float inc = s;
#pragma unroll
        for (int o = 1; o < 64; o <<= 1) { const float t = __shfl_up(inc, o); if (C.lane >= o) inc += t; }
        __syncthreads();
        if (C.lane == 63) wt[C.wave] = inc;
        __syncthreads();
        float run = inc - s; for (int w = 0; w < C.wave; ++w) run += wt[w];
#pragma unroll
        for (int i = 0; i < 16; ++i) { run += v[i]; ncum[(size_t)bh * SEQ + C.tid * 16 + i] = -run * LOG2E; }
    }
}
__device__ __forceinline__ void ph_fox(const Ctx& C, const bf16* Q, const bf16* K, const bf16* V, const float* ncum, const unsigned* norms, unsigned char* O, unsigned* qctr) {
    if (C.wave >= 4) __builtin_amdgcn_s_setprio(1);
    constexpr int GB = 33280;
    LAS int* uinfo = (LAS int*)(C.lds + UINFO_OFF);
    const int lane = C.lane, wave = C.wave, r32 = lane & 31, hi = lane >> 5;
    for (;;) {
        __syncthreads();
        if (C.tid == 0) { uinfo[0] = (int)__hip_atomic_fetch_add(qctr, 1u, __ATOMIC_RELAXED, __HIP_MEMORY_SCOPE_AGENT); uinfo[1] = 0; uinfo[2] = 0; uinfo[3] = -1; }
        __syncthreads();
        const int idx = uinfo[0];
        if (idx >= BATCH * H * NBLK) break;
        const int qb = 31 - (idx >> 6), bh = idx & 63, b = bh >> 4, h = bh & 15, NT = 4 * (qb + 1);
        const float* ng = ncum + (size_t)bh * SEQ; const float nref = ng[qb * 256];
        const int qblk = wave < 4 ? wave : 11 - wave;
        const int qrel = qblk * 32 + r32;
        bf16x8 qr[4]; load_q(qr, Q + (size_t)(b * SEQ + qb * 256 + qrel) * D + h * 64, hi);
        {   float q2 = 0.f;
#pragma unroll
            for (int d0 = 0; d0 < 4; ++d0)
#pragma unroll
                for (int i = 0; i < 8; ++i) { const float x = bf2f((unsigned)(unsigned short)qr[d0][i]); q2 += x * x; }
            q2 += __shfl_xor(q2, 32);
#pragma unroll
            for (int o = 1; o < 32; o <<= 1) q2 = fmaxf(q2, __shfl_xor(q2, o));
            if (lane == 0) (void)__hip_atomic_fetch_max((LAS unsigned*)&uinfo[2], __float_as_uint(q2), __ATOMIC_RELAXED, __HIP_MEMORY_SCOPE_WORKGROUP);
            bf16x8 kr[4]; load_q(kr, K + (size_t)(b * SEQ + qb * 256 + qrel) * D + h * 64, hi);
            float sq = 0.f;
#pragma unroll
            for (int d0 = 0; d0 < 4; ++d0)
#pragma unroll
                for (int i = 0; i < 8; ++i) sq += bf2f((unsigned)(unsigned short)qr[d0][i]) * bf2f((unsigned)(unsigned short)kr[d0][i]);
            sq += __shfl_xor(sq, 32);
#pragma unroll
            for (int o = 1; o < 32; o <<= 1) sq = fminf(sq, __shfl_xor(sq, o));
            if (lane == 0) (void)__hip_atomic_fetch_min((LAS unsigned*)&uinfo[3], sort_key(sq), __ATOMIC_RELAXED, __HIP_MEMORY_SCOPE_WORKGROUP); }
        __syncthreads();
        {   const float qn2 = __uint_as_float((unsigned)uinfo[2]), qa = __uint_as_float(norms[bh * 4 + 0]), qb2 = __uint_as_float(norms[bh * 4 + 1]), ka = __uint_as_float(norms[bh * 4 + 2]), kb2 = __uint_as_float(norms[bh * 4 + 3]);
            const unsigned mk = (unsigned)uinfo[3]; const float smin = __uint_as_float((mk & 0x80000000u) ? (mk ^ 0x80000000u) : ~mk) - 0.05f;
            const float smax = sqrtf(fminf(qn2, qa + qb2)) * sqrtf(ka + kb2) * 1.02f;
            const float thr = smax - fmaxf(smin, -smax) + 40.f;
            if (C.tid < 128) { const bool skip = (C.tid < NT) && (ng[(C.tid < NT ? C.tid : 0) * 64 + 63] - nref < -thr); const int c = __popcll(__ballot(skip)); if (lane == 0 && c) (void)__hip_atomic_fetch_add(&uinfo[1], c, __ATOMIC_RELAXED, __HIP_MEMORY_SCOPE_WORKGROUP); } }
        __syncthreads();
        const int t0 = uinfo[1], tf = t0 & ~1, g0 = t0 >> 1, NG = NT >> 1, tmax = 4 * qb + (qblk >> 1);
        const bf16* Kg = K + (size_t)(b * SEQ) * D + h * 64; const bf16* Vg = V + (size_t)(b * SEQ) * D + h * 64;
#define FOX_DMA(g) do { LAS unsigned char* sb_ = C.lds + ((g) & 3) * GB; \
            dma_tile(Kg + (size_t)(2 * (g)) * 64 * D, Vg + (size_t)(2 * (g)) * 64 * D, sb_, sb_ + 16384, wave, lane); \
            dma_tile(Kg + (size_t)(2 * (g) + 1) * 64 * D, Vg + (size_t)(2 * (g) + 1) * 64 * D, sb_ + 8192, sb_ + 24576, wave, lane); \
            if (wave < 2) glds4(ng + (2 * (g) + wave) * 64 + lane, lds_addr(sb_ + 32768 + wave * 256)); } while (0)
        FOX_DMA(g0);
        if (g0 + 1 < NG) FOX_DMA(g0 + 1);
        VM_WAIT(); __syncthreads();
        AttnAcc A; acc_init(A);
        f32x16 a0, a1, b0, b1; v4u wa[4], wb[4];
        FoxBias B{nullptr, qrel, 0, false};
#define FOX_SETB(t) do { const LAS unsigned char* sb_ = C.lds + (((t) >> 1) & 3) * GB; B.cb = (const LAS float*)(sb_ + 32768 + ((t) & 1) * 256); B.krel0 = (t) * 64 - qb * 256; B.causal = (t) >= 4 * qb; } while (0)
#define FOX_KS(t) (C.lds + (((t) >> 1) & 3) * GB + ((t) & 1) * 8192)
#define FOX_VS(t) (C.lds + (((t) >> 1) & 3) * GB + 16384 + ((t) & 1) * 8192)
#define FOX_STEP(C0, C1, N0, N1, WP, WN, t) do { FOX_SETB((t) + 1); \
            attn_step3(A, C0, C1, N0, N1, WP, WN, qr, FOX_KS((t) + 1), FOX_VS((t) > tf ? (t) - 1 : (t)), r32, hi, lane, B, (t) <= tmax); } while (0)
#pragma unroll
        for (int k_ = 0; k_ < 4; ++k_) { wa[k_] = (v4u){0u, 0u, 0u, 0u}; wb[k_] = (v4u){0u, 0u, 0u, 0u}; }
        if (tf <= tmax) { FOX_SETB(tf); qk_tile(a0, a1, qr, FOX_KS(tf), r32, hi, B); }
#pragma unroll 1
        for (int g = g0; g <= NG; ++g) {
            const int ta = 2 * g, tb = ta + 1;
            if (g + 2 < NG) FOX_DMA(g + 2);
            if (ta <= tmax + 1) FOX_STEP(a0, a1, b0, b1, wb, wa, ta);
            if (tb <= tmax + 1 && g < NG) FOX_STEP(b0, b1, a0, a1, wa, wb, tb);
            VM_WAIT(); __syncthreads();
        }
#undef FOX_DMA
#undef FOX_SETB
#undef FOX_KS
#undef FOX_VS
#undef FOX_STEP
        const float lt = A.la[0];
        store_o8(O + (size_t)(b * SEQ + qb * 256 + qrel) * D + h * 64, A, 1.f / lt, hi);
    }
    __builtin_amdgcn_s_setprio(0);
}
__device__ __forceinline__ void ln_stats(f32x4 (&v)[4], float& rstd) {
    float s = 0.f;
#pragma unroll
    for (int j = 0; j < 4; ++j) s += (v[j].x + v[j].y) + (v[j].z + v[j].w);
    const float mean = wave_sum(s) * (1.f / D); float s2 = 0.f;
#pragma unroll
    for (int j = 0; j < 4; ++j) { v[j] = v[j] - mean; s2 += (v[j].x * v[j].x + v[j].y * v[j].y) + (v[j].z * v[j].z + v[j].w * v[j].w); }
    rstd = 1.f / sqrtf(wave_sum(s2) * (1.f / D) + LN_EPS);
}
__device__ __forceinline__ void ph_ln1(const Ctx& C, const float* xin, const bf16* xin16, const bf16* y, const float* g, const float* bta, bf16* AR, unsigned char* xb8) {
    const int gw = C.vcu * NWAVES + C.wave, NGW = C.G * NWAVES, lane = C.lane;
    f32x4 gv[4], bv[4];
#pragma unroll
    for (int j = 0; j < 4; ++j) { gv[j] = *(const GAS f32x4*)(g + 4 * lane + 256 * j); bv[j] = *(const GAS f32x4*)(bta + 4 * lane + 256 * j); }
    u32x2 wn[4], zn16[4]; f32x4 zn32[4];
    {   const GAS u32x2* yr = (const GAS u32x2*)(y + (size_t)gw * D) + lane;
#pragma unroll
        for (int j = 0; j < 4; ++j) wn[j] = yr[64 * j];
        if (xin16) { const GAS u32x2* zr = (const GAS u32x2*)(xin16 + (size_t)gw * D) + lane;
#pragma unroll
            for (int j = 0; j < 4; ++j) zn16[j] = zr[64 * j];
        } else { const GAS f32x4* zr = (const GAS f32x4*)(xin + (size_t)gw * D) + lane;
#pragma unroll
            for (int j = 0; j < 4; ++j) zn32[j] = zr[64 * j]; } }
    for (int t = gw; t < T; t += NGW) {
        f32x4 v[4];
        const int tn = t + NGW < T ? t + NGW : t;
        const GAS u32x2* yr = (const GAS u32x2*)(y + (size_t)tn * D) + lane;
        if (xin16) { const GAS u32x2* zr = (const GAS u32x2*)(xin16 + (size_t)tn * D) + lane;
#pragma unroll
            for (int j = 0; j < 4; ++j) { const u32x2 w = wn[j], z = zn16[j]; v[j] = (f32x4){bflo(z.x), bfhi(z.x), bflo(z.y), bfhi(z.y)} * DN_ALPHA + (f32x4){bflo(w.x), bfhi(w.x), bflo(w.y), bfhi(w.y)}; }
#pragma unroll
            for (int j = 0; j < 4; ++j) { wn[j] = yr[64 * j]; zn16[j] = zr[64 * j]; }
        } else { const GAS f32x4* zr = (const GAS f32x4*)(xin + (size_t)tn * D) + lane;
#pragma unroll
            for (int j = 0; j < 4; ++j) { const u32x2 w = wn[j]; v[j] = zn32[j] * DN_ALPHA + (f32x4){bflo(w.x), bfhi(w.x), bflo(w.y), bfhi(w.y)}; }
#pragma unroll
            for (int j = 0; j < 4; ++j) { wn[j] = yr[64 * j]; zn32[j] = zr[64 * j]; } }
        float rstd; ln_stats(v, rstd);
#pragma unroll
        for (int j = 0; j < 4; ++j) {
            const f32x4 y = v[j] * rstd * gv[j] + bv[j]; const int d = 4 * lane + 256 * j;
            u32x2 hw; hw.x = cvtpk(y.x, y.y); hw.y = cvtpk(y.z, y.w);
            u32x2 lw; lw.x = cvtpk(y.x - bflo(hw.x), y.y - bfhi(hw.x)); lw.y = cvtpk(y.z - bflo(hw.y), y.w - bfhi(hw.y));
            *(GAS unsigned*)(xb8 + (size_t)t * D + d) = pk4_f8(y.x * XQ_SCALE, y.y * XQ_SCALE, y.z * XQ_SCALE, y.w * XQ_SCALE);
            *(GAS u32x2*)(AR + (size_t)t * 1536 + d) = hw;
            *(GAS u32x2*)(AR + (size_t)(T + t) * 1536 + 512 + d) = hw;
            if (j < 2) *(GAS u32x2*)(AR + (size_t)t * 1536 + 1024 + d) = lw; else *(GAS u32x2*)(AR + (size_t)(T + t) * 1536 + (d - 512)) = lw;
        }
    }
}
__device__ __forceinline__ int below(unsigned long long mask) { return (int)__builtin_amdgcn_mbcnt_hi((unsigned)(mask >> 32), __builtin_amdgcn_mbcnt_lo((unsigned)mask, 0u)); }
__device__ __forceinline__ void ph_route(const Ctx& C, const float* logp, const float* rbias, int* topi, float* gate, unsigned* ecnt) {
    LAS unsigned* hist = (LAS unsigned*)C.lds;
    const int gw = C.vcu * NWAVES + C.wave, NGW = C.G * NWAVES, lane = C.lane;
    __syncthreads();
    if (C.tid < NE) hist[C.tid] = 0u;
    __syncthreads();
    const f32x4 rb = *(const GAS f32x4*)(rbias + 4 * lane);
    f32x4 an = *(const GAS f32x4*)(logp + (size_t)gw * NE + 4 * lane), bn = *(const GAS f32x4*)(logp + (size_t)(T + gw) * NE + 4 * lane);
    for (int t = gw; t < T; t += NGW) {
        const f32x4 a = an, b2 = bn;
        { const int tn = t + NGW < T ? t + NGW : t; an = *(const GAS f32x4*)(logp + (size_t)tn * NE + 4 * lane); bn = *(const GAS f32x4*)(logp + (size_t)(T + tn) * NE + 4 * lane); }
        float s[4], c[4];
#pragma unroll
        for (int i = 0; i < 4; ++i) { const float lg = a[i] + b2[i]; s[i] = 1.f / (1.f + __builtin_amdgcn_exp2f(-lg * LOG2E)); c[i] = s[i] + rb[i]; }
        float m1 = fmaxf(c[0], c[1]), m2 = fminf(c[0], c[1]);
        { const float x = c[2]; const float n1 = fmaxf(m1, x); m2 = fmaxf(m2, fminf(m1, x)); m1 = n1; }
        { const float x = c[3]; const float n1 = fmaxf(m1, x); m2 = fmaxf(m2, fminf(m1, x)); m1 = n1; }
#pragma unroll
        for (int o = 1; o < 8; o <<= 1) { const float o1 = __shfl_xor(m1, o), o2 = __shfl_xor(m2, o); const float n1 = fmaxf(m1, o1), n2 = fmaxf(fminf(m1, o1), fmaxf(m2, o2)); m1 = n1; m2 = n2; }
        const float gs = m1 + m2; const int mygrp = lane >> 3; int rk = 0;
#pragma unroll
        for (int g2 = 0; g2 < NGRP; ++g2) { const float og = __uint_as_float((unsigned)__builtin_amdgcn_readlane((int)__float_as_uint(gs), 8 * g2)); rk += (og > gs || (og == gs && g2 < mygrp)) ? 1 : 0; }
        unsigned k[4];
#pragma unroll
        for (int i = 0; i < 4; ++i) k[i] = rk < 4 ? sort_key(c[i]) : 0u;
        unsigned thr = 0u;
#pragma unroll 1
        for (int b = 31; b >= 0; --b) {
            const unsigned cand = thr | (1u << b);
            const int cnt = __popcll(__ballot(k[0] >= cand)) + __popcll(__ballot(k[1] >= cand)) + __popcll(__ballot(k[2] >= cand)) + __popcll(__ballot(k[3] >= cand));
            if (cnt >= TOPK) thr = cand;
        }
        unsigned long long gm[4], em[4]; int ngt = 0;
#pragma unroll
        for (int i = 0; i < 4; ++i) { gm[i] = __ballot(k[i] > thr); em[i] = __ballot(k[i] == thr); ngt += __popcll(gm[i]); }
        const int need = TOPK - ngt;
        int eqb = below(em[0]) + below(em[1]) + below(em[2]) + below(em[3]);
        bool sel[4];
#pragma unroll
        for (int i = 0; i < 4; ++i) { const bool eq = k[i] == thr; sel[i] = (k[i] > thr) || (eq && eqb < need); eqb += eq ? 1 : 0; }
        unsigned long long sm[4]; float wpart = 0.f;
#pragma unroll
        for (int i = 0; i < 4; ++i) { sm[i] = __ballot(sel[i]); wpart += sel[i] ? s[i] : 0.f; }
        const float wsum = wave_sum(wpart);
        int pos = below(sm[0]) + below(sm[1]) + below(sm[2]) + below(sm[3]);
#pragma unroll
        for (int i = 0; i < 4; ++i) if (sel[i]) { gate[(size_t)t * TOPK + pos] = s[i] / wsum * ROUTED_SCALE;
            const unsigned rk = __hip_atomic_fetch_add(&hist[4 * lane + i], 1u, __ATOMIC_RELAXED, __HIP_MEMORY_SCOPE_WORKGROUP);
            topi[(size_t)t * TOPK + pos] = (4 * lane + i) | (int)(rk << 8); ++pos; }
    }
    __syncthreads();
    if (C.tid < NE) { const unsigned c = hist[C.tid]; hist[NE + C.tid] = c ? __hip_atomic_fetch_add(ecnt + C.tid, c, __ATOMIC_RELAXED, __HIP_MEMORY_SCOPE_AGENT) : 0u; }
}
__device__ __forceinline__ void ph_scatter(const Ctx& C, const unsigned* ecnt, unsigned* ecur, const int* topi, const float* gate, const bf16* xb, int* slotof, int* tokof, float* gslot, bf16* HS) {
    build_tpre(C, ecnt);
    const LAS int* tpre = (const LAS int*)(C.lds + TPRE_OFF);
    const LAS unsigned* wgbase = (const LAS unsigned*)C.lds + NE;
    const int gw = C.vcu * NWAVES + C.wave, NGW = C.G * NWAVES;
    for (int n = C.lane >> 3; gw + n * NGW < T; n += 8) {
        const int t = gw + n * NGW;
        { const int i = t * TOPK + (C.lane & 7); const int v = topi[i], e = v & 255, rk = v >> 8;
            const int slot = tpre[e] * 256 + (int)wgbase[e] + rk; tokof[slot] = t; gslot[slot] = gate[i] * GS_FOLD; slotof[i] = slot; }
    }
    for (int e = C.vcu; e < NE; e += C.G) {
        const int cnt = (int)__hip_atomic_load(ecnt + e, __ATOMIC_RELAXED, __HIP_MEMORY_SCOPE_AGENT), s0 = tpre[e] * 256 + cnt, s1 = tpre[e + 1] * 256;
        for (int s = s0 + C.tid; s < s1; s += NTHR) { gslot[s] = 0.f; tokof[s] = 0; }
    }
}
__device__ __forceinline__ float log_sigmoid(float z) {
    const float e = __builtin_amdgcn_exp2f(-fabsf(z) * LOG2E);
    const float l1p = e < 0.015625f ? e * (1.f - e * (0.5f - e * 0.33333334f)) : __builtin_amdgcn_logf(1.f + e) * 0.6931471805599453f;
    return fminf(z, 0.f) - l1p;
}
__device__ __forceinline__ void ph_combine(const Ctx& C, const bf16* x1hi, const unsigned char* SO, const int* slotof, const float* g, const float* bta, bf16* xres, unsigned char* xb8, float* dout,
                                           const float* fox_in, const float* fox_bf, float* logf) {
    const int gw = C.vcu * NWAVES + C.wave, NGW = C.G * NWAVES, lane = C.lane;
    LAS float* wfT = (LAS float*)C.lds;
    __syncthreads();
    if (logf) { for (int i = C.tid; i < D * H; i += NTHR) { const int d = i >> 4, h = i & 15; wfT[h * D + d] = fox_in[(size_t)d * FOXW + 3 * D + h]; } }
    __syncthreads();
    f32x4 gv[4], bv[4];
#pragma unroll
    for (int j = 0; j < 4; ++j) { gv[j] = *(const GAS f32x4*)(g + 4 * lane + 256 * j); bv[j] = *(const GAS f32x4*)(bta + 4 * lane + 256 * j); }
    int sl_n = lane < TOPK ? slotof[(size_t)gw * TOPK + lane] : 0;
    for (int t = gw; t < T; t += NGW) {
        const GAS u32x2* zr = (const GAS u32x2*)(x1hi + (size_t)t * 1536) + lane;
        f32x4 v[4];
#pragma unroll
        for (int j = 0; j < 4; ++j) { const u32x2 z = zr[64 * j]; v[j] = (f32x4){bflo(z.x), bfhi(z.x), bflo(z.y), bfhi(z.y)} * DN_ALPHA; }
        const int sl = sl_n; { const int tn = t + NGW < T ? t + NGW : t; sl_n = lane < TOPK ? slotof[(size_t)tn * TOPK + lane] : 0; }
        f32x4 rs[4];
#pragma unroll
        for (int j = 0; j < 4; ++j) rs[j] = (f32x4){0.f, 0.f, 0.f, 0.f};
#pragma unroll
        for (int k = 0; k < TOPK; ++k) { const int sk = __builtin_amdgcn_readlane(sl, k); const unsigned char* row = SO + (size_t)sk * D + 4 * lane;
#pragma unroll
            for (int j = 0; j < 4; ++j) { const unsigned w = *(const GAS unsigned*)(row + 256 * j); const f32x2 lo2 = __builtin_amdgcn_cvt_pk_f32_fp8(w, false), hi2 = __builtin_amdgcn_cvt_pk_f32_fp8(w, true);
                rs[j].x += lo2.x; rs[j].y += lo2.y; rs[j].z += hi2.x; rs[j].w += hi2.y; } }
        {   const unsigned char* row = SO + (size_t)(NSLOT_MAX + t) * D + 4 * lane;
#pragma unroll
            for (int j = 0; j < 4; ++j) { const unsigned w = *(const GAS unsigned*)(row + 256 * j); const f32x2 lo2 = __builtin_amdgcn_cvt_pk_f32_fp8(w, false), hi2 = __builtin_amdgcn_cvt_pk_f32_fp8(w, true);
                rs[j].x += lo2.x; rs[j].y += lo2.y; rs[j].z += hi2.x; rs[j].w += hi2.y; } }
#pragma unroll
        for (int j = 0; j < 4; ++j) v[j] = v[j] + rs[j] * SO_INV;
        float rstd; ln_stats(v, rstd);
        f32x4 y[4];
#pragma unroll
        for (int j = 0; j < 4; ++j) {
            y[j] = v[j] * rstd * gv[j] + bv[j]; const int d = 4 * lane + 256 * j;
            if (dout) *(GAS f32x4*)(dout + (size_t)t * D + d) = y[j];
            else { u32x2 hw; hw.x = cvtpk(y[j].x, y[j].y); hw.y = cvtpk(y[j].z, y[j].w); *(GAS u32x2*)(xres + (size_t)t * D + d) = hw;
                *(GAS unsigned*)(xb8 + (size_t)t * D + d) = pk4_f8(y[j].x * XQ_SCALE, y[j].y * XQ_SCALE, y[j].z * XQ_SCALE, y[j].w * XQ_SCALE); }
        }
        if (logf) {
            float acc[16];
#pragma unroll
            for (int h = 0; h < 16; ++h) { float a = 0.f;
#pragma unroll
                for (int j = 0; j < 4; ++j) { const f32x4 w = *(const LAS f32x4*)(wfT + h * D + 4 * lane + 256 * j); a += y[j].x * w.x; a += y[j].y * w.y; a += y[j].z * w.z; a += y[j].w * w.w; }
                acc[h] = a; }
            float a8[8], a4[4], a2[2], a1;
            { const bool bit = (lane >> 5) & 1;
#pragma unroll
              for (int i = 0; i < 8; ++i) { const float send = bit ? acc[i] : acc[i + 8]; const float recv = __shfl_xor(send, 32); a8[i] = (bit ? acc[i + 8] : acc[i]) + recv; } }
            { const bool bit = (lane >> 4) & 1;
#pragma unroll
              for (int i = 0; i < 4; ++i) { const float send = bit ? a8[i] : a8[i + 4]; const float recv = __shfl_xor(send, 16); a4[i] = (bit ? a8[i + 4] : a8[i]) + recv; } }
            { const bool bit = (lane >> 3) & 1;
#pragma unroll
              for (int i = 0; i < 2; ++i) { const float send = bit ? a4[i] : a4[i + 2]; const float recv = __shfl_xor(send, 8); a2[i] = (bit ? a4[i + 2] : a4[i]) + recv; } }
            { const bool bit = (lane >> 2) & 1; const float send = bit ? a2[0] : a2[1]; const float recv = __shfl_xor(send, 4); a1 = (bit ? a2[1] : a2[0]) + recv; }
            a1 += __shfl_xor(a1, 2); a1 += __shfl_xor(a1, 1);
            const int hh = ((lane >> 5) & 1) * 8 + ((lane >> 4) & 1) * 4 + ((lane >> 3) & 1) * 2 + ((lane >> 2) & 1);
            if ((lane & 3) == 0) logf[(size_t)t * H + hh] = log_sigmoid(a1 + fox_bf[hh]);
        }
    }
}
#ifndef MK_MULTI
#define MK_MULTI 0
#endif
constexpr int NPH = 27;
struct Args { const float* in[19]; float* out; unsigned char* ws; int ph_lo, ph_hi; };

__global__ void __launch_bounds__(NTHR, 2) mk_fwd(Args args) {
    extern __shared__ __attribute__((aligned(16))) unsigned char lds_raw[];
    Ctx C;
    C.lds = (LAS unsigned char*)lds_raw;
    C.tid = threadIdx.x; C.lane = C.tid & 63; C.wave = __builtin_amdgcn_readfirstlane(C.tid >> 6);
    C.G = gridDim.x; { const int bx = blockIdx.x; C.vcu = (C.G % 8 == 0) ? (bx % 8) * (C.G / 8) + bx / 8 : bx; }
    LAS unsigned long long* PTAB = (LAS unsigned long long*)(C.lds + PTAB_OFF);
    if (C.tid == 0) {
#pragma unroll
        for (int i = 0; i < 19; ++i) PTAB[i] = (unsigned long long)(uintptr_t)args.in[i];
        PTAB[19] = (unsigned long long)(uintptr_t)args.out; PTAB[20] = (unsigned long long)(uintptr_t)args.ws;
    }
    for (int u = C.tid; u < (PTAB_OFF - LDSCTL_OFF) / 4; u += NTHR) ((LAS unsigned*)(C.lds + LDSCTL_OFF))[u] = 0u;
    __syncthreads();
#define PIN(i) ((const float*)ldptr(PTAB, (i)))
#define WSP() ((unsigned char*)ldptr(PTAB, 20))
    XcdBarrier bar; bar.bar = (unsigned*)(args.ws + WS_CTL) + CW_BAR; bar.x = 0; bar.st = nullptr;
    if (!MK_MULTI) bar = xcd_barrier_post((unsigned*)(args.ws + WS_CTL) + CW_BAR, (volatile LAS unsigned*)(C.lds + MISC_OFF) + 8);
    const int lo = args.ph_lo, hi = args.ph_hi;
#ifndef MK_PH_MASK
#define MK_PH_MASK 0xFFFFFFFFu
#endif
#define PHON(b) (((MK_PH_MASK) >> (b)) & 1u)
#ifndef MK_DUP_MASK
#define MK_DUP_MASK 0u
#endif
#define NREP(b) ((((MK_DUP_MASK) >> (b)) & 1u) ? 2 : 1)
#define REP(b) _Pragma("unroll 1") for (int rep_ = 0; rep_ < NREP(b); ++rep_)
#define IN(k) (lo <= (k) && (k) < hi)
#define SEAM(k) do { if ((k) + 1 < hi) { asm volatile("" : "+s"(bar.bar)); xcd_barrier(bar); if (NREP(23) == 2) xcd_barrier(bar); } } while (0)
#define OPAQ(v) asm volatile("" : "+s"(v))
#define LC() do { int l_; asm volatile("v_mbcnt_lo_u32_b32 %0, -1, 0\n\tv_mbcnt_hi_u32_b32 %0, -1, %0" : "=v"(l_)); C.lane = l_; C.tid = C.wave * 64 + l_; } while (0)

    if (PHON(0) && IN(0)) { LC();
        unsigned char* ws = WSP();
        SmallW W{PIN(2), PIN(3), PIN(4), PIN(6), PIN(11), PIN(16), PIN(17), PIN(18),
                 ws + WS_WMI, ws + WS_WFI, ws + WS_WMO, ws + WS_WFO, ws + WS_WSGU, ws + WS_WSDN, (bf16*)(ws + WS_WR)};
        REP(21) conv_small(C, W);
        REP(22) to_f8_rows(C, PIN(0), ws + WS_XB8);
        __syncthreads();
        REP(0) conv_experts(C, PIN(13), PIN(14), PIN(15), 0, ws + WS_WEGU, ws + WS_WEDN, C.vcu, C.G);
        SEAM(0);
    }
#pragma unroll 1
    for (int l = 0; l < 2; ++l) {
        const int pb = 1 + 13 * l;
        if (PHON(1) && IN(pb + 0)) { LC();
            unsigned char* ws = WSP();
            if (PHON(15) && l == 1) ph_scan(C, (const float*)(ws + WS_LOGF), (float*)(ws + WS_CUM));
            REP(1) {
            __syncthreads();
            int kk = D / 2; OPAQ(kk);
            pg8::Gemm g{(const bf16*)(ws + WS_XB8), (const bf16*)(ws + (l == 0 ? WS_WMI : WS_WFI)), T, 3 * D, kk}; pg8::StaticOrder S; S.init(T, 3 * D, C.G, (int)blockIdx.x);
            EpiQKV E{(bf16*)(ws + WS_Q), (size_t)(WS_K - WS_Q) / 2, C2, (unsigned*)(ws + WS_CTL) + CW_NORM + l * 256, l == 0 ? (float*)(ws + WS_CTL) + CW_KSUM : nullptr};
            pg8::gemm_phase<EpiQKV, pg8::StaticOrder, true, true, false, true>(C.lds, g, S, E, C.tid);
            }
            SEAM(pb + 0);
        }
        if (l == 0) {
            if (PHON(3) && IN(pb + 2)) { LC(); unsigned char* ws = WSP(); REP(3) ph_select(C, (const bf16*)(ws + WS_Q), (const float*)(ws + WS_CTL) + CW_KSUM, (unsigned*)(ws + WS_CTL) + (rep_ ? 133120 : CW_MCNT), (unsigned*)(ws + (rep_ ? WS_PARTO : WS_MLIST))); SEAM(pb + 2); }
            if (PHON(4) && IN(pb + 3)) { LC(); unsigned char* ws = WSP();
                const int uw = 1, usb = C.vcu, per = C.G;
                REP(4) ph_moba_part(C, (const bf16*)(ws + WS_Q), (const bf16*)(ws + WS_K), (const bf16*)(ws + WS_V), PIN(1), (const unsigned*)(ws + WS_CTL) + CW_MCNT, (const unsigned*)(ws + WS_MLIST), (bf16*)(ws + WS_PARTO), (float*)(ws + WS_PARTML), uw, usb, per); SEAM(pb + 3); }
            if (PHON(5) && IN(pb + 4)) { LC(); unsigned char* ws = WSP(); REP(5) ph_moba_own(C, (const bf16*)(ws + WS_Q), (const bf16*)(ws + WS_K), (const bf16*)(ws + WS_V), PIN(1), (const bf16*)(ws + WS_PARTO), (const float*)(ws + WS_PARTML), ws + WS_O); SEAM(pb + 4); }
        } else {
            if (PHON(6) && IN(pb + 4)) { LC(); unsigned char* ws = WSP();
                REP(6) ph_fox(C, (const bf16*)(ws + WS_Q), (const bf16*)(ws + WS_K), (const bf16*)(ws + WS_V), (const float*)(ws + WS_CUM), (const unsigned*)(ws + WS_CTL) + CW_NORM + 256, ws + WS_O, (unsigned*)(ws + WS_CTL) + CW_FOXQ + rep_ * 64); SEAM(pb + 4); }
        }
        if (PHON(7) && IN(pb + 5)) { LC();
            unsigned char* ws = WSP();
            REP(7) {
            __syncthreads();
            int kk = D / 2; OPAQ(kk);
            pg8::Gemm g{(const bf16*)(ws + WS_O), (const bf16*)(ws + (l == 0 ? WS_WMO : WS_WFO)), T, D, kk}; PlainOrder<4> S{C.vcu, C.G, (T / 256) * 4};
            pg8::EpiBf16<0> E{(bf16*)(ws + WS_Z), D, nullptr, D, 0, 1.f / (OQ_SCALE * WQ_SCALE)};
            pg8::gemm_phase<pg8::EpiBf16<0>, PlainOrder<4>, true, true, false, true>(C.lds, g, S, E, C.tid);
            }
            SEAM(pb + 5);
        }
        if (PHON(8) && IN(pb + 6)) { LC(); unsigned char* ws = WSP(); REP(8) ph_ln1(C, PIN(0), l == 0 ? nullptr : (const bf16*)(ws + WS_XRES), (const bf16*)(ws + WS_Z), PIN(7) + l * D, PIN(8) + l * D, (bf16*)(ws + WS_AR), ws + WS_XB8); SEAM(pb + 6); }
        if (PHON(9) && IN(pb + 7)) { LC();
            __syncthreads();
            REP(16) if (PHON(16)) { __syncthreads(); unsigned char* ws = WSP(); int kk = 1536; OPAQ(kk);
              pg8::Gemm g{(const bf16*)(ws + WS_AR), (const bf16*)(ws + WS_WR) + (size_t)l * (512 * 1536), 2 * T, 512, kk}; RouterOrder S{C.vcu, C.G}; EpiF32<true> E{(float*)(ws + WS_LOGP), nullptr, NE, 0.f};
              pg8::gemm_phase<EpiF32<true>, RouterOrder, true, true>(C.lds, g, S, E, C.tid); }
            __syncthreads();
            REP(17) if (PHON(17)) { __syncthreads(); unsigned char* ws = WSP(); int kk = D / 2; OPAQ(kk);
              pg8::Gemm g{(const bf16*)(ws + WS_XB8), (const bf16*)(ws + WS_WSGU + (size_t)l * (512 * 1024)), T, 512, kk}; PlainOrder<2> S{C.vcu, C.G, (T / 256) * 2}; EpiSwiGLU<true> E{ws + WS_ACTSH, nullptr};
              pg8::gemm_phase<EpiSwiGLU<true>, PlainOrder<2>, true, true, false, true>(C.lds, g, S, E, C.tid); }
            SEAM(pb + 7);
        }
        if (PHON(10) && IN(pb + 8)) { LC(); unsigned char* ws = WSP(); REP(10) ph_route(C, (const float*)(ws + WS_LOGP), PIN(12) + l * NE, (int*)(ws + WS_TOPI), (float*)(ws + WS_GATE), (unsigned*)(ws + WS_CTL) + (rep_ ? 131072 : CW_ECNT) + l * NE); SEAM(pb + 8); }
        if (PHON(11) && IN(pb + 9)) { LC(); unsigned char* ws = WSP(); REP(11) { if (rep_) xcd_barrier(bar); ph_scatter(C, (const unsigned*)(ws + WS_CTL) + CW_ECNT + l * NE, (unsigned*)(ws + WS_CTL) + (rep_ ? 132096 : CW_ECUR) + l * NE, (const int*)(ws + WS_TOPI), (const float*)(ws + WS_GATE), (const bf16*)(ws + WS_XB8),
                                                                            (int*)(ws + WS_SLOTOF), (int*)(ws + WS_TOKOF), (float*)(ws + WS_GSLOT), (bf16*)(ws + WS_HS)); } SEAM(pb + 9); }
        if (PHON(12) && IN(pb + 10)) { LC();
            unsigned char* ws = WSP();
            build_tpre(C, (const unsigned*)(ws + WS_CTL) + CW_ECNT + l * NE);
            REP(12) {
            __syncthreads();
            int kk = D / 2; OPAQ(kk);
            pg8::Gemm g{(const bf16*)(ws + WS_XB8), (const bf16*)(ws + WS_WEGU), NSLOT_MAX, NE * 512, kk, (const int*)(ws + WS_TOKOF)}; ExpertOrder<1> S{C.vcu, C.G, (const LAS int*)(C.lds + TPRE_OFF)}; EpiSwiGLU<true> E{ws + WS_ACT, (const float*)(ws + WS_GSLOT)};
            pg8::gemm_phase<EpiSwiGLU<true>, ExpertOrder<1>, true, true, true, true>(C.lds, g, S, E, C.tid);
            }
            SEAM(pb + 10);
        }
        if (PHON(13) && IN(pb + 11)) { LC();
            { unsigned char* ws = WSP(); build_tpre(C, (const unsigned*)(ws + WS_CTL) + CW_ECNT + l * NE); }
            REP(18) if (PHON(18)) { __syncthreads(); unsigned char* ws = WSP(); int kk = DE / 2; OPAQ(kk);
              pg8::Gemm g{(const bf16*)(ws + WS_ACT), (const bf16*)(ws + WS_WEDN), NSLOT_MAX, NE * 1024, kk}; ExpertOrder<2> S{C.vcu, C.G, (const LAS int*)(C.lds + TPRE_OFF)}; EpiDown<true> E{(unsigned char*)(ws + WS_HS)};
              pg8::gemm_phase<EpiDown<true>, ExpertOrder<2>, true, true, false, true>(C.lds, g, S, E, C.tid); }
            __syncthreads();
            REP(19) if (PHON(19)) { __syncthreads(); unsigned char* ws = WSP(); int kk = DE / 2; OPAQ(kk);
              pg8::Gemm g{(const bf16*)(ws + WS_ACTSH), (const bf16*)(ws + WS_WSDN + (size_t)l * (1024 * 256)), T, D, kk}; PlainOrder<4> S{C.vcu, C.G, (T / 256) * 4}; EpiDown<true> E{(unsigned char*)(ws + WS_HS) + (size_t)NSLOT_MAX * 1024};
              pg8::gemm_phase<EpiDown<true>, PlainOrder<4>, true, true, false, true>(C.lds, g, S, E, C.tid); }
            SEAM(pb + 11);
        }
        if (PHON(14) && IN(pb + 12)) { LC();
            REP(14) { unsigned char* ws = WSP();
              ph_combine(C, (const bf16*)(ws + WS_AR), (const unsigned char*)(ws + WS_HS), (const int*)(ws + WS_SLOTOF), PIN(9) + l * D, PIN(10) + l * D, (bf16*)(ws + WS_XRES), ws + WS_XB8, l == 1 ? (float*)ldptr(PTAB, 19) : nullptr,
                         PIN(4), PIN(5), l == 0 ? (float*)(ws + WS_LOGF) : nullptr); }
            if (l == 0) { unsigned char* ws = WSP(); __syncthreads(); conv_experts(C, PIN(13), PIN(14), PIN(15), 1, ws + WS_WEGU, ws + WS_WEDN, C.vcu, C.G); }
            SEAM(pb + 12);
        }
    }
#undef IN
#undef SEAM
#undef PIN
#undef WSP
#undef OPAQ
#undef REP
#undef NREP
}
}

extern "C" void kernel_launch(void* const* d_in, const int* in_sizes, int n_in, void* d_out, int out_size, void* d_ws, size_t ws_size, hipStream_t stream) {
    using namespace mk;
    static int grid = 0;
    if (grid == 0) {
        if (n_in != 19 || in_sizes[0] != T * D || out_size != T * D || ws_size < WS_END) { fprintf(stderr, "kernel_launch: unexpected problem shape (n_in %d, in0 %d, out %d, ws %zu < %zu)\n", n_in, n_in > 0 ? in_sizes[0] : -1, out_size, ws_size, (size_t)WS_END); grid = -1; return; }
        int dev = 0, cus = 0, per_cu = 0;
        if (hipGetDevice(&dev) != hipSuccess || hipDeviceGetAttribute(&cus, hipDeviceAttributeMultiprocessorCount, dev) != hipSuccess) { grid = -1; return; }
        if (hipFuncSetAttribute((const void*)mk_fwd, hipFuncAttributeMaxDynamicSharedMemorySize, LDS_BYTES) != hipSuccess) { fprintf(stderr, "kernel_launch: hipFuncSetAttribute failed\n"); grid = -1; return; }
        if (hipOccupancyMaxActiveBlocksPerMultiprocessor(&per_cu, (const void*)mk_fwd, NTHR, LDS_BYTES) != hipSuccess || per_cu < 1) fprintf(stderr, "kernel_launch: occupancy query reports %d\n", per_cu);
        (void)hipGetLastError();
        grid = cus;
    }
    if (grid < 0) return;
    if (hipMemsetAsync((char*)d_ws + WS_CTL, 0, CTL_ZERO_BYTES, stream) != hipSuccess) return;
    Args a{};
    for (int i = 0; i < 19; ++i) a.in[i] = (const float*)d_in[i];
    a.out = (float*)d_out; a.ws = (unsigned char*)d_ws;
#if MK_MULTI
    for (int p = 0; p < NPH; ++p) {
        if (p == 2 || (p >= 15 && p <= 17)) continue;
        a.ph_lo = p; a.ph_hi = p + 1;
        hipLaunchKernelGGL(mk_fwd, dim3(grid), dim3(NTHR), LDS_BYTES, stream, a);
    }
#else
    a.ph_lo = 0; a.ph_hi = NPH;
    hipLaunchKernelGGL(mk_fwd, dim3(grid), dim3(NTHR), LDS_BYTES, stream, a);
#endif
    const hipError_t le = hipPeekAtLastError();
    if (le != hipSuccess) fprintf(stderr, "kernel_launch: launch failed: %s\n", hipGetErrorName(le));
}
```

```cpp
#include <hip/hip_runtime.h>
#include <cstdio>
#include <cstdint>
namespace pg8 {
#define PG8_LAS __attribute__((address_space(3)))
typedef unsigned short bf16_t;
typedef short bf16x8 __attribute__((ext_vector_type(8)));
typedef float f32x4 __attribute__((ext_vector_type(4)));
typedef unsigned u32x4 __attribute__((ext_vector_type(4)));
typedef int i32x4 __attribute__((ext_vector_type(4)));
typedef int i32x8 __attribute__((ext_vector_type(8)));
__device__ __forceinline__ i32x8 cat8(bf16x8 a, bf16x8 b) { return __builtin_shufflevector(__builtin_bit_cast(i32x4, a), __builtin_bit_cast(i32x4, b), 0, 1, 2, 3, 4, 5, 6, 7); }
constexpr int BM = 256, BK = 64, HALF = 128, HTB = HALF * BK * 2  , STAGE_BYTES = 8 * HTB, NXCD = 8, WGM = 8;

__host__ __device__ __forceinline__ int lds_byte(int r, int c) { const int st = (r >> 4) * 2 + (c >> 5), rr = r & 15, cc = c & 31, ob = rr * 64 + cc * 2; return st * 1024 + (ob ^ (((ob >> 9) & 1) << 5)); }
__host__ __device__ __forceinline__ void stage_rc(int b, int& R, int& C) { const int st = b / 1024, sb = b % 1024, swz = sb ^ (((sb >> 9) & 1) << 5); R = (st >> 1) * 16 + swz / 64; C = (st & 1) * 32 + (swz % 64) / 2; }
__host__ __device__ __forceinline__ int perm32(int rho) { const int n = rho >> 4, i = rho & 15; return 8 * (i >> 2) + 4 * n + (i & 3); }

struct Unit { int pm, pn; int hf = 0; };
struct Gemm { const bf16_t* A; const bf16_t* Bt; int M, N, K; const int* arow = nullptr; };

struct StaticOrder {
    int nM, nN, nwg, G, c;
    __host__ __device__ void init(int M, int N, int G_, int c_) { nM = M / BM; nN = N / BM; nwg = nM * nN; G = G_; c = c_; }
    __host__ __device__ bool next(int i, Unit& u) const {
        const long L = (long)i * G + c; if (L >= nwg) return false;
        int wgid = (int)L; { const int q = nwg / NXCD, r = nwg % NXCD, xcd = wgid % NXCD, off = wgid / NXCD; wgid = (xcd < r ? xcd * (q + 1) : r * (q + 1) + (xcd - r) * q) + off; }
        const int nig = WGM * nN, gid = wgid / nig, fm = gid * WGM, gsz = (nM - fm) < WGM ? (nM - fm) : WGM;
        u.pm = fm + ((wgid % nig) % gsz); u.pn = (wgid % nig) / gsz; return true;
    }
    __device__ __forceinline__ void a_ready(const Unit&) const {}
    __device__ __forceinline__ void done(const Unit&) const {}
};

__device__ __forceinline__ unsigned cvt_pk_bf16(float lo, float hi) { unsigned r; asm volatile("v_cvt_pk_bf16_f32 %0, %1, %2" : "=v"(r) : "v"(lo), "v"(hi)); return r; }
typedef float f32x2 __attribute__((ext_vector_type(2)));
__device__ __forceinline__ f32x2 gelu_pk(f32x2 v) {
    const f32x2 av = __builtin_elementwise_abs(v), d = av * 0.2316418882f + 1.0f;
    f32x2 t; t.x = __builtin_amdgcn_rcpf(d.x); t.y = __builtin_amdgcn_rcpf(d.y);
    f32x2 q = t * 0.5307027145f + (-0.7265760135f); q = q * t + 0.7107068705f; q = q * t + (-0.142248368f); q = q * t + 0.127414796f; q = q * t;
    const f32x2 s = (v * v) * (-0.72134752044f);
    f32x2 e; e.x = __builtin_amdgcn_exp2f(s.x); e.y = __builtin_amdgcn_exp2f(s.y);
    const f32x2 m = v * (q * e), r = v - m;
    f32x2 o; o.x = v.x < 0.f ? m.x : r.x; o.y = v.y < 0.f ? m.y : r.y; return o;
}

template <int ACT  > struct EpiBf16 {
    static constexpr bool PERM = true, AFTER_DRAIN = false; static_assert(ACT == 0 || ACT == 1, "EpiBf16: ACT is 0 (none) or 1 (gelu_pk)");
    bf16_t* O; int ldc; const float* bias; int split_cols; size_t split_stride; float scale0;
    __device__ __forceinline__ void operator()(const f32x4 (&acc)[2][2][4][2], const Unit& u, int wr, int wc, int fr, int fq) const {
        const int row0 = u.pm * BM + wr * 64 + fr; int colt = u.pn * BM; bf16_t* base = O;
        float sc = 1.f; if (split_cols) { const int t = colt / split_cols; base += (size_t)t * split_stride; colt -= t * split_cols; if (t == 0) sc = scale0; }
        const int col0 = colt + wc * 32 + 8 * fq, bcol0 = u.pn * BM + wc * 32 + 8 * fq;
        f32x4 bv[2][2];
#pragma unroll
        for (int bj = 0; bj < 2; ++bj)
#pragma unroll
            for (int n = 0; n < 2; ++n) bv[bj][n] = bias ? *(const f32x4*)(bias + bcol0 + bj * HALF + 4 * n) : (f32x4){0.f, 0.f, 0.f, 0.f};
#pragma unroll
        for (int ai = 0; ai < 2; ++ai)
#pragma unroll
            for (int m = 0; m < 4; ++m) { bf16_t* rowp = base + (size_t)(row0 + ai * HALF + m * 16) * ldc + col0;
#pragma unroll
                for (int bj = 0; bj < 2; ++bj) { f32x4 v0 = acc[ai][bj][m][0] + bv[bj][0], v1 = acc[ai][bj][m][1] + bv[bj][1];
                    if (ACT == 1) { f32x2 a = gelu_pk((f32x2){v0[0], v0[1]}), b = gelu_pk((f32x2){v0[2], v0[3]}), c = gelu_pk((f32x2){v1[0], v1[1]}), d = gelu_pk((f32x2){v1[2], v1[3]});
                        v0 = (f32x4){a.x, a.y, b.x, b.y}; v1 = (f32x4){c.x, c.y, d.x, d.y}; }
                    v0 = v0 * sc; v1 = v1 * sc; u32x4 w; w.x = cvt_pk_bf16(v0[0], v0[1]); w.y = cvt_pk_bf16(v0[2], v0[3]); w.z = cvt_pk_bf16(v1[0], v1[1]); w.w = cvt_pk_bf16(v1[2], v1[3]);
                    *(u32x4*)(rowp + bj * HALF) = w; } }
    }
};
template <class Epi, class Sched, bool ALIGN_EPI = false, bool SP2 = false, bool GATHER = false, bool F8 = false>
__device__ __forceinline__ void gemm_phase(PG8_LAS unsigned char* lds, const Gemm g, const Sched& S, const Epi& E, const int tid_in) {
    const int tid = tid_in,
              wid = __builtin_amdgcn_readfirstlane(tid >> 6), lane = tid & 63, wr = wid >> 2, wc = wid & 3, fr = lane & 15, fq = lane >> 4;
    const int K = g.K, nt = K / BK;
    unsigned voffA[2], voffB[2], voffA1[2], nvA0[2], nvA1[2]; int gR[2], gC[2];
#pragma unroll
    for (int i = 0; i < 2; ++i) { int R, C; stage_rc(tid * 16 + i * 8192, R, C); const int Rb = Epi::PERM ? ((R & ~31) + perm32(R & 31)) : R;
        voffA[i] = (unsigned)(R * K + C) * 2u; voffB[i] = (unsigned)(Rb * K + C) * 2u; voffA1[i] = voffA[i]; nvA0[i] = voffA[i]; nvA1[i] = voffA[i]; gR[i] = R; gC[i] = C; }
    const size_t kstep = (size_t)(BK * 2);
    const size_t hstep = (size_t)HALF * K * 2;
    const size_t tstep = 2 * hstep;
    const unsigned ldsw = (unsigned)wid * 1024u;
    const unsigned ldsu = (unsigned)__builtin_amdgcn_readfirstlane((int)((unsigned)(uintptr_t)lds + ldsw));
    const int aoff = lds_byte(wr * 64 + fr, fq * 8), boff = lds_byte(wc * 32 + fr, fq * 8);
#define PG8_SA(b, h) (((b) * 2 + (h)) * HTB)
#define PG8_SB(b, h) ((4 + (b) * 2 + (h)) * HTB)
#define PG8_DMA(sbase, vo, ldsdst) do { unsigned keep_; asm volatile("s_mov_b32 %0, m0\n\ts_mov_b32 m0, %3\n\ts_nop 0\n\tglobal_load_lds_dwordx4 %1, %2\n\ts_mov_b32 m0, %0" : "=&s"(keep_) : "v"(vo), "s"(sbase), "s"(ldsdst) : "memory"); } while (0)
#define PG8_STAGE(bufoff, gbase, voff) do { _Pragma("unroll") for (int _i = 0; _i < 2; ++_i) PG8_DMA((const char*)(gbase), (voff)[_i], ldsu + (unsigned)((bufoff) + _i * 8192)); } while (0)
#define PG8_GROW(dst0, dst1, pm_) do { if constexpr (GATHER) { _Pragma("unroll") for (int _i = 0; _i < 2; ++_i) { const int r0_ = g.arow[(pm_) * 256 + gR[_i]], r1_ = g.arow[(pm_) * 256 + 128 + gR[_i]]; \
        dst0[_i] = (unsigned)(r0_ * K + gC[_i]) * 2u; dst1[_i] = (unsigned)(r1_ * K + gC[_i]) * 2u; } } } while (0)
#define PG8_STAGE_A(bufoff, h, koff, nx) do { if constexpr (GATHER) { _Pragma("unroll") for (int _i = 0; _i < 2; ++_i) { const unsigned vo_ = (nx) ? ((h) ? nvA1[_i] : nvA0[_i]) : ((h) ? voffA1[_i] : voffA[_i]); \
        PG8_DMA((const char*)g.A + (koff), vo_, ldsu + (unsigned)((bufoff) + _i * 8192)); } } \
    else { PG8_STAGE(bufoff, ((nx) ? nA : cA) + (koff) + ((h) ? hstep : 0), voffA); } } while (0)
#define PG8_LDA(dst, b, h) do { _Pragma("unroll") for (int m = 0; m < 4; ++m) _Pragma("unroll") for (int k = 0; k < 2; ++k) dst[m][k] = *(const PG8_LAS bf16x8*)(lds + PG8_SA(b, h) + aoff + m * 2048 + k * 1024); } while (0)
#define PG8_LDB(dst, b, h) do { _Pragma("unroll") for (int n = 0; n < 2; ++n) _Pragma("unroll") for (int k = 0; k < 2; ++k) dst[n][k] = *(const PG8_LAS bf16x8*)(lds + PG8_SB(b, h) + boff + n * 2048 + k * 1024); } while (0)
#define PG8_MMA(ai, bj, At, Bt) do { __builtin_amdgcn_s_setprio(1); _Pragma("unroll") for (int m = 0; m < 4; ++m) _Pragma("unroll") for (int n = 0; n < 2; ++n) { \
        if constexpr (F8) acc[ai][bj][m][n] = __builtin_amdgcn_mfma_scale_f32_16x16x128_f8f6f4(cat8(Bt[n][0], Bt[n][1]), cat8(At[m][0], At[m][1]), acc[ai][bj][m][n], 0, 0, 0, 0, 0, 0); \
        else { _Pragma("unroll") for (int k = 0; k < 2; ++k) acc[ai][bj][m][n] = __builtin_amdgcn_mfma_f32_16x16x32_bf16(Bt[n][k], At[m][k], acc[ai][bj][m][n], 0, 0, 0); } } __builtin_amdgcn_s_setprio(0); } while (0)
#define PG8_WAIT_V(n) asm volatile("s_waitcnt vmcnt(" #n ")" ::: "memory")
#define PG8_WAIT_L(n) asm volatile("s_waitcnt lgkmcnt(" #n ")" ::: "memory")
#define PG8_BAR __builtin_amdgcn_s_barrier()
#define PG8_SCHED __builtin_amdgcn_sched_barrier(0)
    Unit cur, nxt; int ui = 0;
    if (!S.next(0, cur)) return;
    f32x4 acc[2][2][4][2];
    float zz = 0.f; asm volatile("" : "+v"(zz));
#pragma unroll
    for (int a = 0; a < 2; ++a)
#pragma unroll
        for (int b = 0; b < 2; ++b)
#pragma unroll
            for (int m = 0; m < 4; ++m)
#pragma unroll
                for (int n = 0; n < 2; ++n) acc[a][b][m][n] = (f32x4){zz, zz, zz, zz};
    bf16x8 At[4][2], B0[2][2], B1[2][2];
    const char* cA = (const char*)g.A + (size_t)cur.pm * tstep; const char* cB = (const char*)g.Bt + (size_t)cur.pn * tstep;
    S.a_ready(cur);
    PG8_GROW(voffA, voffA1, cur.pm);
    const char* nA = cA; const char* nB = cB;
    if constexpr (SP2) {
        PG8_STAGE(PG8_SB(0, 0), cB, voffB); PG8_STAGE(PG8_SB(0, 1), cB + hstep, voffB); PG8_STAGE_A(PG8_SA(0, 0), 0, 0, false); PG8_STAGE_A(PG8_SA(0, 1), 1, 0, false);
        if (wr == 1) PG8_BAR;
        PG8_WAIT_V(2); PG8_BAR;
        PG8_STAGE(PG8_SB(1, 0), cB + kstep, voffB); PG8_STAGE_A(PG8_SA(1, 0), 0, kstep, false); PG8_STAGE(PG8_SB(1, 1), cB + hstep + kstep, voffB);
        PG8_WAIT_V(6); PG8_BAR;
    } else {
        PG8_STAGE(PG8_SB(0, 0), cB, voffB); PG8_STAGE(PG8_SA(0, 0), cA, voffA); PG8_STAGE(PG8_SB(0, 1), cB + hstep, voffB); PG8_STAGE(PG8_SA(0, 1), cA + hstep, voffA);
        if (wr == 1) PG8_BAR;
        PG8_WAIT_V(4); PG8_BAR;
        PG8_STAGE(PG8_SB(1, 0), cB + kstep, voffB); PG8_STAGE(PG8_SA(1, 0), cA + kstep, voffA); PG8_STAGE(PG8_SB(1, 1), cB + hstep + kstep, voffB);
        PG8_WAIT_V(6); PG8_BAR;
    }
    for (;;) {
        const bool has_next = S.next(ui + 1, nxt);
        nA = has_next ? (const char*)g.A + (size_t)nxt.pm * tstep : cA; nB = has_next ? (const char*)g.Bt + (size_t)nxt.pn * tstep : cB;
        if constexpr (GATHER) { if (has_next) PG8_GROW(nvA0, nvA1, nxt.pm); else { _Pragma("unroll") for (int _i = 0; _i < 2; ++_i) { nvA0[_i] = voffA[_i]; nvA1[_i] = voffA1[_i]; } } }
        for (int t = 0; t < nt; t += 2) {
            const bool last = (t == nt - 2);
            const size_t ko1 = (size_t)(t + 1) * kstep, ko2 = last ? 0 : (size_t)(t + 2) * kstep, ko3 = ko2 + kstep;
            const char* b2 = last ? nB : cB + (size_t)(t + 2) * kstep;
            const char* b3 = b2 + kstep;
            if (last && has_next) S.a_ready(nxt);
            if constexpr (SP2) {
            PG8_LDB(B0, 0, 0); PG8_LDB(B1, 0, 1); PG8_SCHED; PG8_LDA(At, 0, 0); PG8_STAGE_A(PG8_SA(1, 1), 1, ko1, false);
            PG8_WAIT_V(8); PG8_WAIT_L(0); PG8_BAR; PG8_MMA(0, 0, At, B0); PG8_MMA(0, 1, At, B1); PG8_BAR; PG8_SCHED;
            PG8_LDA(At, 0, 1); PG8_STAGE(PG8_SB(0, 0), b2, voffB); PG8_STAGE(PG8_SB(0, 1), b2 + hstep, voffB); PG8_STAGE_A(PG8_SA(0, 0), 0, ko2, last);
            PG8_WAIT_V(8); PG8_WAIT_L(0); PG8_BAR; if (!cur.hf) { PG8_MMA(1, 0, At, B0); PG8_MMA(1, 1, At, B1); } PG8_BAR; PG8_SCHED;
            PG8_LDB(B0, 1, 0); PG8_LDB(B1, 1, 1); PG8_SCHED; PG8_LDA(At, 1, 0); PG8_STAGE_A(PG8_SA(0, 1), 1, ko2, last);
            PG8_WAIT_V(8); PG8_WAIT_L(0); PG8_BAR; PG8_MMA(0, 0, At, B0); PG8_MMA(0, 1, At, B1); PG8_BAR; PG8_SCHED;
            PG8_LDA(At, 1, 1); PG8_STAGE(PG8_SB(1, 0), b3, voffB); PG8_STAGE(PG8_SB(1, 1), b3 + hstep, voffB); PG8_STAGE_A(PG8_SA(1, 0), 0, ko3, last);
            PG8_WAIT_V(8); PG8_WAIT_L(0); PG8_BAR; if (!cur.hf) { PG8_MMA(1, 0, At, B0); PG8_MMA(1, 1, At, B1); } PG8_BAR; PG8_SCHED;
            } else {
            const char* a1 = cA + ko1; const char* a2 = (last ? nA : cA) + ko2; const char* a3 = a2 + kstep;
            PG8_LDB(B0, 0, 0); PG8_SCHED; PG8_LDA(At, 0, 0); PG8_STAGE(PG8_SA(1, 1), a1 + hstep, voffA);
            PG8_WAIT_L(8); PG8_BAR; PG8_WAIT_L(0); PG8_MMA(0, 0, At, B0); PG8_BAR; PG8_SCHED;
            PG8_LDB(B1, 0, 1); PG8_STAGE(PG8_SB(0, 0), b2, voffB);
            PG8_BAR; PG8_WAIT_L(0); PG8_MMA(0, 1, At, B1); PG8_BAR;
            PG8_LDA(At, 0, 1); PG8_STAGE(PG8_SA(0, 0), a2, voffA);
            PG8_BAR; PG8_WAIT_L(0); PG8_MMA(1, 0, At, B0); PG8_BAR; PG8_SCHED;
            PG8_STAGE(PG8_SB(0, 1), b2 + hstep, voffB);
            PG8_WAIT_V(6); PG8_BAR; PG8_MMA(1, 1, At, B1); PG8_BAR;
            PG8_LDB(B0, 1, 0); PG8_SCHED; PG8_LDA(At, 1, 0); PG8_STAGE(PG8_SA(0, 1), a2 + hstep, voffA);
            PG8_WAIT_L(8); PG8_BAR; PG8_WAIT_L(0); PG8_MMA(0, 0, At, B0); PG8_BAR; PG8_SCHED;
            PG8_LDB(B1, 1, 1); PG8_STAGE(PG8_SB(1, 0), b3, voffB);
            PG8_BAR; PG8_WAIT_L(0); PG8_MMA(0, 1, At, B1); PG8_BAR;
            PG8_LDA(At, 1, 1); PG8_STAGE(PG8_SA(1, 0), a3, voffA);
            PG8_BAR; PG8_WAIT_L(0); PG8_MMA(1, 0, At, B0); PG8_BAR; PG8_SCHED;
            PG8_STAGE(PG8_SB(1, 1), b3 + hstep, voffB);
            PG8_WAIT_V(6); PG8_BAR; PG8_MMA(1, 1, At, B1); PG8_BAR;
            }
        }
        if constexpr (ALIGN_EPI) { if (wr == 0) PG8_BAR; }
        if constexpr (!Epi::AFTER_DRAIN) { E(acc, cur, wr, wc, fr, fq); S.done(cur); }
        if (!has_next) break;
        zz = 0.f; asm volatile("" : "+v"(zz));
#pragma unroll
        for (int a = 0; a < 2; ++a)
#pragma unroll
            for (int b = 0; b < 2; ++b)
#pragma unroll
                for (int m = 0; m < 4; ++m)
#pragma unroll
                    for (int n = 0; n < 2; ++n) acc[a][b][m][n] = (f32x4){zz, zz, zz, zz};
        cur = nxt; cA = nA; cB = nB; ++ui;
        if constexpr (GATHER) { _Pragma("unroll") for (int _i = 0; _i < 2; ++_i) { voffA[_i] = nvA0[_i]; voffA1[_i] = nvA1[_i]; } }
        if constexpr (ALIGN_EPI) { if (wr == 1) PG8_BAR; }
    }
    PG8_WAIT_V(0);
    if constexpr (!ALIGN_EPI) { if (wr == 0) PG8_BAR; }
    PG8_BAR;
    if constexpr (Epi::AFTER_DRAIN) { E.fused(acc, cur, wr, wc, fr, fq, lds, wid, lane); S.done(cur); }
#undef PG8_SA
#undef PG8_SB
#undef PG8_STAGE
#undef PG8_DMA
#undef PG8_STAGE_A
#undef PG8_GROW
#undef PG8_LDA
#undef PG8_LDB
#undef PG8_MMA
#undef PG8_WAIT_V
#undef PG8_WAIT_L
#undef PG8_BAR
#undef PG8_SCHED
}
}
#define GAS __attribute__((address_space(1)))
#define LAS __attribute__((address_space(3)))
typedef unsigned short bf16;
typedef unsigned v4u __attribute__((ext_vector_type(4)));
typedef float f32x4 __attribute__((ext_vector_type(4)));
typedef short bf16x8 __attribute__((ext_vector_type(8)));
typedef GAS unsigned gu32;
typedef GAS unsigned long long gu64;
#define RLX_AGENT __ATOMIC_RELAXED, __HIP_MEMORY_SCOPE_AGENT
#define LDS_WAIT() asm volatile("s_waitcnt lgkmcnt(0)" ::: "memory")
#define VM_WAIT() asm volatile("s_waitcnt vmcnt(0)" ::: "memory")
__device__ __forceinline__ int lane_now() { int l; asm volatile("v_mbcnt_lo_u32_b32 %0, -1, 0\n\tv_mbcnt_hi_u32_b32 %0, -1, %0" : "=v"(l)); return l; }
__device__ __forceinline__ int shfl_xor_l(int v, int o) { return __builtin_amdgcn_ds_bpermute((lane_now() ^ o) << 2, v); }
__device__ __forceinline__ unsigned shfl_xor_l(unsigned v, int o) { return (unsigned)shfl_xor_l((int)v, o); }
__device__ __forceinline__ float shfl_xor_l(float v, int o) { return __builtin_bit_cast(float, shfl_xor_l(__builtin_bit_cast(int, v), o)); }
__device__ __forceinline__ int shfl_up_l(int v, int o) { const int l = lane_now(), s = l - o; return __builtin_amdgcn_ds_bpermute((s < 0 ? l : s) << 2, v); }
__device__ __forceinline__ float shfl_up_l(float v, int o) { return __builtin_bit_cast(float, shfl_up_l(__builtin_bit_cast(int, v), o)); }
#define __shfl_xor(v, o) shfl_xor_l((v), (o))
#define __shfl_up(v, o) shfl_up_l((v), (o))
__device__ __forceinline__ unsigned long long rt() { return __builtin_amdgcn_s_memrealtime(); }
__device__ __forceinline__ unsigned f2bf(float f) { unsigned u = __builtin_bit_cast(unsigned, f); return (u + 0x7fffu + ((u >> 16) & 1u)) >> 16; }
__device__ __forceinline__ unsigned pk2(float lo, float hi) { return f2bf(lo) | (f2bf(hi) << 16); }

#define XB_TMO      128
#define XB_XCNT(j)  (256  + 64 * (j))
#define XB_XSUB(j)  (1280 + 64 * (j))
#define XB_XGEN(j)  (2304 + 64 * (j))
#define XB_TOP      3328
#define XB_TOPGEN   3392
#define XCD_BAR_WORDS 3456
#define XB_SPIN_CAP (1u << 18)

__device__ __forceinline__ unsigned xb_ld(unsigned* p)              { return __hip_atomic_load(p, __ATOMIC_RELAXED, __HIP_MEMORY_SCOPE_AGENT); }
__device__ __forceinline__ unsigned xb_add(unsigned* p, unsigned v) { return __hip_atomic_fetch_add(p, v, __ATOMIC_RELAXED, __HIP_MEMORY_SCOPE_AGENT); }
__device__ __forceinline__ unsigned xb_xcc_id() { return (unsigned)__builtin_amdgcn_s_getreg((3 << 11) | 20) & 0xFu; }
#define XB_SPIN(cond, bar) do { unsigned _sp = 0; while (cond) { __builtin_amdgcn_s_sleep(1); \
    if ((++_sp & 255u) == 0u) { if (xb_ld(&(bar)[XB_TMO])) break; if (_sp > XB_SPIN_CAP) { atomicAdd(&(bar)[XB_TMO], 1u); break; } } } } while (0)

struct XcdBarrier {
    unsigned* bar; unsigned x;
    volatile LAS unsigned* st;
};

__device__ __forceinline__ XcdBarrier xcd_barrier_post(unsigned* bar, volatile LAS unsigned* st) {
    XcdBarrier b; b.bar = bar; b.x = xb_xcc_id(); b.st = st;
    if (threadIdx.x == 0) (void)xb_add(&bar[XB_XCNT(b.x)], 1u);
    return b;
}
__device__ __forceinline__ void xcd_barrier_complete(unsigned* bar, unsigned x, unsigned& nloc, unsigned& nx) {
    const unsigned G = gridDim.x * gridDim.y * gridDim.z;
    unsigned sum, cnt, mine, sp = 0u;
    for (;;) {
        sum = 0u; cnt = 0u; mine = 0u;
#pragma unroll
        for (unsigned j = 0; j < 16; ++j) { const unsigned c = xb_ld(&bar[XB_XCNT(j)]); sum += c; cnt += (c > 0u) ? 1u : 0u; mine = (j == x) ? c : mine; }
        if (sum == G) break;
        __builtin_amdgcn_s_sleep(1);
        if ((++sp & 255u) == 0u) { if (xb_ld(&bar[XB_TMO])) break; if (sp > XB_SPIN_CAP) { atomicAdd(&bar[XB_TMO], 1u); break; } }
    }
    nloc = mine > 0u ? mine : 1u; nx = cnt > 0u ? cnt : 1u;
}

__device__ __forceinline__ void xcd_barrier(const XcdBarrier& b) {
    asm volatile("s_waitcnt vmcnt(0)" ::: "memory");
    __syncthreads();
    if (threadIdx.x == 0) {
        unsigned* bar = b.bar;
        __builtin_amdgcn_s_waitcnt(0);
        unsigned nloc = b.st[0], nx = b.st[1];
        if (nloc == 0u) { xcd_barrier_complete(bar, b.x, nloc, nx); b.st[0] = nloc; b.st[1] = nx; }
        const unsigned old = xb_add(&bar[XB_XSUB(b.x)], 1u);
        const unsigned gen = old / nloc;
        if (old + 1u == (gen + 1u) * nloc) {
            __builtin_amdgcn_fence(__ATOMIC_RELEASE, "agent");
            asm volatile("s_waitcnt vmcnt(0)" ::: "memory");
            const unsigned og = xb_add(&bar[XB_TOP], 1u);
            const unsigned tg = og / nx;
            if (og + 1u == (tg + 1u) * nx) xb_add(&bar[XB_TOPGEN], 1u);
            else XB_SPIN(xb_ld(&bar[XB_TOPGEN]) == tg, bar);
            __builtin_amdgcn_fence(__ATOMIC_ACQUIRE, "agent");
            xb_add(&bar[XB_XGEN(b.x)], 1u);
            asm volatile("s_waitcnt vmcnt(0)" ::: "memory");
        } else {
            XB_SPIN(xb_ld(&bar[XB_XGEN(b.x)]) == gen, bar);
            __builtin_amdgcn_fence(__ATOMIC_ACQUIRE, "agent");
            asm volatile("s_waitcnt vmcnt(0)" ::: "memory");
        }
    }
    __syncthreads();
}
namespace mk {
typedef float f32x16 __attribute__((ext_vector_type(16)));
typedef float f32x2 __attribute__((ext_vector_type(2)));
typedef short s16x4 __attribute__((ext_vector_type(4)));
typedef unsigned u32x2 __attribute__((ext_vector_type(2)));
typedef unsigned u32x4 __attribute__((ext_vector_type(4)));

constexpr int NWAVES = 8, NTHR = 512;
constexpr int BATCH = 4, SEQ = 8192, D = 1024, H = 16, HD = 64, T = BATCH * SEQ;
constexpr int NE = 256, TOPK = 8, DE = 256, NGRP = 8, GRPSZ = 32;
constexpr int NBLK = SEQ / 256;
constexpr int NSLOT_MAX = 327680;
constexpr float LN_EPS = 1e-5f;
constexpr float DN_ALPHA = 1.4142135623730951f;
constexpr float ROUTED_SCALE = 2.5f;
constexpr float LOG2E = 1.4426950408889634f;
constexpr float C2 = 0.125f * LOG2E;
constexpr float XQ_SCALE = 16.f, WQ_SCALE = 256.f, AQ_SCALE = 64.f, OQ_SCALE = 64.f, F8_MAX = 448.f;
constexpr float GS_FOLD = AQ_SCALE / (XQ_SCALE * WQ_SCALE);
constexpr int FOXW = 3 * D + H;

constexpr size_t MiB = 1u << 20;
constexpr size_t WS_CTL = 0, CTL_ZERO_BYTES = 1 * MiB;
constexpr size_t WS_WMI = 2 * MiB;
constexpr size_t WS_WMO = 8 * MiB;
constexpr size_t WS_WFI = 10 * MiB;
constexpr size_t WS_WFO = 16 * MiB;
constexpr size_t WS_WR = 18 * MiB;
constexpr size_t WS_WSGU = 21 * MiB;
constexpr size_t WS_WSDN = 23 * MiB;
constexpr size_t WS_WEGU = 24 * MiB;
constexpr size_t WS_WEDN = 280 * MiB;
constexpr size_t WS_XRES = 408 * MiB;
constexpr size_t WS_Z = 536 * MiB;
constexpr size_t WS_XB8 = 600 * MiB;
constexpr size_t WS_XB = 664 * MiB;
constexpr size_t WS_AR = 728 * MiB;
constexpr size_t WS_LOGP = 920 * MiB;
constexpr size_t WS_ACTSH = 984 * MiB;
constexpr size_t WS_TOPI = 1000 * MiB;
constexpr size_t WS_GATE = 1001 * MiB;
constexpr size_t WS_SLOTOF = 1002 * MiB;
constexpr size_t WS_TOKOF = 1003 * MiB;
constexpr size_t WS_GSLOT = 1005 * MiB;
constexpr size_t WS_KMEAN = 1008 * MiB;
constexpr size_t WS_LOGF = 1009 * MiB;
constexpr size_t WS_CUM = 1011 * MiB;
constexpr size_t WS_OVL = 1016 * MiB;
constexpr size_t WS_Q = WS_OVL, WS_K = WS_OVL + 64 * MiB, WS_V = WS_OVL + 128 * MiB, WS_O = WS_OVL + 192 * MiB;
constexpr size_t WS_MLIST = WS_OVL + 256 * MiB;
constexpr size_t WS_PARTO = WS_OVL + 288 * MiB;
constexpr size_t WS_PARTML = WS_OVL + 480 * MiB;
constexpr size_t WS_HS = WS_OVL;
constexpr size_t WS_ACT = WS_OVL + 640 * MiB;
constexpr size_t WS_END = WS_OVL + 800 * MiB;
static_assert(WS_END <= 2048 * MiB, "d_ws map");
static_assert(WS_PARTML + (size_t)T * H * 3 * 2 * 4 <= WS_END, "attention overlay");
constexpr int MLIST_PER_BH = 256 * 496;
constexpr int CW_BAR = 4096;
constexpr int CW_MCNT = 16384;
constexpr int CW_ECNT = 20480;
constexpr int CW_ECUR = 21504;
constexpr int CW_FOXQ = 24576;
constexpr int CW_KSUM = 131072;
constexpr int CW_NORM = 24832;
constexpr int RING_BYTES = 131072, LDSCTL_OFF = 155648, MISC_OFF = LDSCTL_OFF + 320, TPRE_OFF = LDSCTL_OFF + 1024, PTAB_OFF = LDSCTL_OFF + 4096, LDS_BYTES = 163840;
typedef __bf16 bf16x2_t __attribute__((ext_vector_type(2)));
__device__ __forceinline__ unsigned cvtpk(float lo, float hi) { f32x2 v = {lo, hi}; bf16x2_t b = __builtin_convertvector(v, bf16x2_t); return __builtin_bit_cast(unsigned, b); }
__device__ __forceinline__ float bf2f(unsigned b) { return __uint_as_float(b << 16); }
__device__ __forceinline__ float bflo(unsigned w) { return __uint_as_float(w << 16); }
__device__ __forceinline__ float bfhi(unsigned w) { return __uint_as_float(w & 0xffff0000u); }
__device__ __forceinline__ float wave_sum(float v) {
#pragma unroll
    for (int o = 1; o < 64; o <<= 1) v += __shfl_xor(v, o);
    return v;
}
__device__ __forceinline__ unsigned sort_key(float x) { const unsigned b = __float_as_uint(x); return b ^ ((unsigned)((int)b >> 31) | 0x80000000u); }
__device__ __forceinline__ int crow(int r, int hi) { return (r & 3) + 8 * (r >> 2) + 4 * hi; }
__device__ __forceinline__ s16x4 vtr(const LAS unsigned char* p) { typedef short v4i16_t __attribute__((ext_vector_type(4))); return __builtin_bit_cast(s16x4, __builtin_amdgcn_ds_read_tr16_b64_v4i16((LAS v4i16_t*)p)); }

__device__ __forceinline__ unsigned long long ldptr(const LAS unsigned long long* tab, int i) { const unsigned long long v = tab[i]; const unsigned lo = __builtin_amdgcn_readfirstlane((unsigned)v), hi = __builtin_amdgcn_readfirstlane((unsigned)(v >> 32)); return ((unsigned long long)hi << 32) | lo; }

struct Ctx {
    LAS unsigned char* lds;
    int tid, lane, wave, vcu, G;
};

template <bool LO> __device__ __forceinline__ void tr_item(const float* src, size_t ld, bf16* dst, size_t dpitch, LAS float* scr, int lane) {
#pragma unroll 8
    for (int i = 0; i < 32; ++i) { const int kk = 2 * i + (lane >> 5); scr[kk * 33 + (lane & 31)] = src[(size_t)kk * ld + (lane & 31)]; }
    LDS_WAIT(); asm volatile("" ::: "memory");
    const int c = lane & 7;
#pragma unroll
    for (int j = 0; j < 4; ++j) { const int n = (lane >> 3) + 8 * j; const LAS float* s = scr + (8 * c) * 33 + n;
        float v[8];
#pragma unroll
        for (int i = 0; i < 8; ++i) { v[i] = s[i * 33]; if (LO) v[i] = v[i] - bf2f(f2bf(v[i])); }
        v4u o; o.x = pk2(v[0], v[1]); o.y = pk2(v[2], v[3]); o.z = pk2(v[4], v[5]); o.w = pk2(v[6], v[7]);
        *(GAS v4u*)(dst + (size_t)n * dpitch + 8 * c) = o; }
    LDS_WAIT(); asm volatile("" ::: "memory");
}

__device__ __forceinline__ void tr_item64(const float* src, size_t ld, bf16* dst0, size_t rstride, LAS unsigned char* scr, int lane) {
    float v[64];
    const GAS float* p = (const GAS float*)src + lane;
#pragma unroll
    for (int k = 0; k < 64; ++k) v[k] = p[(size_t)k * ld];
#pragma unroll
    for (int c = 0; c < 8; ++c) { v4u o; o.x = cvtpk(v[8 * c], v[8 * c + 1]); o.y = cvtpk(v[8 * c + 2], v[8 * c + 3]); o.z = cvtpk(v[8 * c + 4], v[8 * c + 5]); o.w = cvtpk(v[8 * c + 6], v[8 * c + 7]);
        *(LAS v4u*)(scr + lane * 144 + c * 16) = o; }
    LDS_WAIT(); asm volatile("" ::: "memory");
#pragma unroll
    for (int i = 0; i < 8; ++i) { const int row = 8 * i + (lane >> 3), c = lane & 7; const v4u o = *(const LAS v4u*)(scr + row * 144 + c * 16);
        *(GAS v4u*)(dst0 + (size_t)row * rstride + 8 * c) = o; }
    LDS_WAIT(); asm volatile("" ::: "memory");
}
__device__ __forceinline__ unsigned pk4_f8(float a, float b, float c, float d) {
    a = __builtin_amdgcn_fmed3f(a, -F8_MAX, F8_MAX); b = __builtin_amdgcn_fmed3f(b, -F8_MAX, F8_MAX); c = __builtin_amdgcn_fmed3f(c, -F8_MAX, F8_MAX); d = __builtin_amdgcn_fmed3f(d, -F8_MAX, F8_MAX);
    unsigned w = 0u; w = (unsigned)__builtin_amdgcn_cvt_pk_fp8_f32(a, b, (int)w, false); w = (unsigned)__builtin_amdgcn_cvt_pk_fp8_f32(c, d, (int)w, true); return w;
}
__device__ __forceinline__ void tr_item_f8(const float* src, size_t ld, unsigned char* dst0, size_t rstride, LAS unsigned char* scr, int lane) {
#pragma unroll 1
    for (int h = 0; h < 2; ++h) {
        float v[64];
        const GAS float* p = (const GAS float*)src + lane + (size_t)(64 * h) * ld;
#pragma unroll
        for (int k = 0; k < 64; ++k) v[k] = __builtin_nontemporal_load(p + (size_t)k * ld);
#pragma unroll
        for (int c = 0; c < 4; ++c) { v4u o;
            o.x = pk4_f8(v[16 * c] * WQ_SCALE, v[16 * c + 1] * WQ_SCALE, v[16 * c + 2] * WQ_SCALE, v[16 * c + 3] * WQ_SCALE); o.y = pk4_f8(v[16 * c + 4] * WQ_SCALE, v[16 * c + 5] * WQ_SCALE, v[16 * c + 6] * WQ_SCALE, v[16 * c + 7] * WQ_SCALE);
            o.z = pk4_f8(v[16 * c + 8] * WQ_SCALE, v[16 * c + 9] * WQ_SCALE, v[16 * c + 10] * WQ_SCALE, v[16 * c + 11] * WQ_SCALE); o.w = pk4_f8(v[16 * c + 12] * WQ_SCALE, v[16 * c + 13] * WQ_SCALE, v[16 * c + 14] * WQ_SCALE, v[16 * c + 15] * WQ_SCALE);
            *(LAS v4u*)(scr + lane * 144 + h * 64 + c * 16) = o; }
    }
    LDS_WAIT(); asm volatile("" ::: "memory");
#pragma unroll
    for (int i = 0; i < 8; ++i) { const int row = 8 * i + (lane >> 3), c = lane & 7; const v4u o = *(const LAS v4u*)(scr + row * 144 + c * 16);
        *(GAS v4u*)(dst0 + (size_t)row * rstride + 16 * c) = o; }
    LDS_WAIT(); asm volatile("" ::: "memory");
}
__device__ __forceinline__ void conv_experts(const Ctx& C, const float* wg, const float* wu, const float* wd, int l, unsigned char* WEGU, unsigned char* WEDN, int part, int nparts) {
    const int gw = part * NWAVES + C.wave, NGW = nparts * NWAVES, lane = C.lane;
    LAS unsigned char* scr = C.lds + C.wave * 9216;
    constexpr int IG = NE * 8 * 4;
    constexpr int IDN = NE * 2 * 16;
    for (int it = gw; it < 2 * IG + IDN; it += NGW) {
        if (it < 2 * IG) {
            const int up = it >= IG, r = it - up * IG, e = r >> 5, kb = (r >> 2) & 7, nb = r & 3, n0 = 64 * nb;
            const float* src = (up ? wu : wg) + ((size_t)(l * NE + e) * 1024 + 128 * kb) * 256 + 64 * nb;
            unsigned char* dst = WEGU + ((size_t)e * 512 + (n0 >> 7) * 256 + up * 128 + (n0 & 127)) * 1024 + 128 * kb;
            tr_item_f8(src, 256, dst, 1024, scr, lane);
        } else {
            const int r = it - 2 * IG, e = r >> 5, kb = (r >> 4) & 1, nb = r & 15;
            const float* src = wd + ((size_t)(l * NE + e) * 256 + 128 * kb) * 1024 + 64 * nb;
            unsigned char* dst = WEDN + ((size_t)e * 1024 + 64 * nb) * 256 + 128 * kb;
            tr_item_f8(src, 1024, dst, 256, scr, lane);
        }
    }
}

struct SmallW {
    const float *moba_in, *moba_out, *fox_in, *fox_out, *w_router, *ws_gate, *ws_up, *ws_down;
    unsigned char *WMI, *WFI, *WMO, *WFO, *WSGU, *WSDN;
    bf16 *WR;
};
__device__ __forceinline__ void conv_small(const Ctx& C, const SmallW& W) {
    LAS float* scr = (LAS float*)(C.lds + C.wave * 16384);
    const int gw = C.vcu * NWAVES + C.wave, NGW = C.G * NWAVES;
    constexpr int I_IN = 8 * 48  , I_OUT = 8 * 16, I_R = 16 * 8, I_SG = 8 * 4, I_SD = 2 * 16;
    constexpr int NIT = 2 * I_IN + 2 * I_OUT + 2 * (3 * I_R) + 2 * (2 * I_SG + I_SD);
    for (int it = gw; it < NIT; it += NGW) {
        int r = it;
        if (r < I_IN) { const int kb = r / 48, nb = r % 48; tr_item_f8(W.moba_in + (size_t)(128 * kb) * 3072 + 64 * nb, 3072, W.WMI + (size_t)(64 * nb) * 1024 + 128 * kb, 1024, (LAS unsigned char*)scr, C.lane); continue; } r -= I_IN;
        if (r < I_IN) { const int kb = r / 48, nb = r % 48; tr_item_f8(W.fox_in + (size_t)(128 * kb) * FOXW + 64 * nb, FOXW, W.WFI + (size_t)(64 * nb) * 1024 + 128 * kb, 1024, (LAS unsigned char*)scr, C.lane); continue; } r -= I_IN;
        if (r < I_OUT) { const int kb = r >> 4, nb = r & 15; tr_item_f8(W.moba_out + (size_t)(128 * kb) * 1024 + 64 * nb, 1024, W.WMO + (size_t)(64 * nb) * 1024 + 128 * kb, 1024, (LAS unsigned char*)scr, C.lane); continue; } r -= I_OUT;
        if (r < I_OUT) { const int kb = r >> 4, nb = r & 15; tr_item_f8(W.fox_out + (size_t)(128 * kb) * 1024 + 64 * nb, 1024, W.WFO + (size_t)(64 * nb) * 1024 + 128 * kb, 1024, (LAS unsigned char*)scr, C.lane); continue; } r -= I_OUT;
        if (r < 6 * I_R) {
            const int l = r / (3 * I_R), q = (r % (3 * I_R)) / I_R, s = r % I_R, kb = s >> 3, nb = s & 7;
            const float* src = W.w_router + ((size_t)l * 1024 + 64 * kb) * 256 + 32 * nb;
            bf16* base = W.WR + (size_t)l * (512 * 1536) + (size_t)(32 * nb) * 1536;
            if (q == 0) tr_item<false>(src, 256, base + 64 * kb, 1536, scr, C.lane);
            else if (q == 1) { if (kb < 8) tr_item<false>(src, 256, base + 1024 + 64 * kb, 1536, scr, C.lane); else tr_item<false>(src, 256, base + (size_t)256 * 1536 + 64 * (kb - 8), 1536, scr, C.lane); }
            else tr_item<true>(src, 256, base + (size_t)256 * 1536 + 512 + 64 * kb, 1536, scr, C.lane);
            continue; } r -= 6 * I_R;
        {
            constexpr int PER = 2 * I_SG + I_SD; const int l = r / PER; int s = r % PER;
            if (s < 2 * I_SG) { const int up = s >= I_SG; s -= up * I_SG; const int kb = s >> 2, nb = s & 3, n0 = 64 * nb;
                const float* src = (up ? W.ws_up : W.ws_gate) + ((size_t)l * 1024 + 128 * kb) * 256 + n0;
                tr_item_f8(src, 256, W.WSGU + (size_t)l * (512 * 1024) + (size_t)((n0 >> 7) * 256 + up * 128 + (n0 & 127)) * 1024 + 128 * kb, 1024, (LAS unsigned char*)scr, C.lane); }
            else { s -= 2 * I_SG; const int kb = s >> 4, nb = s & 15;
                tr_item_f8(W.ws_down + ((size_t)l * 256 + 128 * kb) * 1024 + 64 * nb, 1024, W.WSDN + (size_t)l * (1024 * 256) + (size_t)(64 * nb) * 256 + 128 * kb, 256, (LAS unsigned char*)scr, C.lane); }
        }
    }
}
__device__ __forceinline__ void to_f8_rows(const Ctx& C, const float* x, unsigned char* xb8) {
    const size_t n16 = (size_t)T * D / 16;
    for (size_t i = (size_t)C.vcu * NTHR + C.tid; i < n16; i += (size_t)C.G * NTHR) {
        const f32x4 a = *(const GAS f32x4*)(x + 16 * i) * XQ_SCALE, b = *(const GAS f32x4*)(x + 16 * i + 4) * XQ_SCALE, c = *(const GAS f32x4*)(x + 16 * i + 8) * XQ_SCALE, d = *(const GAS f32x4*)(x + 16 * i + 12) * XQ_SCALE;
        v4u o; o.x = pk4_f8(a.x, a.y, a.z, a.w); o.y = pk4_f8(b.x, b.y, b.z, b.w); o.z = pk4_f8(c.x, c.y, c.z, c.w); o.w = pk4_f8(d.x, d.y, d.z, d.w);
        *(GAS v4u*)(xb8 + 16 * i) = o;
    }
}

template <bool COL0> struct EpiF32 {
    static constexpr bool PERM = false, AFTER_DRAIN = false;
    float* out; const float* base; int ldc; float alpha;
    __device__ __forceinline__ void operator()(const pg8::f32x4 (&acc)[2][2][4][2], const pg8::Unit& u, int wr, int wc, int fr, int fq) const {
        const int row0 = u.pm * 256 + wr * 64 + fr, col0 = (COL0 ? 0 : u.pn * 256) + wc * 32 + 4 * fq;
#pragma unroll
        for (int ai = 0; ai < 2; ++ai)
#pragma unroll
            for (int m = 0; m < 4; ++m) { const size_t off = (size_t)(row0 + ai * 128 + m * 16) * ldc + col0;
#pragma unroll
                for (int bj = 0; bj < 2; ++bj)
#pragma unroll
                    for (int n = 0; n < 2; ++n) { f32x4 v = acc[ai][bj][m][n];
                        if (base) { const f32x4 b = *(const GAS f32x4*)(base + off + bj * 128 + n * 16); v = v + b * alpha; }
                        *(GAS f32x4*)(out + off + bj * 128 + n * 16) = v; } }
    }
};
struct EpiQKV {
    static constexpr bool PERM = true, AFTER_DRAIN = false;
    bf16* Qb; size_t split_stride; float scale0; unsigned* norms;
    float* ksum;
    __device__ __forceinline__ void operator()(const pg8::f32x4 (&acc)[2][2][4][2], const pg8::Unit& u, int wr, int wc, int fr, int fq) const {
        asm volatile("" : "+v"(fr), "+v"(fq));
        const int t = u.pn >> 2, colt = (u.pn & 3) * 256;
        constexpr float IS = 1.f / (XQ_SCALE * WQ_SCALE);
        bf16* base = Qb + (size_t)t * split_stride; const float sc = (t == 0 ? scale0 : 1.f) * IS;
        const int row0 = u.pm * 256 + wr * 64 + fr, col0 = colt + wc * 32 + 8 * fq;
        float nmax[2] = {0.f, 0.f};
#pragma unroll
        for (int ai = 0; ai < 2; ++ai)
#pragma unroll
            for (int m = 0; m < 4; ++m) { bf16* rowp = base + (size_t)(row0 + ai * 128 + m * 16) * D + col0;
#pragma unroll
                for (int bj = 0; bj < 2; ++bj) { const f32x4 v0 = acc[ai][bj][m][0] * sc, v1 = acc[ai][bj][m][1] * sc;
                    v4u w; w.x = cvtpk(v0[0], v0[1]); w.y = cvtpk(v0[2], v0[3]); w.z = cvtpk(v1[0], v1[1]); w.w = cvtpk(v1[2], v1[3]);
                    *(GAS v4u*)(rowp + bj * 128) = w;
                    if (t < 2) { float ss = (v0[0] * v0[0] + v0[1] * v0[1]) + (v0[2] * v0[2] + v0[3] * v0[3]) + (v1[0] * v1[0] + v1[1] * v1[1]) + (v1[2] * v1[2] + v1[3] * v1[3]);
                        ss += __shfl_xor(ss, 16); ss += __shfl_xor(ss, 32); nmax[bj] = fmaxf(nmax[bj], ss); } } }
        if (t == 1 && ksum) {
#pragma unroll
            for (int bj = 0; bj < 2; ++bj)
#pragma unroll
                for (int n = 0; n < 2; ++n) { f32x4 cs = (f32x4){0.f, 0.f, 0.f, 0.f};
#pragma unroll
                    for (int ai = 0; ai < 2; ++ai)
#pragma unroll
                        for (int m = 0; m < 4; ++m) cs = cs + acc[ai][bj][m][n];
#pragma unroll
                    for (int i = 0; i < 4; ++i) { float v = cs[i];
#pragma unroll
                        for (int o = 1; o < 16; o <<= 1) v += __shfl_xor(v, o);
                        if (fr == 0) (void)__hip_atomic_fetch_add(ksum + (size_t)u.pm * D + colt + bj * 128 + wc * 32 + 8 * fq + 4 * n + i, v * IS, __ATOMIC_RELAXED, __HIP_MEMORY_SCOPE_AGENT); } }
        }
        if (t < 2) {
#pragma unroll
            for (int bj = 0; bj < 2; ++bj) { float v = nmax[bj];
#pragma unroll
                for (int o = 1; o < 16; o <<= 1) v = fmaxf(v, __shfl_xor(v, o));
                const int head = (u.pn & 3) * 4 + 2 * bj + (wc >> 1), b = u.pm >> 5;
                if (fr == 0 && fq == 0) (void)__hip_atomic_fetch_max(norms + ((b * 16 + head) * 2 + t) * 2 + (wc & 1), __float_as_uint(v * 1.01f), __ATOMIC_RELAXED, __HIP_MEMORY_SCOPE_AGENT); }
        }
    }
};
template <bool F8> struct EpiSwiGLU {
    static constexpr bool PERM = true, AFTER_DRAIN = false;
    void* actp; const float* rowscale;
    __device__ __forceinline__ void operator()(const pg8::f32x4 (&acc)[2][2][4][2], const pg8::Unit& u, int wr, int wc, int fr, int fq) const {
        asm volatile("" : "+v"(fr), "+v"(fq));
        const int row0 = u.pm * 256 + wr * 64 + fr, col0 = (u.pn & 1) * 128 + wc * 32 + 8 * fq;
        const int ln = fr + 16 * fq, src4 = ((ln >> 2) + 16 * (ln & 3)) << 2, srow0 = u.pm * 256 + wr * 64 + (ln >> 2), scol0 = (u.pn & 1) * 128 + wc * 32 + 8 * (ln & 3);
        constexpr float IS = F8 ? 1.f / (XQ_SCALE * WQ_SCALE) : 1.f;
#pragma unroll
        for (int ai = 0; ai < 2; ++ai) if (ai == 0 || !u.hf)
#pragma unroll
            for (int m = 0; m < 4; ++m) { const int row = row0 + ai * 128 + m * 16; const float rs = rowscale ? rowscale[row] : (F8 ? GS_FOLD : 1.f);
                float o[8];
#pragma unroll
                for (int n = 0; n < 2; ++n)
#pragma unroll
                    for (int i = 0; i < 4; ++i) { const float g = acc[ai][0][m][n][i] * IS, up = acc[ai][1][m][n][i];
                        const float sg = g * __builtin_amdgcn_rcpf(1.f + __builtin_amdgcn_exp2f(-g * LOG2E)); o[4 * n + i] = sg * up * rs; }
                if constexpr (F8) { u32x2 w; w.x = pk4_f8(o[0], o[1], o[2], o[3]); w.y = pk4_f8(o[4], o[5], o[6], o[7]);
                    w.x = (unsigned)__builtin_amdgcn_ds_bpermute(src4, (int)w.x); w.y = (unsigned)__builtin_amdgcn_ds_bpermute(src4, (int)w.y);
                    *(GAS u32x2*)((unsigned char*)actp + (size_t)(srow0 + ai * 128 + m * 16) * 256 + scol0) = w; }
                else { v4u w; w.x = cvtpk(o[0], o[1]); w.y = cvtpk(o[2], o[3]); w.z = cvtpk(o[4], o[5]); w.w = cvtpk(o[6], o[7]);
                    *(GAS v4u*)((bf16*)actp + (size_t)row * 256 + col0) = w; } }
    }
};
constexpr float SO_SCALE = 64.f, SO_INV = 1.f / 64.f;
template <bool F8> struct EpiDown {
    static constexpr bool PERM = true, AFTER_DRAIN = false;
    static constexpr float sc = F8 ? SO_SCALE / (AQ_SCALE * WQ_SCALE) : SO_SCALE;
    unsigned char* out;
    __device__ __forceinline__ void operator()(const pg8::f32x4 (&acc)[2][2][4][2], const pg8::Unit& u, int wr, int wc, int fr, int fq) const {
        const int ln = fr + 16 * fq, src4 = ((ln >> 2) + 16 * (ln & 3)) << 2, fr2 = ln >> 2, fq2 = ln & 3;
        const int row0 = u.pm * 256 + wr * 64 + fr2, col0 = (u.pn & 3) * 256 + wc * 32 + 8 * fq2;
#pragma unroll
        for (int ai = 0; ai < 2; ++ai) if (ai == 0 || !u.hf)
#pragma unroll
            for (int m = 0; m < 4; ++m) { unsigned char* rowp = out + (size_t)(row0 + ai * 128 + m * 16) * 1024 + col0;
#pragma unroll
                for (int bj = 0; bj < 2; ++bj) { const f32x4 v0 = acc[ai][bj][m][0] * sc, v1 = acc[ai][bj][m][1] * sc;
                    u32x2 w; w.x = 0u; w.y = 0u;
                    w.x = __builtin_amdgcn_cvt_pk_fp8_f32(v0[0], v0[1], w.x, false); w.x = __builtin_amdgcn_cvt_pk_fp8_f32(v0[2], v0[3], w.x, true);
                    w.y = __builtin_amdgcn_cvt_pk_fp8_f32(v1[0], v1[1], w.y, false); w.y = __builtin_amdgcn_cvt_pk_fp8_f32(v1[2], v1[3], w.y, true);
                    w.x = (unsigned)__builtin_amdgcn_ds_bpermute(src4, (int)w.x); w.y = (unsigned)__builtin_amdgcn_ds_bpermute(src4, (int)w.y);
                    *(GAS u32x2*)(rowp + bj * 128) = w; } }
    }
};
template <int NN> struct PlainOrder {
    int vcu, G, nunits;
    __device__ __forceinline__ bool next(int i, pg8::Unit& u) const { const int idx = vcu + i * G; if (idx >= nunits) return false;
        u.pm = __builtin_amdgcn_readfirstlane(idx / NN); u.pn = __builtin_amdgcn_readfirstlane(idx % NN);
        int z = 0; asm volatile("" : "+s"(z)); u.hf = z;
        return true; }
    __device__ __forceinline__ void a_ready(const pg8::Unit&) const {}
    __device__ __forceinline__ void done(const pg8::Unit&) const {}
};
struct RouterOrder {
    int vcu, G;
    __device__ __forceinline__ bool next(int i, pg8::Unit& u) const { const int idx = vcu + i * G; if (idx >= 256) return false; u.pm = idx; u.pn = idx >> 7; return true; }
    __device__ __forceinline__ void a_ready(const pg8::Unit&) const {}
    __device__ __forceinline__ void done(const pg8::Unit&) const {}
};
template <int SH> struct ExpertOrder {
    int vcu, G; const LAS int* tpre;
    __device__ __forceinline__ bool next(int i, pg8::Unit& u) const {
        const int idx = vcu + i * G, ti = idx >> SH; if (ti >= tpre[NE]) return false;
        int lo = 0, hi = NE;
#pragma unroll
        for (int s = 0; s < 8; ++s) { const int mid = (lo + hi) >> 1; if (tpre[mid] <= ti) lo = mid; else hi = mid; }
        u.pm = __builtin_amdgcn_readfirstlane(ti); u.pn = __builtin_amdgcn_readfirstlane((lo << SH) + (idx & ((1 << SH) - 1)));
        u.hf = __builtin_amdgcn_readfirstlane((tpre[272 + lo] - 256 * (ti - tpre[lo])) <= 128 ? 1 : 0); return true;
    }
    __device__ __forceinline__ void a_ready(const pg8::Unit&) const {}
    __device__ __forceinline__ void done(const pg8::Unit&) const {}
};
__device__ __forceinline__ void build_tpre(const Ctx& C, const unsigned* ecnt) {
    LAS int* tpre = (LAS int*)(C.lds + TPRE_OFF);
    __syncthreads();
    int v = 0;
    if (C.tid < NE) { const int c = (int)__hip_atomic_load(ecnt + C.tid, __ATOMIC_RELAXED, __HIP_MEMORY_SCOPE_AGENT); v = (c + 255) >> 8; tpre[272 + C.tid] = c; }
    int inc = v;
#pragma unroll
    for (int o = 1; o < 64; o <<= 1) { const int t = __shfl_up(inc, o); if (C.lane >= o) inc += t; }
    if (C.tid < NE && C.lane == 63) tpre[260 + C.wave] = inc;
    __syncthreads();
    if (C.tid < NE) { int base = 0; for (int w = 0; w < C.wave; ++w) base += tpre[260 + w]; tpre[C.tid + 1] = base + inc; if (C.tid == 0) tpre[0] = 0; }
    __syncthreads();
}
struct AttnAcc { float m; f32x16 o0, o1, la; };
#define MFMA32(a, b, c) __builtin_amdgcn_mfma_f32_32x32x16_bf16((a), (b), (c), 0, 0, 0)
constexpr float NEG_INF = -__builtin_inff();

__device__ __forceinline__ void glds16(const void* gsrc, unsigned lds_dst) { unsigned keep;
    asm volatile("s_mov_b32 %0, m0\n\ts_mov_b32 m0, %2\n\ts_nop 0\n\tglobal_load_lds_dwordx4 %1, off\n\ts_mov_b32 m0, %0" : "=&s"(keep) : "v"(gsrc), "s"(lds_dst) : "memory"); }
__device__ __forceinline__ void glds4(const void* gsrc, unsigned lds_dst) { unsigned keep;
    asm volatile("s_mov_b32 %0, m0\n\ts_mov_b32 m0, %2\n\ts_nop 0\n\tglobal_load_lds_dword %1, off\n\ts_mov_b32 m0, %0" : "=&s"(keep) : "v"(gsrc), "s"(lds_dst) : "memory"); }
__device__ __forceinline__ unsigned lds_addr(const LAS unsigned char* p) { return (unsigned)__builtin_amdgcn_readfirstlane((int)(unsigned)(uintptr_t)p); }
__device__ __forceinline__ void dma_tile(const bf16* Kg, const bf16* Vg, LAS unsigned char* Ks, LAS unsigned char* Vs, int wave, int lane) {
    { const int kr = 8 * wave + (lane >> 3), kc = (lane & 7) ^ ((kr >> 1) & 7); glds16(Kg + (size_t)kr * D + kc * 8, lds_addr(Ks + wave * 1024)); }
    glds16(Vg + (size_t)(16 * (wave & 3) + (lane >> 2)) * D + (wave >> 2) * 32 + (lane & 3) * 8, lds_addr(Vs + wave * 1024));
}
__device__ __forceinline__ void load_q(bf16x8 (&qr)[4], const bf16* Qrow, int hi) {
#pragma unroll
    for (int d0 = 0; d0 < 4; ++d0) qr[d0] = *(const GAS bf16x8*)(Qrow + d0 * 16 + hi * 8);
}
template <class Bias> __device__ __forceinline__ void qk_tile(f32x16& p0, f32x16& p1, const bf16x8 (&qr)[4], const LAS unsigned char* Ks, int r32, int hi, const Bias& B) {
    __builtin_amdgcn_sched_barrier(0);
    B.init(p0, p1, hi);
    const LAS unsigned char* kb = Ks + r32 * 128; const int ko = (hi ^ ((r32 >> 1) & 7)) << 4;
    bf16x8 kf[8];
#pragma unroll
    for (int d0 = 0; d0 < 4; ++d0) { kf[2 * d0] = *(const LAS bf16x8*)(kb + (ko ^ (d0 << 5))); kf[2 * d0 + 1] = *(const LAS bf16x8*)(kb + (ko ^ (d0 << 5)) + 4096); }
    __builtin_amdgcn_sched_barrier(0);
#pragma unroll
    for (int d0 = 0; d0 < 4; ++d0) { p0 = MFMA32(kf[2 * d0], qr[d0], p0); p1 = MFMA32(kf[2 * d0 + 1], qr[d0], p1); }
    B.mask(p0, p1, hi);
    __builtin_amdgcn_sched_barrier(0);
}
constexpr float ATT_THR = 8.f;
__device__ __forceinline__ float half_max(float m) { auto rr = __builtin_amdgcn_permlane32_swap(__float_as_uint(m), __float_as_uint(m), false, false); return fmaxf(__uint_as_float(rr[0]), __uint_as_float(rr[1])); }
__device__ __forceinline__ void attn_rescale(AttnAcc& A, float rm) {
    const bool need = rm > A.m + ATT_THR;
    if (__any(need)) {
        const float mn = need ? rm : A.m, f = __builtin_amdgcn_exp2f(A.m - mn);
        A.la[0] *= f;
#pragma unroll
        for (int r = 0; r < 16; ++r) { A.o0[r] *= f; A.o1[r] *= f; }
        A.m = mn;
    }
}
__device__ __forceinline__ void softmax_pv(AttnAcc& A, f32x16& p0, f32x16& p1, const LAS unsigned char* Vs, int hi, int lane) {
    __builtin_amdgcn_sched_barrier(0);
    const LAS unsigned char* vb = Vs + ((lane >> 4) & 1) * 32 + (lane & 3) * 8 + (4 * hi + ((lane & 15) >> 2)) * 64;
    s16x4 vt[16];
#pragma unroll
    for (int ks = 0; ks < 4; ++ks) { vt[4 * ks] = vtr(vb + ks * 1024); vt[4 * ks + 1] = vtr(vb + ks * 1024 + 512); vt[4 * ks + 2] = vtr(vb + (4 + ks) * 1024); vt[4 * ks + 3] = vtr(vb + (4 + ks) * 1024 + 512); }
    __builtin_amdgcn_sched_barrier(0);
    float rm = fmaxf(p0[0], p1[0]);
#pragma unroll
    for (int r = 1; r < 16; ++r) rm = fmaxf(fmaxf(rm, p0[r]), p1[r]);
    rm = half_max(rm);
    attn_rescale(A, rm);
    const float mn = A.m;
#pragma unroll
    for (int r = 0; r < 16; ++r) { p0[r] = __builtin_amdgcn_exp2f(p0[r] - mn); p1[r] = __builtin_amdgcn_exp2f(p1[r] - mn); }
    v4u pw[4];
#pragma unroll
    for (int s = 0; s < 2; ++s) {
        pw[s].x = cvtpk(p0[8 * s + 0], p0[8 * s + 1]); pw[s].y = cvtpk(p0[8 * s + 2], p0[8 * s + 3]); pw[s].z = cvtpk(p0[8 * s + 4], p0[8 * s + 5]); pw[s].w = cvtpk(p0[8 * s + 6], p0[8 * s + 7]);
        pw[2 + s].x = cvtpk(p1[8 * s + 0], p1[8 * s + 1]); pw[2 + s].y = cvtpk(p1[8 * s + 2], p1[8 * s + 3]); pw[2 + s].z = cvtpk(p1[8 * s + 4], p1[8 * s + 5]); pw[2 + s].w = cvtpk(p1[8 * s + 6], p1[8 * s + 7]);
    }
    const bf16x8 ones = {(short)0x3F80, (short)0x3F80, (short)0x3F80, (short)0x3F80, (short)0x3F80, (short)0x3F80, (short)0x3F80, (short)0x3F80};
#pragma unroll
    for (int ks = 0; ks < 4; ++ks) {
        const bf16x8 pa = __builtin_bit_cast(bf16x8, pw[ks]);
        const s16x4 a0 = vt[4 * ks], a1 = vt[4 * ks + 1], b0 = vt[4 * ks + 2], b1 = vt[4 * ks + 3];
        const bf16x8 v0 = {a0[0], a0[1], a0[2], a0[3], a1[0], a1[1], a1[2], a1[3]}, v1 = {b0[0], b0[1], b0[2], b0[3], b1[0], b1[1], b1[2], b1[3]};
        A.o0 = MFMA32(v0, pa, A.o0); A.o1 = MFMA32(v1, pa, A.o1); A.la = MFMA32(ones, pa, A.la);
    }
    __builtin_amdgcn_sched_barrier(0);
}
__device__ __forceinline__ void acc_init(AttnAcc& A) {
    A.m = NEG_INF;
    float z = 0.f; asm volatile("" : "+v"(z));
#pragma unroll
    for (int r = 0; r < 16; ++r) { A.o0[r] = z; A.o1[r] = z; A.la[r] = z; }
}
#define ATT_SB() __builtin_amdgcn_sched_barrier(0)
template <class Bias> __device__ __forceinline__ void attn_step(AttnAcc& A, f32x16& pc0, f32x16& pc1, f32x16& pn0, f32x16& pn1, const bf16x8 (&qr)[4],
                                                               const LAS unsigned char* Kn, const LAS unsigned char* Vc, int r32, int hi, int lane, const Bias& Bn, const bool doNext) {
    ATT_SB();
    if (doNext) Bn.init(pn0, pn1, hi);
    const LAS unsigned char* kb = Kn + r32 * 128; const int ko = (hi ^ ((r32 >> 1) & 7)) << 4;
    bf16x8 ka[4], kc[4];
#pragma unroll
    for (int d0 = 0; d0 < 2; ++d0) { ka[2 * d0] = *(const LAS bf16x8*)(kb + (ko ^ (d0 << 5))); ka[2 * d0 + 1] = *(const LAS bf16x8*)(kb + (ko ^ (d0 << 5)) + 4096); }
    ATT_SB();
    float ra = fmaxf(fmaxf(pc0[0], pc0[1]), fmaxf(pc0[2], pc0[3]));
    if (doNext) pn0 = MFMA32(ka[0], qr[0], pn0);
    ra = fmaxf(fmaxf(ra, pc1[0]), pc1[1]); ra = fmaxf(fmaxf(ra, pc1[2]), pc1[3]); ATT_SB();
    if (doNext) pn1 = MFMA32(ka[1], qr[0], pn1);
#pragma unroll
    for (int d0 = 2; d0 < 4; ++d0) { kc[2 * d0 - 4] = *(const LAS bf16x8*)(kb + (ko ^ (d0 << 5))); kc[2 * d0 - 3] = *(const LAS bf16x8*)(kb + (ko ^ (d0 << 5)) + 4096); }
    ra = fmaxf(fmaxf(ra, pc0[4]), pc0[5]); ra = fmaxf(fmaxf(ra, pc0[6]), pc0[7]); ra = fmaxf(fmaxf(ra, pc1[4]), pc1[5]); ra = fmaxf(fmaxf(ra, pc1[6]), pc1[7]); ATT_SB();
    if (doNext) pn0 = MFMA32(ka[2], qr[1], pn0);
    ra = fmaxf(fmaxf(ra, pc0[8]), pc0[9]); ra = fmaxf(fmaxf(ra, pc0[10]), pc0[11]); ra = fmaxf(fmaxf(ra, pc1[8]), pc1[9]); ra = fmaxf(fmaxf(ra, pc1[10]), pc1[11]); ATT_SB();
    if (doNext) pn1 = MFMA32(ka[3], qr[1], pn1);
    ra = fmaxf(fmaxf(ra, pc0[12]), pc0[13]); ra = fmaxf(fmaxf(ra, pc0[14]), pc0[15]); ra = fmaxf(fmaxf(ra, pc1[12]), pc1[13]); ra = fmaxf(fmaxf(ra, pc1[14]), pc1[15]);
    ra = half_max(ra); ATT_SB();
    attn_rescale(A, ra);
    const float mn = A.m;
    ATT_SB();
    const LAS unsigned char* vb = Vc + ((lane >> 4) & 1) * 32 + (lane & 3) * 8 + (4 * hi + ((lane & 15) >> 2)) * 64;
    s16x4 vt[16];
    v4u pw[4];
#define ATT_VRD(ks) do { vt[4 * (ks)] = vtr(vb + (ks) * 1024); vt[4 * (ks) + 1] = vtr(vb + (ks) * 1024 + 512); vt[4 * (ks) + 2] = vtr(vb + (4 + (ks)) * 1024); vt[4 * (ks) + 3] = vtr(vb + (4 + (ks)) * 1024 + 512); } while (0)
#define ATT_EXP4(P, c) do { _Pragma("unroll") for (int i_ = 0; i_ < 4; ++i_) P[4 * (c) + i_] = __builtin_amdgcn_exp2f(P[4 * (c) + i_] - mn); } while (0)
    ATT_VRD(0); ATT_VRD(1); ATT_SB();
    if (doNext) pn0 = MFMA32(kc[0], qr[2], pn0); ATT_EXP4(pc0, 0); ATT_EXP4(pc0, 1);
    pw[0].x = cvtpk(pc0[0], pc0[1]); pw[0].y = cvtpk(pc0[2], pc0[3]); pw[0].z = cvtpk(pc0[4], pc0[5]); pw[0].w = cvtpk(pc0[6], pc0[7]); ATT_SB();
    if (doNext) pn1 = MFMA32(kc[1], qr[2], pn1); ATT_EXP4(pc0, 2); ATT_EXP4(pc0, 3);
    pw[1].x = cvtpk(pc0[8], pc0[9]); pw[1].y = cvtpk(pc0[10], pc0[11]); pw[1].z = cvtpk(pc0[12], pc0[13]); pw[1].w = cvtpk(pc0[14], pc0[15]); ATT_SB();
    ATT_VRD(2); ATT_VRD(3); ATT_SB();
    if (doNext) pn0 = MFMA32(kc[2], qr[3], pn0); ATT_EXP4(pc1, 0); ATT_EXP4(pc1, 1);
    pw[2].x = cvtpk(pc1[0], pc1[1]); pw[2].y = cvtpk(pc1[2], pc1[3]); pw[2].z = cvtpk(pc1[4], pc1[5]); pw[2].w = cvtpk(pc1[6], pc1[7]); ATT_SB();
    if (doNext) pn1 = MFMA32(kc[3], qr[3], pn1); ATT_EXP4(pc1, 2); ATT_EXP4(pc1, 3);
    pw[3].x = cvtpk(pc1[8], pc1[9]); pw[3].y = cvtpk(pc1[10], pc1[11]); pw[3].z = cvtpk(pc1[12], pc1[13]); pw[3].w = cvtpk(pc1[14], pc1[15]); ATT_SB();
#undef ATT_EXP4
#undef ATT_VRD
    if (doNext) Bn.mask(pn0, pn1, hi);
    ATT_SB();
    const bf16x8 ones = {(short)0x3F80, (short)0x3F80, (short)0x3F80, (short)0x3F80, (short)0x3F80, (short)0x3F80, (short)0x3F80, (short)0x3F80};
#pragma unroll
    for (int ks = 0; ks < 4; ++ks) {
        const bf16x8 pa = __builtin_bit_cast(bf16x8, pw[ks]);
        const s16x4 a0 = vt[4 * ks], a1 = vt[4 * ks + 1], b0 = vt[4 * ks + 2], b1 = vt[4 * ks + 3];
        const bf16x8 v0 = {a0[0], a0[1], a0[2], a0[3], a1[0], a1[1], a1[2], a1[3]}, v1 = {b0[0], b0[1], b0[2], b0[3], b1[0], b1[1], b1[2], b1[3]};
        A.o0 = MFMA32(v0, pa, A.o0); A.o1 = MFMA32(v1, pa, A.o1); A.la = MFMA32(ones, pa, A.la);
    }
    ATT_SB();
}

template <class Bias> __device__ __forceinline__ void attn_step3(AttnAcc& A, f32x16& pc0, f32x16& pc1, f32x16& pn0, f32x16& pn1, const v4u (&pwp)[4], v4u (&pw)[4], const bf16x8 (&qr)[4],
        const LAS unsigned char* Kn, const LAS unsigned char* Vp, int r32, int hi, int lane, const Bias& Bn, const bool doCur) {
    const bf16x8 ones = {(short)0x3F80, (short)0x3F80, (short)0x3F80, (short)0x3F80, (short)0x3F80, (short)0x3F80, (short)0x3F80, (short)0x3F80};
    const LAS unsigned char* kb = Kn + r32 * 128; const int ko = (hi ^ ((r32 >> 1) & 7)) << 4;
    const LAS unsigned char* vb = Vp + ((lane >> 4) & 1) * 32 + (lane & 3) * 8 + (4 * hi + ((lane & 15) >> 2)) * 64;
    bf16x8 ka[2], kc[2]; s16x4 va[4], vc[4], vd[4], ve[4];
#define ATT_VRD(dst, ks) do { dst[0] = vtr(vb + (ks) * 1024); dst[1] = vtr(vb + (ks) * 1024 + 512); dst[2] = vtr(vb + (4 + (ks)) * 1024); dst[3] = vtr(vb + (4 + (ks)) * 1024 + 512); } while (0)
#define ATT_V0(v) ((bf16x8){v[0][0], v[0][1], v[0][2], v[0][3], v[1][0], v[1][1], v[1][2], v[1][3]})
#define ATT_V1(v) ((bf16x8){v[2][0], v[2][1], v[2][2], v[2][3], v[3][0], v[3][1], v[3][2], v[3][3]})
#define ATT_PA(k) __builtin_bit_cast(bf16x8, pwp[k])
#define ATT_PIN(x) asm volatile("" : "+v"(x))
    ATT_SB();
    Bn.init(pn0, pn1, hi);
    ka[0] = *(const LAS bf16x8*)(kb + ko); ka[1] = *(const LAS bf16x8*)(kb + ko + 4096); kc[0] = *(const LAS bf16x8*)(kb + (ko ^ 32)); kc[1] = *(const LAS bf16x8*)(kb + (ko ^ 32) + 4096);
    ATT_VRD(va, 0);
    ATT_SB();
    float ra = fmaxf(fmaxf(pc0[0], pc0[1]), fmaxf(pc0[2], pc0[3]));
    pn0 = MFMA32(ka[0], qr[0], pn0);
    A.o0 = MFMA32(ATT_V0(va), ATT_PA(0), A.o0);
    ra = fmaxf(fmaxf(ra, pc1[0]), pc1[1]); ra = fmaxf(fmaxf(ra, pc1[2]), pc1[3]); ra = fmaxf(fmaxf(ra, pc0[4]), pc0[5]); ra = fmaxf(fmaxf(ra, pc0[6]), pc0[7]); ATT_PIN(ra);
    ATT_VRD(vc, 1);
    ATT_SB();
    pn1 = MFMA32(ka[1], qr[0], pn1);
    A.o1 = MFMA32(ATT_V1(va), ATT_PA(0), A.o1);
    ra = fmaxf(fmaxf(ra, pc1[4]), pc1[5]); ra = fmaxf(fmaxf(ra, pc1[6]), pc1[7]); ra = fmaxf(fmaxf(ra, pc0[8]), pc0[9]); ra = fmaxf(fmaxf(ra, pc0[10]), pc0[11]); ATT_PIN(ra);
    ka[0] = *(const LAS bf16x8*)(kb + (ko ^ 64)); ka[1] = *(const LAS bf16x8*)(kb + (ko ^ 64) + 4096);
    ATT_SB();
    pn0 = MFMA32(kc[0], qr[1], pn0);
    A.la = MFMA32(ones, ATT_PA(0), A.la); A.o0 = MFMA32(ATT_V0(vc), ATT_PA(1), A.o0);
    ATT_VRD(vd, 2);
    ra = fmaxf(fmaxf(ra, pc1[8]), pc1[9]); ra = fmaxf(fmaxf(ra, pc1[10]), pc1[11]); ra = fmaxf(fmaxf(ra, pc0[12]), pc0[13]); ra = fmaxf(fmaxf(ra, pc0[14]), pc0[15]); ATT_PIN(ra); ATT_SB();
    pn1 = MFMA32(kc[1], qr[1], pn1);
    A.o1 = MFMA32(ATT_V1(vc), ATT_PA(1), A.o1); A.la = MFMA32(ones, ATT_PA(1), A.la);
    ATT_VRD(ve, 3);
    kc[0] = *(const LAS bf16x8*)(kb + (ko ^ 96)); kc[1] = *(const LAS bf16x8*)(kb + (ko ^ 96) + 4096);
    ra = fmaxf(fmaxf(ra, pc1[12]), pc1[13]); ra = fmaxf(fmaxf(ra, pc1[14]), pc1[15]); ra = half_max(ra);
    const bool need = doCur && (ra > A.m + ATT_THR);
    float mn = need ? ra : A.m; const float fr = __builtin_amdgcn_exp2f(A.m - mn); ATT_PIN(mn);
    ATT_SB();
#define ATT_EXP4(P, c) do { _Pragma("unroll") for (int i_ = 0; i_ < 4; ++i_) P[4 * (c) + i_] = __builtin_amdgcn_exp2f(P[4 * (c) + i_] - mn); } while (0)
    pn0 = MFMA32(ka[0], qr[2], pn0);
    A.o0 = MFMA32(ATT_V0(vd), ATT_PA(2), A.o0);
    { ATT_EXP4(pc0, 0); ATT_EXP4(pc0, 1); pw[0].x = cvtpk(pc0[0], pc0[1]); pw[0].y = cvtpk(pc0[2], pc0[3]); pw[0].z = cvtpk(pc0[4], pc0[5]); pw[0].w = cvtpk(pc0[6], pc0[7]); ATT_PIN(pw[0]); }
    ATT_SB();
    pn1 = MFMA32(ka[1], qr[2], pn1);
    A.o1 = MFMA32(ATT_V1(vd), ATT_PA(2), A.o1);
    { ATT_EXP4(pc0, 2); ATT_EXP4(pc0, 3); pw[1].x = cvtpk(pc0[8], pc0[9]); pw[1].y = cvtpk(pc0[10], pc0[11]); pw[1].z = cvtpk(pc0[12], pc0[13]); pw[1].w = cvtpk(pc0[14], pc0[15]); ATT_PIN(pw[1]); }
    ATT_SB();
    pn0 = MFMA32(kc[0], qr[3], pn0);
    A.la = MFMA32(ones, ATT_PA(2), A.la); A.o0 = MFMA32(ATT_V0(ve), ATT_PA(3), A.o0);
    { ATT_EXP4(pc1, 0); ATT_EXP4(pc1, 1); pw[2].x = cvtpk(pc1[0], pc1[1]); pw[2].y = cvtpk(pc1[2], pc1[3]); pw[2].z = cvtpk(pc1[4], pc1[5]); pw[2].w = cvtpk(pc1[6], pc1[7]); ATT_PIN(pw[2]); }
    ATT_SB();
    pn1 = MFMA32(kc[1], qr[3], pn1);
    A.o1 = MFMA32(ATT_V1(ve), ATT_PA(3), A.o1); A.la = MFMA32(ones, ATT_PA(3), A.la);
    { ATT_EXP4(pc1, 2); ATT_EXP4(pc1, 3); pw[3].x = cvtpk(pc1[8], pc1[9]); pw[3].y = cvtpk(pc1[10], pc1[11]); pw[3].z = cvtpk(pc1[12], pc1[13]); pw[3].w = cvtpk(pc1[14], pc1[15]); ATT_PIN(pw[3]); }
    ATT_SB();
#undef ATT_EXP4
#undef ATT_VRD
#undef ATT_V0
#undef ATT_V1
#undef ATT_PA
#undef ATT_PIN
    Bn.mask(pn0, pn1, hi);
    if (__any(need)) {
        A.la[0] *= fr;
#pragma unroll
        for (int r = 0; r < 16; ++r) { A.o0[r] *= fr; A.o1[r] *= fr; }
    }
    A.m = mn;
    ATT_SB();
}

__device__ __forceinline__ void swap32(unsigned x, unsigned y, unsigned& r0, unsigned& r1) { auto rr = __builtin_amdgcn_permlane32_swap(x, y, false, false); r0 = rr[0]; r1 = rr[1]; }
__device__ __forceinline__ void store_o(bf16* op, const AttnAcc& A, float inv, int hi) {
#pragma unroll
    for (int p = 0; p < 2; ++p) {
#pragma unroll
        for (int s = 0; s < 2; ++s) { const f32x16& o = s ? A.o1 : A.o0; const int g0 = 2 * p, g1 = 2 * p + 1;
            const unsigned xa = cvtpk(o[4 * g0] * inv, o[4 * g0 + 1] * inv), xb = cvtpk(o[4 * g0 + 2] * inv, o[4 * g0 + 3] * inv), ya = cvtpk(o[4 * g1] * inv, o[4 * g1 + 1] * inv), yb = cvtpk(o[4 * g1 + 2] * inv, o[4 * g1 + 3] * inv);
            unsigned w0, w1, w2, w3; swap32(xa, ya, w0, w2); swap32(xb, yb, w1, w3); v4u w; w.x = w0; w.y = w1; w.z = w2; w.w = w3;
            *(GAS v4u*)(op + 32 * s + 16 * p + 8 * hi) = w; } }
}

__device__ __forceinline__ void store_o8(unsigned char* op, const AttnAcc& A, float inv, int hi) {
    const float sc = inv * OQ_SCALE;
#pragma unroll
    for (int p = 0; p < 2; ++p) {
#pragma unroll
        for (int s = 0; s < 2; ++s) { const f32x16& o = s ? A.o1 : A.o0; const int g0 = 2 * p, g1 = 2 * p + 1;
            const unsigned x = pk4_f8(o[4 * g0] * sc, o[4 * g0 + 1] * sc, o[4 * g0 + 2] * sc, o[4 * g0 + 3] * sc), y = pk4_f8(o[4 * g1] * sc, o[4 * g1 + 1] * sc, o[4 * g1 + 2] * sc, o[4 * g1 + 3] * sc);
            unsigned w0, w1; swap32(x, y, w0, w1); u32x2 w; w.x = w0; w.y = w1;
            *(GAS u32x2*)(op + 32 * s + 16 * p + 8 * hi) = w; } }
}

__device__ __forceinline__ int rel_bucket(int n) {
    if (n < 16) return n;
    int b = 16;
    b += (n >= 19); b += (n >= 21); b += (n >= 24); b += (n >= 27); b += (n >= 31); b += (n >= 35); b += (n >= 40); b += (n >= 46);
    b += (n >= 52); b += (n >= 59); b += (n >= 67); b += (n >= 77); b += (n >= 87); b += (n >= 99); b += (n >= 113);
    return b;
}
__device__ __forceinline__ void build_relb(const Ctx& C, const float* rel_bias, LAS float* relb) {
    for (int i = C.tid; i < H * 128; i += NTHR) { const int h = i >> 7, n = i & 127; relb[i] = rel_bias[rel_bucket(n) * H + h] * LOG2E; }
}
struct MobaBias {
    const LAS float* relb; int qpos, kpos0; bool lookup, causal; float cbias;
    __device__ __forceinline__ void init(f32x16& p0, f32x16& p1, int hi) const {
        if (lookup) {
            int dbase = qpos - kpos0 - 4 * hi; asm volatile("" : "+v"(dbase));
#pragma unroll
            for (int r = 0; r < 16; ++r) { const int d0 = dbase - ((r & 3) + 8 * (r >> 2)), d1 = d0 - 32;
                const int i0 = d0 < 0 ? 0 : (d0 > 127 ? 127 : d0), i1 = d1 < 0 ? 0 : (d1 > 127 ? 127 : d1);
                p0[r] = relb[i0]; p1[r] = relb[i1];
                if ((r & 3) == 3) __builtin_amdgcn_sched_barrier(0); }
        } else {
#pragma unroll
            for (int r = 0; r < 16; ++r) { p0[r] = cbias; p1[r] = cbias; }
        }
    }
    __device__ __forceinline__ void mask(f32x16& p0, f32x16& p1, int hi) const {
        if (causal) {
            int d = qpos - kpos0 - 4 * hi; asm volatile("" : "+v"(d));
#pragma unroll
            for (int r = 0; r < 16; ++r) { const int c = (r & 3) + 8 * (r >> 2); if (c > d) p0[r] = NEG_INF; if (c + 32 > d) p1[r] = NEG_INF; }
        }
    }
};
struct FoxBias {
    const LAS float* cb; int qrel, krel0; bool causal;
    __device__ __forceinline__ void init(f32x16& p0, f32x16& p1, int hi) const {
#pragma unroll
        for (int g = 0; g < 4; ++g) { const f32x4 c0 = *(const LAS f32x4*)(cb + 8 * g + 4 * hi), c1 = *(const LAS f32x4*)(cb + 32 + 8 * g + 4 * hi);
#pragma unroll
            for (int i = 0; i < 4; ++i) { p0[4 * g + i] = c0[i]; p1[4 * g + i] = c1[i]; } }
    }
    __device__ __forceinline__ void mask(f32x16& p0, f32x16& p1, int hi) const {
        if (causal) {
            int d = qrel - krel0 - 4 * hi; asm volatile("" : "+v"(d));
#pragma unroll
            for (int r = 0; r < 16; ++r) { const int c = (r & 3) + 8 * (r >> 2); if (c > d) p0[r] = NEG_INF; if (c + 32 > d) p1[r] = NEG_INF; }
        }
    }
};

__device__ __forceinline__ int mlist_off(int j) { return 256 * (31 * j - (j * (j - 1)) / 2); }
#define INS3(s_, j_) do { const float s__ = (s_); const int j__ = (j_); \
    if (s__ > sv0 || (s__ == sv0 && j__ < sel0)) { sv2 = sv1; sel2 = sel1; sv1 = sv0; sel1 = sel0; sv0 = s__; sel0 = j__; } \
    else if (s__ > sv1 || (s__ == sv1 && j__ < sel1)) { sv2 = sv1; sel2 = sel1; sv1 = s__; sel1 = j__; } \
    else if (s__ > sv2 || (s__ == sv2 && j__ < sel2)) { sv2 = s__; sel2 = j__; } } while (0)
__device__ __forceinline__ void ph_select(const Ctx& C, const bf16* Q, const float* ksum, unsigned* mcnt, unsigned* mlist) {
    LAS float* km = (LAS float*)C.lds;
    LAS unsigned* lcnt = (LAS unsigned*)(C.lds + 8192);
    const int lane = C.lane, wave = C.wave, r32 = lane & 31, hi = lane >> 5;
    for (int u = C.vcu; u < BATCH * H * 31; u += C.G) {
        const int bh = u / 31, own = 1 + u % 31, b = bh >> 4, h = bh & 15;
        __syncthreads();
        for (int i = C.tid; i < 32 * 64; i += NTHR) km[i] = ksum[(size_t)(b * NBLK + (i >> 6)) * D + h * 64 + (i & 63)];
        if (C.tid < 64) lcnt[C.tid] = 0u;
        bf16x8 qr[4]; load_q(qr, Q + (size_t)(b * SEQ + own * 256 + wave * 32 + r32) * D + h * 64, hi);
        __syncthreads();
        f32x16 sc; { float z = 0.f; asm volatile("" : "+v"(z));
#pragma unroll
        for (int r = 0; r < 16; ++r) sc[r] = z; }
#pragma unroll
        for (int d0 = 0; d0 < 4; ++d0) {
            const f32x4 x0 = *(const LAS f32x4*)(km + r32 * 64 + 16 * d0 + 8 * hi), x1 = *(const LAS f32x4*)(km + r32 * 64 + 16 * d0 + 8 * hi + 4);
            v4u wh, wl; wh.x = cvtpk(x0.x, x0.y); wh.y = cvtpk(x0.z, x0.w); wh.z = cvtpk(x1.x, x1.y); wh.w = cvtpk(x1.z, x1.w);
            wl.x = cvtpk(x0.x - bflo(wh.x), x0.y - bfhi(wh.x)); wl.y = cvtpk(x0.z - bflo(wh.y), x0.w - bfhi(wh.y)); wl.z = cvtpk(x1.x - bflo(wh.z), x1.y - bfhi(wh.z)); wl.w = cvtpk(x1.z - bflo(wh.w), x1.w - bfhi(wh.w));
            sc = MFMA32(__builtin_bit_cast(bf16x8, wh), qr[d0], sc); sc = MFMA32(__builtin_bit_cast(bf16x8, wl), qr[d0], sc);
        }
        float sv0 = NEG_INF, sv1 = NEG_INF, sv2 = NEG_INF; int sel0 = 64, sel1 = 64, sel2 = 64;
#pragma unroll
        for (int r = 0; r < 16; ++r) { const int j = (r & 3) + 8 * (r >> 2) + 4 * hi; if (j < own) INS3(sc[r], j); }
        {
            const float pv0 = __shfl_xor(sv0, 32), pv1 = __shfl_xor(sv1, 32), pv2 = __shfl_xor(sv2, 32);
            const int p0 = __shfl_xor(sel0, 32), p1 = __shfl_xor(sel1, 32), p2 = __shfl_xor(sel2, 32);
            if (p0 < 64) INS3(pv0, p0);
            if (p1 < 64) INS3(pv1, p1);
            if (p2 < 64) INS3(pv2, p2); }
        const int nv = own < 3 ? own : 3; int rk0 = 0, rk1 = 0, rk2 = 0;
        if (hi == 0) {
            rk0 = (int)__hip_atomic_fetch_add(&lcnt[sel0], 1u, __ATOMIC_RELAXED, __HIP_MEMORY_SCOPE_WORKGROUP);
            if (nv > 1) rk1 = (int)__hip_atomic_fetch_add(&lcnt[sel1], 1u, __ATOMIC_RELAXED, __HIP_MEMORY_SCOPE_WORKGROUP);
            if (nv > 2) rk2 = (int)__hip_atomic_fetch_add(&lcnt[sel2], 1u, __ATOMIC_RELAXED, __HIP_MEMORY_SCOPE_WORKGROUP);
        }
        __syncthreads();
        if (C.tid < 32) { const unsigned c = lcnt[C.tid]; if (c) lcnt[32 + C.tid] = __hip_atomic_fetch_add(mcnt + bh * 32 + C.tid, c, __ATOMIC_RELAXED, __HIP_MEMORY_SCOPE_AGENT); }
        __syncthreads();
        if (hi == 0) {
            unsigned* lst = mlist + (size_t)bh * MLIST_PER_BH; const unsigned tl = (unsigned)(own * 256 + wave * 32 + r32);
            lst[mlist_off(sel0) + lcnt[32 + sel0] + rk0] = tl;
            if (nv > 1) lst[mlist_off(sel1) + lcnt[32 + sel1] + rk1] = tl | (1u << 16);
            if (nv > 2) lst[mlist_off(sel2) + lcnt[32 + sel2] + rk2] = tl | (2u << 16);
        }
    }
}
constexpr int RELB_OFF = 131072;
constexpr int PRE_OFF = 139264;
constexpr int UINFO_OFF = 147456;
static_assert(PRE_OFF + 2080 * 4 <= LDSCTL_OFF && UINFO_OFF + 64 <= LDSCTL_OFF && 4 * 33280 <= UINFO_OFF, "attention LDS map");

__device__ __forceinline__ int part_next(int u, int uw, int usb, int per) { const int k = (u - usb) % per; return (k + 1 < uw) ? u + 1 : u - k + per; }
__device__ __forceinline__ void ph_moba_part(const Ctx& C, const bf16* Q, const bf16* K, const bf16* V, const float* rel_bias, const unsigned* mcnt, const unsigned* mlist, bf16* parto, float* partml, const int uw, const int usb, const int per) {
    if (C.wave >= 4) __builtin_amdgcn_s_setprio(1);
    LAS float* relb = (LAS float*)(C.lds + RELB_OFF);
    LAS int* pre = (LAS int*)(C.lds + PRE_OFF);
    const int lane = C.lane, wave = C.wave, r32 = lane & 31, hi = lane >> 5;
    __syncthreads();
    build_relb(C, rel_bias, relb);
    {   int v[4], s = 0;
#pragma unroll
        for (int i = 0; i < 4; ++i) { v[i] = (int)((__hip_atomic_load(mcnt + 4 * C.tid + i, __ATOMIC_RELAXED, __HIP_MEMORY_SCOPE_AGENT) + 255u) >> 8); s += v[i]; }
        int inc = s;
#pragma unroll
        for (int o = 1; o < 64; o <<= 1) { const int t = __shfl_up(inc, o); if (lane >= o) inc += t; }
        if (lane == 63) pre[2056 + wave] = inc;
        __syncthreads();
        int base = 0; for (int w = 0; w < wave; ++w) base += pre[2056 + w];
        const int ex = base + inc - s;
        pre[4 * C.tid] = ex; pre[4 * C.tid + 1] = ex + v[0]; pre[4 * C.tid + 2] = ex + v[0] + v[1]; pre[4 * C.tid + 3] = ex + v[0] + v[1] + v[2];
        if (C.tid == NTHR - 1) pre[2048] = ex + s;
        __syncthreads();
    }
    const int total = pre[2048];
    int u = usb, cur = 0, idx = 0;
    if (u < total) {
        int lo = 0, hi_ = 2048;
#pragma unroll
        for (int s = 0; s < 11; ++s) { const int mid = (lo + hi_) >> 1; if (pre[mid] <= u) lo = mid; else hi_ = mid; }
        idx = lo;
        const int bh = idx >> 5, j = idx & 31, b = bh >> 4, h = bh & 15;
        const bf16* Kg = K + (size_t)(b * SEQ + j * 256) * D + h * 64; const bf16* Vg = V + (size_t)(b * SEQ + j * 256) * D + h * 64;
#pragma unroll
        for (int t4 = 0; t4 < 4; ++t4) dma_tile(Kg + (size_t)t4 * 64 * D, Vg + (size_t)t4 * 64 * D, C.lds + t4 * 8192, C.lds + 32768 + t4 * 8192, wave, lane);
    }
    unsigned ent = 0u, ent_n = 0u; bool valid = false, valid_n = false;
    if (u < total) { const int bh = idx >> 5, j = idx & 31, chunk = u - pre[idx]; const int n = (int)__hip_atomic_load(mcnt + idx, __ATOMIC_RELAXED, __HIP_MEMORY_SCOPE_AGENT);
        const int i = chunk * 256 + wave * 32 + r32; valid = i < n; ent = mlist[(size_t)bh * MLIST_PER_BH + mlist_off(j) + (valid ? i : chunk * 256)]; }
    while (u < total) {
        const int bh = idx >> 5, j = idx & 31, b = bh >> 4, h = bh & 15;
        const int tl = (int)(ent & 0xffffu), slot = (int)(ent >> 16);
        bf16x8 qr[4]; load_q(qr, Q + (size_t)(b * SEQ + tl) * D + h * 64, hi);
        LAS unsigned char* Ks = C.lds + cur * 65536; LAS unsigned char* Vs = Ks + 32768;
        VM_WAIT(); __syncthreads();
        const int un = u + per; int nidx = 0;
        if (un < total) {
            int lo = 0, hi_ = 2048;
#pragma unroll
            for (int s = 0; s < 11; ++s) { const int mid = (lo + hi_) >> 1; if (pre[mid] <= un) lo = mid; else hi_ = mid; }
            nidx = lo;
            const int nbh = nidx >> 5, nj = nidx & 31, nb = nbh >> 4, nh = nbh & 15;
            const bf16* Kg = K + (size_t)(nb * SEQ + nj * 256) * D + nh * 64; const bf16* Vg = V + (size_t)(nb * SEQ + nj * 256) * D + nh * 64;
            LAS unsigned char* Kn = C.lds + (cur ^ 1) * 65536;
#pragma unroll
            for (int t4 = 0; t4 < 4; ++t4) dma_tile(Kg + (size_t)t4 * 64 * D, Vg + (size_t)t4 * 64 * D, Kn + t4 * 8192, Kn + 32768 + t4 * 8192, wave, lane);
            const int nchunk = un - pre[nidx], nn = (int)__hip_atomic_load(mcnt + nidx, __ATOMIC_RELAXED, __HIP_MEMORY_SCOPE_AGENT), ni = nchunk * 256 + wave * 32 + r32;
            valid_n = ni < nn; ent_n = mlist[(size_t)nbh * MLIST_PER_BH + mlist_off(nj) + (valid_n ? ni : nchunk * 256)];
        }
        AttnAcc A;
        const bool lk = __any((tl - (j * 256 + 255)) < 128) != 0;
        MobaBias B{relb + h * 128, tl, j * 256, lk, false, relb[h * 128 + 127]};
        f32x16 a0, a1, b0, b1;
        acc_init(A); B.kpos0 = j * 256;
        if (__any(valid)) {
        qk_tile(a0, a1, qr, Ks, r32, hi, B);
#pragma unroll 1
        for (int tp = 0; tp < 4; tp += 2) {
            B.kpos0 = j * 256 + 64 * (tp + 1); attn_step(A, a0, a1, b0, b1, qr, Ks + (tp + 1) * 8192, Vs + tp * 8192, r32, hi, lane, B, true);
            B.kpos0 = j * 256 + 64 * (tp + 2); attn_step(A, b0, b1, a0, a1, qr, Ks + ((tp + 2) & 3) * 8192, Vs + (tp + 1) * 8192, r32, hi, lane, B, tp == 0);
        }
        }
        const float lt = A.la[0], inv = 1.f / lt;
        if (valid) {
            const size_t rowi = ((size_t)(b * SEQ + tl) * H + h) * 3 + slot;
            store_o(parto + rowi * 64, A, inv, hi);
            if (hi == 0) *(GAS f32x2*)(partml + rowi * 2) = (f32x2){A.m, lt};
        }
        u = un; idx = nidx; cur ^= 1; ent = ent_n; valid = valid_n;
    }
    __builtin_amdgcn_s_setprio(0);
}
__device__ __forceinline__ void ph_moba_own(const Ctx& C, const bf16* Q, const bf16* K, const bf16* V, const float* rel_bias, const bf16* parto, const float* partml, unsigned char* O) {
    if (C.wave >= 4) __builtin_amdgcn_s_setprio(1);
    LAS float* relb = (LAS float*)(C.lds + RELB_OFF);
    const int lane = C.lane, wave = C.wave, r32 = lane & 31, hi = lane >> 5;
    __syncthreads();
    build_relb(C, rel_bias, relb);
    constexpr int NU = BATCH * H * NBLK;
    int u = C.vcu, cur = 0;
    if (u < NU) {
        const int bh = u >> 5, own = u & 31, b = bh >> 4, h = bh & 15;
        const bf16* Kg = K + (size_t)(b * SEQ + own * 256) * D + h * 64; const bf16* Vg = V + (size_t)(b * SEQ + own * 256) * D + h * 64;
#pragma unroll
        for (int t4 = 0; t4 < 4; ++t4) dma_tile(Kg + (size_t)t4 * 64 * D, Vg + (size_t)t4 * 64 * D, C.lds + t4 * 8192, C.lds + 32768 + t4 * 8192, wave, lane);
    }
    while (u < NU) {
        const int bh = u >> 5, own = u & 31, b = bh >> 4, h = bh & 15;
        const int qblk = wave < 4 ? wave : 11 - wave;
        const int tl = own * 256 + qblk * 32 + r32;
        bf16x8 qr[4]; load_q(qr, Q + (size_t)(b * SEQ + tl) * D + h * 64, hi);
        const int nv = own < 3 ? own : 3;
        const size_t rowi = ((size_t)(b * SEQ + tl) * H + h) * 3;
        LAS unsigned char* Ks = C.lds + cur * 65536; LAS unsigned char* Vs = Ks + 32768;
        VM_WAIT(); __syncthreads();
        const int un = u + C.G;
        if (un < NU) {
            const int nbh = un >> 5, nown = un & 31, nb = nbh >> 4, nh = nbh & 15;
            const bf16* Kg = K + (size_t)(nb * SEQ + nown * 256) * D + nh * 64; const bf16* Vg = V + (size_t)(nb * SEQ + nown * 256) * D + nh * 64;
            LAS unsigned char* Kn = C.lds + (cur ^ 1) * 65536;
#pragma unroll
            for (int t4 = 0; t4 < 4; ++t4) dma_tile(Kg + (size_t)t4 * 64 * D, Vg + (size_t)t4 * 64 * D, Kn + t4 * 8192, Kn + 32768 + t4 * 8192, wave, lane);
        }
        AttnAcc A; acc_init(A);
        const int tlast = qblk >> 1;
        MobaBias B{relb + h * 128, tl, own * 256, true, tlast == 0, 0.f};
        f32x16 a0, a1, b0, b1;
        qk_tile(a0, a1, qr, Ks, r32, hi, B);
#pragma unroll 1
        for (int tp = 0; tp < 4; tp += 2) {
            if (tp <= tlast) { B.kpos0 = own * 256 + 64 * (tp + 1); B.causal = (tp + 1 == tlast); attn_step(A, a0, a1, b0, b1, qr, Ks + (tp + 1) * 8192, Vs + tp * 8192, r32, hi, lane, B, tp + 1 <= tlast); }
            if (tp + 1 <= tlast) { B.kpos0 = own * 256 + 64 * (tp + 2); B.causal = (tp + 2 == tlast); attn_step(A, b0, b1, a0, a1, qr, Ks + ((tp + 2) & 3) * 8192, Vs + (tp + 1) * 8192, r32, hi, lane, B, tp + 2 <= tlast); }
        }
        const float lt = A.la[0];
        float mi[3], li[3];
#pragma unroll
        for (int i = 0; i < 3; ++i) { mi[i] = NEG_INF; li[i] = 0.f; if (i < nv) { const f32x2 ml = *(const GAS f32x2*)(partml + (rowi + i) * 2); mi[i] = ml.x; li[i] = ml.y; } }
        float M = A.m;
#pragma unroll
        for (int i = 0; i < 3; ++i) M = fmaxf(M, mi[i]);
        const float w0 = __builtin_amdgcn_exp2f(A.m - M); float den = w0 * lt;
#pragma unroll
        for (int r = 0; r < 16; ++r) { A.o0[r] *= w0; A.o1[r] *= w0; }
#pragma unroll
        for (int i = 0; i < 3; ++i) if (i < nv) {
            const float wi = li[i] * __builtin_amdgcn_exp2f(mi[i] - M); den += wi;
            const bf16* po = parto + (rowi + i) * 64;
#pragma unroll
            for (int p = 0; p < 2; ++p) {
                const v4u La = *(const GAS v4u*)(po + 16 * p + 8 * hi), Lc = *(const GAS v4u*)(po + 32 + 16 * p + 8 * hi);
                unsigned a0x, a1x, a0y, a1y, c0x, c1x, c0y, c1y;
                swap32(La.x, La.z, a0x, a1x); swap32(La.y, La.w, a0y, a1y); swap32(Lc.x, Lc.z, c0x, c1x); swap32(Lc.y, Lc.w, c0y, c1y);
                const int g0 = 2 * p, g1 = 2 * p + 1;
                A.o0[4 * g0] += wi * bflo(a0x); A.o0[4 * g0 + 1] += wi * bfhi(a0x); A.o0[4 * g0 + 2] += wi * bflo(a0y); A.o0[4 * g0 + 3] += wi * bfhi(a0y);
                A.o0[4 * g1] += wi * bflo(a1x); A.o0[4 * g1 + 1] += wi * bfhi(a1x); A.o0[4 * g1 + 2] += wi * bflo(a1y); A.o0[4 * g1 + 3] += wi * bfhi(a1y);
                A.o1[4 * g0] += wi * bflo(c0x); A.o1[4 * g0 + 1] += wi * bfhi(c0x); A.o1[4 * g0 + 2] += wi * bflo(c0y); A.o1[4 * g0 + 3] += wi * bfhi(c0y);
                A.o1[4 * g1] += wi * bflo(c1x); A.o1[4 * g1 + 1] += wi * bfhi(c1x); A.o1[4 * g1 + 2] += wi * bflo(c1y); A.o1[4 * g1 + 3] += wi * bfhi(c1y); }
        }
        store_o8(O + (size_t)(b * SEQ + tl) * D + h * 64, A, 1.f / den, hi);
        u = un; cur ^= 1;
    }
    __builtin_amdgcn_s_setprio(0);
}

__device__ __forceinline__ void ph_scan(const Ctx& C, const float* logf, float* ncum) {
    LAS float* wt = (LAS float*)C.lds;
    for (int bh = C.vcu; bh < BATCH * H; bh += C.G) {
        const int b = bh >> 4, h = bh & 15;
        float v[16], s = 0.f;
#pragma unroll
        for (int i = 0; i < 16; ++i) { v[i] = logf[(size_t)(b * SEQ + C.tid * 16 + i) * H + h]; s += v[i]; }
        float inc = s;
#pragma unroll
        for (int o = 1; o < 64; o <<= 1) { const float t = __shfl_up(inc, o); if (C.lane >= o) inc += t; }
        __syncthreads();
        if (C.lane == 63) wt[C.wave] = inc;
        __syncthreads();
        float run = inc - s; for (int w = 0; w < C.wave; ++w) run += wt[w];
#pragma unroll
        for (int i = 0; i < 16; ++i) { run += v[i]; ncum[(size_t)bh * SEQ + C.tid * 16 + i] = -run * LOG2E; }
    }
}
__device__ __forceinline__ void ph_fox(const Ctx& C, const bf16* Q, const bf16* K, const bf16* V, const float* ncum, const unsigned* norms, unsigned char* O, unsigned* qctr) {
    if (C.wave >= 4) __builtin_amdgcn_s_setprio(1);
    constexpr int GB = 33280;
    LAS int* uinfo = (LAS int*)(C.lds + UINFO_OFF);
    const int lane = C.lane, wave = C.wave, r32 = lane & 31, hi = lane >> 5;
    for (;;) {
        __syncthreads();
        if (C.tid == 0) { uinfo[0] = (int)__hip_atomic_fetch_add(qctr, 1u, __ATOMIC_RELAXED, __HIP_MEMORY_SCOPE_AGENT); uinfo[1] = 0; uinfo[2] = 0; uinfo[3] = -1; }
        __syncthreads();
        const int idx = uinfo[0];
        if (idx >= BATCH * H * NBLK) break;
        const int qb = 31 - (idx >> 6), bh = idx & 63, b = bh >> 4, h = bh & 15, NT = 4 * (qb + 1);
        const float* ng = ncum + (size_t)bh * SEQ; const float nref = ng[qb * 256];
        const int qblk = wave < 4 ? wave : 11 - wave;
        const int qrel = qblk * 32 + r32;
        bf16x8 qr[4]; load_q(qr, Q + (size_t)(b * SEQ + qb * 256 + qrel) * D + h * 64, hi);
        {   float q2 = 0.f;
#pragma unroll
            for (int d0 = 0; d0 < 4; ++d0)
#pragma unroll
                for (int i = 0; i < 8; ++i) { const float x = bf2f((unsigned)(unsigned short)qr[d0][i]); q2 += x * x; }
            q2 += __shfl_xor(q2, 32);
#pragma unroll
            for (int o = 1; o < 32; o <<= 1) q2 = fmaxf(q2, __shfl_xor(q2, o));
            if (lane == 0) (void)__hip_atomic_fetch_max((LAS unsigned*)&uinfo[2], __float_as_uint(q2), __ATOMIC_RELAXED, __HIP_MEMORY_SCOPE_WORKGROUP);
            bf16x8 kr[4]; load_q(kr, K + (size_t)(b * SEQ + qb * 256 + qrel) * D + h * 64, hi);
            float sq = 0.f;
#pragma unroll
            for (int d0 = 0; d0 < 4; ++d0)
#pragma unroll
                for (int i = 0; i < 8; ++i) sq += bf2f((unsigned)(unsigned short)qr[d0][i]) * bf2f((unsigned)(unsigned short)kr[d0][i]);
            sq += __shfl_xor(sq, 32);
#pragma unroll
            for (int o = 1; o < 32; o <<= 1) sq = fminf(sq, __shfl_xor(sq, o));
            if (lane == 0) (void)__hip_atomic_fetch_min((LAS unsigned*)&uinfo[3], sort_key(sq), __ATOMIC_RELAXED, __HIP_MEMORY_SCOPE_WORKGROUP); }
        __syncthreads();
        {   const float qn2 = __uint_as_float((unsigned)uinfo[2]), qa = __uint_as_float(norms[bh * 4 + 0]), qb2 = __uint_as_float(norms[bh * 4 + 1]), ka = __uint_as_float(norms[bh * 4 + 2]), kb2 = __uint_as_float(norms[bh * 4 + 3]);
            const unsigned mk = (unsigned)uinfo[3]; const float smin = __uint_as_float((mk & 0x80000000u) ? (mk ^ 0x80000000u) : ~mk) - 0.05f;
            const float smax = sqrtf(fminf(qn2, qa + qb2)) * sqrtf(ka + kb2) * 1.02f;
            const float thr = smax - fmaxf(smin, -smax) + 40.f;
            if (C.tid < 128) { const bool skip = (C.tid < NT) && (ng[(C.tid < NT ? C.tid : 0) * 64 + 63] - nref < -thr); const int c = __popcll(__ballot(skip)); if (lane == 0 && c) (void)__hip_atomic_fetch_add(&uinfo[1], c, __ATOMIC_RELAXED, __HIP_MEMORY_SCOPE_WORKGROUP); } }
        __syncthreads();
        const int t0 = uinfo[1], tf = t0 & ~1, g0 = t0 >> 1, NG = NT >> 1, tmax = 4 * qb + (qblk >> 1);
        const bf16* Kg = K + (size_t)(b * SEQ) * D + h * 64; const bf16* Vg = V + (size_t)(b * SEQ) * D + h * 64;
#define FOX_DMA(g) do { LAS unsigned char* sb_ = C.lds + ((g) & 3) * GB; \
            dma_tile(Kg + (size_t)(2 * (g)) * 64 * D, Vg + (size_t)(2 * (g)) * 64 * D, sb_, sb_ + 16384, wave, lane); \
            dma_tile(Kg + (size_t)(2 * (g) + 1) * 64 * D, Vg + (size_t)(2 * (g) + 1) * 64 * D, sb_ + 8192, sb_ + 24576, wave, lane); \
            if (wave < 2) glds4(ng + (2 * (g) + wave) * 64 + lane, lds_addr(sb_ + 32768 + wave * 256)); } while (0)
        FOX_DMA(g0);
        if (g0 + 1 < NG) FOX_DMA(g0 + 1);
        VM_WAIT(); __syncthreads();
        AttnAcc A; acc_init(A);
        f32x16 a0, a1, b0, b1; v4u wa[4], wb[4];
        FoxBias B{nullptr, qrel, 0, false};
#define FOX_SETB(t) do { const LAS unsigned char* sb_ = C.lds + (((t) >> 1) & 3) * GB; B.cb = (const LAS float*)(sb_ + 32768 + ((t) & 1) * 256); B.krel0 = (t) * 64 - qb * 256; B.causal = (t) >= 4 * qb; } while (0)
#define FOX_KS(t) (C.lds + (((t) >> 1) & 3) * GB + ((t) & 1) * 8192)
#define FOX_VS(t) (C.lds + (((t) >> 1) & 3) * GB + 16384 + ((t) & 1) * 8192)
#define FOX_STEP(C0, C1, N0, N1, WP, WN, t) do { FOX_SETB((t) + 1); \
            attn_step3(A, C0, C1, N0, N1, WP, WN, qr, FOX_KS((t) + 1), FOX_VS((t) > tf ? (t) - 1 : (t)), r32, hi, lane, B, (t) <= tmax); } while (0)
#pragma unroll
        for (int k_ = 0; k_ < 4; ++k_) { wa[k_] = (v4u){0u, 0u, 0u, 0u}; wb[k_] = (v4u){0u, 0u, 0u, 0u}; }
        if (tf <= tmax) { FOX_SETB(tf); qk_tile(a0, a1, qr, FOX_KS(tf), r32, hi, B); }
#pragma unroll 1
        for (int g = g0; g <= NG; ++g) {
            const int ta = 2 * g, tb = ta + 1;
            if (g + 2 < NG) FOX_DMA(g + 2);
            if (ta <= tmax + 1) FOX_STEP(a0, a1, b0, b1, wb, wa, ta);
            if (tb <= tmax + 1 && g < NG) FOX_STEP(b0, b1, a0, a1, wa, wb, tb);
            VM_WAIT(); __syncthreads();
        }
#undef FOX_DMA
#undef FOX_SETB
#undef FOX_KS
#undef FOX_VS
#undef FOX_STEP
        const float lt = A.la[0];
        store_o8(O + (size_t)(b * SEQ + qb * 256 + qrel) * D + h * 64, A, 1.f / lt, hi);
    }
    __builtin_amdgcn_s_setprio(0);
}
__device__ __forceinline__ void ln_stats(f32x4 (&v)[4], float& rstd) {
    float s = 0.f;
#pragma unroll
    for (int j = 0; j < 4; ++j) s += (v[j].x + v[j].y) + (v[j].z + v[j].w);
    const float mean = wave_sum(s) * (1.f / D); float s2 = 0.f;
#pragma unroll
    for (int j = 0; j < 4; ++j) { v[j] = v[j] - mean; s2 += (v[j].x * v[j].x + v[j].y * v[j].y) + (v[j].z * v[j].z + v[j].w * v[j].w); }
    rstd = 1.f / sqrtf(wave_sum(s2) * (1.f / D) + LN_EPS);
}
__device__ __forceinline__ void ph_ln1(const Ctx& C, const float* xin, const bf16* xin16, const bf16* y, const float* g, const float* bta, bf16* AR, unsigned char* xb8) {
    const int gw = C.vcu * NWAVES + C.wave, NGW = C.G * NWAVES, lane = C.lane;
    f32x4 gv[4], bv[4];
#pragma unroll
    for (int j = 0; j < 4; ++j) { gv[j] = *(const GAS f32x4*)(g + 4 * lane + 256 * j); bv[j] = *(const GAS f32x4*)(bta + 4 * lane + 256 * j); }
    u32x2 wn[4], zn16[4]; f32x4 zn32[4];
    {   const GAS u32x2* yr = (const GAS u32x2*)(y + (size_t)gw * D) + lane;
#pragma unroll
        for (int j = 0; j < 4; ++j) wn[j] = yr[64 * j];
        if (xin16) { const GAS u32x2* zr = (const GAS u32x2*)(xin16 + (size_t)gw * D) + lane;
#pragma unroll
            for (int j = 0; j < 4; ++j) zn16[j] = zr[64 * j];
        } else { const GAS f32x4* zr = (const GAS f32x4*)(xin + (size_t)gw * D) + lane;
#pragma unroll
            for (int j = 0; j < 4; ++j) zn32[j] = zr[64 * j]; } }
    for (int t = gw; t < T; t += NGW) {
        f32x4 v[4];
        const int tn = t + NGW < T ? t + NGW : t;
        const GAS u32x2* yr = (const GAS u32x2*)(y + (size_t)tn * D) + lane;
        if (xin16) { const GAS u32x2* zr = (const GAS u32x2*)(xin16 + (size_t)tn * D) + lane;
#pragma unroll
            for (int j = 0; j < 4; ++j) { const u32x2 w = wn[j], z = zn16[j]; v[j] = (f32x4){bflo(z.x), bfhi(z.x), bflo(z.y), bfhi(z.y)} * DN_ALPHA + (f32x4){bflo(w.x), bfhi(w.x), bflo(w.y), bfhi(w.y)}; }
#pragma unroll
            for (int j = 0; j < 4; ++j) { wn[j] = yr[64 * j]; zn16[j] = zr[64 * j]; }
        } else { const GAS f32x4* zr = (const GAS f32x4*)(xin + (size_t)tn * D) + lane;
#pragma unroll
            for (int j = 0; j < 4; ++j) { const u32x2 w = wn[j]; v[j] = zn32[j] * DN_ALPHA + (f32x4){bflo(w.x), bfhi(w.x), bflo(w.y), bfhi(w.y)}; }
#pragma unroll
            for (int j = 0; j < 4; ++j) { wn[j] = yr[64 * j]; zn32[j] = zr[64 * j]; } }
        float rstd; ln_stats(v, rstd);
#pragma unroll
        for (int j = 0; j < 4; ++j) {
            const f32x4 y = v[j] * rstd * gv[j] + bv[j]; const int d = 4 * lane + 256 * j;
            u32x2 hw; hw.x = cvtpk(y.x, y.y); hw.y = cvtpk(y.z, y.w);
            u32x2 lw; lw.x = cvtpk(y.x - bflo(hw.x), y.y - bfhi(hw.x)); lw.y = cvtpk(y.z - bflo(hw.y), y.w - bfhi(hw.y));
            *(GAS unsigned*)(xb8 + (size_t)t * D + d) = pk4_f8(y.x * XQ_SCALE, y.y * XQ_SCALE, y.z * XQ_SCALE, y.w * XQ_SCALE);
            *(GAS u32x2*)(AR + (size_t)t * 1536 + d) = hw;
            *(GAS u32x2*)(AR + (size_t)(T + t) * 1536 + 512 + d) = hw;
            if (j < 2) *(GAS u32x2*)(AR + (size_t)t * 1536 + 1024 + d) = lw; else *(GAS u32x2*)(AR + (size_t)(T + t) * 1536 + (d - 512)) = lw;
        }
    }
}
__device__ __forceinline__ int below(unsigned long long mask) { return (int)__builtin_amdgcn_mbcnt_hi((unsigned)(mask >> 32), __builtin_amdgcn_mbcnt_lo((unsigned)mask, 0u)); }
__device__ __forceinline__ void ph_route(const Ctx& C, const float* logp, const float* rbias, int* topi, float* gate, unsigned* ecnt) {
    LAS unsigned* hist = (LAS unsigned*)C.lds;
    const int gw = C.vcu * NWAVES + C.wave, NGW = C.G * NWAVES, lane = C.lane;
    __syncthreads();
    if (C.tid < NE) hist[C.tid] = 0u;
    __syncthreads();
    const f32x4 rb = *(const GAS f32x4*)(rbias + 4 * lane);
    f32x4 an = *(const GAS f32x4*)(logp + (size_t)gw * NE + 4 * lane), bn = *(const GAS f32x4*)(logp + (size_t)(T + gw) * NE + 4 * lane);
    for (int t = gw; t < T; t += NGW) {
        const f32x4 a = an, b2 = bn;
        { const int tn = t + NGW < T ? t + NGW : t; an = *(const GAS f32x4*)(logp + (size_t)tn * NE + 4 * lane); bn = *(const GAS f32x4*)(logp + (size_t)(T + tn) * NE + 4 * lane); }
        float s[4], c[4];
#pragma unroll
        for (int i = 0; i < 4; ++i) { const float lg = a[i] + b2[i]; s[i] = 1.f / (1.f + __builtin_amdgcn_exp2f(-lg * LOG2E)); c[i] = s[i] + rb[i]; }
        float m1 = fmaxf(c[0], c[1]), m2 = fminf(c[0], c[1]);
        { const float x = c[2]; const float n1 = fmaxf(m1, x); m2 = fmaxf(m2, fminf(m1, x)); m1 = n1; }
        { const float x = c[3]; const float n1 = fmaxf(m1, x); m2 = fmaxf(m2, fminf(m1, x)); m1 = n1; }
#pragma unroll
        for (int o = 1; o < 8; o <<= 1) { const float o1 = __shfl_xor(m1, o), o2 = __shfl_xor(m2, o); const float n1 = fmaxf(m1, o1), n2 = fmaxf(fminf(m1, o1), fmaxf(m2, o2)); m1 = n1; m2 = n2; }
        const float gs = m1 + m2; const int mygrp = lane >> 3; int rk = 0;
#pragma unroll
        for (int g2 = 0; g2 < NGRP; ++g2) { const float og = __uint_as_float((unsigned)__builtin_amdgcn_readlane((int)__float_as_uint(gs), 8 * g2)); rk += (og > gs || (og == gs && g2 < mygrp)) ? 1 : 0; }
        unsigned k[4];
#pragma unroll
        for (int i = 0; i < 4; ++i) k[i] = rk < 4 ? sort_key(c[i]) : 0u;
        unsigned thr = 0u;
#pragma unroll 1
        for (int b = 31; b >= 0; --b) {
            const unsigned cand = thr | (1u << b);
            const int cnt = __popcll(__ballot(k[0] >= cand)) + __popcll(__ballot(k[1] >= cand)) + __popcll(__ballot(k[2] >= cand)) + __popcll(__ballot(k[3] >= cand));
            if (cnt >= TOPK) thr = cand;
        }
        unsigned long long gm[4], em[4]; int ngt = 0;
#pragma unroll
        for (int i = 0; i < 4; ++i) { gm[i] = __ballot(k[i] > thr); em[i] = __ballot(k[i] == thr); ngt += __popcll(gm[i]); }
        const int need = TOPK - ngt;
        int eqb = below(em[0]) + below(em[1]) + below(em[2]) + below(em[3]);
        bool sel[4];
#pragma unroll
        for (int i = 0; i < 4; ++i) { const bool eq = k[i] == thr; sel[i] = (k[i] > thr) || (eq && eqb < need); eqb += eq ? 1 : 0; }
        unsigned long long sm[4]; float wpart = 0.f;
#pragma unroll
        for (int i = 0; i < 4; ++i) { sm[i] = __ballot(sel[i]); wpart += sel[i] ? s[i] : 0.f; }
        const float wsum = wave_sum(wpart);
        int pos = below(sm[0]) + below(sm[1]) + below(sm[2]) + below(sm[3]);
#pragma unroll
        for (int i = 0; i < 4; ++i) if (sel[i]) { gate[(size_t)t * TOPK + pos] = s[i] / wsum * ROUTED_SCALE;
            const unsigned rk = __hip_atomic_fetch_add(&hist[4 * lane + i], 1u, __ATOMIC_RELAXED, __HIP_MEMORY_SCOPE_WORKGROUP);
            topi[(size_t)t * TOPK + pos] = (4 * lane + i) | (int)(rk << 8); ++pos; }
    }
    __syncthreads();
    if (C.tid < NE) { const unsigned c = hist[C.tid]; hist[NE + C.tid] = c ? __hip_atomic_fetch_add(ecnt + C.tid, c, __ATOMIC_RELAXED, __HIP_MEMORY_SCOPE_AGENT) : 0u; }
}
__device__ __forceinline__ void ph_scatter(const Ctx& C, const unsigned* ecnt, unsigned* ecur, const int* topi, const float* gate, const bf16* xb, int* slotof, int* tokof, float* gslot, bf16* HS) {
    build_tpre(C, ecnt);
    const LAS int* tpre = (const LAS int*)(C.lds + TPRE_OFF);
    const LAS unsigned* wgbase = (const LAS unsigned*)C.lds + NE;
    const int gw = C.vcu * NWAVES + C.wave, NGW = C.G * NWAVES;
    for (int n = C.lane >> 3; gw + n * NGW < T; n += 8) {
        const int t = gw + n * NGW;
        { const int i = t * TOPK + (C.lane & 7); const int v = topi[i], e = v & 255, rk = v >> 8;
            const int slot = tpre[e] * 256 + (int)wgbase[e] + rk; tokof[slot] = t; gslot[slot] = gate[i] * GS_FOLD; slotof[i] = slot; }
    }
    for (int e = C.vcu; e < NE; e += C.G) {
        const int cnt = (int)__hip_atomic_load(ecnt + e, __ATOMIC_RELAXED, __HIP_MEMORY_SCOPE_AGENT), s0 = tpre[e] * 256 + cnt, s1 = tpre[e + 1] * 256;
        for (int s = s0 + C.tid; s < s1; s += NTHR) { gslot[s] = 0.f; tokof[s] = 0; }
    }
}
__device__ __forceinline__ float log_sigmoid(float z) {
    const float e = __builtin_amdgcn_exp2f(-fabsf(z) * LOG2E);
    const float l1p = e < 0.015625f ? e * (1.f - e * (0.5f - e * 0.33333334f)) : __builtin_amdgcn_logf(1.f + e) * 0.6931471805599453f;
    return fminf(z, 0.f) - l1p;
}
__device__ __forceinline__ void ph_combine(const Ctx& C, const bf16* x1hi, const unsigned char* SO, const int* slotof, const float* g, const float* bta, bf16* xres, unsigned char* xb8, float* dout,
                                           const float* fox_in, const float* fox_bf, float* logf) {
    const int gw = C.vcu * NWAVES + C.wave, NGW = C.G * NWAVES, lane = C.lane;
    LAS float* wfT = (LAS float*)C.lds;
    __syncthreads();
    if (logf) { for (int i = C.tid; i < D * H; i += NTHR) { const int d = i >> 4, h = i & 15; wfT[h * D + d] = fox_in[(size_t)d * FOXW + 3 * D + h]; } }
    __syncthreads();
    f32x4 gv[4], bv[4];
#pragma unroll
    for (int j = 0; j < 4; ++j) { gv[j] = *(const GAS f32x4*)(g + 4 * lane + 256 * j); bv[j] = *(const GAS f32x4*)(bta + 4 * lane + 256 * j); }
    int sl_n = lane < TOPK ? slotof[(size_t)gw * TOPK + lane] : 0;
    for (int t = gw; t < T; t += NGW) {
        const GAS u32x2* zr = (const GAS u32x2*)(x1hi + (size_t)t * 1536) + lane;
        f32x4 v[4];
#pragma unroll
        for (int j = 0; j < 4; ++j) { const u32x2 z = zr[64 * j]; v[j] = (f32x4){bflo(z.x), bfhi(z.x), bflo(z.y), bfhi(z.y)} * DN_ALPHA; }
        const int sl = sl_n; { const int tn = t + NGW < T ? t + NGW : t; sl_n = lane < TOPK ? slotof[(size_t)tn * TOPK + lane] : 0; }
        f32x4 rs[4];
#pragma unroll
        for (int j = 0; j < 4; ++j) rs[j] = (f32x4){0.f, 0.f, 0.f, 0.f};
#pragma unroll
        for (int k = 0; k < TOPK; ++k) { const int sk = __builtin_amdgcn_readlane(sl, k); const unsigned char* row = SO + (size_t)sk * D + 4 * lane;
#pragma unroll
            for (int j = 0; j < 4; ++j) { const unsigned w = *(const GAS unsigned*)(row + 256 * j); const f32x2 lo2 = __builtin_amdgcn_cvt_pk_f32_fp8(w, false), hi2 = __builtin_amdgcn_cvt_pk_f32_fp8(w, true);
                rs[j].x += lo2.x; rs[j].y += lo2.y; rs[j].z += hi2.x; rs[j].w += hi2.y; } }
        {   const unsigned char* row = SO + (size_t)(NSLOT_MAX + t) * D + 4 * lane;
#pragma unroll
            for (int j = 0; j < 4; ++j) { const unsigned w = *(const GAS unsigned*)(row + 256 * j); const f32x2 lo2 = __builtin_amdgcn_cvt_pk_f32_fp8(w, false), hi2 = __builtin_amdgcn_cvt_pk_f32_fp8(w, true);
                rs[j].x += lo2.x; rs[j].y += lo2.y; rs[j].z += hi2.x; rs[j].w += hi2.y; } }
#pragma unroll
        for (int j = 0; j < 4; ++j) v[j] = v[j] + rs[j] * SO_INV;
        float rstd; ln_stats(v, rstd);
        f32x4 y[4];
#pragma unroll
        for (int j = 0; j < 4; ++j) {
            y[j] = v[j] * rstd * gv[j] + bv[j]; const int d = 4 * lane + 256 * j;
            if (dout) *(GAS f32x4*)(dout + (size_t)t * D + d) = y[j];
            else { u32x2 hw; hw.x = cvtpk(y[j].x, y[j].y); hw.y = cvtpk(y[j].z, y[j].w); *(GAS u32x2*)(xres + (size_t)t * D + d) = hw;
                *(GAS unsigned*)(xb8 + (size_t)t * D + d) = pk4_f8(y[j].x * XQ_SCALE, y[j].y * XQ_SCALE, y[j].z * XQ_SCALE, y[j].w * XQ_SCALE); }
        }
        if (logf) {
            float acc[16];
#pragma unroll
            for (int h = 0; h < 16; ++h) { float a = 0.f;
#pragma unroll
                for (int j = 0; j < 4; ++j) { const f32x4 w = *(const LAS f32x4*)(wfT + h * D + 4 * lane + 256 * j); a += y[j].x * w.x; a += y[j].y * w.y; a += y[j].z * w.z; a += y[j].w * w.w; }
                acc[h] = a; }
            float a8[8], a4[4], a2[2], a1;
            { const bool bit = (lane >> 5) & 1;
#pragma unroll
              for (int i = 0; i < 8; ++i) { const float send = bit ? acc[i] : acc[i + 8]; const float recv = __shfl_xor(send, 32); a8[i] = (bit ? acc[i + 8] : acc[i]) + recv; } }
            { const bool bit = (lane >> 4) & 1;
#pragma unroll
              for (int i = 0; i < 4; ++i) { const float send = bit ? a8[i] : a8[i + 4]; const float recv = __shfl_xor(send, 16); a4[i] = (bit ? a8[i + 4] : a8[i]) + recv; } }
            { const bool bit = (lane >> 3) & 1;
#pragma unroll
              for (int i = 0; i < 2; ++i) { const float send = bit ? a4[i] : a4[i + 2]; const float recv = __shfl_xor(send, 8); a2[i] = (bit ? a4[i + 2] : a4[i]) + recv; } }
            { const bool bit = (lane >> 2) & 1; const float send = bit ? a2[0] : a2[1]; const float recv = __shfl_xor(send, 4); a1 = (bit ? a2[1] : a2[0]) + recv; }
            a1 += __shfl_xor(a1, 2); a1 += __shfl_xor(a1, 1);
            const int hh = ((lane >> 5) & 1) * 8 + ((lane >> 4) & 1) * 4 + ((lane >> 3) & 1) * 2 + ((lane >> 2) & 1);
            if ((lane & 3) == 0) logf[(size_t)t * H + hh] = log_sigmoid(a1 + fox_bf[hh]);
        }
    }
}
#ifndef MK_MULTI
#define MK_MULTI 0
#endif
constexpr int NPH = 27;
struct Args { const float* in[19]; float* out; unsigned char* ws; int ph_lo, ph_hi; };

__global__ void __launch_bounds__(NTHR, 2) mk_fwd(Args args) {
    extern __shared__ __attribute__((aligned(16))) unsigned char lds_raw[];
    Ctx C;
    C.lds = (LAS unsigned char*)lds_raw;
    C.tid = threadIdx.x; C.lane = C.tid & 63; C.wave = __builtin_amdgcn_readfirstlane(C.tid >> 6);
    C.G = gridDim.x; { const int bx = blockIdx.x; C.vcu = (C.G % 8 == 0) ? (bx % 8) * (C.G / 8) + bx / 8 : bx; }
    LAS unsigned long long* PTAB = (LAS unsigned long long*)(C.lds + PTAB_OFF);
    if (C.tid == 0) {
#pragma unroll
        for (int i = 0; i < 19; ++i) PTAB[i] = (unsigned long long)(uintptr_t)args.in[i];
        PTAB[19] = (unsigned long long)(uintptr_t)args.out; PTAB[20] = (unsigned long long)(uintptr_t)args.ws;
    }
    for (int u = C.tid; u < (PTAB_OFF - LDSCTL_OFF) / 4; u += NTHR) ((LAS unsigned*)(C.lds + LDSCTL_OFF))[u] = 0u;
    __syncthreads();
#define PIN(i) ((const float*)ldptr(PTAB, (i)))
#define WSP() ((unsigned char*)ldptr(PTAB, 20))
    XcdBarrier bar; bar.bar = (unsigned*)(args.ws + WS_CTL) + CW_BAR; bar.x = 0; bar.st = nullptr;
    if (!MK_MULTI) bar = xcd_barrier_post((unsigned*)(args.ws + WS_CTL) + CW_BAR, (volatile LAS unsigned*)(C.lds + MISC_OFF) + 8);
    const int lo = args.ph_lo, hi = args.ph_hi;
#ifndef MK_PH_MASK
#define MK_PH_MASK 0xFFFFFFFFu
#endif
#define PHON(b) (((MK_PH_MASK) >> (b)) & 1u)
#ifndef MK_DUP_MASK
#define MK_DUP_MASK 0u
#endif
#define NREP(b) ((((MK_DUP_MASK) >> (b)) & 1u) ? 2 : 1)
#define REP(b) _Pragma("unroll 1") for (int rep_ = 0; rep_ < NREP(b); ++rep_)
#define IN(k) (lo <= (k) && (k) < hi)
#define SEAM(k) do { if ((k) + 1 < hi) { asm volatile("" : "+s"(bar.bar)); xcd_barrier(bar); if (NREP(23) == 2) xcd_barrier(bar); } } while (0)
#define OPAQ(v) asm volatile("" : "+s"(v))
#define LC() do { int l_; asm volatile("v_mbcnt_lo_u32_b32 %0, -1, 0\n\tv_mbcnt_hi_u32_b32 %0, -1, %0" : "=v"(l_)); C.lane = l_; C.tid = C.wave * 64 + l_; } while (0)

    if (PHON(0) && IN(0)) { LC();
        unsigned char* ws = WSP();
        SmallW W{PIN(2), PIN(3), PIN(4), PIN(6), PIN(11), PIN(16), PIN(17), PIN(18),
                 ws + WS_WMI, ws + WS_WFI, ws + WS_WMO, ws + WS_WFO, ws + WS_WSGU, ws + WS_WSDN, (bf16*)(ws + WS_WR)};
        REP(21) conv_small(C, W);
        REP(22) to_f8_rows(C, PIN(0), ws + WS_XB8);
        __syncthreads();
        REP(0) conv_experts(C, PIN(13), PIN(14), PIN(15), 0, ws + WS_WEGU, ws + WS_WEDN, C.vcu, C.G);
        SEAM(0);
    }
#pragma unroll 1
    for (int l = 0; l < 2; ++l) {
        const int pb = 1 + 13 * l;
        if (PHON(1) && IN(pb + 0)) { LC();
            unsigned char* ws = WSP();
            if (PHON(15) && l == 1) ph_scan(C, (const float*)(ws + WS_LOGF), (float*)(ws + WS_CUM));
            REP(1) {
            __syncthreads();
            int kk = D / 2; OPAQ(kk);
            pg8::Gemm g{(const bf16*)(ws + WS_XB8), (const bf16*)(ws + (l == 0 ? WS_WMI : WS_WFI)), T, 3 * D, kk}; pg8::StaticOrder S; S.init(T, 3 * D, C.G, (int)blockIdx.x);
            EpiQKV E{(bf16*)(ws + WS_Q), (size_t)(WS_K - WS_Q) / 2, C2, (unsigned*)(ws + WS_CTL) + CW_NORM + l * 256, l == 0 ? (float*)(ws + WS_CTL) + CW_KSUM : nullptr};
            pg8::gemm_phase<EpiQKV, pg8::StaticOrder, true, true, false, true>(C.lds, g, S, E, C.tid);
            }
            SEAM(pb + 0);
        }
        if (l == 0) {
            if (PHON(3) && IN(pb + 2)) { LC(); unsigned char* ws = WSP(); REP(3) ph_select(C, (const bf16*)(ws + WS_Q), (const float*)(ws + WS_CTL) + CW_KSUM, (unsigned*)(ws + WS_CTL) + (rep_ ? 133120 : CW_MCNT), (unsigned*)(ws + (rep_ ? WS_PARTO : WS_MLIST))); SEAM(pb + 2); }
            if (PHON(4) && IN(pb + 3)) { LC(); unsigned char* ws = WSP();
                const int uw = 1, usb = C.vcu, per = C.G;
                REP(4) ph_moba_part(C, (const bf16*)(ws + WS_Q), (const bf16*)(ws + WS_K), (const bf16*)(ws + WS_V), PIN(1), (const unsigned*)(ws + WS_CTL) + CW_MCNT, (const unsigned*)(ws + WS_MLIST), (bf16*)(ws + WS_PARTO), (float*)(ws + WS_PARTML), uw, usb, per); SEAM(pb + 3); }
            if (PHON(5) && IN(pb + 4)) { LC(); unsigned char* ws = WSP(); REP(5) ph_moba_own(C, (const bf16*)(ws + WS_Q), (const bf16*)(ws + WS_K), (const bf16*)(ws + WS_V), PIN(1), (const bf16*)(ws + WS_PARTO), (const float*)(ws + WS_PARTML), ws + WS_O); SEAM(pb + 4); }
        } else {
            if (PHON(6) && IN(pb + 4)) { LC(); unsigned char* ws = WSP();
                REP(6) ph_fox(C, (const bf16*)(ws + WS_Q), (const bf16*)(ws + WS_K), (const bf16*)(ws + WS_V), (const float*)(ws + WS_CUM), (const unsigned*)(ws + WS_CTL) + CW_NORM + 256, ws + WS_O, (unsigned*)(ws + WS_CTL) + CW_FOXQ + rep_ * 64); SEAM(pb + 4); }
        }
        if (PHON(7) && IN(pb + 5)) { LC();
            unsigned char* ws = WSP();
            REP(7) {
            __syncthreads();
            int kk = D / 2; OPAQ(kk);
            pg8::Gemm g{(const bf16*)(ws + WS_O), (const bf16*)(ws + (l == 0 ? WS_WMO : WS_WFO)), T, D, kk}; PlainOrder<4> S{C.vcu, C.G, (T / 256) * 4};
            pg8::EpiBf16<0> E{(bf16*)(ws + WS_Z), D, nullptr, D, 0, 1.f / (OQ_SCALE * WQ_SCALE)};
            pg8::gemm_phase<pg8::EpiBf16<0>, PlainOrder<4>, true, true, false, true>(C.lds, g, S, E, C.tid);
            }
            SEAM(pb + 5);
        }
        if (PHON(8) && IN(pb + 6)) { LC(); unsigned char* ws = WSP(); REP(8) ph_ln1(C, PIN(0), l == 0 ? nullptr : (const bf16*)(ws + WS_XRES), (const bf16*)(ws + WS_Z), PIN(7) + l * D, PIN(8) + l * D, (bf16*)(ws + WS_AR), ws + WS_XB8); SEAM(pb + 6); }
        if (PHON(9) && IN(pb + 7)) { LC();
            __syncthreads();
            REP(16) if (PHON(16)) { __syncthreads(); unsigned char* ws = WSP(); int kk = 1536; OPAQ(kk);
              pg8::Gemm g{(const bf16*)(ws + WS_AR), (const bf16*)(ws + WS_WR) + (size_t)l * (512 * 1536), 2 * T, 512, kk}; RouterOrder S{C.vcu, C.G}; EpiF32<true> E{(float*)(ws + WS_LOGP), nullptr, NE, 0.f};
              pg8::gemm_phase<EpiF32<true>, RouterOrder, true, true>(C.lds, g, S, E, C.tid); }
            __syncthreads();
            REP(17) if (PHON(17)) { __syncthreads(); unsigned char* ws = WSP(); int kk = D / 2; OPAQ(kk);
              pg8::Gemm g{(const bf16*)(ws + WS_XB8), (const bf16*)(ws + WS_WSGU + (size_t)l * (512 * 1024)), T, 512, kk}; PlainOrder<2> S{C.vcu, C.G, (T / 256) * 2}; EpiSwiGLU<true> E{ws + WS_ACTSH, nullptr};
              pg8::gemm_phase<EpiSwiGLU<true>, PlainOrder<2>, true, true, false, true>(C.lds, g, S, E, C.tid); }
            SEAM(pb + 7);
        }
        if (PHON(10) && IN(pb + 8)) { LC(); unsigned char* ws = WSP(); REP(10) ph_route(C, (const float*)(ws + WS_LOGP), PIN(12) + l * NE, (int*)(ws + WS_TOPI), (float*)(ws + WS_GATE), (unsigned*)(ws + WS_CTL) + (rep_ ? 131072 : CW_ECNT) + l * NE); SEAM(pb + 8); }
        if (PHON(11) && IN(pb + 9)) { LC(); unsigned char* ws = WSP(); REP(11) { if (rep_) xcd_barrier(bar); ph_scatter(C, (const unsigned*)(ws + WS_CTL) + CW_ECNT + l * NE, (unsigned*)(ws + WS_CTL) + (rep_ ? 132096 : CW_ECUR) + l * NE, (const int*)(ws + WS_TOPI), (const float*)(ws + WS_GATE), (const bf16*)(ws + WS_XB8),
                                                                            (int*)(ws + WS_SLOTOF), (int*)(ws + WS_TOKOF), (float*)(ws + WS_GSLOT), (bf16*)(ws + WS_HS)); } SEAM(pb + 9); }
        if (PHON(12) && IN(pb + 10)) { LC();
            unsigned char* ws = WSP();
            build_tpre(C, (const unsigned*)(ws + WS_CTL) + CW_ECNT + l * NE);
            REP(12) {
            __syncthreads();
            int kk = D / 2; OPAQ(kk);
            pg8::Gemm g{(const bf16*)(ws + WS_XB8), (const bf16*)(ws + WS_WEGU), NSLOT_MAX, NE * 512, kk, (const int*)(ws + WS_TOKOF)}; ExpertOrder<1> S{C.vcu, C.G, (const LAS int*)(C.lds + TPRE_OFF)}; EpiSwiGLU<true> E{ws + WS_ACT, (const float*)(ws + WS_GSLOT)};
            pg8::gemm_phase<EpiSwiGLU<true>, ExpertOrder<1>, true, true, true, true>(C.lds, g, S, E, C.tid);
            }
            SEAM(pb + 10);
        }
        if (PHON(13) && IN(pb + 11)) { LC();
            { unsigned char* ws = WSP(); build_tpre(C, (const unsigned*)(ws + WS_CTL) + CW_ECNT + l * NE); }
            REP(18) if (PHON(18)) { __syncthreads(); unsigned char* ws = WSP(); int kk = DE / 2; OPAQ(kk);
              pg8::Gemm g{(const bf16*)(ws + WS_ACT), (const bf16*)(ws + WS_WEDN), NSLOT_MAX, NE * 1024, kk}; ExpertOrder<2> S{C.vcu, C.G, (const LAS int*)(C.lds + TPRE_OFF)}; EpiDown<true> E{(unsigned char*)(ws + WS_HS)};
              pg8::gemm_phase<EpiDown<true>, ExpertOrder<2>, true, true, false, true>(C.lds, g, S, E, C.tid); }
            __syncthreads();
            REP(19) if (PHON(19)) { __syncthreads(); unsigned char* ws = WSP(); int kk = DE / 2; OPAQ(kk);
              pg8::Gemm g{(const bf16*)(ws + WS_ACTSH), (const bf16*)(ws + WS_WSDN + (size_t)l * (1024 * 256)), T, D, kk}; PlainOrder<4> S{C.vcu, C.G, (T / 256) * 4}; EpiDown<true> E{(unsigned char*)(ws + WS_HS) + (size_t)NSLOT_MAX * 1024};
              pg8::gemm_phase<EpiDown<true>, PlainOrder<4>, true, true, false, true>(C.lds, g, S, E, C.tid); }
            SEAM(pb + 11);
        }
        if (PHON(14) && IN(pb + 12)) { LC();
            REP(14) { unsigned char* ws = WSP();
              ph_combine(C, (const bf16*)(ws + WS_AR), (const unsigned char*)(ws + WS_HS), (const int*)(ws + WS_SLOTOF), PIN(9) + l * D, PIN(10) + l * D, (bf16*)(ws + WS_XRES), ws + WS_XB8, l == 1 ? (float*)ldptr(PTAB, 19) : nullptr,
                         PIN(4), PIN(5), l == 0 ? (float*)(ws + WS_LOGF) : nullptr); }
            if (l == 0) { unsigned char* ws = WSP(); __syncthreads(); conv_experts(C, PIN(13), PIN(14), PIN(15), 1, ws + WS_WEGU, ws + WS_WEDN, C.vcu, C.G); }
            SEAM(pb + 12);
        }
    }
#undef IN
#undef SEAM
#undef PIN
#undef WSP
#undef OPAQ
#undef REP
#undef NREP
}
}

extern "C" void kernel_launch(void* const* d_in, const int* in_sizes, int n_in, void* d_out, int out_size, void* d_ws, size_t ws_size, hipStream_t stream) {
    using namespace mk;
    static int grid = 0;
    if (grid == 0) {
        if (n_in != 19 || in_sizes[0] != T * D || out_size != T * D || ws_size < WS_END) { fprintf(stderr, "kernel_launch: unexpected problem shape (n_in %d, in0 %d, out %d, ws %zu < %zu)\n", n_in, n_in > 0 ? in_sizes[0] : -1, out_size, ws_size, (size_t)WS_END); grid = -1; return; }
        int dev = 0, cus = 0, per_cu = 0;
        if (hipGetDevice(&dev) != hipSuccess || hipDeviceGetAttribute(&cus, hipDeviceAttributeMultiprocessorCount, dev) != hipSuccess) { grid = -1; return; }
        if (hipFuncSetAttribute((const void*)mk_fwd, hipFuncAttributeMaxDynamicSharedMemorySize, LDS_BYTES) != hipSuccess) { fprintf(stderr, "kernel_launch: hipFuncSetAttribute failed\n"); grid = -1; return; }
        if (hipOccupancyMaxActiveBlocksPerMultiprocessor(&per_cu, (const void*)mk_fwd, NTHR, LDS_BYTES) != hipSuccess || per_cu < 1) fprintf(stderr, "kernel_launch: occupancy query reports %d\n", per_cu);
        (void)hipGetLastError();
        grid = cus;
    }
    if (grid < 0) return;
    if (hipMemsetAsync((char*)d_ws + WS_CTL, 0, CTL_ZERO_BYTES, stream) != hipSuccess) return;
    Args a{};
    for (int i = 0; i < 19; ++i) a.in[i] = (const float*)d_in[i];
    a.out = (float*)d_out; a.ws = (unsigned char*)d_ws;
#if MK_MULTI
    for (int p = 0; p < NPH; ++p) {
        if (p == 2 || (p >= 15 && p <= 17)) continue;
        a.ph_lo = p; a.ph_hi = p + 1;
        hipLaunchKernelGGL(mk_fwd, dim3(grid), dim3(NTHR), LDS_BYTES, stream, a);
    }
#else
    a.ph_lo = 0; a.ph_hi = NPH;
    hipLaunchKernelGGL(mk_fwd, dim3(grid), dim3(NTHR), LDS_BYTES, stream, a);
#endif
    const hipError_t le = hipPeekAtLastError();
    if (le != hipSuccess) fprintf(stderr, "kernel_launch: launch failed: %s\n", hipGetErrorName(le));
}
```

```cpp
#include <hip/hip_runtime.h>
#include <cstdio>
#include <cstdint>
namespace pg8 {
#define PG8_LAS __attribute__((address_space(3)))
typedef unsigned short bf16_t;
typedef short bf16x8 __attribute__((ext_vector_type(8)));
typedef float f32x4 __attribute__((ext_vector_type(4)));
typedef unsigned u32x4 __attribute__((ext_vector_type(4)));
typedef int i32x4 __attribute__((ext_vector_type(4)));
typedef int i32x8 __attribute__((ext_vector_type(8)));
__device__ __forceinline__ i32x8 cat8(bf16x8 a, bf16x8 b) { return __builtin_shufflevector(__builtin_bit_cast(i32x4, a), __builtin_bit_cast(i32x4, b), 0, 1, 2, 3, 4, 5, 6, 7); }
constexpr int BM = 256, BK = 64, HALF = 128, HTB = HALF * BK * 2  , STAGE_BYTES = 8 * HTB, NXCD = 8, WGM = 8;

__host__ __device__ __forceinline__ int lds_byte(int r, int c) { const int st = (r >> 4) * 2 + (c >> 5), rr = r & 15, cc = c & 31, ob = rr * 64 + cc * 2; return st * 1024 + (ob ^ (((ob >> 9) & 1) << 5)); }
__host__ __device__ __forceinline__ void stage_rc(int b, int& R, int& C) { const int st = b / 1024, sb = b % 1024, swz = sb ^ (((sb >> 9) & 1) << 5); R = (st >> 1) * 16 + swz / 64; C = (st & 1) * 32 + (swz % 64) / 2; }
__host__ __device__ __forceinline__ int perm32(int rho) { const int n = rho >> 4, i = rho & 15; return 8 * (i >> 2) + 4 * n + (i & 3); }

struct Unit { int pm, pn; int hf = 0; };
struct Gemm { const bf16_t* A; const bf16_t* Bt; int M, N, K; const int* arow = nullptr; int lda = 0; };

struct StaticOrder {
    int nM, nN, nwg, G, c;
    __host__ __device__ void init(int M, int N, int G_, int c_) { nM = M / BM; nN = N / BM; nwg = nM * nN; G = G_; c = c_; }
    __host__ __device__ bool next(int i, Unit& u) const {
        const long L = (long)i * G + c; if (L >= nwg) return false;
        int wgid = (int)L; { const int q = nwg / NXCD, r = nwg % NXCD, xcd = wgid % NXCD, off = wgid / NXCD; wgid = (xcd < r ? xcd * (q + 1) : r * (q + 1) + (xcd - r) * q) + off; }
        const int nig = WGM * nN, gid = wgid / nig, fm = gid * WGM, gsz = (nM - fm) < WGM ? (nM - fm) : WGM;
        u.pm = fm + ((wgid % nig) % gsz); u.pn = (wgid % nig) / gsz; return true;
    }
    __device__ __forceinline__ void a_ready(const Unit&) const {}
    __device__ __forceinline__ void done(const Unit&) const {}
    __device__ __forceinline__ long a_off(const Unit&) const { return 0; }
};

__device__ __forceinline__ unsigned cvt_pk_bf16(float lo, float hi) { unsigned r; asm volatile("v_cvt_pk_bf16_f32 %0, %1, %2" : "=v"(r) : "v"(lo), "v"(hi)); return r; }
typedef float f32x2 __attribute__((ext_vector_type(2)));
__device__ __forceinline__ f32x2 gelu_pk(f32x2 v) {
    const f32x2 av = __builtin_elementwise_abs(v), d = av * 0.2316418882f + 1.0f;
    f32x2 t; t.x = __builtin_amdgcn_rcpf(d.x); t.y = __builtin_amdgcn_rcpf(d.y);
    f32x2 q = t * 0.5307027145f + (-0.7265760135f); q = q * t + 0.7107068705f; q = q * t + (-0.142248368f); q = q * t + 0.127414796f; q = q * t;
    const f32x2 s = (v * v) * (-0.72134752044f);
    f32x2 e; e.x = __builtin_amdgcn_exp2f(s.x); e.y = __builtin_amdgcn_exp2f(s.y);
    const f32x2 m = v * (q * e), r = v - m;
    f32x2 o; o.x = v.x < 0.f ? m.x : r.x; o.y = v.y < 0.f ? m.y : r.y; return o;
}

template <int ACT  > struct EpiBf16 {
    static constexpr bool PERM = true, AFTER_DRAIN = false; static_assert(ACT == 0 || ACT == 1, "EpiBf16: ACT is 0 (none) or 1 (gelu_pk)");
    bf16_t* O; int ldc; const float* bias; int split_cols; size_t split_stride; float scale0;
    __device__ __forceinline__ void operator()(const f32x4 (&acc)[2][2][4][2], const Unit& u, int wr, int wc, int fr, int fq) const {
        const int row0 = u.pm * BM + wr * 64 + fr; int colt = u.pn * BM; bf16_t* base = O;
        float sc = 1.f; if (split_cols) { const int t = colt / split_cols; base += (size_t)t * split_stride; colt -= t * split_cols; if (t == 0) sc = scale0; }
        const int col0 = colt + wc * 32 + 8 * fq, bcol0 = u.pn * BM + wc * 32 + 8 * fq;
        f32x4 bv[2][2];
#pragma unroll
        for (int bj = 0; bj < 2; ++bj)
#pragma unroll
            for (int n = 0; n < 2; ++n) bv[bj][n] = bias ? *(const f32x4*)(bias + bcol0 + bj * HALF + 4 * n) : (f32x4){0.f, 0.f, 0.f, 0.f};
#pragma unroll
        for (int ai = 0; ai < 2; ++ai)
#pragma unroll
            for (int m = 0; m < 4; ++m) { bf16_t* rowp = base + (size_t)(row0 + ai * HALF + m * 16) * ldc + col0;
#pragma unroll
                for (int bj = 0; bj < 2; ++bj) { f32x4 v0 = acc[ai][bj][m][0] + bv[bj][0], v1 = acc[ai][bj][m][1] + bv[bj][1];
                    if (ACT == 1) { f32x2 a = gelu_pk((f32x2){v0[0], v0[1]}), b = gelu_pk((f32x2){v0[2], v0[3]}), c = gelu_pk((f32x2){v1[0], v1[1]}), d = gelu_pk((f32x2){v1[2], v1[3]});
                        v0 = (f32x4){a.x, a.y, b.x, b.y}; v1 = (f32x4){c.x, c.y, d.x, d.y}; }
                    v0 = v0 * sc; v1 = v1 * sc; u32x4 w; w.x = cvt_pk_bf16(v0[0], v0[1]); w.y = cvt_pk_bf16(v0[2], v0[3]); w.z = cvt_pk_bf16(v1[0], v1[1]); w.w = cvt_pk_bf16(v1[2], v1[3]);
                    *(u32x4*)(rowp + bj * HALF) = w; } }
    }
};
template <class Epi, class Sched, bool ALIGN_EPI = false, bool SP2 = false, bool GATHER = false, bool F8 = false>
__device__ __forceinline__ void gemm_phase(PG8_LAS unsigned char* lds, const Gemm g, const Sched& S, const Epi& E, const int tid_in) {
    const int tid = tid_in,
              wid = __builtin_amdgcn_readfirstlane(tid >> 6), lane = tid & 63, wr = wid >> 2, wc = wid & 3, fr = lane & 15, fq = lane >> 4;
    const int K = g.K, nt = K / BK, KA = g.lda ? g.lda : K;
    unsigned voffA[2], voffB[2], voffA1[2], nvA0[2], nvA1[2]; int gR[2], gC[2];
#pragma unroll
    for (int i = 0; i < 2; ++i) { int R, C; stage_rc(tid * 16 + i * 8192, R, C); const int Rb = Epi::PERM ? ((R & ~31) + perm32(R & 31)) : R;
        voffA[i] = (unsigned)(R * KA + C) * 2u; voffB[i] = (unsigned)(Rb * K + C) * 2u; voffA1[i] = voffA[i]; nvA0[i] = voffA[i]; nvA1[i] = voffA[i]; gR[i] = R; gC[i] = C; }
    const size_t kstep = (size_t)(BK * 2);
    const size_t hstep = (size_t)HALF * K * 2;
    const size_t tstep = 2 * hstep;
    const size_t hstepA = (size_t)HALF * KA * 2, tstepA = 2 * hstepA;
    const unsigned ldsw = (unsigned)wid * 1024u;
    const unsigned ldsu = (unsigned)__builtin_amdgcn_readfirstlane((int)((unsigned)(uintptr_t)lds + ldsw));
    const int aoff = lds_byte(wr * 64 + fr, fq * 8), boff = lds_byte(wc * 32 + fr, fq * 8);
#define PG8_SA(b, h) (((b) * 2 + (h)) * HTB)
#define PG8_SB(b, h) ((4 + (b) * 2 + (h)) * HTB)
#define PG8_DMA(sbase, vo, ldsdst) do { unsigned keep_; asm volatile("s_mov_b32 %0, m0\n\ts_mov_b32 m0, %3\n\ts_nop 0\n\tglobal_load_lds_dwordx4 %1, %2\n\ts_mov_b32 m0, %0" : "=&s"(keep_) : "v"(vo), "s"(sbase), "s"(ldsdst) : "memory"); } while (0)
#define PG8_STAGE(bufoff, gbase, voff) do { _Pragma("unroll") for (int _i = 0; _i < 2; ++_i) PG8_DMA((const char*)(gbase), (voff)[_i], ldsu + (unsigned)((bufoff) + _i * 8192)); } while (0)
#define PG8_GROW(dst0, dst1, pm_) do { if constexpr (GATHER) { _Pragma("unroll") for (int _i = 0; _i < 2; ++_i) { const int r0_ = g.arow[(pm_) * 256 + gR[_i]], r1_ = g.arow[(pm_) * 256 + 128 + gR[_i]]; \
        dst0[_i] = (unsigned)(r0_ * K + gC[_i]) * 2u; dst1[_i] = (unsigned)(r1_ * K + gC[_i]) * 2u; } } } while (0)
#define PG8_STAGE_A(bufoff, h, koff, nx) do { if constexpr (GATHER) { _Pragma("unroll") for (int _i = 0; _i < 2; ++_i) { const unsigned vo_ = (nx) ? ((h) ? nvA1[_i] : nvA0[_i]) : ((h) ? voffA1[_i] : voffA[_i]); \
        PG8_DMA((const char*)g.A + (koff), vo_, ldsu + (unsigned)((bufoff) + _i * 8192)); } } \
    else { PG8_STAGE(bufoff, ((nx) ? nA : cA) + (koff) + ((h) ? hstepA : 0), voffA); } } while (0)
#define PG8_LDA(dst, b, h) do { _Pragma("unroll") for (int m = 0; m < 4; ++m) _Pragma("unroll") for (int k = 0; k < 2; ++k) dst[m][k] = *(const PG8_LAS bf16x8*)(lds + PG8_SA(b, h) + aoff + m * 2048 + k * 1024); } while (0)
#define PG8_LDB(dst, b, h) do { _Pragma("unroll") for (int n = 0; n < 2; ++n) _Pragma("unroll") for (int k = 0; k < 2; ++k) dst[n][k] = *(const PG8_LAS bf16x8*)(lds + PG8_SB(b, h) + boff + n * 2048 + k * 1024); } while (0)
#define PG8_MMA(ai, bj, At, Bt) do { __builtin_amdgcn_s_setprio(1); _Pragma("unroll") for (int m = 0; m < 4; ++m) _Pragma("unroll") for (int n = 0; n < 2; ++n) { \
        if constexpr (F8) acc[ai][bj][m][n] = __builtin_amdgcn_mfma_scale_f32_16x16x128_f8f6f4(cat8(Bt[n][0], Bt[n][1]), cat8(At[m][0], At[m][1]), acc[ai][bj][m][n], 0, 0, 0, 0, 0, 0); \
        else { _Pragma("unroll") for (int k = 0; k < 2; ++k) acc[ai][bj][m][n] = __builtin_amdgcn_mfma_f32_16x16x32_bf16(Bt[n][k], At[m][k], acc[ai][bj][m][n], 0, 0, 0); } } __builtin_amdgcn_s_setprio(0); } while (0)
#define PG8_WAIT_V(n) asm volatile("s_waitcnt vmcnt(" #n ")" ::: "memory")
#define PG8_WAIT_L(n) asm volatile("s_waitcnt lgkmcnt(" #n ")" ::: "memory")
#define PG8_BAR __builtin_amdgcn_s_barrier()
#define PG8_SCHED __builtin_amdgcn_sched_barrier(0)
    Unit cur, nxt; int ui = 0;
    if (!S.next(0, cur)) return;
    f32x4 acc[2][2][4][2];
    float zz = 0.f; asm volatile("" : "+v"(zz));
#pragma unroll
    for (int a = 0; a < 2; ++a)
#pragma unroll
        for (int b = 0; b < 2; ++b)
#pragma unroll
            for (int m = 0; m < 4; ++m)
#pragma unroll
                for (int n = 0; n < 2; ++n) acc[a][b][m][n] = (f32x4){zz, zz, zz, zz};
    bf16x8 At[4][2], B0[2][2], B1[2][2];
    const char* cA = (const char*)g.A + (size_t)cur.pm * tstepA + S.a_off(cur); const char* cB = (const char*)g.Bt + (size_t)cur.pn * tstep;
    S.a_ready(cur);
    PG8_GROW(voffA, voffA1, cur.pm);
    const char* nA = cA; const char* nB = cB;
    if constexpr (SP2) {
        PG8_STAGE(PG8_SB(0, 0), cB, voffB); PG8_STAGE(PG8_SB(0, 1), cB + hstep, voffB); PG8_STAGE_A(PG8_SA(0, 0), 0, 0, false); PG8_STAGE_A(PG8_SA(0, 1), 1, 0, false);
        if (wr == 1) PG8_BAR;
        PG8_WAIT_V(2); PG8_BAR;
        PG8_STAGE(PG8_SB(1, 0), cB + kstep, voffB); PG8_STAGE_A(PG8_SA(1, 0), 0, kstep, false); PG8_STAGE(PG8_SB(1, 1), cB + hstep + kstep, voffB);
        PG8_WAIT_V(6); PG8_BAR;
    } else {
        PG8_STAGE(PG8_SB(0, 0), cB, voffB); PG8_STAGE(PG8_SA(0, 0), cA, voffA); PG8_STAGE(PG8_SB(0, 1), cB + hstep, voffB); PG8_STAGE(PG8_SA(0, 1), cA + hstepA, voffA);
        if (wr == 1) PG8_BAR;
        PG8_WAIT_V(4); PG8_BAR;
        PG8_STAGE(PG8_SB(1, 0), cB + kstep, voffB); PG8_STAGE(PG8_SA(1, 0), cA + kstep, voffA); PG8_STAGE(PG8_SB(1, 1), cB + hstep + kstep, voffB);
        PG8_WAIT_V(6); PG8_BAR;
    }
    for (;;) {
        const bool has_next = S.next(ui + 1, nxt);
        nA = has_next ? (const char*)g.A + (size_t)nxt.pm * tstepA + S.a_off(nxt) : cA; nB = has_next ? (const char*)g.Bt + (size_t)nxt.pn * tstep : cB;
        if constexpr (GATHER) { if (has_next) PG8_GROW(nvA0, nvA1, nxt.pm); else { _Pragma("unroll") for (int _i = 0; _i < 2; ++_i) { nvA0[_i] = voffA[_i]; nvA1[_i] = voffA1[_i]; } } }
        for (int t = 0; t < nt; t += 2) {
            const bool last = (t == nt - 2);
            const size_t ko1 = (size_t)(t + 1) * kstep, ko2 = last ? 0 : (size_t)(t + 2) * kstep, ko3 = ko2 + kstep;
            const char* b2 = last ? nB : cB + (size_t)(t + 2) * kstep;
            const char* b3 = b2 + kstep;
            if (last && has_next) S.a_ready(nxt);
            if constexpr (SP2) {
            PG8_LDB(B0, 0, 0); PG8_LDB(B1, 0, 1); PG8_SCHED; PG8_LDA(At, 0, 0); PG8_STAGE_A(PG8_SA(1, 1), 1, ko1, false);
            PG8_WAIT_V(8); PG8_WAIT_L(0); PG8_BAR; PG8_MMA(0, 0, At, B0); PG8_MMA(0, 1, At, B1); PG8_BAR; PG8_SCHED;
            PG8_LDA(At, 0, 1); PG8_STAGE(PG8_SB(0, 0), b2, voffB); PG8_STAGE(PG8_SB(0, 1), b2 + hstep, voffB); PG8_STAGE_A(PG8_SA(0, 0), 0, ko2, last);
            PG8_WAIT_V(8); PG8_WAIT_L(0); PG8_BAR; if (!cur.hf) { PG8_MMA(1, 0, At, B0); PG8_MMA(1, 1, At, B1); } PG8_BAR; PG8_SCHED;
            PG8_LDB(B0, 1, 0); PG8_LDB(B1, 1, 1); PG8_SCHED; PG8_LDA(At, 1, 0); PG8_STAGE_A(PG8_SA(0, 1), 1, ko2, last);
            PG8_WAIT_V(8); PG8_WAIT_L(0); PG8_BAR; PG8_MMA(0, 0, At, B0); PG8_MMA(0, 1, At, B1); PG8_BAR; PG8_SCHED;
            PG8_LDA(At, 1, 1); PG8_STAGE(PG8_SB(1, 0), b3, voffB); PG8_STAGE(PG8_SB(1, 1), b3 + hstep, voffB); PG8_STAGE_A(PG8_SA(1, 0), 0, ko3, last);
            PG8_WAIT_V(8); PG8_WAIT_L(0); PG8_BAR; if (!cur.hf) { PG8_MMA(1, 0, At, B0); PG8_MMA(1, 1, At, B1); } PG8_BAR; PG8_SCHED;
            } else {
            const char* a1 = cA + ko1; const char* a2 = (last ? nA : cA) + ko2; const char* a3 = a2 + kstep;
            PG8_LDB(B0, 0, 0); PG8_SCHED; PG8_LDA(At, 0, 0); PG8_STAGE(PG8_SA(1, 1), a1 + hstepA, voffA);
            PG8_WAIT_L(8); PG8_BAR; PG8_WAIT_L(0); PG8_MMA(0, 0, At, B0); PG8_BAR; PG8_SCHED;
            PG8_LDB(B1, 0, 1); PG8_STAGE(PG8_SB(0, 0), b2, voffB);
            PG8_BAR; PG8_WAIT_L(0); PG8_MMA(0, 1, At, B1); PG8_BAR;
            PG8_LDA(At, 0, 1); PG8_STAGE(PG8_SA(0, 0), a2, voffA);
            PG8_BAR; PG8_WAIT_L(0); PG8_MMA(1, 0, At, B0); PG8_BAR; PG8_SCHED;
            PG8_STAGE(PG8_SB(0, 1), b2 + hstep, voffB);
            PG8_WAIT_V(6); PG8_BAR; PG8_MMA(1, 1, At, B1); PG8_BAR;
            PG8_LDB(B0, 1, 0); PG8_SCHED; PG8_LDA(At, 1, 0); PG8_STAGE(PG8_SA(0, 1), a2 + hstepA, voffA);
            PG8_WAIT_L(8); PG8_BAR; PG8_WAIT_L(0); PG8_MMA(0, 0, At, B0); PG8_BAR; PG8_SCHED;
            PG8_LDB(B1, 1, 1); PG8_STAGE(PG8_SB(1, 0), b3, voffB);
            PG8_BAR; PG8_WAIT_L(0); PG8_MMA(0, 1, At, B1); PG8_BAR;
            PG8_LDA(At, 1, 1); PG8_STAGE(PG8_SA(1, 0), a3, voffA);
            PG8_BAR; PG8_WAIT_L(0); PG8_MMA(1, 0, At, B0); PG8_BAR; PG8_SCHED;
            PG8_STAGE(PG8_SB(1, 1), b3 + hstep, voffB);
            PG8_WAIT_V(6); PG8_BAR; PG8_MMA(1, 1, At, B1); PG8_BAR;
            }
        }
        if constexpr (ALIGN_EPI) { if (wr == 0) PG8_BAR; }
        if constexpr (!Epi::AFTER_DRAIN) { E(acc, cur, wr, wc, fr, fq); S.done(cur); }
        if (!has_next) break;
        zz = 0.f; asm volatile("" : "+v"(zz));
#pragma unroll
        for (int a = 0; a < 2; ++a)
#pragma unroll
            for (int b = 0; b < 2; ++b)
#pragma unroll
                for (int m = 0; m < 4; ++m)
#pragma unroll
                    for (int n = 0; n < 2; ++n) acc[a][b][m][n] = (f32x4){zz, zz, zz, zz};
        cur = nxt; cA = nA; cB = nB; ++ui;
        if constexpr (GATHER) { _Pragma("unroll") for (int _i = 0; _i < 2; ++_i) { voffA[_i] = nvA0[_i]; voffA1[_i] = nvA1[_i]; } }
        if constexpr (ALIGN_EPI) { if (wr == 1) PG8_BAR; }
    }
    PG8_WAIT_V(0);
    if constexpr (!ALIGN_EPI) { if (wr == 0) PG8_BAR; }
    PG8_BAR;
    if constexpr (Epi::AFTER_DRAIN) { E.fused(acc, cur, wr, wc, fr, fq, lds, wid, lane); S.done(cur); }
#undef PG8_SA
#undef PG8_SB
#undef PG8_STAGE
#undef PG8_DMA
#undef PG8_STAGE_A
#undef PG8_GROW
#undef PG8_LDA
#undef PG8_LDB
#undef PG8_MMA
#undef PG8_WAIT_V
#undef PG8_WAIT_L
#undef PG8_BAR
#undef PG8_SCHED
}
}
#define GAS __attribute__((address_space(1)))
#define LAS __attribute__((address_space(3)))
typedef unsigned short bf16;
typedef unsigned v4u __attribute__((ext_vector_type(4)));
typedef float f32x4 __attribute__((ext_vector_type(4)));
typedef short bf16x8 __attribute__((ext_vector_type(8)));
typedef GAS unsigned gu32;
typedef GAS unsigned long long gu64;
#define RLX_AGENT __ATOMIC_RELAXED, __HIP_MEMORY_SCOPE_AGENT
#define LDS_WAIT() asm volatile("s_waitcnt lgkmcnt(0)" ::: "memory")
#define VM_WAIT() asm volatile("s_waitcnt vmcnt(0)" ::: "memory")
__device__ __forceinline__ int lane_now() { int l; asm volatile("v_mbcnt_lo_u32_b32 %0, -1, 0\n\tv_mbcnt_hi_u32_b32 %0, -1, %0" : "=v"(l)); return l; }
__device__ __forceinline__ int shfl_xor_l(int v, int o) { return __builtin_amdgcn_ds_bpermute((lane_now() ^ o) << 2, v); }
__device__ __forceinline__ unsigned shfl_xor_l(unsigned v, int o) { return (unsigned)shfl_xor_l((int)v, o); }
__device__ __forceinline__ float shfl_xor_l(float v, int o) { return __builtin_bit_cast(float, shfl_xor_l(__builtin_bit_cast(int, v), o)); }
__device__ __forceinline__ int shfl_up_l(int v, int o) { const int l = lane_now(), s = l - o; return __builtin_amdgcn_ds_bpermute((s < 0 ? l : s) << 2, v); }
__device__ __forceinline__ float shfl_up_l(float v, int o) { return __builtin_bit_cast(float, shfl_up_l(__builtin_bit_cast(int, v), o)); }
#define __shfl_xor(v, o) shfl_xor_l((v), (o))
#define __shfl_up(v, o) shfl_up_l((v), (o))
__device__ __forceinline__ unsigned long long rt() { return __builtin_amdgcn_s_memrealtime(); }
__device__ __forceinline__ unsigned f2bf(float f) { unsigned u = __builtin_bit_cast(unsigned, f); return (u + 0x7fffu + ((u >> 16) & 1u)) >> 16; }
__device__ __forceinline__ unsigned pk2(float lo, float hi) { return f2bf(lo) | (f2bf(hi) << 16); }

#define XB_TMO      128
#define XB_XCNT(j)  (256  + 64 * (j))
#define XB_XSUB(j)  (1280 + 64 * (j))
#define XB_XGEN(j)  (2304 + 64 * (j))
#define XB_TOP      3328
#define XB_TOPGEN   3392
#define XCD_BAR_WORDS 3456
#define XB_SPIN_CAP (1u << 18)

__device__ __forceinline__ unsigned xb_ld(unsigned* p)              { return __hip_atomic_load(p, __ATOMIC_RELAXED, __HIP_MEMORY_SCOPE_AGENT); }
__device__ __forceinline__ unsigned xb_add(unsigned* p, unsigned v) { return __hip_atomic_fetch_add(p, v, __ATOMIC_RELAXED, __HIP_MEMORY_SCOPE_AGENT); }
__device__ __forceinline__ unsigned xb_xcc_id() { return (unsigned)__builtin_amdgcn_s_getreg((3 << 11) | 20) & 0xFu; }
#define XB_SPIN(cond, bar) do { unsigned _sp = 0; while (cond) { __builtin_amdgcn_s_sleep(1); \
    if ((++_sp & 255u) == 0u) { if (xb_ld(&(bar)[XB_TMO])) break; if (_sp > XB_SPIN_CAP) { atomicAdd(&(bar)[XB_TMO], 1u); break; } } } } while (0)

struct XcdBarrier {
    unsigned* bar; unsigned x;
    volatile LAS unsigned* st;
};

__device__ __forceinline__ XcdBarrier xcd_barrier_post(unsigned* bar, volatile LAS unsigned* st) {
    XcdBarrier b; b.bar = bar; b.x = xb_xcc_id(); b.st = st;
    if (threadIdx.x == 0) (void)xb_add(&bar[XB_XCNT(b.x)], 1u);
    return b;
}
__device__ __forceinline__ void xcd_barrier_complete(unsigned* bar, unsigned x, unsigned& nloc, unsigned& nx) {
    const unsigned G = gridDim.x * gridDim.y * gridDim.z;
    unsigned sum, cnt, mine, sp = 0u;
    for (;;) {
        sum = 0u; cnt = 0u; mine = 0u;
#pragma unroll
        for (unsigned j = 0; j < 16; ++j) { const unsigned c = xb_ld(&bar[XB_XCNT(j)]); sum += c; cnt += (c > 0u) ? 1u : 0u; mine = (j == x) ? c : mine; }
        if (sum == G) break;
        __builtin_amdgcn_s_sleep(1);
        if ((++sp & 255u) == 0u) { if (xb_ld(&bar[XB_TMO])) break; if (sp > XB_SPIN_CAP) { atomicAdd(&bar[XB_TMO], 1u); break; } }
    }
    nloc = mine > 0u ? mine : 1u; nx = cnt > 0u ? cnt : 1u;
}

__device__ __forceinline__ void xcd_barrier(const XcdBarrier& b) {
    asm volatile("s_waitcnt vmcnt(0)" ::: "memory");
    __syncthreads();
    if (threadIdx.x == 0) {
        unsigned* bar = b.bar;
        __builtin_amdgcn_s_waitcnt(0);
        unsigned nloc = b.st[0], nx = b.st[1];
        if (nloc == 0u) { xcd_barrier_complete(bar, b.x, nloc, nx); b.st[0] = nloc; b.st[1] = nx; }
        const unsigned old = xb_add(&bar[XB_XSUB(b.x)], 1u);
        const unsigned gen = old / nloc;
        if (old + 1u == (gen + 1u) * nloc) {
            __builtin_amdgcn_fence(__ATOMIC_RELEASE, "agent");
            asm volatile("s_waitcnt vmcnt(0)" ::: "memory");
            const unsigned og = xb_add(&bar[XB_TOP], 1u);
            const unsigned tg = og / nx;
            if (og + 1u == (tg + 1u) * nx) xb_add(&bar[XB_TOPGEN], 1u);
            else XB_SPIN(xb_ld(&bar[XB_TOPGEN]) == tg, bar);
            __builtin_amdgcn_fence(__ATOMIC_ACQUIRE, "agent");
            xb_add(&bar[XB_XGEN(b.x)], 1u);
            asm volatile("s_waitcnt vmcnt(0)" ::: "memory");
        } else {
            XB_SPIN(xb_ld(&bar[XB_XGEN(b.x)]) == gen, bar);
            __builtin_amdgcn_fence(__ATOMIC_ACQUIRE, "agent");
            asm volatile("s_waitcnt vmcnt(0)" ::: "memory");
        }
    }
    __syncthreads();
}
namespace mk {
typedef float f32x16 __attribute__((ext_vector_type(16)));
typedef float f32x2 __attribute__((ext_vector_type(2)));
typedef short s16x4 __attribute__((ext_vector_type(4)));
typedef unsigned u32x2 __attribute__((ext_vector_type(2)));
typedef unsigned u32x4 __attribute__((ext_vector_type(4)));

constexpr int NWAVES = 8, NTHR = 512;
constexpr int BATCH = 4, SEQ = 8192, D = 1024, H = 16, HD = 64, T = BATCH * SEQ;
constexpr int NE = 256, TOPK = 8, DE = 256, NGRP = 8, GRPSZ = 32;
constexpr int NBLK = SEQ / 256;
constexpr int NSLOT_MAX = 327680;
constexpr float LN_EPS = 1e-5f;
constexpr float DN_ALPHA = 1.4142135623730951f;
constexpr float ROUTED_SCALE = 2.5f;
constexpr float LOG2E = 1.4426950408889634f;
constexpr float C2 = 0.125f * LOG2E;
constexpr float XQ_SCALE = 16.f, WQ_SCALE = 256.f, AQ_SCALE = 64.f, OQ_SCALE = 64.f, F8_MAX = 448.f;
constexpr float GS_FOLD = AQ_SCALE / (XQ_SCALE * WQ_SCALE);
constexpr int FOXW = 3 * D + H;

constexpr size_t MiB = 1u << 20;
constexpr size_t WS_CTL = 0, CTL_ZERO_BYTES = 1 * MiB;
constexpr size_t WS_WMI = 2 * MiB;
constexpr size_t WS_WMO = 8 * MiB;
constexpr size_t WS_WFI = 10 * MiB;
constexpr size_t WS_WFO = 16 * MiB;
constexpr size_t WS_WR = 18 * MiB;
constexpr size_t WS_WSGU = 21 * MiB;
constexpr size_t WS_WSDN = 23 * MiB;
constexpr size_t WS_WEGU = 24 * MiB;
constexpr size_t WS_WEDN = 280 * MiB;
constexpr size_t WS_XRES = 408 * MiB;
constexpr size_t WS_Z = 536 * MiB;
constexpr size_t WS_XB8 = 600 * MiB;
constexpr size_t WS_XB = 664 * MiB;
constexpr size_t WS_AR = 728 * MiB;
constexpr size_t WS_LOGP = 920 * MiB;
constexpr size_t WS_ACTSH = 984 * MiB;
constexpr size_t WS_TOPI = 1000 * MiB;
constexpr size_t WS_GATE = 1001 * MiB;
constexpr size_t WS_SLOTOF = 1002 * MiB;
constexpr size_t WS_TOKOF = 1003 * MiB;
constexpr size_t WS_GSLOT = 1005 * MiB;
constexpr size_t WS_KMEAN = 1008 * MiB;
constexpr size_t WS_LOGF = 1009 * MiB;
constexpr size_t WS_CUM = 1011 * MiB;
constexpr size_t WS_OVL = 1016 * MiB;
constexpr size_t WS_Q = WS_OVL, WS_K = WS_OVL + 64 * MiB, WS_V = WS_OVL + 128 * MiB, WS_O = WS_OVL + 192 * MiB;
constexpr size_t WS_MLIST = WS_OVL + 256 * MiB;
constexpr size_t WS_PARTO = WS_OVL + 288 * MiB;
constexpr size_t WS_PARTML = WS_OVL + 480 * MiB;
constexpr size_t WS_HS = WS_OVL;
constexpr size_t WS_ACT = WS_OVL + 640 * MiB;
constexpr size_t WS_END = WS_OVL + 800 * MiB;
static_assert(WS_END <= 2048 * MiB, "d_ws map");
static_assert(WS_PARTML + (size_t)T * H * 3 * 2 * 4 <= WS_END, "attention overlay");
constexpr int MLIST_PER_BH = 256 * 496;
constexpr int CW_BAR = 4096;
constexpr int CW_MCNT = 16384;
constexpr int CW_ECNT = 20480;
constexpr int CW_ECUR = 21504;
constexpr int CW_FOXQ = 24576;
constexpr int CW_KSUM = 131072;
constexpr int CW_NORM = 24832;
constexpr int RING_BYTES = 131072, LDSCTL_OFF = 155648, MISC_OFF = LDSCTL_OFF + 320, TPRE_OFF = LDSCTL_OFF + 1024, PTAB_OFF = LDSCTL_OFF + 4096, LDS_BYTES = 163840;
typedef __bf16 bf16x2_t __attribute__((ext_vector_type(2)));
__device__ __forceinline__ unsigned cvtpk(float lo, float hi) { f32x2 v = {lo, hi}; bf16x2_t b = __builtin_convertvector(v, bf16x2_t); return __builtin_bit_cast(unsigned, b); }
__device__ __forceinline__ float bf2f(unsigned b) { return __uint_as_float(b << 16); }
__device__ __forceinline__ float bflo(unsigned w) { return __uint_as_float(w << 16); }
__device__ __forceinline__ float bfhi(unsigned w) { return __uint_as_float(w & 0xffff0000u); }
__device__ __forceinline__ float wave_sum(float v) {
#pragma unroll
    for (int o = 1; o < 64; o <<= 1) v += __shfl_xor(v, o);
    return v;
}
__device__ __forceinline__ unsigned sort_key(float x) { const unsigned b = __float_as_uint(x); return b ^ ((unsigned)((int)b >> 31) | 0x80000000u); }
__device__ __forceinline__ int crow(int r, int hi) { return (r & 3) + 8 * (r >> 2) + 4 * hi; }
__device__ __forceinline__ s16x4 vtr(const LAS unsigned char* p) { typedef short v4i16_t __attribute__((ext_vector_type(4))); return __builtin_bit_cast(s16x4, __builtin_amdgcn_ds_read_tr16_b64_v4i16((LAS v4i16_t*)p)); }

__device__ __forceinline__ unsigned long long ldptr(const LAS unsigned long long* tab, int i) { const unsigned long long v = tab[i]; const unsigned lo = __builtin_amdgcn_readfirstlane((unsigned)v), hi = __builtin_amdgcn_readfirstlane((unsigned)(v >> 32)); return ((unsigned long long)hi << 32) | lo; }

struct Ctx {
    LAS unsigned char* lds;
    int tid, lane, wave, vcu, G;
};

template <bool LO> __device__ __forceinline__ void tr_item(const float* src, size_t ld, bf16* dst, size_t dpitch, LAS float* scr, int lane) {
#pragma unroll 8
    for (int i = 0; i < 32; ++i) { const int kk = 2 * i + (lane >> 5); scr[kk * 33 + (lane & 31)] = src[(size_t)kk * ld + (lane & 31)]; }
    LDS_WAIT(); asm volatile("" ::: "memory");
    const int c = lane & 7;
#pragma unroll
    for (int j = 0; j < 4; ++j) { const int n = (lane >> 3) + 8 * j; const LAS float* s = scr + (8 * c) * 33 + n;
        float v[8];
#pragma unroll
        for (int i = 0; i < 8; ++i) { v[i] = s[i * 33]; if (LO) v[i] = v[i] - bf2f(f2bf(v[i])); }
        v4u o; o.x = pk2(v[0], v[1]); o.y = pk2(v[2], v[3]); o.z = pk2(v[4], v[5]); o.w = pk2(v[6], v[7]);
        *(GAS v4u*)(dst + (size_t)n * dpitch + 8 * c) = o; }
    LDS_WAIT(); asm volatile("" ::: "memory");
}

__device__ __forceinline__ void tr_item64(const float* src, size_t ld, bf16* dst0, size_t rstride, LAS unsigned char* scr, int lane) {
    float v[64];
    const GAS float* p = (const GAS float*)src + lane;
#pragma unroll
    for (int k = 0; k < 64; ++k) v[k] = p[(size_t)k * ld];
#pragma unroll
    for (int c = 0; c < 8; ++c) { v4u o; o.x = cvtpk(v[8 * c], v[8 * c + 1]); o.y = cvtpk(v[8 * c + 2], v[8 * c + 3]); o.z = cvtpk(v[8 * c + 4], v[8 * c + 5]); o.w = cvtpk(v[8 * c + 6], v[8 * c + 7]);
        *(LAS v4u*)(scr + lane * 144 + c * 16) = o; }
    LDS_WAIT(); asm volatile("" ::: "memory");
#pragma unroll
    for (int i = 0; i < 8; ++i) { const int row = 8 * i + (lane >> 3), c = lane & 7; const v4u o = *(const LAS v4u*)(scr + row * 144 + c * 16);
        *(GAS v4u*)(dst0 + (size_t)row * rstride + 8 * c) = o; }
    LDS_WAIT(); asm volatile("" ::: "memory");
}
__device__ __forceinline__ unsigned pk4_f8(float a, float b, float c, float d) {
    a = __builtin_amdgcn_fmed3f(a, -F8_MAX, F8_MAX); b = __builtin_amdgcn_fmed3f(b, -F8_MAX, F8_MAX); c = __builtin_amdgcn_fmed3f(c, -F8_MAX, F8_MAX); d = __builtin_amdgcn_fmed3f(d, -F8_MAX, F8_MAX);
    unsigned w = 0u; w = (unsigned)__builtin_amdgcn_cvt_pk_fp8_f32(a, b, (int)w, false); w = (unsigned)__builtin_amdgcn_cvt_pk_fp8_f32(c, d, (int)w, true); return w;
}
__device__ __forceinline__ void tr_item_f8(const float* src, size_t ld, unsigned char* dst0, size_t rstride, LAS unsigned char* scr, int lane) {
#pragma unroll 1
    for (int h = 0; h < 2; ++h) {
        float v[64];
        const GAS float* p = (const GAS float*)src + lane + (size_t)(64 * h) * ld;
#pragma unroll
        for (int k = 0; k < 64; ++k) v[k] = __builtin_nontemporal_load(p + (size_t)k * ld);
#pragma unroll
        for (int c = 0; c < 4; ++c) { v4u o;
            o.x = pk4_f8(v[16 * c] * WQ_SCALE, v[16 * c + 1] * WQ_SCALE, v[16 * c + 2] * WQ_SCALE, v[16 * c + 3] * WQ_SCALE); o.y = pk4_f8(v[16 * c + 4] * WQ_SCALE, v[16 * c + 5] * WQ_SCALE, v[16 * c + 6] * WQ_SCALE, v[16 * c + 7] * WQ_SCALE);
            o.z = pk4_f8(v[16 * c + 8] * WQ_SCALE, v[16 * c + 9] * WQ_SCALE, v[16 * c + 10] * WQ_SCALE, v[16 * c + 11] * WQ_SCALE); o.w = pk4_f8(v[16 * c + 12] * WQ_SCALE, v[16 * c + 13] * WQ_SCALE, v[16 * c + 14] * WQ_SCALE, v[16 * c + 15] * WQ_SCALE);
            *(LAS v4u*)(scr + lane * 144 + h * 64 + c * 16) = o; }
    }
    LDS_WAIT(); asm volatile("" ::: "memory");
#pragma unroll
    for (int i = 0; i < 8; ++i) { const int row = 8 * i + (lane >> 3), c = lane & 7; const v4u o = *(const LAS v4u*)(scr + row * 144 + c * 16);
        *(GAS v4u*)(dst0 + (size_t)row * rstride + 16 * c) = o; }
    LDS_WAIT(); asm volatile("" ::: "memory");
}
__device__ __forceinline__ void conv_experts(const Ctx& C, const float* wg, const float* wu, const float* wd, int l, unsigned char* WEGU, unsigned char* WEDN, int part, int nparts) {
    const int gw = part * NWAVES + C.wave, NGW = nparts * NWAVES, lane = C.lane;
    LAS unsigned char* scr = C.lds + C.wave * 9216;
    constexpr int IG = NE * 8 * 4;
    constexpr int IDN = NE * 2 * 16;
    for (int it = gw; it < 2 * IG + IDN; it += NGW) {
        if (it < 2 * IG) {
            const int up = it >= IG, r = it - up * IG, e = r >> 5, kb = (r >> 2) & 7, nb = r & 3, n0 = 64 * nb;
            const float* src = (up ? wu : wg) + ((size_t)(l * NE + e) * 1024 + 128 * kb) * 256 + 64 * nb;
            unsigned char* dst = WEGU + ((size_t)e * 512 + (n0 >> 7) * 256 + up * 128 + (n0 & 127)) * 1024 + 128 * kb;
            tr_item_f8(src, 256, dst, 1024, scr, lane);
        } else {
            const int r = it - 2 * IG, e = r >> 5, kb = (r >> 4) & 1, nb = r & 15;
            const float* src = wd + ((size_t)(l * NE + e) * 256 + 128 * kb) * 1024 + 64 * nb;
            unsigned char* dst = WEDN + ((size_t)e * 1024 + 64 * nb) * 256 + 128 * kb;
            tr_item_f8(src, 1024, dst, 256, scr, lane);
        }
    }
}

struct SmallW {
    const float *moba_in, *moba_out, *fox_in, *fox_out, *w_router, *ws_gate, *ws_up, *ws_down;
    unsigned char *WMI, *WFI, *WMO, *WFO, *WSGU, *WSDN;
    bf16 *WR;
};
__device__ __forceinline__ void conv_small(const Ctx& C, const SmallW& W) {
    LAS float* scr = (LAS float*)(C.lds + C.wave * 16384);
    const int gw = C.vcu * NWAVES + C.wave, NGW = C.G * NWAVES;
    constexpr int I_IN = 8 * 48  , I_OUT = 8 * 16, I_R = 16 * 8, I_SG = 8 * 4, I_SD = 2 * 16;
    constexpr int NIT = 2 * I_IN + 2 * I_OUT + 2 * (3 * I_R) + 2 * (2 * I_SG + I_SD);
    for (int it = gw; it < NIT; it += NGW) {
        int r = it;
        if (r < I_IN) { const int kb = r / 48, nb = r % 48; tr_item_f8(W.moba_in + (size_t)(128 * kb) * 3072 + 64 * nb, 3072, W.WMI + (size_t)(64 * nb) * 1024 + 128 * kb, 1024, (LAS unsigned char*)scr, C.lane); continue; } r -= I_IN;
        if (r < I_IN) { const int kb = r / 48, nb = r % 48; tr_item_f8(W.fox_in + (size_t)(128 * kb) * FOXW + 64 * nb, FOXW, W.WFI + (size_t)(64 * nb) * 1024 + 128 * kb, 1024, (LAS unsigned char*)scr, C.lane); continue; } r -= I_IN;
        if (r < I_OUT) { const int kb = r >> 4, nb = r & 15; tr_item_f8(W.moba_out + (size_t)(128 * kb) * 1024 + 64 * nb, 1024, W.WMO + (size_t)(64 * nb) * 1024 + 128 * kb, 1024, (LAS unsigned char*)scr, C.lane); continue; } r -= I_OUT;
        if (r < I_OUT) { const int kb = r >> 4, nb = r & 15; tr_item_f8(W.fox_out + (size_t)(128 * kb) * 1024 + 64 * nb, 1024, W.WFO + (size_t)(64 * nb) * 1024 + 128 * kb, 1024, (LAS unsigned char*)scr, C.lane); continue; } r -= I_OUT;
        if (r < 6 * I_R) {
            const int l = r / (3 * I_R), q = (r % (3 * I_R)) / I_R, s = r % I_R, kb = s >> 3, nb = s & 7;
            const float* src = W.w_router + ((size_t)l * 1024 + 64 * kb) * 256 + 32 * nb;
            bf16* base = W.WR + (size_t)l * (512 * 1536) + (size_t)(32 * nb) * 1536;
            if (q == 0) tr_item<false>(src, 256, base + 64 * kb, 1536, scr, C.lane);
            else if (q == 1) { if (kb < 8) tr_item<false>(src, 256, base + 1024 + 64 * kb, 1536, scr, C.lane); else tr_item<false>(src, 256, base + (size_t)256 * 1536 + 64 * (kb - 8), 1536, scr, C.lane); }
            else tr_item<true>(src, 256, base + (size_t)256 * 1536 + 512 + 64 * kb, 1536, scr, C.lane);
            continue; } r -= 6 * I_R;
        {
            constexpr int PER = 2 * I_SG + I_SD; const int l = r / PER; int s = r % PER;
            if (s < 2 * I_SG) { const int up = s >= I_SG; s -= up * I_SG; const int kb = s >> 2, nb = s & 3, n0 = 64 * nb;
                const float* src = (up ? W.ws_up : W.ws_gate) + ((size_t)l * 1024 + 128 * kb) * 256 + n0;
                tr_item_f8(src, 256, W.WSGU + (size_t)l * (512 * 1024) + (size_t)((n0 >> 7) * 256 + up * 128 + (n0 & 127)) * 1024 + 128 * kb, 1024, (LAS unsigned char*)scr, C.lane); }
            else { s -= 2 * I_SG; const int kb = s >> 4, nb = s & 15;
                tr_item_f8(W.ws_down + ((size_t)l * 256 + 128 * kb) * 1024 + 64 * nb, 1024, W.WSDN + (size_t)l * (1024 * 256) + (size_t)(64 * nb) * 256 + 128 * kb, 256, (LAS unsigned char*)scr, C.lane); }
        }
    }
}
__device__ __forceinline__ void to_f8_rows(const Ctx& C, const float* x, unsigned char* xb8) {
    const size_t n16 = (size_t)T * D / 16;
    for (size_t i = (size_t)C.vcu * NTHR + C.tid; i < n16; i += (size_t)C.G * NTHR) {
        const f32x4 a = *(const GAS f32x4*)(x + 16 * i) * XQ_SCALE, b = *(const GAS f32x4*)(x + 16 * i + 4) * XQ_SCALE, c = *(const GAS f32x4*)(x + 16 * i + 8) * XQ_SCALE, d = *(const GAS f32x4*)(x + 16 * i + 12) * XQ_SCALE;
        v4u o; o.x = pk4_f8(a.x, a.y, a.z, a.w); o.y = pk4_f8(b.x, b.y, b.z, b.w); o.z = pk4_f8(c.x, c.y, c.z, c.w); o.w = pk4_f8(d.x, d.y, d.z, d.w);
        *(GAS v4u*)(xb8 + 16 * i) = o;
    }
}

template <bool COL0> struct EpiF32 {
    static constexpr bool PERM = false, AFTER_DRAIN = false;
    float* out; const float* base; int ldc; float alpha;
    __device__ __forceinline__ void operator()(const pg8::f32x4 (&acc)[2][2][4][2], const pg8::Unit& u, int wr, int wc, int fr, int fq) const {
        const int row0 = u.pm * 256 + wr * 64 + fr, col0 = (COL0 ? 0 : u.pn * 256) + wc * 32 + 4 * fq;
#pragma unroll
        for (int ai = 0; ai < 2; ++ai)
#pragma unroll
            for (int m = 0; m < 4; ++m) { const size_t off = (size_t)(row0 + ai * 128 + m * 16) * ldc + col0;
#pragma unroll
                for (int bj = 0; bj < 2; ++bj)
#pragma unroll
                    for (int n = 0; n < 2; ++n) { f32x4 v = acc[ai][bj][m][n];
                        if (base) { const f32x4 b = *(const GAS f32x4*)(base + off + bj * 128 + n * 16); v = v + b * alpha; }
                        *(GAS f32x4*)(out + off + bj * 128 + n * 16) = v; } }
    }
};
struct EpiQKV {
    static constexpr bool PERM = true, AFTER_DRAIN = false;
    bf16* Qb; size_t split_stride; float scale0; unsigned* norms;
    float* ksum;
    __device__ __forceinline__ void operator()(const pg8::f32x4 (&acc)[2][2][4][2], const pg8::Unit& u, int wr, int wc, int fr, int fq) const {
        asm volatile("" : "+v"(fr), "+v"(fq));
        const int t = u.pn >> 2, colt = (u.pn & 3) * 256;
        constexpr float IS = 1.f / (XQ_SCALE * WQ_SCALE);
        bf16* base = Qb + (size_t)t * split_stride; const float sc = (t == 0 ? scale0 : 1.f) * IS;
        const int row0 = u.pm * 256 + wr * 64 + fr, col0 = colt + wc * 32 + 8 * fq;
        float nmax[2] = {0.f, 0.f};
#pragma unroll
        for (int ai = 0; ai < 2; ++ai)
#pragma unroll
            for (int m = 0; m < 4; ++m) { bf16* rowp = base + (size_t)(row0 + ai * 128 + m * 16) * D + col0;
#pragma unroll
                for (int bj = 0; bj < 2; ++bj) { const f32x4 v0 = acc[ai][bj][m][0] * sc, v1 = acc[ai][bj][m][1] * sc;
                    v4u w; w.x = cvtpk(v0[0], v0[1]); w.y = cvtpk(v0[2], v0[3]); w.z = cvtpk(v1[0], v1[1]); w.w = cvtpk(v1[2], v1[3]);
                    *(GAS v4u*)(rowp + bj * 128) = w;
                    if (t < 2) { float ss = (v0[0] * v0[0] + v0[1] * v0[1]) + (v0[2] * v0[2] + v0[3] * v0[3]) + (v1[0] * v1[0] + v1[1] * v1[1]) + (v1[2] * v1[2] + v1[3] * v1[3]);
                        ss += __shfl_xor(ss, 16); ss += __shfl_xor(ss, 32); nmax[bj] = fmaxf(nmax[bj], ss); } } }
        if (t == 1 && ksum) {
#pragma unroll
            for (int bj = 0; bj < 2; ++bj)
#pragma unroll
                for (int n = 0; n < 2; ++n) { f32x4 cs = (f32x4){0.f, 0.f, 0.f, 0.f};
#pragma unroll
                    for (int ai = 0; ai < 2; ++ai)
#pragma unroll
                        for (int m = 0; m < 4; ++m) cs = cs + acc[ai][bj][m][n];
#pragma unroll
                    for (int i = 0; i < 4; ++i) { float v = cs[i];
#pragma unroll
                        for (int o = 1; o < 16; o <<= 1) v += __shfl_xor(v, o);
                        if (fr == 0) (void)__hip_atomic_fetch_add(ksum + (size_t)u.pm * D + colt + bj * 128 + wc * 32 + 8 * fq + 4 * n + i, v * IS, __ATOMIC_RELAXED, __HIP_MEMORY_SCOPE_AGENT); } }
        }
        if (t < 2) {
#pragma unroll
            for (int bj = 0; bj < 2; ++bj) { float v = nmax[bj];
#pragma unroll
                for (int o = 1; o < 16; o <<= 1) v = fmaxf(v, __shfl_xor(v, o));
                const int head = (u.pn & 3) * 4 + 2 * bj + (wc >> 1), b = u.pm >> 5;
                if (fr == 0 && fq == 0) (void)__hip_atomic_fetch_max(norms + ((b * 16 + head) * 2 + t) * 2 + (wc & 1), __float_as_uint(v * 1.01f), __ATOMIC_RELAXED, __HIP_MEMORY_SCOPE_AGENT); }
        }
    }
};
template <bool F8> struct EpiSwiGLU {
    static constexpr bool PERM = true, AFTER_DRAIN = false;
    void* actp; const float* rowscale;
    __device__ __forceinline__ void operator()(const pg8::f32x4 (&acc)[2][2][4][2], const pg8::Unit& u, int wr, int wc, int fr, int fq) const {
        asm volatile("" : "+v"(fr), "+v"(fq));
        const int row0 = u.pm * 256 + wr * 64 + fr, col0 = (u.pn & 1) * 128 + wc * 32 + 8 * fq;
        const int ln = fr + 16 * fq, src4 = ((ln >> 2) + 16 * (ln & 3)) << 2, srow0 = u.pm * 256 + wr * 64 + (ln >> 2), scol0 = (u.pn & 1) * 128 + wc * 32 + 8 * (ln & 3);
        constexpr float IS = F8 ? 1.f / (XQ_SCALE * WQ_SCALE) : 1.f;
#pragma unroll
        for (int ai = 0; ai < 2; ++ai) if (ai == 0 || !u.hf)
#pragma unroll
            for (int m = 0; m < 4; ++m) { const int row = row0 + ai * 128 + m * 16; const float rs = rowscale ? rowscale[row] : (F8 ? GS_FOLD : 1.f);
                float o[8];
#pragma unroll
                for (int n = 0; n < 2; ++n)
#pragma unroll
                    for (int i = 0; i < 4; ++i) { const float g = acc[ai][0][m][n][i] * IS, up = acc[ai][1][m][n][i];
                        const float sg = g * __builtin_amdgcn_rcpf(1.f + __builtin_amdgcn_exp2f(-g * LOG2E)); o[4 * n + i] = sg * up * rs; }
                if constexpr (F8) { u32x2 w; w.x = pk4_f8(o[0], o[1], o[2], o[3]); w.y = pk4_f8(o[4], o[5], o[6], o[7]);
                    w.x = (unsigned)__builtin_amdgcn_ds_bpermute(src4, (int)w.x); w.y = (unsigned)__builtin_amdgcn_ds_bpermute(src4, (int)w.y);
                    *(GAS u32x2*)((unsigned char*)actp + (size_t)(srow0 + ai * 128 + m * 16) * 256 + scol0) = w; }
                else { v4u w; w.x = cvtpk(o[0], o[1]); w.y = cvtpk(o[2], o[3]); w.z = cvtpk(o[4], o[5]); w.w = cvtpk(o[6], o[7]);
                    *(GAS v4u*)((bf16*)actp + (size_t)row * 256 + col0) = w; } }
    }
};
constexpr float SO_SCALE = 64.f, SO_INV = 1.f / 64.f;
template <bool F8> struct EpiDown {
    static constexpr bool PERM = true, AFTER_DRAIN = false;
    static constexpr float sc = F8 ? SO_SCALE / (AQ_SCALE * WQ_SCALE) : SO_SCALE;
    unsigned char* out;
    __device__ __forceinline__ void operator()(const pg8::f32x4 (&acc)[2][2][4][2], const pg8::Unit& u, int wr, int wc, int fr, int fq) const {
        const int ln = fr + 16 * fq, src4 = ((ln >> 2) + 16 * (ln & 3)) << 2, fr2 = ln >> 2, fq2 = ln & 3;
        const int row0 = u.pm * 256 + wr * 64 + fr2, col0 = (u.pn & 3) * 256 + wc * 32 + 8 * fq2;
#pragma unroll
        for (int ai = 0; ai < 2; ++ai) if (ai == 0 || !u.hf)
#pragma unroll
            for (int m = 0; m < 4; ++m) { unsigned char* rowp = out + (size_t)(row0 + ai * 128 + m * 16) * 1024 + col0;
#pragma unroll
                for (int bj = 0; bj < 2; ++bj) { const f32x4 v0 = acc[ai][bj][m][0] * sc, v1 = acc[ai][bj][m][1] * sc;
                    u32x2 w; w.x = 0u; w.y = 0u;
                    w.x = __builtin_amdgcn_cvt_pk_fp8_f32(v0[0], v0[1], w.x, false); w.x = __builtin_amdgcn_cvt_pk_fp8_f32(v0[2], v0[3], w.x, true);
                    w.y = __builtin_amdgcn_cvt_pk_fp8_f32(v1[0], v1[1], w.y, false); w.y = __builtin_amdgcn_cvt_pk_fp8_f32(v1[2], v1[3], w.y, true);
                    w.x = (unsigned)__builtin_amdgcn_ds_bpermute(src4, (int)w.x); w.y = (unsigned)__builtin_amdgcn_ds_bpermute(src4, (int)w.y);
                    *(GAS u32x2*)(rowp + bj * 128) = w; } }
    }
};
template <int NN> struct PlainOrder {
    int vcu, G, nunits;
    __device__ __forceinline__ bool next(int i, pg8::Unit& u) const { const int idx = vcu + i * G; if (idx >= nunits) return false;
        u.pm = __builtin_amdgcn_readfirstlane(idx / NN); u.pn = __builtin_amdgcn_readfirstlane(idx % NN);
        int z = 0; asm volatile("" : "+s"(z)); u.hf = z;
        return true; }
    __device__ __forceinline__ void a_ready(const pg8::Unit&) const {}
    __device__ __forceinline__ void done(const pg8::Unit&) const {}
    __device__ __forceinline__ long a_off(const pg8::Unit&) const { return 0; }
};
struct RouterOrder {
    int vcu, G;
    __device__ __forceinline__ bool next(int i, pg8::Unit& u) const { const int idx = vcu + i * G; if (idx >= 256) return false; u.pm = idx; u.pn = idx >> 7; return true; }
    __device__ __forceinline__ void a_ready(const pg8::Unit&) const {}
    __device__ __forceinline__ void done(const pg8::Unit&) const {}
    __device__ __forceinline__ long a_off(const pg8::Unit& u) const { return u.pn ? -(long)128 * (256L * 2048 * 2) : 1024L; }
};
template <int SH> struct ExpertOrder {
    int vcu, G; const LAS int* tpre;
    __device__ __forceinline__ bool next(int i, pg8::Unit& u) const {
        const int idx = vcu + i * G, ti = idx >> SH; if (ti >= tpre[NE]) return false;
        int lo = 0, hi = NE;
#pragma unroll
        for (int s = 0; s < 8; ++s) { const int mid = (lo + hi) >> 1; if (tpre[mid] <= ti) lo = mid; else hi = mid; }
        u.pm = __builtin_amdgcn_readfirstlane(ti); u.pn = __builtin_amdgcn_readfirstlane((lo << SH) + (idx & ((1 << SH) - 1)));
        u.hf = __builtin_amdgcn_readfirstlane((tpre[272 + lo] - 256 * (ti - tpre[lo])) <= 128 ? 1 : 0); return true;
    }
    __device__ __forceinline__ void a_ready(const pg8::Unit&) const {}
    __device__ __forceinline__ void done(const pg8::Unit&) const {}
    __device__ __forceinline__ long a_off(const pg8::Unit&) const { return 0; }
};
__device__ __forceinline__ void build_tpre(const Ctx& C, const unsigned* ecnt) {
    LAS int* tpre = (LAS int*)(C.lds + TPRE_OFF);
    __syncthreads();
    int v = 0;
    if (C.tid < NE) { const int c = (int)__hip_atomic_load(ecnt + C.tid, __ATOMIC_RELAXED, __HIP_MEMORY_SCOPE_AGENT); v = (c + 255) >> 8; tpre[272 + C.tid] = c; }
    int inc = v;
#pragma unroll
    for (int o = 1; o < 64; o <<= 1) { const int t = __shfl_up(inc, o); if (C.lane >= o) inc += t; }
    if (C.tid < NE && C.lane == 63) tpre[260 + C.wave] = inc;
    __syncthreads();
    if (C.tid < NE) { int base = 0; for (int w = 0; w < C.wave; ++w) base += tpre[260 + w]; tpre[C.tid + 1] = base + inc; if (C.tid == 0) tpre[0] = 0; }
    __syncthreads();
}
struct AttnAcc { float m; f32x16 o0, o1, la; };
#define MFMA32(a, b, c) __builtin_amdgcn_mfma_f32_32x32x16_bf16((a), (b), (c), 0, 0, 0)
constexpr float NEG_INF = -__builtin_inff();

__device__ __forceinline__ void glds16(const void* gsrc, unsigned lds_dst) { unsigned keep;
    asm volatile("s_mov_b32 %0, m0\n\ts_mov_b32 m0, %2\n\ts_nop 0\n\tglobal_load_lds_dwordx4 %1, off\n\ts_mov_b32 m0, %0" : "=&s"(keep) : "v"(gsrc), "s"(lds_dst) : "memory"); }
__device__ __forceinline__ void glds4(const void* gsrc, unsigned lds_dst) { unsigned keep;
    asm volatile("s_mov_b32 %0, m0\n\ts_mov_b32 m0, %2\n\ts_nop 0\n\tglobal_load_lds_dword %1, off\n\ts_mov_b32 m0, %0" : "=&s"(keep) : "v"(gsrc), "s"(lds_dst) : "memory"); }
__device__ __forceinline__ unsigned lds_addr(const LAS unsigned char* p) { return (unsigned)__builtin_amdgcn_readfirstlane((int)(unsigned)(uintptr_t)p); }
__device__ __forceinline__ void dma_tile(const bf16* Kg, const bf16* Vg, LAS unsigned char* Ks, LAS unsigned char* Vs, int wave, int lane) {
    { const int kr = 8 * wave + (lane >> 3), kc = (lane & 7) ^ ((kr >> 1) & 7); glds16(Kg + (size_t)kr * D + kc * 8, lds_addr(Ks + wave * 1024)); }
    glds16(Vg + (size_t)(16 * (wave & 3) + (lane >> 2)) * D + (wave >> 2) * 32 + (lane & 3) * 8, lds_addr(Vs + wave * 1024));
}
__device__ __forceinline__ void load_q(bf16x8 (&qr)[4], const bf16* Qrow, int hi) {
#pragma unroll
    for (int d0 = 0; d0 < 4; ++d0) qr[d0] = *(const GAS bf16x8*)(Qrow + d0 * 16 + hi * 8);
}
template <class Bias> __device__ __forceinline__ void qk_tile(f32x16& p0, f32x16& p1, const bf16x8 (&qr)[4], const LAS unsigned char* Ks, int r32, int hi, const Bias& B) {
    __builtin_amdgcn_sched_barrier(0);
    B.init(p0, p1, hi);
    const LAS unsigned char* kb = Ks + r32 * 128; const int ko = (hi ^ ((r32 >> 1) & 7)) << 4;
    bf16x8 kf[8];
#pragma unroll
    for (int d0 = 0; d0 < 4; ++d0) { kf[2 * d0] = *(const LAS bf16x8*)(kb + (ko ^ (d0 << 5))); kf[2 * d0 + 1] = *(const LAS bf16x8*)(kb + (ko ^ (d0 << 5)) + 4096); }
    __builtin_amdgcn_sched_barrier(0);
#pragma unroll
    for (int d0 = 0; d0 < 4; ++d0) { p0 = MFMA32(kf[2 * d0], qr[d0], p0); p1 = MFMA32(kf[2 * d0 + 1], qr[d0], p1); }
    B.mask(p0, p1, hi);
    __builtin_amdgcn_sched_barrier(0);
}
constexpr float ATT_THR = 8.f;
__device__ __forceinline__ float half_max(float m) { auto rr = __builtin_amdgcn_permlane32_swap(__float_as_uint(m), __float_as_uint(m), false, false); return fmaxf(__uint_as_float(rr[0]), __uint_as_float(rr[1])); }
__device__ __forceinline__ void attn_rescale(AttnAcc& A, float rm) {
    const bool need = rm > A.m + ATT_THR;
    if (__any(need)) {
        const float mn = need ? rm : A.m, f = __builtin_amdgcn_exp2f(A.m - mn);
        A.la[0] *= f;
#pragma unroll
        for (int r = 0; r < 16; ++r) { A.o0[r] *= f; A.o1[r] *= f; }
        A.m = mn;
    }
}
__device__ __forceinline__ void softmax_pv(AttnAcc& A, f32x16& p0, f32x16& p1, const LAS unsigned char* Vs, int hi, int lane) {
    __builtin_amdgcn_sched_barrier(0);
    const LAS unsigned char* vb = Vs + ((lane >> 4) & 1) * 32 + (lane & 3) * 8 + (4 * hi + ((lane & 15) >> 2)) * 64;
    s16x4 vt[16];
#pragma unroll
    for (int ks = 0; ks < 4; ++ks) { vt[4 * ks] = vtr(vb + ks * 1024); vt[4 * ks + 1] = vtr(vb + ks * 1024 + 512); vt[4 * ks + 2] = vtr(vb + (4 + ks) * 1024); vt[4 * ks + 3] = vtr(vb + (4 + ks) * 1024 + 512); }
    __builtin_amdgcn_sched_barrier(0);
    float rm = fmaxf(p0[0], p1[0]);
#pragma unroll
    for (int r = 1; r < 16; ++r) rm = fmaxf(fmaxf(rm, p0[r]), p1[r]);
    rm = half_max(rm);
    attn_rescale(A, rm);
    const float mn = A.m;
#pragma unroll
    for (int r = 0; r < 16; ++r) { p0[r] = __builtin_amdgcn_exp2f(p0[r] - mn); p1[r] = __builtin_amdgcn_exp2f(p1[r] - mn); }
    v4u pw[4];
#pragma unroll
    for (int s = 0; s < 2; ++s) {
        pw[s].x = cvtpk(p0[8 * s + 0], p0[8 * s + 1]); pw[s].y = cvtpk(p0[8 * s + 2], p0[8 * s + 3]); pw[s].z = cvtpk(p0[8 * s + 4], p0[8 * s + 5]); pw[s].w = cvtpk(p0[8 * s + 6], p0[8 * s + 7]);
        pw[2 + s].x = cvtpk(p1[8 * s + 0], p1[8 * s + 1]); pw[2 + s].y = cvtpk(p1[8 * s + 2], p1[8 * s + 3]); pw[2 + s].z = cvtpk(p1[8 * s + 4], p1[8 * s + 5]); pw[2 + s].w = cvtpk(p1[8 * s + 6], p1[8 * s + 7]);
    }
    const bf16x8 ones = {(short)0x3F80, (short)0x3F80, (short)0x3F80, (short)0x3F80, (short)0x3F80, (short)0x3F80, (short)0x3F80, (short)0x3F80};
#pragma unroll
    for (int ks = 0; ks < 4; ++ks) {
        const bf16x8 pa = __builtin_bit_cast(bf16x8, pw[ks]);
        const s16x4 a0 = vt[4 * ks], a1 = vt[4 * ks + 1], b0 = vt[4 * ks + 2], b1 = vt[4 * ks + 3];
        const bf16x8 v0 = {a0[0], a0[1], a0[2], a0[3], a1[0], a1[1], a1[2], a1[3]}, v1 = {b0[0], b0[1], b0[2], b0[3], b1[0], b1[1], b1[2], b1[3]};
        A.o0 = MFMA32(v0, pa, A.o0); A.o1 = MFMA32(v1, pa, A.o1); A.la = MFMA32(ones, pa, A.la);
    }
    __builtin_amdgcn_sched_barrier(0);
}
__device__ __forceinline__ void acc_init(AttnAcc& A) {
    A.m = NEG_INF;
    float z = 0.f; asm volatile("" : "+v"(z));
#pragma unroll
    for (int r = 0; r < 16; ++r) { A.o0[r] = z; A.o1[r] = z; A.la[r] = z; }
}
#define ATT_SB() __builtin_amdgcn_sched_barrier(0)
template <class Bias> __device__ __forceinline__ void attn_step(AttnAcc& A, f32x16& pc0, f32x16& pc1, f32x16& pn0, f32x16& pn1, const bf16x8 (&qr)[4],
                                                               const LAS unsigned char* Kn, const LAS unsigned char* Vc, int r32, int hi, int lane, const Bias& Bn, const bool doNext) {
    ATT_SB();
    if (doNext) Bn.init(pn0, pn1, hi);
    const LAS unsigned char* kb = Kn + r32 * 128; const int ko = (hi ^ ((r32 >> 1) & 7)) << 4;
    bf16x8 ka[4], kc[4];
#pragma unroll
    for (int d0 = 0; d0 < 2; ++d0) { ka[2 * d0] = *(const LAS bf16x8*)(kb + (ko ^ (d0 << 5))); ka[2 * d0 + 1] = *(const LAS bf16x8*)(kb + (ko ^ (d0 << 5)) + 4096); }
    ATT_SB();
    float ra = fmaxf(fmaxf(pc0[0], pc0[1]), fmaxf(pc0[2], pc0[3]));
    if (doNext) pn0 = MFMA32(ka[0], qr[0], pn0);
    ra = fmaxf(fmaxf(ra, pc1[0]), pc1[1]); ra = fmaxf(fmaxf(ra, pc1[2]), pc1[3]); ATT_SB();
    if (doNext) pn1 = MFMA32(ka[1], qr[0], pn1);
#pragma unroll
    for (int d0 = 2; d0 < 4; ++d0) { kc[2 * d0 - 4] = *(const LAS bf16x8*)(kb + (ko ^ (d0 << 5))); kc[2 * d0 - 3] = *(const LAS bf16x8*)(kb + (ko ^ (d0 << 5)) + 4096); }
    ra = fmaxf(fmaxf(ra, pc0[4]), pc0[5]); ra = fmaxf(fmaxf(ra, pc0[6]), pc0[7]); ra = fmaxf(fmaxf(ra, pc1[4]), pc1[5]); ra = fmaxf(fmaxf(ra, pc1[6]), pc1[7]); ATT_SB();
    if (doNext) pn0 = MFMA32(ka[2], qr[1], pn0);
    ra = fmaxf(fmaxf(ra, pc0[8]), pc0[9]); ra = fmaxf(fmaxf(ra, pc0[10]), pc0[11]); ra = fmaxf(fmaxf(ra, pc1[8]), pc1[9]); ra = fmaxf(fmaxf(ra, pc1[10]), pc1[11]); ATT_SB();
    if (doNext) pn1 = MFMA32(ka[3], qr[1], pn1);
    ra = fmaxf(fmaxf(ra, pc0[12]), pc0[13]); ra = fmaxf(fmaxf(ra, pc0[14]), pc0[15]); ra = fmaxf(fmaxf(ra, pc1[12]), pc1[13]); ra = fmaxf(fmaxf(ra, pc1[14]), pc1[15]);
    ra = half_max(ra); ATT_SB();
    attn_rescale(A, ra);
    const float mn = A.m;
    ATT_SB();
    const LAS unsigned char* vb = Vc + ((lane >> 4) & 1) * 32 + (lane & 3) * 8 + (4 * hi + ((lane & 15) >> 2)) * 64;
    s16x4 vt[16];
    v4u pw[4];
#define ATT_VRD(ks) do { vt[4 * (ks)] = vtr(vb + (ks) * 1024); vt[4 * (ks) + 1] = vtr(vb + (ks) * 1024 + 512); vt[4 * (ks) + 2] = vtr(vb + (4 + (ks)) * 1024); vt[4 * (ks) + 3] = vtr(vb + (4 + (ks)) * 1024 + 512); } while (0)
#define ATT_EXP4(P, c) do { _Pragma("unroll") for (int i_ = 0; i_ < 4; ++i_) P[4 * (c) + i_] = __builtin_amdgcn_exp2f(P[4 * (c) + i_] - mn); } while (0)
    ATT_VRD(0); ATT_VRD(1); ATT_SB();
    if (doNext) pn0 = MFMA32(kc[0], qr[2], pn0); ATT_EXP4(pc0, 0); ATT_EXP4(pc0, 1);
    pw[0].x = cvtpk(pc0[0], pc0[1]); pw[0].y = cvtpk(pc0[2], pc0[3]); pw[0].z = cvtpk(pc0[4], pc0[5]); pw[0].w = cvtpk(pc0[6], pc0[7]); ATT_SB();
    if (doNext) pn1 = MFMA32(kc[1], qr[2], pn1); ATT_EXP4(pc0, 2); ATT_EXP4(pc0, 3);
    pw[1].x = cvtpk(pc0[8], pc0[9]); pw[1].y = cvtpk(pc0[10], pc0[11]); pw[1].z = cvtpk(pc0[12], pc0[13]); pw[1].w = cvtpk(pc0[14], pc0[15]); ATT_SB();
    ATT_VRD(2); ATT_VRD(3); ATT_SB();
    if (doNext) pn0 = MFMA32(kc[2], qr[3], pn0); ATT_EXP4(pc1, 0); ATT_EXP4(pc1, 1);
    pw[2].x = cvtpk(pc1[0], pc1[1]); pw[2].y = cvtpk(pc1[2], pc1[3]); pw[2].z = cvtpk(pc1[4], pc1[5]); pw[2].w = cvtpk(pc1[6], pc1[7]); ATT_SB();
    if (doNext) pn1 = MFMA32(kc[3], qr[3], pn1); ATT_EXP4(pc1, 2); ATT_EXP4(pc1, 3);
    pw[3].x = cvtpk(pc1[8], pc1[9]); pw[3].y = cvtpk(pc1[10], pc1[11]); pw[3].z = cvtpk(pc1[12], pc1[13]); pw[3].w = cvtpk(pc1[14], pc1[15]); ATT_SB();
#undef ATT_EXP4
#undef ATT_VRD
    if (doNext) Bn.mask(pn0, pn1, hi);
    ATT_SB();
    const bf16x8 ones = {(short)0x3F80, (short)0x3F80, (short)0x3F80, (short)0x3F80, (short)0x3F80, (short)0x3F80, (short)0x3F80, (short)0x3F80};
#pragma unroll
    for (int ks = 0; ks < 4; ++ks) {
        const bf16x8 pa = __builtin_bit_cast(bf16x8, pw[ks]);
        const s16x4 a0 = vt[4 * ks], a1 = vt[4 * ks + 1], b0 = vt[4 * ks + 2], b1 = vt[4 * ks + 3];
        const bf16x8 v0 = {a0[0], a0[1], a0[2], a0[3], a1[0], a1[1], a1[2], a1[3]}, v1 = {b0[0], b0[1], b0[2], b0[3], b1[0], b1[1], b1[2], b1[3]};
        A.o0 = MFMA32(v0, pa, A.o0); A.o1 = MFMA32(v1, pa, A.o1); A.la = MFMA32(ones, pa, A.la);
    }
    ATT_SB();
}

template <class Bias> __device__ __forceinline__ void attn_step3(AttnAcc& A, f32x16& pc0, f32x16& pc1, f32x16& pn0, f32x16& pn1, const v4u (&pwp)[4], v4u (&pw)[4], const bf16x8 (&qr)[4],
        const LAS unsigned char* Kn, const LAS unsigned char* Vp, int r32, int hi, int lane, const Bias& Bn, const bool doCur) {
    const bf16x8 ones = {(short)0x3F80, (short)0x3F80, (short)0x3F80, (short)0x3F80, (short)0x3F80, (short)0x3F80, (short)0x3F80, (short)0x3F80};
    const LAS unsigned char* kb = Kn + r32 * 128; const int ko = (hi ^ ((r32 >> 1) & 7)) << 4;
    const LAS unsigned char* vb = Vp + ((lane >> 4) & 1) * 32 + (lane & 3) * 8 + (4 * hi + ((lane & 15) >> 2)) * 64;
    bf16x8 ka[2], kc[2]; s16x4 va[4], vc[4], vd[4], ve[4];
#define ATT_VRD(dst, ks) do { dst[0] = vtr(vb + (ks) * 1024); dst[1] = vtr(vb + (ks) * 1024 + 512); dst[2] = vtr(vb + (4 + (ks)) * 1024); dst[3] = vtr(vb + (4 + (ks)) * 1024 + 512); } while (0)
#define ATT_V0(v) ((bf16x8){v[0][0], v[0][1], v[0][2], v[0][3], v[1][0], v[1][1], v[1][2], v[1][3]})
#define ATT_V1(v) ((bf16x8){v[2][0], v[2][1], v[2][2], v[2][3], v[3][0], v[3][1], v[3][2], v[3][3]})
#define ATT_PA(k) __builtin_bit_cast(bf16x8, pwp[k])
#define ATT_PIN(x) asm volatile("" : "+v"(x))
    ATT_SB();
    Bn.init(pn0, pn1, hi);
    ka[0] = *(const LAS bf16x8*)(kb + ko); ka[1] = *(const LAS bf16x8*)(kb + ko + 4096); kc[0] = *(const LAS bf16x8*)(kb + (ko ^ 32)); kc[1] = *(const LAS bf16x8*)(kb + (ko ^ 32) + 4096);
    ATT_VRD(va, 0);
    ATT_SB();
    float ra = fmaxf(fmaxf(pc0[0], pc0[1]), fmaxf(pc0[2], pc0[3]));
    pn0 = MFMA32(ka[0], qr[0], pn0);
    A.o0 = MFMA32(ATT_V0(va), ATT_PA(0), A.o0);
    ra = fmaxf(fmaxf(ra, pc1[0]), pc1[1]); ra = fmaxf(fmaxf(ra, pc1[2]), pc1[3]); ra = fmaxf(fmaxf(ra, pc0[4]), pc0[5]); ra = fmaxf(fmaxf(ra, pc0[6]), pc0[7]); ATT_PIN(ra);
    ATT_VRD(vc, 1);
    ATT_SB();
    pn1 = MFMA32(ka[1], qr[0], pn1);
    A.o1 = MFMA32(ATT_V1(va), ATT_PA(0), A.o1);
    ra = fmaxf(fmaxf(ra, pc1[4]), pc1[5]); ra = fmaxf(fmaxf(ra, pc1[6]), pc1[7]); ra = fmaxf(fmaxf(ra, pc0[8]), pc0[9]); ra = fmaxf(fmaxf(ra, pc0[10]), pc0[11]); ATT_PIN(ra);
    ka[0] = *(const LAS bf16x8*)(kb + (ko ^ 64)); ka[1] = *(const LAS bf16x8*)(kb + (ko ^ 64) + 4096);
    ATT_SB();
    pn0 = MFMA32(kc[0], qr[1], pn0);
    A.la = MFMA32(ones, ATT_PA(0), A.la); A.o0 = MFMA32(ATT_V0(vc), ATT_PA(1), A.o0);
    ATT_VRD(vd, 2);
    ra = fmaxf(fmaxf(ra, pc1[8]), pc1[9]); ra = fmaxf(fmaxf(ra, pc1[10]), pc1[11]); ra = fmaxf(fmaxf(ra, pc0[12]), pc0[13]); ra = fmaxf(fmaxf(ra, pc0[14]), pc0[15]); ATT_PIN(ra); ATT_SB();
    pn1 = MFMA32(kc[1], qr[1], pn1);
    A.o1 = MFMA32(ATT_V1(vc), ATT_PA(1), A.o1); A.la = MFMA32(ones, ATT_PA(1), A.la);
    ATT_VRD(ve, 3);
    kc[0] = *(const LAS bf16x8*)(kb + (ko ^ 96)); kc[1] = *(const LAS bf16x8*)(kb + (ko ^ 96) + 4096);
    ra = fmaxf(fmaxf(ra, pc1[12]), pc1[13]); ra = fmaxf(fmaxf(ra, pc1[14]), pc1[15]); ra = half_max(ra);
    const bool need = doCur && (ra > A.m + ATT_THR);
    float mn = need ? ra : A.m; const float fr = __builtin_amdgcn_exp2f(A.m - mn); ATT_PIN(mn);
    ATT_SB();
#define ATT_EXP4(P, c) do { _Pragma("unroll") for (int i_ = 0; i_ < 4; ++i_) P[4 * (c) + i_] = __builtin_amdgcn_exp2f(P[4 * (c) + i_] - mn); } while (0)
    pn0 = MFMA32(ka[0], qr[2], pn0);
    A.o0 = MFMA32(ATT_V0(vd), ATT_PA(2), A.o0);
    { ATT_EXP4(pc0, 0); ATT_EXP4(pc0, 1); pw[0].x = cvtpk(pc0[0], pc0[1]); pw[0].y = cvtpk(pc0[2], pc0[3]); pw[0].z = cvtpk(pc0[4], pc0[5]); pw[0].w = cvtpk(pc0[6], pc0[7]); ATT_PIN(pw[0]); }
    ATT_SB();
    pn1 = MFMA32(ka[1], qr[2], pn1);
    A.o1 = MFMA32(ATT_V1(vd), ATT_PA(2), A.o1);
    { ATT_EXP4(pc0, 2); ATT_EXP4(pc0, 3); pw[1].x = cvtpk(pc0[8], pc0[9]); pw[1].y = cvtpk(pc0[10], pc0[11]); pw[1].z = cvtpk(pc0[12], pc0[13]); pw[1].w = cvtpk(pc0[14], pc0[15]); ATT_PIN(pw[1]); }
    ATT_SB();
    pn0 = MFMA32(kc[0], qr[3], pn0);
    A.la = MFMA32(ones, ATT_PA(2), A.la); A.o0 = MFMA32(ATT_V0(ve), ATT_PA(3), A.o0);
    { ATT_EXP4(pc1, 0); ATT_EXP4(pc1, 1); pw[2].x = cvtpk(pc1[0], pc1[1]); pw[2].y = cvtpk(pc1[2], pc1[3]); pw[2].z = cvtpk(pc1[4], pc1[5]); pw[2].w = cvtpk(pc1[6], pc1[7]); ATT_PIN(pw[2]); }
    ATT_SB();
    pn1 = MFMA32(kc[1], qr[3], pn1);
    A.o1 = MFMA32(ATT_V1(ve), ATT_PA(3), A.o1); A.la = MFMA32(ones, ATT_PA(3), A.la);
    { ATT_EXP4(pc1, 2); ATT_EXP4(pc1, 3); pw[3].x = cvtpk(pc1[8], pc1[9]); pw[3].y = cvtpk(pc1[10], pc1[11]); pw[3].z = cvtpk(pc1[12], pc1[13]); pw[3].w = cvtpk(pc1[14], pc1[15]); ATT_PIN(pw[3]); }
    ATT_SB();
#undef ATT_EXP4
#undef ATT_VRD
#undef ATT_V0
#undef ATT_V1
#undef ATT_PA
#undef ATT_PIN
    Bn.mask(pn0, pn1, hi);
    if (__any(need)) {
        A.la[0] *= fr;
#pragma unroll
        for (int r = 0; r < 16; ++r) { A.o0[r] *= fr; A.o1[r] *= fr; }
    }
    A.m = mn;
    ATT_SB();
}

__device__ __forceinline__ void swap32(unsigned x, unsigned y, unsigned& r0, unsigned& r1) { auto rr = __builtin_amdgcn_permlane32_swap(x, y, false, false); r0 = rr[0]; r1 = rr[1]; }
__device__ __forceinline__ void store_o(bf16* op, const AttnAcc& A, float inv, int hi) {
#pragma unroll
    for (int p = 0; p < 2; ++p) {
#pragma unroll
        for (int s = 0; s < 2; ++s) { const f32x16& o = s ? A.o1 : A.o0; const int g0 = 2 * p, g1 = 2 * p + 1;
            const unsigned xa = cvtpk(o[4 * g0] * inv, o[4 * g0 + 1] * inv), xb = cvtpk(o[4 * g0 + 2] * inv, o[4 * g0 + 3] * inv), ya = cvtpk(o[4 * g1] * inv, o[4 * g1 + 1] * inv), yb = cvtpk(o[4 * g1 + 2] * inv, o[4 * g1 + 3] * inv);
            unsigned w0, w1, w2, w3; swap32(xa, ya, w0, w2); swap32(xb, yb, w1, w3); v4u w; w.x = w0; w.y = w1; w.z = w2; w.w = w3;
            *(GAS v4u*)(op + 32 * s + 16 * p + 8 * hi) = w; } }
}

__device__ __forceinline__ void store_o8(unsigned char* op, const AttnAcc& A, float inv, int hi) {
    const float sc = inv * OQ_SCALE;
#pragma unroll
    for (int p = 0; p < 2; ++p) {
#pragma unroll
        for (int s = 0; s < 2; ++s) { const f32x16& o = s ? A.o1 : A.o0; const int g0 = 2 * p, g1 = 2 * p + 1;
            const unsigned x = pk4_f8(o[4 * g0] * sc, o[4 * g0 + 1] * sc, o[4 * g0 + 2] * sc, o[4 * g0 + 3] * sc), y = pk4_f8(o[4 * g1] * sc, o[4 * g1 + 1] * sc, o[4 * g1 + 2] * sc, o[4 * g1 + 3] * sc);
            unsigned w0, w1; swap32(x, y, w0, w1); u32x2 w; w.x = w0; w.y = w1;
            *(GAS u32x2*)(op + 32 * s + 16 * p + 8 * hi) = w; } }
}

__device__ __forceinline__ int rel_bucket(int n) {
    if (n < 16) return n;
    int b = 16;
    b += (n >= 19); b += (n >= 21); b += (n >= 24); b += (n >= 27); b += (n >= 31); b += (n >= 35); b += (n >= 40); b += (n >= 46);
    b += (n >= 52); b += (n >= 59); b += (n >= 67); b += (n >= 77); b += (n >= 87); b += (n >= 99); b += (n >= 113);
    return b;
}
__device__ __forceinline__ void build_relb(const Ctx& C, const float* rel_bias, LAS float* relb) {
    for (int i = C.tid; i < H * 128; i += NTHR) { const int h = i >> 7, n = i & 127; relb[i] = rel_bias[rel_bucket(n) * H + h] * LOG2E; }
}
struct MobaBias {
    const LAS float* relb; int qpos, kpos0; bool lookup, causal; float cbias;
    __device__ __forceinline__ void init(f32x16& p0, f32x16& p1, int hi) const {
        if (lookup) {
            int dbase = qpos - kpos0 - 4 * hi; asm volatile("" : "+v"(dbase));
#pragma unroll
            for (int r = 0; r < 16; ++r) { const int d0 = dbase - ((r & 3) + 8 * (r >> 2)), d1 = d0 - 32;
                const int i0 = d0 < 0 ? 0 : (d0 > 127 ? 127 : d0), i1 = d1 < 0 ? 0 : (d1 > 127 ? 127 : d1);
                p0[r] = relb[i0]; p1[r] = relb[i1];
                if ((r & 3) == 3) __builtin_amdgcn_sched_barrier(0); }
        } else {
#pragma unroll
            for (int r = 0; r < 16; ++r) { p0[r] = cbias; p1[r] = cbias; }
        }
    }
    __device__ __forceinline__ void mask(f32x16& p0, f32x16& p1, int hi) const {
        if (causal) {
            int d = qpos - kpos0 - 4 * hi; asm volatile("" : "+v"(d));
#pragma unroll
            for (int r = 0; r < 16; ++r) { const int c = (r & 3) + 8 * (r >> 2); if (c > d) p0[r] = NEG_INF; if (c + 32 > d) p1[r] = NEG_INF; }
        }
    }
};
struct FoxBias {
    const LAS float* cb; int qrel, krel0; bool causal;
    __device__ __forceinline__ void init(f32x16& p0, f32x16& p1, int hi) const {
#pragma unroll
        for (int g = 0; g < 4; ++g) { const f32x4 c0 = *(const LAS f32x4*)(cb + 8 * g + 4 * hi), c1 = *(const LAS f32x4*)(cb + 32 + 8 * g + 4 * hi);
#pragma unroll
            for (int i = 0; i < 4; ++i) { p0[4 * g + i] = c0[i]; p1[4 * g + i] = c1[i]; } }
    }
    __device__ __forceinline__ void mask(f32x16& p0, f32x16& p1, int hi) const {
        if (causal) {
            int d = qrel - krel0 - 4 * hi; asm volatile("" : "+v"(d));
#pragma unroll
            for (int r = 0; r < 16; ++r) { const int c = (r & 3) + 8 * (r >> 2); if (c > d) p0[r] = NEG_INF; if (c + 32 > d) p1[r] = NEG_INF; }
        }
    }
};

__device__ __forceinline__ int mlist_off(int j) { return 256 * (31 * j - (j * (j - 1)) / 2); }
#define INS3(s_, j_) do { const float s__ = (s_); const int j__ = (j_); \
    if (s__ > sv0 || (s__ == sv0 && j__ < sel0)) { sv2 = sv1; sel2 = sel1; sv1 = sv0; sel1 = sel0; sv0 = s__; sel0 = j__; } \
    else if (s__ > sv1 || (s__ == sv1 && j__ < sel1)) { sv2 = sv1; sel2 = sel1; sv1 = s__; sel1 = j__; } \
    else if (s__ > sv2 || (s__ == sv2 && j__ < sel2)) { sv2 = s__; sel2 = j__; } } while (0)
__device__ __forceinline__ void ph_select(const Ctx& C, const bf16* Q, const float* ksum, unsigned* mcnt, unsigned* mlist) {
    LAS float* km = (LAS float*)C.lds;
    LAS unsigned* lcnt = (LAS unsigned*)(C.lds + 8192);
    const int lane = C.lane, wave = C.wave, r32 = lane & 31, hi = lane >> 5;
    for (int u = C.vcu; u < BATCH * H * 31; u += C.G) {
        const int bh = u / 31, own = 1 + u % 31, b = bh >> 4, h = bh & 15;
        __syncthreads();
        for (int i = C.tid; i < 32 * 64; i += NTHR) km[i] = ksum[(size_t)(b * NBLK + (i >> 6)) * D + h * 64 + (i & 63)];
        if (C.tid < 64) lcnt[C.tid] = 0u;
        bf16x8 qr[4]; load_q(qr, Q + (size_t)(b * SEQ + own * 256 + wave * 32 + r32) * D + h * 64, hi);
        __syncthreads();
        f32x16 sc; { float z = 0.f; asm volatile("" : "+v"(z));
#pragma unroll
        for (int r = 0; r < 16; ++r) sc[r] = z; }
#pragma unroll
        for (int d0 = 0; d0 < 4; ++d0) {
            const f32x4 x0 = *(const LAS f32x4*)(km + r32 * 64 + 16 * d0 + 8 * hi), x1 = *(const LAS f32x4*)(km + r32 * 64 + 16 * d0 + 8 * hi + 4);
            v4u wh, wl; wh.x = cvtpk(x0.x, x0.y); wh.y = cvtpk(x0.z, x0.w); wh.z = cvtpk(x1.x, x1.y); wh.w = cvtpk(x1.z, x1.w);
            wl.x = cvtpk(x0.x - bflo(wh.x), x0.y - bfhi(wh.x)); wl.y = cvtpk(x0.z - bflo(wh.y), x0.w - bfhi(wh.y)); wl.z = cvtpk(x1.x - bflo(wh.z), x1.y - bfhi(wh.z)); wl.w = cvtpk(x1.z - bflo(wh.w), x1.w - bfhi(wh.w));
            sc = MFMA32(__builtin_bit_cast(bf16x8, wh), qr[d0], sc); sc = MFMA32(__builtin_bit_cast(bf16x8, wl), qr[d0], sc);
        }
        float sv0 = NEG_INF, sv1 = NEG_INF, sv2 = NEG_INF; int sel0 = 64, sel1 = 64, sel2 = 64;
#pragma unroll
        for (int r = 0; r < 16; ++r) { const int j = (r & 3) + 8 * (r >> 2) + 4 * hi; if (j < own) INS3(sc[r], j); }
        {
            const float pv0 = __shfl_xor(sv0, 32), pv1 = __shfl_xor(sv1, 32), pv2 = __shfl_xor(sv2, 32);
            const int p0 = __shfl_xor(sel0, 32), p1 = __shfl_xor(sel1, 32), p2 = __shfl_xor(sel2, 32);
            if (p0 < 64) INS3(pv0, p0);
            if (p1 < 64) INS3(pv1, p1);
            if (p2 < 64) INS3(pv2, p2); }
        const int nv = own < 3 ? own : 3; int rk0 = 0, rk1 = 0, rk2 = 0;
        if (hi == 0) {
            rk0 = (int)__hip_atomic_fetch_add(&lcnt[sel0], 1u, __ATOMIC_RELAXED, __HIP_MEMORY_SCOPE_WORKGROUP);
            if (nv > 1) rk1 = (int)__hip_atomic_fetch_add(&lcnt[sel1], 1u, __ATOMIC_RELAXED, __HIP_MEMORY_SCOPE_WORKGROUP);
            if (nv > 2) rk2 = (int)__hip_atomic_fetch_add(&lcnt[sel2], 1u, __ATOMIC_RELAXED, __HIP_MEMORY_SCOPE_WORKGROUP);
        }
        __syncthreads();
        if (C.tid < 32) { const unsigned c = lcnt[C.tid]; if (c) lcnt[32 + C.tid] = __hip_atomic_fetch_add(mcnt + bh * 32 + C.tid, c, __ATOMIC_RELAXED, __HIP_MEMORY_SCOPE_AGENT); }
        __syncthreads();
        if (hi == 0) {
            unsigned* lst = mlist + (size_t)bh * MLIST_PER_BH; const unsigned tl = (unsigned)(own * 256 + wave * 32 + r32);
            lst[mlist_off(sel0) + lcnt[32 + sel0] + rk0] = tl;
            if (nv > 1) lst[mlist_off(sel1) + lcnt[32 + sel1] + rk1] = tl | (1u << 16);
            if (nv > 2) lst[mlist_off(sel2) + lcnt[32 + sel2] + rk2] = tl | (2u << 16);
        }
    }
}
constexpr int RELB_OFF = 131072;
constexpr int PRE_OFF = 139264;
constexpr int UINFO_OFF = 147456;
static_assert(PRE_OFF + 2080 * 4 <= LDSCTL_OFF && UINFO_OFF + 64 <= LDSCTL_OFF && 4 * 33280 <= UINFO_OFF, "attention LDS map");

__device__ __forceinline__ int part_next(int u, int uw, int usb, int per) { const int k = (u - usb) % per; return (k + 1 < uw) ? u + 1 : u - k + per; }
__device__ __forceinline__ void ph_moba_part(const Ctx& C, const bf16* Q, const bf16* K, const bf16* V, const float* rel_bias, const unsigned* mcnt, const unsigned* mlist, bf16* parto, float* partml, const int uw, const int usb, const int per) {
    if (C.wave >= 4) __builtin_amdgcn_s_setprio(1);
    LAS float* relb = (LAS float*)(C.lds + RELB_OFF);
    LAS int* pre = (LAS int*)(C.lds + PRE_OFF);
    const int lane = C.lane, wave = C.wave, r32 = lane & 31, hi = lane >> 5;
    __syncthreads();
    build_relb(C, rel_bias, relb);
    {   int v[4], s = 0;
#pragma unroll
        for (int i = 0; i < 4; ++i) { v[i] = (int)((__hip_atomic_load(mcnt + 4 * C.tid + i, __ATOMIC_RELAXED, __HIP_MEMORY_SCOPE_AGENT) + 255u) >> 8); s += v[i]; }
        int inc = s;
#pragma unroll
        for (int o = 1; o < 64; o <<= 1) { const int t = __shfl_up(inc, o); if (lane >= o) inc += t; }
        if (lane == 63) pre[2056 + wave] = inc;
        __syncthreads();
        int base = 0; for (int w = 0; w < wave; ++w) base += pre[2056 + w];
        const int ex = base + inc - s;
        pre[4 * C.tid] = ex; pre[4 * C.tid + 1] = ex + v[0]; pre[4 * C.tid + 2] = ex + v[0] + v[1]; pre[4 * C.tid + 3] = ex + v[0] + v[1] + v[2];
        if (C.tid == NTHR - 1) pre[2048] = ex + s;
        __syncthreads();
    }
    const int total = pre[2048];
    int u = usb, cur = 0, idx = 0;
    if (u < total) {
        int lo = 0, hi_ = 2048;
#pragma unroll
        for (int s = 0; s < 11; ++s) { const int mid = (lo + hi_) >> 1; if (pre[mid] <= u) lo = mid; else hi_ = mid; }
        idx = lo;
        const int bh = idx >> 5, j = idx & 31, b = bh >> 4, h = bh & 15;
        const bf16* Kg = K + (size_t)(b * SEQ + j * 256) * D + h * 64; const bf16* Vg = V + (size_t)(b * SEQ + j * 256) * D + h * 64;
#pragma unroll
        for (int t4 = 0; t4 < 4; ++t4) dma_tile(Kg + (size_t)t4 * 64 * D, Vg + (size_t)t4 * 64 * D, C.lds + t4 * 8192, C.lds + 32768 + t4 * 8192, wave, lane);
    }
    unsigned ent = 0u, ent_n = 0u; bool valid = false, valid_n = false;
    if (u < total) { const int bh = idx >> 5, j = idx & 31, chunk = u - pre[idx]; const int n = (int)__hip_atomic_load(mcnt + idx, __ATOMIC_RELAXED, __HIP_MEMORY_SCOPE_AGENT);
        const int i = chunk * 256 + wave * 32 + r32; valid = i < n; ent = mlist[(size_t)bh * MLIST_PER_BH + mlist_off(j) + (valid ? i : chunk * 256)]; }
    while (u < total) {
        const int bh = idx >> 5, j = idx & 31, b = bh >> 4, h = bh & 15;
        const int tl = (int)(ent & 0xffffu), slot = (int)(ent >> 16);
        bf16x8 qr[4]; load_q(qr, Q + (size_t)(b * SEQ + tl) * D + h * 64, hi);
        LAS unsigned char* Ks = C.lds + cur * 65536; LAS unsigned char* Vs = Ks + 32768;
        VM_WAIT(); __syncthreads();
        const int un = u + per; int nidx = 0;
        if (un < total) {
            int lo = 0, hi_ = 2048;
#pragma unroll
            for (int s = 0; s < 11; ++s) { const int mid = (lo + hi_) >> 1; if (pre[mid] <= un) lo = mid; else hi_ = mid; }
            nidx = lo;
            const int nbh = nidx >> 5, nj = nidx & 31, nb = nbh >> 4, nh = nbh & 15;
            const bf16* Kg = K + (size_t)(nb * SEQ + nj * 256) * D + nh * 64; const bf16* Vg = V + (size_t)(nb * SEQ + nj * 256) * D + nh * 64;
            LAS unsigned char* Kn = C.lds + (cur ^ 1) * 65536;
#pragma unroll
            for (int t4 = 0; t4 < 4; ++t4) dma_tile(Kg + (size_t)t4 * 64 * D, Vg + (size_t)t4 * 64 * D, Kn + t4 * 8192, Kn + 32768 + t4 * 8192, wave, lane);
            const int nchunk = un - pre[nidx], nn = (int)__hip_atomic_load(mcnt + nidx, __ATOMIC_RELAXED, __HIP_MEMORY_SCOPE_AGENT), ni = nchunk * 256 + wave * 32 + r32;
            valid_n = ni < nn; ent_n = mlist[(size_t)nbh * MLIST_PER_BH + mlist_off(nj) + (valid_n ? ni : nchunk * 256)];
        }
        AttnAcc A;
        const bool lk = __any((tl - (j * 256 + 255)) < 128) != 0;
        MobaBias B{relb + h * 128, tl, j * 256, lk, false, relb[h * 128 + 127]};
        f32x16 a0, a1, b0, b1;
        acc_init(A); B.kpos0 = j * 256;
        if (__any(valid)) {
        qk_tile(a0, a1, qr, Ks, r32, hi, B);
#pragma unroll 1
        for (int tp = 0; tp < 4; tp += 2) {
            B.kpos0 = j * 256 + 64 * (tp + 1); attn_step(A, a0, a1, b0, b1, qr, Ks + (tp + 1) * 8192, Vs + tp * 8192, r32, hi, lane, B, true);
            B.kpos0 = j * 256 + 64 * (tp + 2); attn_step(A, b0, b1, a0, a1, qr, Ks + ((tp + 2) & 3) * 8192, Vs + (tp + 1) * 8192, r32, hi, lane, B, tp == 0);
        }
        }
        const float lt = A.la[0], inv = 1.f / lt;
        if (valid) {
            const size_t rowi = ((size_t)(b * SEQ + tl) * H + h) * 3 + slot;
            store_o(parto + rowi * 64, A, inv, hi);
            if (hi == 0) *(GAS f32x2*)(partml + rowi * 2) = (f32x2){A.m, lt};
        }
        u = un; idx = nidx; cur ^= 1; ent = ent_n; valid = valid_n;
    }
    __builtin_amdgcn_s_setprio(0);
}
__device__ __forceinline__ void ph_moba_own(const Ctx& C, const bf16* Q, const bf16* K, const bf16* V, const float* rel_bias, const bf16* parto, const float* partml, unsigned char* O) {
    if (C.wave >= 4) __builtin_amdgcn_s_setprio(1);
    LAS float* relb = (LAS float*)(C.lds + RELB_OFF);
    const int lane = C.lane, wave = C.wave, r32 = lane & 31, hi = lane >> 5;
    __syncthreads();
    build_relb(C, rel_bias, relb);
    constexpr int NU = BATCH * H * NBLK;
    int u = C.vcu, cur = 0;
    if (u < NU) {
        const int bh = u >> 5, own = u & 31, b = bh >> 4, h = bh & 15;
        const bf16* Kg = K + (size_t)(b * SEQ + own * 256) * D + h * 64; const bf16* Vg = V + (size_t)(b * SEQ + own * 256) * D + h * 64;
#pragma unroll
        for (int t4 = 0; t4 < 4; ++t4) dma_tile(Kg + (size_t)t4 * 64 * D, Vg + (size_t)t4 * 64 * D, C.lds + t4 * 8192, C.lds + 32768 + t4 * 8192, wave, lane);
    }
    while (u < NU) {
        const int bh = u >> 5, own = u & 31, b = bh >> 4, h = bh & 15;
        const int qblk = wave < 4 ? wave : 11 - wave;
        const int tl = own * 256 + qblk * 32 + r32;
        bf16x8 qr[4]; load_q(qr, Q + (size_t)(b * SEQ + tl) * D + h * 64, hi);
        const int nv = own < 3 ? own : 3;
        const size_t rowi = ((size_t)(b * SEQ + tl) * H + h) * 3;
        LAS unsigned char* Ks = C.lds + cur * 65536; LAS unsigned char* Vs = Ks + 32768;
        VM_WAIT(); __syncthreads();
        const int un = u + C.G;
        if (un < NU) {
            const int nbh = un >> 5, nown = un & 31, nb = nbh >> 4, nh = nbh & 15;
            const bf16* Kg = K + (size_t)(nb * SEQ + nown * 256) * D + nh * 64; const bf16* Vg = V + (size_t)(nb * SEQ + nown * 256) * D + nh * 64;
            LAS unsigned char* Kn = C.lds + (cur ^ 1) * 65536;
#pragma unroll
            for (int t4 = 0; t4 < 4; ++t4) dma_tile(Kg + (size_t)t4 * 64 * D, Vg + (size_t)t4 * 64 * D, Kn + t4 * 8192, Kn + 32768 + t4 * 8192, wave, lane);
        }
        AttnAcc A; acc_init(A);
        const int tlast = qblk >> 1;
        MobaBias B{relb + h * 128, tl, own * 256, true, tlast == 0, 0.f};
        f32x16 a0, a1, b0, b1;
        qk_tile(a0, a1, qr, Ks, r32, hi, B);
#pragma unroll 1
        for (int tp = 0; tp < 4; tp += 2) {
            if (tp <= tlast) { B.kpos0 = own * 256 + 64 * (tp + 1); B.causal = (tp + 1 == tlast); attn_step(A, a0, a1, b0, b1, qr, Ks + (tp + 1) * 8192, Vs + tp * 8192, r32, hi, lane, B, tp + 1 <= tlast); }
            if (tp + 1 <= tlast) { B.kpos0 = own * 256 + 64 * (tp + 2); B.causal = (tp + 2 == tlast); attn_step(A, b0, b1, a0, a1, qr, Ks + ((tp + 2) & 3) * 8192, Vs + (tp + 1) * 8192, r32, hi, lane, B, tp + 2 <= tlast); }
        }
        const float lt = A.la[0];
        float mi[3], li[3];
#pragma unroll
        for (int i = 0; i < 3; ++i) { mi[i] = NEG_INF; li[i] = 0.f; if (i < nv) { const f32x2 ml = *(const GAS f32x2*)(partml + (rowi + i) * 2); mi[i] = ml.x; li[i] = ml.y; } }
        float M = A.m;
#pragma unroll
        for (int i = 0; i < 3; ++i) M = fmaxf(M, mi[i]);
        const float w0 = __builtin_amdgcn_exp2f(A.m - M); float den = w0 * lt;
#pragma unroll
        for (int r = 0; r < 16; ++r) { A.o0[r] *= w0; A.o1[r] *= w0; }
#pragma unroll
        for (int i = 0; i < 3; ++i) if (i < nv) {
            const float wi = li[i] * __builtin_amdgcn_exp2f(mi[i] - M); den += wi;
            const bf16* po = parto + (rowi + i) * 64;
#pragma unroll
            for (int p = 0; p < 2; ++p) {
                const v4u La = *(const GAS v4u*)(po + 16 * p + 8 * hi), Lc = *(const GAS v4u*)(po + 32 + 16 * p + 8 * hi);
                unsigned a0x, a1x, a0y, a1y, c0x, c1x, c0y, c1y;
                swap32(La.x, La.z, a0x, a1x); swap32(La.y, La.w, a0y, a1y); swap32(Lc.x, Lc.z, c0x, c1x); swap32(Lc.y, Lc.w, c0y, c1y);
                const int g0 = 2 * p, g1 = 2 * p + 1;
                A.o0[4 * g0] += wi * bflo(a0x); A.o0[4 * g0 + 1] += wi * bfhi(a0x); A.o0[4 * g0 + 2] += wi * bflo(a0y); A.o0[4 * g0 + 3] += wi * bfhi(a0y);
                A.o0[4 * g1] += wi * bflo(a1x); A.o0[4 * g1 + 1] += wi * bfhi(a1x); A.o0[4 * g1 + 2] += wi * bflo(a1y); A.o0[4 * g1 + 3] += wi * bfhi(a1y);
                A.o1[4 * g0] += wi * bflo(c0x); A.o1[4 * g0 + 1] += wi * bfhi(c0x); A.o1[4 * g0 + 2] += wi * bflo(c0y); A.o1[4 * g0 + 3] += wi * bfhi(c0y);
                A.o1[4 * g1] += wi * bflo(c1x); A.o1[4 * g1 + 1] += wi * bfhi(c1x); A.o1[4 * g1 + 2] += wi * bflo(c1y); A.o1[4 * g1 + 3] += wi * bfhi(c1y); }
        }
        store_o8(O + (size_t)(b * SEQ + tl) * D + h * 64, A, 1.f / den, hi);
        u = un; cur ^= 1;
    }
    __builtin_amdgcn_s_setprio(0);
}

__device__ __forceinline__ void ph_scan(const Ctx& C, const float* logf, float* ncum) {
    LAS float* wt = (LAS float*)C.lds;
    for (int bh = C.vcu; bh < BATCH * H; bh += C.G) {
        const int b = bh >> 4, h = bh & 15;
        float v[16], s = 0.f;
#pragma unroll
        for (int i = 0; i < 16; ++i) { v[i] = logf[(size_t)(b * SEQ + C.tid * 16 + i) * H + h]; s += v[i]; }
        float inc = s;
#pragma unroll
        for (int o = 1; o < 64; o <<= 1) { const float t = __shfl_up(inc, o); if (C.lane >= o) inc += t; }
        __syncthreads();
        if (C.lane == 63) wt[C.wave] = inc;
        __syncthreads();
        float run = inc - s; for (int w = 0; w < C.wave; ++w) run += wt[w];
#pragma unroll
        for (int i = 0; i < 16; ++i) { run += v[i]; ncum[(size_t)bh * SEQ + C.tid * 16 + i] = -run * LOG2E; }
    }
}
__device__ __forceinline__ void ph_fox(const Ctx& C, const bf16* Q, const bf16* K, const bf16* V, const float* ncum, const unsigned* norms, unsigned char* O, unsigned* qctr) {
    if (C.wave >= 4) __builtin_amdgcn_s_setprio(1);
    constexpr int GB = 33280;
    LAS int* uinfo = (LAS int*)(C.lds + UINFO_OFF);
    const int lane = C.lane, wave = C.wave, r32 = lane & 31, hi = lane >> 5;
    for (;;) {
        __syncthreads();
        if (C.tid == 0) { uinfo[0] = (int)__hip_atomic_fetch_add(qctr, 1u, __ATOMIC_RELAXED, __HIP_MEMORY_SCOPE_AGENT); uinfo[1] = 0; uinfo[2] = 0; uinfo[3] = -1; }
        __syncthreads();
        const int idx = uinfo[0];
        if (idx >= BATCH * H * NBLK) break;
        const int qb = 31 - (idx >> 6), bh = idx & 63, b = bh >> 4, h = bh & 15, NT = 4 * (qb + 1);
        const float* ng = ncum + (size_t)bh * SEQ; const float nref = ng[qb * 256];
        const int qblk = wave < 4 ? wave : 11 - wave;
        const int qrel = qblk * 32 + r32;
        bf16x8 qr[4]; load_q(qr, Q + (size_t)(b * SEQ + qb * 256 + qrel) * D + h * 64, hi);
        {   float q2 = 0.f;
#pragma unroll
            for (int d0 = 0; d0 < 4; ++d0)
#pragma unroll
                for (int i = 0; i < 8; ++i) { const float x = bf2f((unsigned)(unsigned short)qr[d0][i]); q2 += x * x; }
            q2 += __shfl_xor(q2, 32);
#pragma unroll
            for (int o = 1; o < 32; o <<= 1) q2 = fmaxf(q2, __shfl_xor(q2, o));
            if (lane == 0) (void)__hip_atomic_fetch_max((LAS unsigned*)&uinfo[2], __float_as_uint(q2), __ATOMIC_RELAXED, __HIP_MEMORY_SCOPE_WORKGROUP);
            bf16x8 kr[4]; load_q(kr, K + (size_t)(b * SEQ + qb * 256 + qrel) * D + h * 64, hi);
            float sq = 0.f;
#pragma unroll
            for (int d0 = 0; d0 < 4; ++d0)
#pragma unroll
                for (int i = 0; i < 8; ++i) sq += bf2f((unsigned)(unsigned short)qr[d0][i]) * bf2f((unsigned)(unsigned short)kr[d0][i]);
            sq += __shfl_xor(sq, 32);
#pragma unroll
            for (int o = 1; o < 32; o <<= 1) sq = fminf(sq, __shfl_xor(sq, o));
            if (lane == 0) (void)__hip_atomic_fetch_min((LAS unsigned*)&uinfo[3], sort_key(sq), __ATOMIC_RELAXED, __HIP_MEMORY_SCOPE_WORKGROUP); }
        __syncthreads();
        {   const float qn2 = __uint_as_float((unsigned)uinfo[2]), qa = __uint_as_float(norms[bh * 4 + 0]), qb2 = __uint_as_float(norms[bh * 4 + 1]), ka = __uint_as_float(norms[bh * 4 + 2]), kb2 = __uint_as_float(norms[bh * 4 + 3]);
            const unsigned mk = (unsigned)uinfo[3]; const float smin = __uint_as_float((mk & 0x80000000u) ? (mk ^ 0x80000000u) : ~mk) - 0.05f;
            const float smax = sqrtf(fminf(qn2, qa + qb2)) * sqrtf(ka + kb2) * 1.02f;
            const float thr = smax - fmaxf(smin, -smax) + 40.f;
            if (C.tid < 128) { const bool skip = (C.tid < NT) && (ng[(C.tid < NT ? C.tid : 0) * 64 + 63] - nref < -thr); const int c = __popcll(__ballot(skip)); if (lane == 0 && c) (void)__hip_atomic_fetch_add(&uinfo[1], c, __ATOMIC_RELAXED, __HIP_MEMORY_SCOPE_WORKGROUP); } }
        __syncthreads();
        const int t0 = uinfo[1], tf = t0 & ~1, g0 = t0 >> 1, NG = NT >> 1, tmax = 4 * qb + (qblk >> 1);
        const bf16* Kg = K + (size_t)(b * SEQ) * D + h * 64; const bf16* Vg = V + (size_t)(b * SEQ) * D + h * 64;
#define FOX_DMA(g) do { LAS unsigned char* sb_ = C.lds + ((g) & 3) * GB; \
            dma_tile(Kg + (size_t)(2 * (g)) * 64 * D, Vg + (size_t)(2 * (g)) * 64 * D, sb_, sb_ + 16384, wave, lane); \
            dma_tile(Kg + (size_t)(2 * (g) + 1) * 64 * D, Vg + (size_t)(2 * (g) + 1) * 64 * D, sb_ + 8192, sb_ + 24576, wave, lane); \
            if (wave < 2) glds4(ng + (2 * (g) + wave) * 64 + lane, lds_addr(sb_ + 32768 + wave * 256)); } while (0)
        FOX_DMA(g0);
        if (g0 + 1 < NG) FOX_DMA(g0 + 1);
        VM_WAIT(); __syncthreads();
        AttnAcc A; acc_init(A);
        f32x16 a0, a1, b0, b1; v4u wa[4], wb[4];
        FoxBias B{nullptr, qrel, 0, false};
#define FOX_SETB(t) do { const LAS unsigned char* sb_ = C.lds + (((t) >> 1) & 3) * GB; B.cb = (const LAS float*)(sb_ + 32768 + ((t) & 1) * 256); B.krel0 = (t) * 64 - qb * 256; B.causal = (t) >= 4 * qb; } while (0)
#define FOX_KS(t) (C.lds + (((t) >> 1) & 3) * GB + ((t) & 1) * 8192)
#define FOX_VS(t) (C.lds + (((t) >> 1) & 3) * GB + 16384 + ((t) & 1) * 8192)
#define FOX_STEP(C0, C1, N0, N1, WP, WN, t) do { FOX_SETB((t) + 1); \
            attn_step3(A, C0, C1, N0, N1, WP, WN, qr, FOX_KS((t) + 1), FOX_VS((t) > tf ? (t) - 1 : (t)), r32, hi, lane, B, (t) <= tmax); } while (0)
#pragma unroll
        for (int k_ = 0; k_ < 4; ++k_) { wa[k_] = (v4u){0u, 0u, 0u, 0u}; wb[k_] = (v4u){0u, 0u, 0u, 0u}; }
        if (tf <= tmax) { FOX_SETB(tf); qk_tile(a0, a1, qr, FOX_KS(tf), r32, hi, B); }
#pragma unroll 1
        for (int g = g0; g <= NG; ++g) {
            const int ta = 2 * g, tb = ta + 1;
            if (g + 2 < NG) FOX_DMA(g + 2);
            if (ta <= tmax + 1) FOX_STEP(a0, a1, b0, b1, wb, wa, ta);
            if (tb <= tmax + 1 && g < NG) FOX_STEP(b0, b1, a0, a1, wa, wb, tb);
            VM_WAIT(); __syncthreads();
        }
#undef FOX_DMA
#undef FOX_SETB
#undef FOX_KS
#undef FOX_VS
#undef FOX_STEP
        const float lt = A.la[0];
        store_o8(O + (size_t)(b * SEQ + qb * 256 + qrel) * D + h * 64, A, 1.f / lt, hi);
    }
    __builtin_amdgcn_s_setprio(0);
}
__device__ __forceinline__ void ln_stats(f32x4 (&v)[4], float& rstd) {
    float s = 0.f;
#pragma unroll
    for (int j = 0; j < 4; ++j) s += (v[j].x + v[j].y) + (v[j].z + v[j].w);
    const float mean = wave_sum(s) * (1.f / D); float s2 = 0.f;
#pragma unroll
    for (int j = 0; j < 4; ++j) { v[j] = v[j] - mean; s2 += (v[j].x * v[j].x + v[j].y * v[j].y) + (v[j].z * v[j].z + v[j].w * v[j].w); }
    rstd = 1.f / sqrtf(wave_sum(s2) * (1.f / D) + LN_EPS);
}
__device__ __forceinline__ void ph_ln1(const Ctx& C, const float* xin, const bf16* xin16, const bf16* y, const float* g, const float* bta, bf16* AR, unsigned char* xb8) {
    const int gw = C.vcu * NWAVES + C.wave, NGW = C.G * NWAVES, lane = C.lane;
    f32x4 gv[4], bv[4];
#pragma unroll
    for (int j = 0; j < 4; ++j) { gv[j] = *(const GAS f32x4*)(g + 4 * lane + 256 * j); bv[j] = *(const GAS f32x4*)(bta + 4 * lane + 256 * j); }
    u32x2 wn[4], zn16[4]; f32x4 zn32[4];
    {   const GAS u32x2* yr = (const GAS u32x2*)(y + (size_t)gw * D) + lane;
#pragma unroll
        for (int j = 0; j < 4; ++j) wn[j] = yr[64 * j];
        if (xin16) { const GAS u32x2* zr = (const GAS u32x2*)(xin16 + (size_t)gw * D) + lane;
#pragma unroll
            for (int j = 0; j < 4; ++j) zn16[j] = zr[64 * j];
        } else { const GAS f32x4* zr = (const GAS f32x4*)(xin + (size_t)gw * D) + lane;
#pragma unroll
            for (int j = 0; j < 4; ++j) zn32[j] = zr[64 * j]; } }
    for (int t = gw; t < T; t += NGW) {
        f32x4 v[4];
        const int tn = t + NGW < T ? t + NGW : t;
        const GAS u32x2* yr = (const GAS u32x2*)(y + (size_t)tn * D) + lane;
        if (xin16) { const GAS u32x2* zr = (const GAS u32x2*)(xin16 + (size_t)tn * D) + lane;
#pragma unroll
            for (int j = 0; j < 4; ++j) { const u32x2 w = wn[j], z = zn16[j]; v[j] = (f32x4){bflo(z.x), bfhi(z.x), bflo(z.y), bfhi(z.y)} * DN_ALPHA + (f32x4){bflo(w.x), bfhi(w.x), bflo(w.y), bfhi(w.y)}; }
#pragma unroll
            for (int j = 0; j < 4; ++j) { wn[j] = yr[64 * j]; zn16[j] = zr[64 * j]; }
        } else { const GAS f32x4* zr = (const GAS f32x4*)(xin + (size_t)tn * D) + lane;
#pragma unroll
            for (int j = 0; j < 4; ++j) { const u32x2 w = wn[j]; v[j] = zn32[j] * DN_ALPHA + (f32x4){bflo(w.x), bfhi(w.x), bflo(w.y), bfhi(w.y)}; }
#pragma unroll
            for (int j = 0; j < 4; ++j) { wn[j] = yr[64 * j]; zn32[j] = zr[64 * j]; } }
        float rstd; ln_stats(v, rstd);
#pragma unroll
        for (int j = 0; j < 4; ++j) {
            const f32x4 y = v[j] * rstd * gv[j] + bv[j]; const int d = 4 * lane + 256 * j;
            u32x2 hw; hw.x = cvtpk(y.x, y.y); hw.y = cvtpk(y.z, y.w);
            u32x2 lw; lw.x = cvtpk(y.x - bflo(hw.x), y.y - bfhi(hw.x)); lw.y = cvtpk(y.z - bflo(hw.y), y.w - bfhi(hw.y));
            *(GAS unsigned*)(xb8 + (size_t)t * D + d) = pk4_f8(y.x * XQ_SCALE, y.y * XQ_SCALE, y.z * XQ_SCALE, y.w * XQ_SCALE);
            *(GAS u32x2*)(AR + (size_t)t * 2048 + 512 + d) = hw;
            if (j < 2) *(GAS u32x2*)(AR + (size_t)t * 2048 + 1536 + d) = lw; else *(GAS u32x2*)(AR + (size_t)t * 2048 + (d - 512)) = lw;
        }
    }
}
__device__ __forceinline__ int below(unsigned long long mask) { return (int)__builtin_amdgcn_mbcnt_hi((unsigned)(mask >> 32), __builtin_amdgcn_mbcnt_lo((unsigned)mask, 0u)); }
__device__ __forceinline__ void ph_route(const Ctx& C, const float* logp, const float* rbias, int* topi, float* gate, unsigned* ecnt) {
    LAS unsigned* hist = (LAS unsigned*)C.lds;
    const int gw = C.vcu * NWAVES + C.wave, NGW = C.G * NWAVES, lane = C.lane;
    __syncthreads();
    if (C.tid < NE) hist[C.tid] = 0u;
    __syncthreads();
    const f32x4 rb = *(const GAS f32x4*)(rbias + 4 * lane);
    f32x4 an = *(const GAS f32x4*)(logp + (size_t)gw * NE + 4 * lane), bn = *(const GAS f32x4*)(logp + (size_t)(T + gw) * NE + 4 * lane);
    for (int t = gw; t < T; t += NGW) {
        const f32x4 a = an, b2 = bn;
        { const int tn = t + NGW < T ? t + NGW : t; an = *(const GAS f32x4*)(logp + (size_t)tn * NE + 4 * lane); bn = *(const GAS f32x4*)(logp + (size_t)(T + tn) * NE + 4 * lane); }
        float s[4], c[4];
#pragma unroll
        for (int i = 0; i < 4; ++i) { const float lg = a[i] + b2[i]; s[i] = 1.f / (1.f + __builtin_amdgcn_exp2f(-lg * LOG2E)); c[i] = s[i] + rb[i]; }
        float m1 = fmaxf(c[0], c[1]), m2 = fminf(c[0], c[1]);
        { const float x = c[2]; const float n1 = fmaxf(m1, x); m2 = fmaxf(m2, fminf(m1, x)); m1 = n1; }
        { const float x = c[3]; const float n1 = fmaxf(m1, x); m2 = fmaxf(m2, fminf(m1, x)); m1 = n1; }
#pragma unroll
        for (int o = 1; o < 8; o <<= 1) { const float o1 = __shfl_xor(m1, o), o2 = __shfl_xor(m2, o); const float n1 = fmaxf(m1, o1), n2 = fmaxf(fminf(m1, o1), fmaxf(m2, o2)); m1 = n1; m2 = n2; }
        const float gs = m1 + m2; const int mygrp = lane >> 3; int rk = 0;
#pragma unroll
        for (int g2 = 0; g2 < NGRP; ++g2) { const float og = __uint_as_float((unsigned)__builtin_amdgcn_readlane((int)__float_as_uint(gs), 8 * g2)); rk += (og > gs || (og == gs && g2 < mygrp)) ? 1 : 0; }
        unsigned k[4];
#pragma unroll
        for (int i = 0; i < 4; ++i) k[i] = rk < 4 ? sort_key(c[i]) : 0u;
        unsigned thr = 0u;
#pragma unroll 1
        for (int b = 31; b >= 0; --b) {
            const unsigned cand = thr | (1u << b);
            const int cnt = __popcll(__ballot(k[0] >= cand)) + __popcll(__ballot(k[1] >= cand)) + __popcll(__ballot(k[2] >= cand)) + __popcll(__ballot(k[3] >= cand));
            if (cnt >= TOPK) thr = cand;
        }
        unsigned long long gm[4], em[4]; int ngt = 0;
#pragma unroll
        for (int i = 0; i < 4; ++i) { gm[i] = __ballot(k[i] > thr); em[i] = __ballot(k[i] == thr); ngt += __popcll(gm[i]); }
        const int need = TOPK - ngt;
        int eqb = below(em[0]) + below(em[1]) + below(em[2]) + below(em[3]);
        bool sel[4];
#pragma unroll
        for (int i = 0; i < 4; ++i) { const bool eq = k[i] == thr; sel[i] = (k[i] > thr) || (eq && eqb < need); eqb += eq ? 1 : 0; }
        unsigned long long sm[4]; float wpart = 0.f;
#pragma unroll
        for (int i = 0; i < 4; ++i) { sm[i] = __ballot(sel[i]); wpart += sel[i] ? s[i] : 0.f; }
        const float wsum = wave_sum(wpart);
        int pos = below(sm[0]) + below(sm[1]) + below(sm[2]) + below(sm[3]);
#pragma unroll
        for (int i = 0; i < 4; ++i) if (sel[i]) { gate[(size_t)t * TOPK + pos] = s[i] / wsum * ROUTED_SCALE;
            const unsigned rk = __hip_atomic_fetch_add(&hist[4 * lane + i], 1u, __ATOMIC_RELAXED, __HIP_MEMORY_SCOPE_WORKGROUP);
            topi[(size_t)t * TOPK + pos] = (4 * lane + i) | (int)(rk << 8); ++pos; }
    }
    __syncthreads();
    if (C.tid < NE) { const unsigned c = hist[C.tid]; hist[NE + C.tid] = c ? __hip_atomic_fetch_add(ecnt + C.tid, c, __ATOMIC_RELAXED, __HIP_MEMORY_SCOPE_AGENT) : 0u; }
}
__device__ __forceinline__ void ph_scatter(const Ctx& C, const unsigned* ecnt, unsigned* ecur, const int* topi, const float* gate, const bf16* xb, int* slotof, int* tokof, float* gslot, bf16* HS) {
    build_tpre(C, ecnt);
    const LAS int* tpre = (const LAS int*)(C.lds + TPRE_OFF);
    const LAS unsigned* wgbase = (const LAS unsigned*)C.lds + NE;
    const int gw = C.vcu * NWAVES + C.wave, NGW = C.G * NWAVES;
    for (int n = C.lane >> 3; gw + n * NGW < T; n += 8) {
        const int t = gw + n * NGW;
        { const int i = t * TOPK + (C.lane & 7); const int v = topi[i], e = v & 255, rk = v >> 8;
            const int slot = tpre[e] * 256 + (int)wgbase[e] + rk; tokof[slot] = t; gslot[slot] = gate[i] * GS_FOLD; slotof[i] = slot; }
    }
    for (int e = C.vcu; e < NE; e += C.G) {
        const int cnt = (int)__hip_atomic_load(ecnt + e, __ATOMIC_RELAXED, __HIP_MEMORY_SCOPE_AGENT), s0 = tpre[e] * 256 + cnt, s1 = tpre[e + 1] * 256;
        for (int s = s0 + C.tid; s < s1; s += NTHR) { gslot[s] = 0.f; tokof[s] = 0; }
    }
}
__device__ __forceinline__ float log_sigmoid(float z) {
    const float e = __builtin_amdgcn_exp2f(-fabsf(z) * LOG2E);
    const float l1p = e < 0.015625f ? e * (1.f - e * (0.5f - e * 0.33333334f)) : __builtin_amdgcn_logf(1.f + e) * 0.6931471805599453f;
    return fminf(z, 0.f) - l1p;
}
__device__ __forceinline__ void ph_combine(const Ctx& C, const bf16* x1hi, const unsigned char* SO, const int* slotof, const float* g, const float* bta, bf16* xres, unsigned char* xb8, float* dout,
                                           const float* fox_in, const float* fox_bf, float* logf) {
    const int gw = C.vcu * NWAVES + C.wave, NGW = C.G * NWAVES, lane = C.lane;
    LAS float* wfT = (LAS float*)C.lds;
    __syncthreads();
    if (logf) { for (int i = C.tid; i < D * H; i += NTHR) { const int d = i >> 4, h = i & 15; wfT[h * D + d] = fox_in[(size_t)d * FOXW + 3 * D + h]; } }
    __syncthreads();
    f32x4 gv[4], bv[4];
#pragma unroll
    for (int j = 0; j < 4; ++j) { gv[j] = *(const GAS f32x4*)(g + 4 * lane + 256 * j); bv[j] = *(const GAS f32x4*)(bta + 4 * lane + 256 * j); }
    int sl_n = lane < TOPK ? slotof[(size_t)gw * TOPK + lane] : 0;
    for (int t = gw; t < T; t += NGW) {
        const GAS u32x2* zr = (const GAS u32x2*)(x1hi + (size_t)t * 2048 + 512) + lane;
        f32x4 v[4];
#pragma unroll
        for (int j = 0; j < 4; ++j) { const u32x2 z = zr[64 * j]; v[j] = (f32x4){bflo(z.x), bfhi(z.x), bflo(z.y), bfhi(z.y)} * DN_ALPHA; }
        const int sl = sl_n; { const int tn = t + NGW < T ? t + NGW : t; sl_n = lane < TOPK ? slotof[(size_t)tn * TOPK + lane] : 0; }
        f32x4 rs[4];
#pragma unroll
        for (int j = 0; j < 4; ++j) rs[j] = (f32x4){0.f, 0.f, 0.f, 0.f};
#pragma unroll
        for (int k = 0; k < TOPK; ++k) { const int sk = __builtin_amdgcn_readlane(sl, k); const unsigned char* row = SO + (size_t)sk * D + 4 * lane;
#pragma unroll
            for (int j = 0; j < 4; ++j) { const unsigned w = *(const GAS unsigned*)(row + 256 * j); const f32x2 lo2 = __builtin_amdgcn_cvt_pk_f32_fp8(w, false), hi2 = __builtin_amdgcn_cvt_pk_f32_fp8(w, true);
                rs[j].x += lo2.x; rs[j].y += lo2.y; rs[j].z += hi2.x; rs[j].w += hi2.y; } }
        {   const unsigned char* row = SO + (size_t)(NSLOT_MAX + t) * D + 4 * lane;
#pragma unroll
            for (int j = 0; j < 4; ++j) { const unsigned w = *(const GAS unsigned*)(row + 256 * j); const f32x2 lo2 = __builtin_amdgcn_cvt_pk_f32_fp8(w, false), hi2 = __builtin_amdgcn_cvt_pk_f32_fp8(w, true);
                rs[j].x += lo2.x; rs[j].y += lo2.y; rs[j].z += hi2.x; rs[j].w += hi2.y; } }
#pragma unroll
        for (int j = 0; j < 4; ++j) v[j] = v[j] + rs[j] * SO_INV;
        float rstd; ln_stats(v, rstd);
        f32x4 y[4];
#pragma unroll
        for (int j = 0; j < 4; ++j) {
            y[j] = v[j] * rstd * gv[j] + bv[j]; const int d = 4 * lane + 256 * j;
            if (dout) *(GAS f32x4*)(dout + (size_t)t * D + d) = y[j];
            else { u32x2 hw; hw.x = cvtpk(y[j].x, y[j].y); hw.y = cvtpk(y[j].z, y[j].w); *(GAS u32x2*)(xres + (size_t)t * D + d) = hw;
                *(GAS unsigned*)(xb8 + (size_t)t * D + d) = pk4_f8(y[j].x * XQ_SCALE, y[j].y * XQ_SCALE, y[j].z * XQ_SCALE, y[j].w * XQ_SCALE); }
        }
        if (logf) {
            float acc[16];
#pragma unroll
            for (int h = 0; h < 16; ++h) { float a = 0.f;
#pragma unroll
                for (int j = 0; j < 4; ++j) { const f32x4 w = *(const LAS f32x4*)(wfT + h * D + 4 * lane + 256 * j); a += y[j].x * w.x; a += y[j].y * w.y; a += y[j].z * w.z; a += y[j].w * w.w; }
                acc[h] = a; }
            float a8[8], a4[4], a2[2], a1;
            { const bool bit = (lane >> 5) & 1;
#pragma unroll
              for (int i = 0; i < 8; ++i) { const float send = bit ? acc[i] : acc[i + 8]; const float recv = __shfl_xor(send, 32); a8[i] = (bit ? acc[i + 8] : acc[i]) + recv; } }
            { const bool bit = (lane >> 4) & 1;
#pragma unroll
              for (int i = 0; i < 4; ++i) { const float send = bit ? a8[i] : a8[i + 4]; const float recv = __shfl_xor(send, 16); a4[i] = (bit ? a8[i + 4] : a8[i]) + recv; } }
            { const bool bit = (lane >> 3) & 1;
#pragma unroll
              for (int i = 0; i < 2; ++i) { const float send = bit ? a4[i] : a4[i + 2]; const float recv = __shfl_xor(send, 8); a2[i] = (bit ? a4[i + 2] : a4[i]) + recv; } }
            { const bool bit = (lane >> 2) & 1; const float send = bit ? a2[0] : a2[1]; const float recv = __shfl_xor(send, 4); a1 = (bit ? a2[1] : a2[0]) + recv; }
            a1 += __shfl_xor(a1, 2); a1 += __shfl_xor(a1, 1);
            const int hh = ((lane >> 5) & 1) * 8 + ((lane >> 4) & 1) * 4 + ((lane >> 3) & 1) * 2 + ((lane >> 2) & 1);
            if ((lane & 3) == 0) logf[(size_t)t * H + hh] = log_sigmoid(a1 + fox_bf[hh]);
        }
    }
}
#ifndef MK_MULTI
#define MK_MULTI 0
#endif
constexpr int NPH = 27;
struct Args { const float* in[19]; float* out; unsigned char* ws; int ph_lo, ph_hi; };

__global__ void __launch_bounds__(NTHR, 2) mk_fwd(Args args) {
    extern __shared__ __attribute__((aligned(16))) unsigned char lds_raw[];
    Ctx C;
    C.lds = (LAS unsigned char*)lds_raw;
    C.tid = threadIdx.x; C.lane = C.tid & 63; C.wave = __builtin_amdgcn_readfirstlane(C.tid >> 6);
    C.G = gridDim.x; { const int bx = blockIdx.x; C.vcu = (C.G % 8 == 0) ? (bx % 8) * (C.G / 8) + bx / 8 : bx; }
    LAS unsigned long long* PTAB = (LAS unsigned long long*)(C.lds + PTAB_OFF);
    if (C.tid == 0) {
#pragma unroll
        for (int i = 0; i < 19; ++i) PTAB[i] = (unsigned long long)(uintptr_t)args.in[i];
        PTAB[19] = (unsigned long long)(uintptr_t)args.out; PTAB[20] = (unsigned long long)(uintptr_t)args.ws;
    }
    for (int u = C.tid; u < (PTAB_OFF - LDSCTL_OFF) / 4; u += NTHR) ((LAS unsigned*)(C.lds + LDSCTL_OFF))[u] = 0u;
    __syncthreads();
#define PIN(i) ((const float*)ldptr(PTAB, (i)))
#define WSP() ((unsigned char*)ldptr(PTAB, 20))
    XcdBarrier bar; bar.bar = (unsigned*)(args.ws + WS_CTL) + CW_BAR; bar.x = 0; bar.st = nullptr;
    if (!MK_MULTI) bar = xcd_barrier_post((unsigned*)(args.ws + WS_CTL) + CW_BAR, (volatile LAS unsigned*)(C.lds + MISC_OFF) + 8);
    const int lo = args.ph_lo, hi = args.ph_hi;
#ifndef MK_PH_MASK
#define MK_PH_MASK 0xFFFFFFFFu
#endif
#define PHON(b) (((MK_PH_MASK) >> (b)) & 1u)
#ifndef MK_DUP_MASK
#define MK_DUP_MASK 0u
#endif
#define NREP(b) ((((MK_DUP_MASK) >> (b)) & 1u) ? 2 : 1)
#define REP(b) _Pragma("unroll 1") for (int rep_ = 0; rep_ < NREP(b); ++rep_)
#define IN(k) (lo <= (k) && (k) < hi)
#define SEAM(k) do { if ((k) + 1 < hi) { asm volatile("" : "+s"(bar.bar)); xcd_barrier(bar); if (NREP(23) == 2) xcd_barrier(bar); } } while (0)
#define OPAQ(v) asm volatile("" : "+s"(v))
#define LC() do { int l_; asm volatile("v_mbcnt_lo_u32_b32 %0, -1, 0\n\tv_mbcnt_hi_u32_b32 %0, -1, %0" : "=v"(l_)); C.lane = l_; C.tid = C.wave * 64 + l_; } while (0)

    if (PHON(0) && IN(0)) { LC();
        unsigned char* ws = WSP();
        SmallW W{PIN(2), PIN(3), PIN(4), PIN(6), PIN(11), PIN(16), PIN(17), PIN(18),
                 ws + WS_WMI, ws + WS_WFI, ws + WS_WMO, ws + WS_WFO, ws + WS_WSGU, ws + WS_WSDN, (bf16*)(ws + WS_WR)};
        REP(21) conv_small(C, W);
        REP(22) to_f8_rows(C, PIN(0), ws + WS_XB8);
        __syncthreads();
        REP(0) conv_experts(C, PIN(13), PIN(14), PIN(15), 0, ws + WS_WEGU, ws + WS_WEDN, C.vcu, C.G);
        SEAM(0);
    }
#pragma unroll 1
    for (int l = 0; l < 2; ++l) {
        const int pb = 1 + 13 * l;
        if (PHON(1) && IN(pb + 0)) { LC();
            unsigned char* ws = WSP();
            if (PHON(15) && l == 1) ph_scan(C, (const float*)(ws + WS_LOGF), (float*)(ws + WS_CUM));
            REP(1) {
            __syncthreads();
            int kk = D / 2; OPAQ(kk);
            pg8::Gemm g{(const bf16*)(ws + WS_XB8), (const bf16*)(ws + (l == 0 ? WS_WMI : WS_WFI)), T, 3 * D, kk}; pg8::StaticOrder S; S.init(T, 3 * D, C.G, (int)blockIdx.x);
            EpiQKV E{(bf16*)(ws + WS_Q), (size_t)(WS_K - WS_Q) / 2, C2, (unsigned*)(ws + WS_CTL) + CW_NORM + l * 256, l == 0 ? (float*)(ws + WS_CTL) + CW_KSUM : nullptr};
            pg8::gemm_phase<EpiQKV, pg8::StaticOrder, true, true, false, true>(C.lds, g, S, E, C.tid);
            }
            SEAM(pb + 0);
        }
        if (l == 0) {
            if (PHON(3) && IN(pb + 2)) { LC(); unsigned char* ws = WSP(); REP(3) ph_select(C, (const bf16*)(ws + WS_Q), (const float*)(ws + WS_CTL) + CW_KSUM, (unsigned*)(ws + WS_CTL) + (rep_ ? 133120 : CW_MCNT), (unsigned*)(ws + (rep_ ? WS_PARTO : WS_MLIST))); SEAM(pb + 2); }
            if (PHON(4) && IN(pb + 3)) { LC(); unsigned char* ws = WSP();
                const int uw = 1, usb = C.vcu, per = C.G;
                REP(4) ph_moba_part(C, (const bf16*)(ws + WS_Q), (const bf16*)(ws + WS_K), (const bf16*)(ws + WS_V), PIN(1), (const unsigned*)(ws + WS_CTL) + CW_MCNT, (const unsigned*)(ws + WS_MLIST), (bf16*)(ws + WS_PARTO), (float*)(ws + WS_PARTML), uw, usb, per); SEAM(pb + 3); }
            if (PHON(5) && IN(pb + 4)) { LC(); unsigned char* ws = WSP(); REP(5) ph_moba_own(C, (const bf16*)(ws + WS_Q), (const bf16*)(ws + WS_K), (const bf16*)(ws + WS_V), PIN(1), (const bf16*)(ws + WS_PARTO), (const float*)(ws + WS_PARTML), ws + WS_O); SEAM(pb + 4); }
        } else {
            if (PHON(6) && IN(pb + 4)) { LC(); unsigned char* ws = WSP();
                REP(6) ph_fox(C, (const bf16*)(ws + WS_Q), (const bf16*)(ws + WS_K), (const bf16*)(ws + WS_V), (const float*)(ws + WS_CUM), (const unsigned*)(ws + WS_CTL) + CW_NORM + 256, ws + WS_O, (unsigned*)(ws + WS_CTL) + CW_FOXQ + rep_ * 64); SEAM(pb + 4); }
        }
        if (PHON(7) && IN(pb + 5)) { LC();
            unsigned char* ws = WSP();
            REP(7) {
            __syncthreads();
            int kk = D / 2; OPAQ(kk);
            pg8::Gemm g{(const bf16*)(ws + WS_O), (const bf16*)(ws + (l == 0 ? WS_WMO : WS_WFO)), T, D, kk}; PlainOrder<4> S{C.vcu, C.G, (T / 256) * 4};
            pg8::EpiBf16<0> E{(bf16*)(ws + WS_Z), D, nullptr, D, 0, 1.f / (OQ_SCALE * WQ_SCALE)};
            pg8::gemm_phase<pg8::EpiBf16<0>, PlainOrder<4>, true, true, false, true>(C.lds, g, S, E, C.tid);
            }
            SEAM(pb + 5);
        }
        if (PHON(8) && IN(pb + 6)) { LC(); unsigned char* ws = WSP(); REP(8) ph_ln1(C, PIN(0), l == 0 ? nullptr : (const bf16*)(ws + WS_XRES), (const bf16*)(ws + WS_Z), PIN(7) + l * D, PIN(8) + l * D, (bf16*)(ws + WS_AR), ws + WS_XB8); SEAM(pb + 6); }
        if (PHON(9) && IN(pb + 7)) { LC();
            __syncthreads();
            REP(16) if (PHON(16)) { __syncthreads(); unsigned char* ws = WSP(); int kk = 1536; OPAQ(kk);
              pg8::Gemm g{(const bf16*)(ws + WS_AR), (const bf16*)(ws + WS_WR) + (size_t)l * (512 * 1536), 2 * T, 512, kk, nullptr, 2048}; RouterOrder S{C.vcu, C.G}; EpiF32<true> E{(float*)(ws + WS_LOGP), nullptr, NE, 0.f};
              pg8::gemm_phase<EpiF32<true>, RouterOrder, true, true>(C.lds, g, S, E, C.tid); }
            __syncthreads();
            REP(17) if (PHON(17)) { __syncthreads(); unsigned char* ws = WSP(); int kk = D / 2; OPAQ(kk);
              pg8::Gemm g{(const bf16*)(ws + WS_XB8), (const bf16*)(ws + WS_WSGU + (size_t)l * (512 * 1024)), T, 512, kk}; PlainOrder<2> S{C.vcu, C.G, (T / 256) * 2}; EpiSwiGLU<true> E{ws + WS_ACTSH, nullptr};
              pg8::gemm_phase<EpiSwiGLU<true>, PlainOrder<2>, true, true, false, true>(C.lds, g, S, E, C.tid); }
            SEAM(pb + 7);
        }
        if (PHON(10) && IN(pb + 8)) { LC(); unsigned char* ws = WSP(); REP(10) ph_route(C, (const float*)(ws + WS_LOGP), PIN(12) + l * NE, (int*)(ws + WS_TOPI), (float*)(ws + WS_GATE), (unsigned*)(ws + WS_CTL) + (rep_ ? 131072 : CW_ECNT) + l * NE); SEAM(pb + 8); }
        if (PHON(11) && IN(pb + 9)) { LC(); unsigned char* ws = WSP(); REP(11) { if (rep_) xcd_barrier(bar); ph_scatter(C, (const unsigned*)(ws + WS_CTL) + CW_ECNT + l * NE, (unsigned*)(ws + WS_CTL) + (rep_ ? 132096 : CW_ECUR) + l * NE, (const int*)(ws + WS_TOPI), (const float*)(ws + WS_GATE), (const bf16*)(ws + WS_XB8),
                                                                            (int*)(ws + WS_SLOTOF), (int*)(ws + WS_TOKOF), (float*)(ws + WS_GSLOT), (bf16*)(ws + WS_HS)); } SEAM(pb + 9); }
        if (PHON(12) && IN(pb + 10)) { LC();
            unsigned char* ws = WSP();
            build_tpre(C, (const unsigned*)(ws + WS_CTL) + CW_ECNT + l * NE);
            REP(12) {
            __syncthreads();
            int kk = D / 2; OPAQ(kk);
            pg8::Gemm g{(const bf16*)(ws + WS_XB8), (const bf16*)(ws + WS_WEGU), NSLOT_MAX, NE * 512, kk, (const int*)(ws + WS_TOKOF)}; ExpertOrder<1> S{C.vcu, C.G, (const LAS int*)(C.lds + TPRE_OFF)}; EpiSwiGLU<true> E{ws + WS_ACT, (const float*)(ws + WS_GSLOT)};
            pg8::gemm_phase<EpiSwiGLU<true>, ExpertOrder<1>, true, true, true, true>(C.lds, g, S, E, C.tid);
            }
            SEAM(pb + 10);
        }
        if (PHON(13) && IN(pb + 11)) { LC();
            { unsigned char* ws = WSP(); build_tpre(C, (const unsigned*)(ws + WS_CTL) + CW_ECNT + l * NE); }
            REP(18) if (PHON(18)) { __syncthreads(); unsigned char* ws = WSP(); int kk = DE / 2; OPAQ(kk);
              pg8::Gemm g{(const bf16*)(ws + WS_ACT), (const bf16*)(ws + WS_WEDN), NSLOT_MAX, NE * 1024, kk}; ExpertOrder<2> S{C.vcu, C.G, (const LAS int*)(C.lds + TPRE_OFF)}; EpiDown<true> E{(unsigned char*)(ws + WS_HS)};
              pg8::gemm_phase<EpiDown<true>, ExpertOrder<2>, true, true, false, true>(C.lds, g, S, E, C.tid); }
            __syncthreads();
            REP(19) if (PHON(19)) { __syncthreads(); unsigned char* ws = WSP(); int kk = DE / 2; OPAQ(kk);
              pg8::Gemm g{(const bf16*)(ws + WS_ACTSH), (const bf16*)(ws + WS_WSDN + (size_t)l * (1024 * 256)), T, D, kk}; PlainOrder<4> S{C.vcu, C.G, (T / 256) * 4}; EpiDown<true> E{(unsigned char*)(ws + WS_HS) + (size_t)NSLOT_MAX * 1024};
              pg8::gemm_phase<EpiDown<true>, PlainOrder<4>, true, true, false, true>(C.lds, g, S, E, C.tid); }
            SEAM(pb + 11);
        }
        if (PHON(14) && IN(pb + 12)) { LC();
            REP(14) { unsigned char* ws = WSP();
              ph_combine(C, (const bf16*)(ws + WS_AR), (const unsigned char*)(ws + WS_HS), (const int*)(ws + WS_SLOTOF), PIN(9) + l * D, PIN(10) + l * D, (bf16*)(ws + WS_XRES), ws + WS_XB8, l == 1 ? (float*)ldptr(PTAB, 19) : nullptr,
                         PIN(4), PIN(5), l == 0 ? (float*)(ws + WS_LOGF) : nullptr); }
            if (l == 0) { unsigned char* ws = WSP(); __syncthreads(); conv_experts(C, PIN(13), PIN(14), PIN(15), 1, ws + WS_WEGU, ws + WS_WEDN, C.vcu, C.G); }
            SEAM(pb + 12);
        }
    }
#undef IN
#undef SEAM
#undef PIN
#undef WSP
#undef OPAQ
#undef REP
#undef NREP
}
}

extern "C" void kernel_launch(void* const* d_in, const int* in_sizes, int n_in, void* d_out, int out_size, void* d_ws, size_t ws_size, hipStream_t stream) {
    using namespace mk;
    static int grid = 0;
    if (grid == 0) {
        if (n_in != 19 || in_sizes[0] != T * D || out_size != T * D || ws_size < WS_END) { fprintf(stderr, "kernel_launch: unexpected problem shape (n_in %d, in0 %d, out %d, ws %zu < %zu)\n", n_in, n_in > 0 ? in_sizes[0] : -1, out_size, ws_size, (size_t)WS_END); grid = -1; return; }
        int dev = 0, cus = 0, per_cu = 0;
        if (hipGetDevice(&dev) != hipSuccess || hipDeviceGetAttribute(&cus, hipDeviceAttributeMultiprocessorCount, dev) != hipSuccess) { grid = -1; return; }
        if (hipFuncSetAttribute((const void*)mk_fwd, hipFuncAttributeMaxDynamicSharedMemorySize, LDS_BYTES) != hipSuccess) { fprintf(stderr, "kernel_launch: hipFuncSetAttribute failed\n"); grid = -1; return; }
        if (hipOccupancyMaxActiveBlocksPerMultiprocessor(&per_cu, (const void*)mk_fwd, NTHR, LDS_BYTES) != hipSuccess || per_cu < 1) fprintf(stderr, "kernel_launch: occupancy query reports %d\n", per_cu);
        (void)hipGetLastError();
        grid = cus;
    }
    if (grid < 0) return;
    if (hipMemsetAsync((char*)d_ws + WS_CTL, 0, CTL_ZERO_BYTES, stream) != hipSuccess) return;
    Args a{};
    for (int i = 0; i < 19; ++i) a.in[i] = (const float*)d_in[i];
    a.out = (float*)d_out; a.ws = (unsigned char*)d_ws;
#if MK_MULTI
    for (int p = 0; p < NPH; ++p) {
        if (p == 2 || (p >= 15 && p <= 17)) continue;
        a.ph_lo = p; a.ph_hi = p + 1;
        hipLaunchKernelGGL(mk_fwd, dim3(grid), dim3(NTHR), LDS_BYTES, stream, a);
    }
#else
    a.ph_lo = 0; a.ph_hi = NPH;
    hipLaunchKernelGGL(mk_fwd, dim3(grid), dim3(NTHR), LDS_BYTES, stream, a);
#endif
    const hipError_t le = hipPeekAtLastError();
    if (le != hipSuccess) fprintf(stderr, "kernel_launch: launch failed: %s\n", hipGetErrorName(le));
}
```
